# Optimizing an MI355X kernel written in HIP

```python
import jax, jax.numpy as jnp
from jax import lax
import numpy as np

D_MODEL = 1024
BATCH = 8
SEQ = 4096
DEPTH = 1

HEAD_DIM = 64
SB_HEADS = 6
NSA_HEADS = 6
NSA_KV_GROUPS = 2
NSA_GROUP = NSA_HEADS // NSA_KV_GROUPS
MEM_HEADS = 4
MEM_TOKENS = 256
N_BRANCHES = 3
SB_W = SB_HEADS * HEAD_DIM
NSA_W = NSA_HEADS * HEAD_DIM
NSA_KV_W = NSA_KV_GROUPS * HEAD_DIM
MEM_W = MEM_HEADS * HEAD_DIM
IN_WIDTHS = (SB_W, SB_W, SB_W, NSA_W, 6 * NSA_KV_W, NSA_HEADS * 3, MEM_W, N_BRANCHES * D_MODEL)
IN_DIM = sum(IN_WIDTHS)
SB_Q_BLOCK = 128
NSA_Q_BLOCK = 64
CMP_LEN = 32
CMP_STRIDE = 16
SEL_BLOCK = 64
N_SELECT = 16
WINDOW = 512
FORCED_SCORE = 1e4
PEER_HEADS = 8
PEER_N_KEYS = 128
PEER_N_EXPERTS = PEER_N_KEYS * PEER_N_KEYS
PEER_QUERY_DIM = 256
PEER_TOPK = 16
PEER_T_BLOCK = 32
RMS_EPS = 1e-6
NEG_INF = -1e30

kernel_name = 'hybrid_sb_nsa_mem_peer_block'


def rmsnorm(x, g):
    xf = x.astype(jnp.float32)
    y = xf * lax.rsqrt(jnp.mean(xf * xf, axis=-1, keepdims=True) + RMS_EPS)
    return (y * g.astype(jnp.float32)).astype(x.dtype)


def alibi_slopes(n):
    return jnp.asarray([2.0 ** (-8.0 * (h + 1) / n) for h in range(n)], dtype=jnp.float32)


def split_offsets():
    return [int(o) for o in np.cumsum(IN_WIDTHS)[:-1]]


def stick_breaking_attention(q, k, v):
    B, H, T, dh = q.shape
    nblk = T // SB_Q_BLOCK
    scale = dh ** -0.5
    qb = q.reshape(B, H, nblk, SB_Q_BLOCK, dh).transpose(2, 0, 1, 3, 4)
    kpos = jnp.arange(T)

    def block(args):
        i, qi = args
        qpos = i * SB_Q_BLOCK + jnp.arange(SB_Q_BLOCK)
        z = jnp.einsum('bhqd,bhkd->bhqk', qi, k).astype(jnp.float32) * scale
        before = kpos[None, :] < qpos[:, None]
        log_keep = jnp.where(before, jax.nn.log_sigmoid(-z), 0.0)
        rev = lax.cumsum(log_keep, axis=3, reverse=True)
        excl = jnp.concatenate([rev[..., 1:], jnp.zeros_like(rev[..., :1])], axis=-1)
        a = jnp.where(before, jnp.exp(jax.nn.log_sigmoid(z) + excl), 0.0)
        return jnp.einsum('bhqk,bhkd->bhqd', a.astype(v.dtype), v)

    out = lax.map(block, (jnp.arange(nblk), qb))
    return out.transpose(1, 0, 3, 2, 4).reshape(B, T, H * dh)


def nsa_attention(q, k_cmp, v_cmp, k_slc, v_slc, k_win, v_win, gates, pe_k, pe_v, w_cmp_k, w_cmp_v, slopes):
    B, T, _, dh = q.shape
    G, R = NSA_KV_GROUPS, NSA_GROUP
    scale = dh ** -0.5

    def compress(z, pe, w):
        chunks = z.reshape(B, T // CMP_STRIDE, CMP_STRIDE, G, dh)
        blocks = jnp.concatenate([chunks[:, :-1], chunks[:, 1:]], axis=2)
        blocks = blocks + pe[None, None, :, None, :]
        return jnp.einsum('bnlgd,lde->bgne', blocks, w)

    kc = compress(k_cmp, pe_k, w_cmp_k)
    vc = compress(v_cmp, pe_v, w_cmp_v)
    n_cmp = T // CMP_STRIDE - 1
    cmp_end = jnp.arange(n_cmp) * CMP_STRIDE + CMP_LEN - 1
    n_blk = T // SEL_BLOCK
    n_sel = min(N_SELECT, n_blk)
    ks = k_slc.reshape(B, n_blk, SEL_BLOCK, G, dh).transpose(0, 3, 1, 2, 4)
    vs = v_slc.reshape(B, n_blk, SEL_BLOCK, G, dh).transpose(0, 3, 1, 2, 4)
    kw = jnp.pad(k_win, ((0, 0), (WINDOW, 0), (0, 0), (0, 0))).transpose(0, 2, 1, 3)
    vw = jnp.pad(v_win, ((0, 0), (WINDOW, 0), (0, 0), (0, 0))).transpose(0, 2, 1, 3)
    nq = T // NSA_Q_BLOCK
    qg = q.reshape(B, nq, NSA_Q_BLOCK, G, R, dh).transpose(1, 0, 3, 4, 2, 5)
    gb = gates.reshape(B, nq, NSA_Q_BLOCK, G, R, 3).transpose(1, 0, 3, 4, 2, 5)
    slope = slopes.reshape(G, R)[None, :, :, None, None]
    b_idx = jnp.arange(B)[:, None, None, None]
    g_idx = jnp.arange(G)[None, :, None, None]
    blk = jnp.arange(n_blk)
    offs = jnp.arange(SEL_BLOCK)

    def block(args):
        i, qi, gi = args
        t = i * NSA_Q_BLOCK + jnp.arange(NSA_Q_BLOCK)
        s_c = jnp.einsum('bgrqd,bgnd->bgrqn', qi, kc).astype(jnp.float32) * scale
        dist_c = (t[:, None] - cmp_end[None, :]).astype(jnp.float32)
        valid_c = dist_c >= 0
        s_c = jnp.where(valid_c, s_c - slope * dist_c, NEG_INF)
        p_c = jax.nn.softmax(s_c, axis=-1)
        p_c = jnp.where(valid_c.any(-1)[:, None], p_c, 0.0)
        o_c = jnp.einsum('bgrqn,bgnd->bgrqd', p_c.astype(vc.dtype), vc)
        imp = jnp.pad(p_c.sum(axis=2), ((0, 0), (0, 0), (0, 0), (0, 1)))
        imp = imp.reshape(B, G, NSA_Q_BLOCK, n_blk, SEL_BLOCK // CMP_STRIDE).sum(-1)
        cur = t // SEL_BLOCK
        forced = (blk[None, :] == 0) | (blk[None, :] == cur[:, None]) | (blk[None, :] == cur[:, None] - 1)
        imp = jnp.where(forced, FORCED_SCORE, jnp.where(blk[None, :] <= cur[:, None], imp, -1.0))
        _, idx = lax.top_k(imp, n_sel)
        k_g = ks[b_idx, g_idx, idx]
        v_g = vs[b_idx, g_idx, idx]
        pos = idx[..., None] * SEL_BLOCK + offs
        s_s = jnp.einsum('bgrqd,bgqnld->bgrqnl', qi, k_g).astype(jnp.float32) * scale
        dist_s = (t[:, None, None] - pos).astype(jnp.float32)[:, :, None]
        s_s = jnp.where(dist_s >= 0, s_s - slope[..., None] * dist_s, NEG_INF)
        p_s = jax.nn.softmax(s_s.reshape(B, G, R, NSA_Q_BLOCK, n_sel * SEL_BLOCK), axis=-1)
        p_s = p_s.reshape(B, G, R, NSA_Q_BLOCK, n_sel, SEL_BLOCK)
        o_s = jnp.einsum('bgrqnl,bgqnld->bgrqd', p_s.astype(v_g.dtype), v_g)
        kwi = lax.dynamic_slice_in_dim(kw, i * NSA_Q_BLOCK, WINDOW + NSA_Q_BLOCK, axis=2)
        vwi = lax.dynamic_slice_in_dim(vw, i * NSA_Q_BLOCK, WINDOW + NSA_Q_BLOCK, axis=2)
        kpos = i * NSA_Q_BLOCK - WINDOW + jnp.arange(WINDOW + NSA_Q_BLOCK)
        dist_w = t[:, None] - kpos[None, :]
        valid_w = (dist_w >= 0) & (dist_w < WINDOW) & (kpos[None, :] >= 0)
        s_w = jnp.einsum('bgrqd,bgkd->bgrqk', qi, kwi).astype(jnp.float32) * scale
        s_w = jnp.where(valid_w, s_w - slope * dist_w.astype(jnp.float32), NEG_INF)
        p_w = jax.nn.softmax(s_w, axis=-1)
        o_w = jnp.einsum('bgrqk,bgkd->bgrqd', p_w.astype(vwi.dtype), vwi)
        return gi[..., 0:1] * o_c + gi[..., 1:2] * o_s + gi[..., 2:3] * o_w

    out = lax.map(block, (jnp.arange(nq), qg, gb))
    return out.transpose(1, 0, 4, 2, 3, 5).reshape(B, T, NSA_HEADS * dh)


def memory_attention(q, mk, mv):
    B, T, H, dh = q.shape
    s = jnp.einsum('bthd,bmhd->bhtm', q, mk).astype(jnp.float32) * (dh ** -0.5)
    p = jax.nn.softmax(s, axis=-1)
    o = jnp.einsum('bhtm,bmhd->bthd', p.astype(mv.dtype), mv)
    return o.reshape(B, T, H * dh)


def peer_ffn(h, w_q, subkeys, u_tab, v_tab):
    B, T, D = h.shape
    nb = T // PEER_T_BLOCK
    half = PEER_QUERY_DIM // 2
    K = PEER_TOPK
    hb = h.reshape(B, nb, PEER_T_BLOCK, D).transpose(1, 0, 2, 3)

    def block(hi):
        q = (hi @ w_q).reshape(B, PEER_T_BLOCK, PEER_HEADS, 2, half)
        s = jnp.einsum('bthpd,hpkd->bthpk', q, subkeys).astype(jnp.float32)
        s_top, i_top = lax.top_k(s, K)
        cand = s_top[..., 0, :, None] + s_top[..., 1, None, :]
        cand_idx = i_top[..., 0, :, None] * PEER_N_KEYS + i_top[..., 1, None, :]
        best, pos = lax.top_k(cand.reshape(B, PEER_T_BLOCK, PEER_HEADS, K * K), K)
        expert = jnp.take_along_axis(cand_idx.reshape(B, PEER_T_BLOCK, PEER_HEADS, K * K), pos, axis=-1)
        g = jax.nn.softmax(best, axis=-1)
        a = jax.nn.gelu(jnp.einsum('btd,bthkd->bthk', hi, u_tab[expert]).astype(jnp.float32), approximate=False)
        w = (g * a).astype(v_tab.dtype)
        return jnp.einsum('bthk,bthkd->btd', w, v_tab[expert])

    out = lax.map(block, hb)
    return out.transpose(1, 0, 2, 3).reshape(B, T, D)


def setup_inputs(seed: int = 0) -> dict:
    key = jax.random.key(seed)
    ks = jax.random.split(key, 24)
    f32 = jnp.float32
    L, D = DEPTH, D_MODEL
    half = PEER_QUERY_DIM // 2

    def nrm(k, shape, scale):
        return jax.random.normal(k, shape, f32) * scale

    return {
        'x': nrm(ks[0], (BATCH, SEQ, D), 1.0),
        'mem': nrm(ks[1], (BATCH, MEM_TOKENS, D), 1.0),
        'mix_norm_g': 1.0 + nrm(ks[2], (L, D), 0.02),
        'mem_norm_g': 1.0 + nrm(ks[3], (L, D), 0.02),
        'w_in': nrm(ks[4], (L, D, IN_DIM), D ** -0.5),
        'b_merge': nrm(ks[5], (L, N_BRANCHES * D), 0.02),
        'cmp_pe_k': nrm(ks[6], (L, CMP_LEN, HEAD_DIM), 0.02),
        'cmp_pe_v': nrm(ks[7], (L, CMP_LEN, HEAD_DIM), 0.02),
        'cmp_w_k': nrm(ks[8], (L, CMP_LEN, HEAD_DIM, HEAD_DIM), (CMP_LEN * HEAD_DIM) ** -0.5),
        'cmp_w_v': nrm(ks[9], (L, CMP_LEN, HEAD_DIM, HEAD_DIM), (CMP_LEN * HEAD_DIM) ** -0.5),
        'w_mem_kv': nrm(ks[10], (L, D, 2 * MEM_W), D ** -0.5),
        'w_sb_br': nrm(ks[11], (L, SB_W, D), SB_W ** -0.5),
        'w_nsa_br': nrm(ks[12], (L, NSA_W, D), NSA_W ** -0.5),
        'w_mem_br': nrm(ks[13], (L, MEM_W, D), MEM_W ** -0.5),
        'w_out': nrm(ks[14], (L, D, D), D ** -0.5),
        'ffn_norm_g': 1.0 + nrm(ks[15], (L, D), 0.02),
        'peer_w_q': nrm(ks[16], (L, D, PEER_HEADS * PEER_QUERY_DIM), D ** -0.5),
        'peer_subkeys': nrm(ks[17], (L, PEER_HEADS, 2, PEER_N_KEYS, half), half ** -0.5),
        'peer_u': nrm(ks[18], (L, PEER_N_EXPERTS, D), D ** -0.5),
        'peer_v': nrm(ks[19], (L, PEER_N_EXPERTS, D), 0.3),
        'final_norm_g': 1.0 + nrm(ks[20], (D,), 0.02),
    }


def reference(x, mem, mix_norm_g, mem_norm_g, w_in, b_merge, cmp_pe_k, cmp_pe_v, cmp_w_k, cmp_w_v, w_mem_kv, w_sb_br, w_nsa_br, w_mem_br, w_out, ffn_norm_g, peer_w_q, peer_subkeys, peer_u, peer_v, final_norm_g):
    B, T, D = x.shape
    M = mem.shape[1]
    G = NSA_KV_GROUPS
    slopes = alibi_slopes(NSA_HEADS)
    offsets = split_offsets()
    for l in range(DEPTH):
        h = rmsnorm(x, mix_norm_g[l])
        proj = h @ w_in[l]
        sb_q, sb_k, sb_v, nsa_q, nsa_kv, nsa_g, mem_q, merge_g = jnp.split(proj, offsets, axis=-1)
        sbh = lambda z: z.reshape(B, T, SB_HEADS, HEAD_DIM).transpose(0, 2, 1, 3)
        sb_out = stick_breaking_attention(sbh(sb_q), sbh(sb_k), sbh(sb_v))
        kv = nsa_kv.reshape(B, T, 6, G, HEAD_DIM)
        nsa_out = nsa_attention(nsa_q.reshape(B, T, NSA_HEADS, HEAD_DIM), kv[:, :, 0], kv[:, :, 1], kv[:, :, 2], kv[:, :, 3], kv[:, :, 4], kv[:, :, 5], jax.nn.sigmoid(nsa_g.reshape(B, T, NSA_HEADS, 3)), cmp_pe_k[l], cmp_pe_v[l], cmp_w_k[l], cmp_w_v[l], slopes)
        mkv = (rmsnorm(mem, mem_norm_g[l]) @ w_mem_kv[l]).reshape(B, M, 2, MEM_HEADS, HEAD_DIM)
        mem_out = memory_attention(mem_q.reshape(B, T, MEM_HEADS, HEAD_DIM), mkv[:, :, 0], mkv[:, :, 1])
        gates = jax.nn.sigmoid(merge_g + b_merge[l]).reshape(B, T, N_BRANCHES, D)
        merged = gates[:, :, 0] * (sb_out @ w_sb_br[l]) + gates[:, :, 1] * (nsa_out @ w_nsa_br[l]) + gates[:, :, 2] * (mem_out @ w_mem_br[l])
        x = x + merged @ w_out[l]
        x = x + peer_ffn(rmsnorm(x, ffn_norm_g[l]), peer_w_q[l], peer_subkeys[l], peer_u[l], peer_v[l])
    return rmsnorm(x, final_norm_g)
```

```cpp
#include <hip/hip_runtime.h>
#include <hip/hip_cooperative_groups.h>
#include <cstdio>
#include <cstdint>
namespace cg = cooperative_groups;

#ifndef N_LAUNCH_MODE
#define N_LAUNCH_MODE 0
#endif

typedef unsigned short bf16_t;
typedef short bf16x8 __attribute__((ext_vector_type(8)));
typedef short s16x4 __attribute__((ext_vector_type(4)));
typedef float f32x2 __attribute__((ext_vector_type(2)));
typedef float f32x4 __attribute__((ext_vector_type(4)));
typedef float f32x16 __attribute__((ext_vector_type(16)));
typedef unsigned u32x2 __attribute__((ext_vector_type(2)));
typedef unsigned u32x4 __attribute__((ext_vector_type(4)));
typedef __bf16 bf16x2_t __attribute__((ext_vector_type(2)));
#define DI __device__ __forceinline__

constexpr int NB = 8, T = 4096, D = 1024, NTOK = NB * T;
constexpr int MEMT = 256;
constexpr int NTHREADS = 512, NWAVES = 8;
constexpr int LDP_QKV = 2560;
constexpr int C_SBQ = 0, C_SBK = 384, C_SBV = 768, C_NQ = 1152, C_NKV = 1536, C_MQ = 2304;
constexpr int LDG = 3072;
constexpr int NPROJ = 5760;
constexpr int IN_DIM = 5650;
constexpr float RMS_EPS = 1e-6f;
constexpr float LOG2E = 1.4426950408889634f, LN2 = 0.6931471805599453f;

constexpr size_t MiB = 1u << 20;
constexpr size_t WS_CTL = 0;
constexpr size_t WS_WIN = 1 * MiB;
constexpr size_t WS_WQ = WS_WIN + 12 * MiB;
constexpr size_t WS_WOUT = WS_WQ + 4 * MiB;
constexpr size_t WS_WSB = WS_WOUT + 2 * MiB;
constexpr size_t WS_WNSA = WS_WSB + 1 * MiB;
constexpr size_t WS_WMEM = WS_WNSA + 1 * MiB;
constexpr size_t WS_WMKV = WS_WMEM + 1 * MiB;
constexpr size_t WS_SUBK = WS_WMKV + 1 * MiB;
constexpr size_t WS_H = 24 * MiB;
constexpr size_t WS_QKV = 88 * MiB;
constexpr size_t WS_MERGED = WS_QKV;
constexpr size_t WS_IDX = WS_QKV + 64 * MiB;
constexpr size_t WS_GW = WS_QKV + 80 * MiB;
constexpr size_t WS_ROWSS = WS_QKV + 96 * MiB;
constexpr size_t WS_GATES = 248 * MiB;
constexpr size_t WS_H2 = WS_GATES;
constexpr size_t WS_QP = WS_GATES + 64 * MiB;
constexpr size_t WS_TABU = 440 * MiB;
constexpr size_t WS_TABV = 472 * MiB;
constexpr size_t WS_END = 504 * MiB;
constexpr size_t DO_VSLC = 0;
constexpr size_t DO_VWIN = 8 * MiB;
constexpr size_t DO_SBV = 16 * MiB;
constexpr size_t DO_KC = 40 * MiB;
constexpr size_t DO_VCT = 41 * MiB;
constexpr size_t DO_MEMN = 42 * MiB;
constexpr size_t DO_MKV = 46 * MiB;
constexpr size_t DO_MVT = 48 * MiB;
constexpr size_t DO_NSAG = 50 * MiB;
constexpr size_t DO_SELM = 54 * MiB;

constexpr int LDS_BYTES = 81920;

struct Params {
    const float* in[21];
    float* out;
    unsigned char* ws;
    int ph_lo, ph_hi;
};

DI unsigned f2bf(float f) { unsigned u = __float_as_uint(f); return (u + 0x7fffu + ((u >> 16) & 1u)) >> 16; }
DI unsigned pk2(float lo, float hi) { f32x2 v = {lo, hi}; bf16x2_t b = __builtin_convertvector(v, bf16x2_t); return __builtin_bit_cast(unsigned, b); }
DI float bf2f(unsigned short h) { return __uint_as_float((unsigned)h << 16); }
DI float bflo(unsigned w) { return __uint_as_float(w << 16); }
DI float bfhi(unsigned w) { return __uint_as_float(w & 0xffff0000u); }
DI float wave_sum(float v) {
#pragma unroll
    for (int o = 1; o < 64; o <<= 1) v += __shfl_xor(v, o);
    return v;
}
DI float fexp2(float x) { return __builtin_amdgcn_exp2f(x); }
DI float flog2(float x) { return __builtin_amdgcn_logf(x); }
DI float fexp(float x) { return __builtin_amdgcn_exp2f(x * LOG2E); }
DI float sigmoidf_(float x) { return 1.0f / (1.0f + fexp(-x)); }
DI int krow(int r, int hi) { return (r & 3) + 8 * (r >> 2) + 4 * hi; }
#define MFMA32(a, b, c) __builtin_amdgcn_mfma_f32_32x32x16_bf16((a), (b), (c), 0, 0, 0)
#define MFMA16(a, b, c) __builtin_amdgcn_mfma_f32_16x16x32_bf16((a), (b), (c), 0, 0, 0)

DI void rms_row_bf16(const float* xrow, const float* g, bf16_t* orow, int lane) {
    const f32x4* xr = (const f32x4*)xrow + lane;
    const f32x4* gr = (const f32x4*)g + lane;
    f32x4 v[4]; float s = 0.f;
#pragma unroll
    for (int j = 0; j < 4; ++j) { v[j] = xr[64 * j]; s += (v[j].x * v[j].x + v[j].y * v[j].y) + (v[j].z * v[j].z + v[j].w * v[j].w); }
    const float rstd = 1.0f / sqrtf(wave_sum(s) * (1.0f / D) + RMS_EPS);
    u32x2* o8 = (u32x2*)orow + lane;
#pragma unroll
    for (int j = 0; j < 4; ++j) { const f32x4 gg = gr[64 * j]; u32x2 w; w.x = pk2(v[j].x * rstd * gg.x, v[j].y * rstd * gg.y); w.y = pk2(v[j].z * rstd * gg.z, v[j].w * rstd * gg.w); o8[64 * j] = w; }
}
DI void transpose_w(const float* W, int K, int N, bf16_t* Wt, int gtid, int gthreads) {
    const int total = (K / 8) * N;
    for (int it = gtid; it < total; it += gthreads) {
        const int n = it % N, k8 = it / N;
        const float* s = W + (size_t)(k8 * 8) * N + n;
        u32x4 o; o.x = pk2(s[0], s[(size_t)N]); o.y = pk2(s[(size_t)2 * N], s[(size_t)3 * N]); o.z = pk2(s[(size_t)4 * N], s[(size_t)5 * N]); o.w = pk2(s[(size_t)6 * N], s[(size_t)7 * N]);
        *(u32x4*)(Wt + (size_t)n * K + k8 * 8) = o;
    }
}
DI void phase0(const Params& p) {
    const int gtid = blockIdx.x * NTHREADS + threadIdx.x, gthreads = gridDim.x * NTHREADS;
    const int lane = threadIdx.x & 63, gwave = gtid >> 6, nwaves = gthreads >> 6;
    unsigned char* ws = p.ws;
    bf16_t* h = (bf16_t*)(ws + WS_H);
    for (int row = gwave; row < NTOK; row += nwaves) rms_row_bf16(p.in[0] + (size_t)row * D, p.in[2], h + (size_t)row * D, lane);
    bf16_t* memn = (bf16_t*)((unsigned char*)p.out + DO_MEMN);
    for (int row = gwave; row < NB * MEMT; row += nwaves) rms_row_bf16(p.in[1] + (size_t)row * D, p.in[3], memn + (size_t)row * D, lane);
    {
        const float* W = p.in[4]; bf16_t* Wt = (bf16_t*)(ws + WS_WIN);
        const int total = (D / 8) * NPROJ;
        for (int it = gtid; it < total; it += gthreads) {
            const int n = it % NPROJ, k8 = it / NPROJ;
            int src;
            if (n < 2304) src = n; else if (n < 2560) src = 2322 + (n - 2304); else if (n < 5632) src = 2578 + (n - 2560); else if (n < 5650) src = 2304 + (n - 5632); else src = -1;
            u32x4 o = {0u, 0u, 0u, 0u};
            if (src >= 0) { const float* s = W + (size_t)(k8 * 8) * IN_DIM + src;
                o.x = pk2(s[0], s[(size_t)IN_DIM]); o.y = pk2(s[(size_t)2 * IN_DIM], s[(size_t)3 * IN_DIM]); o.z = pk2(s[(size_t)4 * IN_DIM], s[(size_t)5 * IN_DIM]); o.w = pk2(s[(size_t)6 * IN_DIM], s[(size_t)7 * IN_DIM]); }
            *(u32x4*)(Wt + (size_t)n * D + k8 * 8) = o;
        }
    }
    transpose_w(p.in[16], D, 2048, (bf16_t*)(ws + WS_WQ), gtid, gthreads);
    transpose_w(p.in[14], D, D, (bf16_t*)(ws + WS_WOUT), gtid, gthreads);
    transpose_w(p.in[11], 384, D, (bf16_t*)(ws + WS_WSB), gtid, gthreads);
    transpose_w(p.in[12], 384, D, (bf16_t*)(ws + WS_WNSA), gtid, gthreads);
    transpose_w(p.in[13], 256, D, (bf16_t*)(ws + WS_WMEM), gtid, gthreads);
    transpose_w(p.in[10], D, 512, (bf16_t*)(ws + WS_WMKV), gtid, gthreads);
    {
        const f32x4* s = (const f32x4*)p.in[17]; u32x2* o = (u32x2*)(ws + WS_SUBK);
        for (int i = gtid; i < 8 * 2 * 128 * 128 / 4; i += gthreads) { const f32x4 v = s[i]; u32x2 w; w.x = pk2(v.x, v.y); w.y = pk2(v.z, v.w); o[i] = w; }
    }
    {
        const f32x4* su = (const f32x4*)p.in[18]; const f32x4* sv = (const f32x4*)p.in[19];
        u32x2* ou = (u32x2*)(ws + WS_TABU); u32x2* ov = (u32x2*)(ws + WS_TABV);
        for (int i = gtid; i < 16384 * 1024 / 4; i += gthreads) {
            const f32x4 a = su[i], b = sv[i]; u32x2 w; w.x = pk2(a.x, a.y); w.y = pk2(a.z, a.w); ou[i] = w; w.x = pk2(b.x, b.y); w.y = pk2(b.z, b.w); ov[i] = w; }
    }
}

constexpr int GEMM_LDS_ROW = 72;
constexpr int GEMM_TILE_ELEMS = 128 * GEMM_LDS_ROW;
DI void gemm_mainloop(const bf16_t* __restrict__ Ag, int lda, const bf16_t* __restrict__ Bg, int ldb, int K, f32x4 (&acc)[4][2], bf16_t* lds) {
    const int tid = threadIdx.x, lane = tid & 63, wid = tid >> 6, wr = wid >> 2, wc = wid & 3;
    const int r0 = tid >> 3, kc = tid & 7;
    const bf16_t* ap0 = Ag + (size_t)r0 * lda + kc * 8; const bf16_t* ap1 = ap0 + (size_t)64 * lda;
    const bf16_t* bp0 = Bg + (size_t)r0 * ldb + kc * 8; const bf16_t* bp1 = bp0 + (size_t)64 * ldb;
    const int so0 = r0 * GEMM_LDS_ROW + kc * 8, so1 = so0 + 64 * GEMM_LDS_ROW;
    u32x4 ra0, ra1, rb0, rb1;
    ra0 = *(const u32x4*)ap0; ra1 = *(const u32x4*)ap1; rb0 = *(const u32x4*)bp0; rb1 = *(const u32x4*)bp1;
    __syncthreads();
    {
        bf16_t* As = lds; bf16_t* Bs = lds + GEMM_TILE_ELEMS;
        *(u32x4*)(As + so0) = ra0; *(u32x4*)(As + so1) = ra1; *(u32x4*)(Bs + so0) = rb0; *(u32x4*)(Bs + so1) = rb1;
    }
    __syncthreads();
    const int nk = K / 64;
    const int fr = lane & 15, fq = lane >> 4;
    for (int kt = 0; kt < nk; ++kt) {
        const int buf = kt & 1;
        if (kt + 1 < nk) { const int ko = (kt + 1) * 64; ra0 = *(const u32x4*)(ap0 + ko); ra1 = *(const u32x4*)(ap1 + ko); rb0 = *(const u32x4*)(bp0 + ko); rb1 = *(const u32x4*)(bp1 + ko); }
        const bf16_t* As = lds + buf * 2 * GEMM_TILE_ELEMS; const bf16_t* Bs = As + GEMM_TILE_ELEMS;
#pragma unroll
        for (int kk = 0; kk < 2; ++kk) {
            bf16x8 af[4], bfr[2];
#pragma unroll
            for (int m = 0; m < 4; ++m) af[m] = *(const bf16x8*)(As + (wr * 64 + m * 16 + fr) * GEMM_LDS_ROW + kk * 32 + fq * 8);
#pragma unroll
            for (int n = 0; n < 2; ++n) bfr[n] = *(const bf16x8*)(Bs + (wc * 32 + n * 16 + fr) * GEMM_LDS_ROW + kk * 32 + fq * 8);
#pragma unroll
            for (int m = 0; m < 4; ++m)
#pragma unroll
                for (int n = 0; n < 2; ++n) acc[m][n] = MFMA16(bfr[n], af[m], acc[m][n]);
        }
        if (kt + 1 < nk) {
            bf16_t* An = lds + (buf ^ 1) * 2 * GEMM_TILE_ELEMS; bf16_t* Bn = An + GEMM_TILE_ELEMS;
            *(u32x4*)(An + so0) = ra0; *(u32x4*)(An + so1) = ra1; *(u32x4*)(Bn + so0) = rb0; *(u32x4*)(Bn + so1) = rb1;
        }
        __syncthreads();
    }
}
DI void zero_acc(f32x4 (&acc)[4][2]) {
#pragma unroll
    for (int m = 0; m < 4; ++m)
#pragma unroll
        for (int n = 0; n < 2; ++n) acc[m][n] = (f32x4){0.f, 0.f, 0.f, 0.f};
}
DI void tile_coords(int tile, int ntn, int& pm, int& pn) { const int per = 8 * ntn, g = tile / per, r = tile % per; pm = g * 8 + (r & 7); pn = r >> 3; }
DI void store_bf16x4(bf16_t* p, f32x4 v) { u32x2 w; w.x = pk2(v.x, v.y); w.y = pk2(v.z, v.w); *(u32x2*)p = w; }

DI void phase1(const Params& p, bf16_t* lds) {
    unsigned char* ws = p.ws;
    const int lane = threadIdx.x & 63, wid = threadIdx.x >> 6, wr = wid >> 2, wc = wid & 3, fr = lane & 15, fq = lane >> 4;
    {
        const bf16_t* A = (const bf16_t*)(ws + WS_H); const bf16_t* Bt = (const bf16_t*)(ws + WS_WIN);
        bf16_t* qkv = (bf16_t*)(ws + WS_QKV); bf16_t* gates = (bf16_t*)(ws + WS_GATES); float* nsag = (float*)((unsigned char*)p.out + DO_NSAG);
        const float* bm = p.in[5];
        const int ntn = NPROJ / 128, ntiles = (NTOK / 128) * ntn;
        for (int tile = blockIdx.x; tile < ntiles; tile += gridDim.x) {
            int pm, pn; tile_coords(tile, ntn, pm, pn);
            f32x4 acc[4][2]; zero_acc(acc);
            gemm_mainloop(A + (size_t)pm * 128 * D, D, Bt + (size_t)pn * 128 * D, D, D, acc, lds);
#pragma unroll
            for (int m = 0; m < 4; ++m)
#pragma unroll
                for (int n = 0; n < 2; ++n) {
                    const int row = pm * 128 + wr * 64 + m * 16 + fr, col = pn * 128 + wc * 32 + n * 16 + fq * 4;
                    f32x4 v = acc[m][n];
                    if (col < 2560) store_bf16x4(qkv + (size_t)row * LDP_QKV + col, v);
                    else if (col < 5632) { const int c = col - 2560; const f32x4 b = *(const f32x4*)(bm + c);
                        v.x = sigmoidf_(v.x + b.x); v.y = sigmoidf_(v.y + b.y); v.z = sigmoidf_(v.z + b.z); v.w = sigmoidf_(v.w + b.w);
                        store_bf16x4(gates + (size_t)row * LDG + c, v); }
                    else { const int c = col - 5632; if (c < 32) { v.x = sigmoidf_(v.x); v.y = sigmoidf_(v.y); v.z = sigmoidf_(v.z); v.w = sigmoidf_(v.w); *(f32x4*)(nsag + (size_t)row * 32 + c) = v; } }
                }
        }
    }
    {
        const bf16_t* A = (const bf16_t*)((unsigned char*)p.out + DO_MEMN); const bf16_t* Bt = (const bf16_t*)(ws + WS_WMKV);
        bf16_t* mkv = (bf16_t*)((unsigned char*)p.out + DO_MKV);
        const int ntn = 4, ntiles = 16 * 4;
        for (int tile = blockIdx.x; tile < ntiles; tile += gridDim.x) {
            int pm, pn; tile_coords(tile, ntn, pm, pn);
            f32x4 acc[4][2]; zero_acc(acc);
            gemm_mainloop(A + (size_t)pm * 128 * D, D, Bt + (size_t)pn * 128 * D, D, D, acc, lds);
#pragma unroll
            for (int m = 0; m < 4; ++m)
#pragma unroll
                for (int n = 0; n < 2; ++n) { const int row = pm * 128 + wr * 64 + m * 16 + fr, col = pn * 128 + wc * 32 + n * 16 + fq * 4; store_bf16x4(mkv + (size_t)row * 512 + col, acc[m][n]); }
        }
    }
}

DI void transpose64(const bf16_t* src, size_t sp, bf16_t* dst, size_t dp, unsigned short* scr, int lane) {
#pragma unroll
    for (int i = 0; i < 8; ++i) { const int r = i * 8 + (lane >> 3), c8 = lane & 7; const u32x4 v = *(const u32x4*)(src + (size_t)r * sp + c8 * 8);
        unsigned short* s = scr + r * 66 + c8 * 8;
        s[0] = (unsigned short)(v.x & 0xffff); s[1] = (unsigned short)(v.x >> 16); s[2] = (unsigned short)(v.y & 0xffff); s[3] = (unsigned short)(v.y >> 16);
        s[4] = (unsigned short)(v.z & 0xffff); s[5] = (unsigned short)(v.z >> 16); s[6] = (unsigned short)(v.w & 0xffff); s[7] = (unsigned short)(v.w >> 16); }
    __builtin_amdgcn_s_waitcnt(0xc07f);
    __builtin_amdgcn_wave_barrier();
#pragma unroll
    for (int i = 0; i < 8; ++i) { const int c = i * 8 + (lane >> 3), r8 = lane & 7; const unsigned short* s = scr + (r8 * 8) * 66 + c;
        u32x4 o; o.x = (unsigned)s[0] | ((unsigned)s[66] << 16); o.y = (unsigned)s[2 * 66] | ((unsigned)s[3 * 66] << 16); o.z = (unsigned)s[4 * 66] | ((unsigned)s[5 * 66] << 16); o.w = (unsigned)s[6 * 66] | ((unsigned)s[7 * 66] << 16);
        *(u32x4*)(dst + (size_t)c * dp + r8 * 8) = o; }
    __builtin_amdgcn_s_waitcnt(0xc07f);
    __builtin_amdgcn_wave_barrier();
}
DI void phase2(const Params& p, bf16_t* lds) {
    unsigned char* ws = p.ws; unsigned char* dout = (unsigned char*)p.out;
    const int lane = threadIdx.x & 63, wid = threadIdx.x >> 6;
    const int gwave = blockIdx.x * NWAVES + wid, nwaves = gridDim.x * NWAVES;
    unsigned short* scr = (unsigned short*)lds + wid * (64 * 66);
    const bf16_t* qkv = (const bf16_t*)(ws + WS_QKV);
    const int n_items = 1024 + 1024 + 3072 + 128;
    for (int it = gwave; it < n_items; it += nwaves) {
        if (it < 2048) { const int which = it >> 10, r = it & 1023, b = r >> 7, g = (r >> 6) & 1, tt = r & 63;
            const bf16_t* src = qkv + (size_t)(b * T + tt * 64) * LDP_QKV + C_NKV + (which ? 5 : 3) * 128 + g * 64;
            bf16_t* dst = (bf16_t*)(dout + (which ? DO_VWIN : DO_VSLC)) + (size_t)((b * 2 + g) * 64) * T + tt * 64;
            transpose64(src, LDP_QKV, dst, T, scr, lane);
        } else if (it < 2048 + 3072) { const int r = it - 2048, b = r / 384, hh = (r / 64) % 6, tt = r & 63;
            const bf16_t* src = qkv + (size_t)(b * T + tt * 64) * LDP_QKV + C_SBV + hh * 64;
            bf16_t* dst = (bf16_t*)(dout + DO_SBV) + (size_t)((b * 6 + hh) * 64) * T + tt * 64;
            transpose64(src, LDP_QKV, dst, T, scr, lane);
        } else { const int r = it - 5120, b = r >> 4, hh = (r >> 2) & 3, mt = r & 3;
            const bf16_t* src = (const bf16_t*)(dout + DO_MKV) + (size_t)(b * MEMT + mt * 64) * 512 + 256 + hh * 64;
            bf16_t* dst = (bf16_t*)(dout + DO_MVT) + (size_t)((b * 4 + hh) * 64) * MEMT + mt * 64;
            transpose64(src, 512, dst, MEMT, scr, lane);
        }
    }
    bf16_t* kc = (bf16_t*)(dout + DO_KC); bf16_t* vct = (bf16_t*)(dout + DO_VCT);
    for (int it = gwave; it < 2 * 16 * 256; it += nwaves) {
        const int which = it >> 12, r = it & 4095, bg = r >> 8, n = r & 255, b = bg >> 1, g = bg & 1;
        float acc = 0.f;
        if (n < 255) {
            const float* pe = p.in[6 + which]; const float* w = p.in[8 + which];
            const bf16_t* src = qkv + (size_t)(b * T + 16 * n) * LDP_QKV + C_NKV + which * 128 + g * 64 + lane;
            for (int l = 0; l < 32; ++l) {
                const float xv = bf2f(src[(size_t)l * LDP_QKV]) + pe[l * 64 + lane];
                const float* wl = w + (size_t)l * 4096 + lane;
#pragma unroll 16
                for (int d = 0; d < 64; ++d) acc += __shfl(xv, d) * wl[d * 64];
            }
        }
        if (which == 0) kc[((size_t)bg * 256 + n) * 64 + lane] = (bf16_t)f2bf(acc);
        else vct[((size_t)bg * 64 + lane) * 256 + n] = (bf16_t)f2bf(acc);
    }
}

DI bf16x8 pack8(const f32x16& p, int base) {
    u32x4 w; w.x = pk2(p[base], p[base + 1]); w.y = pk2(p[base + 2], p[base + 3]); w.z = pk2(p[base + 4], p[base + 5]); w.w = pk2(p[base + 6], p[base + 7]);
    return __builtin_bit_cast(bf16x8, w);
}
DI f32x16 st_tile(const bf16_t* kbase, size_t kpitch, const bf16x8 (&qf)[4], int r32, int hi) {
    f32x16 s;
#pragma unroll
    for (int i = 0; i < 16; ++i) s[i] = 0.f;
    const bf16_t* kp = kbase + (size_t)r32 * kpitch + hi * 8;
#pragma unroll
    for (int ks = 0; ks < 4; ++ks) { const bf16x8 a = *(const bf16x8*)(kp + ks * 16); s = MFMA32(a, qf[ks], s); }
    return s;
}
DI void pv_tile(f32x16 (&o)[2], const bf16_t* vT, size_t vpitch, const f32x16& pr, int r32, int hi) {
    const bf16x8 pf0 = pack8(pr, 0), pf1 = pack8(pr, 8);
#pragma unroll
    for (int db = 0; db < 2; ++db) {
        const bf16_t* vp = vT + (size_t)(32 * db + r32) * vpitch + 4 * hi;
#pragma unroll
        for (int s2 = 0; s2 < 2; ++s2) {
            const s16x4 lo = *(const s16x4*)(vp + 16 * s2); const s16x4 hh = *(const s16x4*)(vp + 16 * s2 + 8);
            const bf16x8 a = {lo[0], lo[1], lo[2], lo[3], hh[0], hh[1], hh[2], hh[3]};
            o[db] = MFMA32(a, s2 ? pf1 : pf0, o[db]);
        }
    }
}
DI void load_q(bf16x8 (&qf)[4], const bf16_t* qrow  , int hi) {
#pragma unroll
    for (int ks = 0; ks < 4; ++ks) qf[ks] = *(const bf16x8*)(qrow + ks * 16 + hi * 8);
}
DI void zero16(f32x16& v) {
#pragma unroll
    for (int i = 0; i < 16; ++i) v[i] = 0.f;
}
DI void softmax_tile(f32x16& sv, unsigned vmask, float& m, float& l, f32x16 (&o)[2]) {
    float tm = -1e30f;
#pragma unroll
    for (int r = 0; r < 16; ++r) tm = fmaxf(tm, ((vmask >> r) & 1u) ? sv[r] : -1e30f);
    tm = fmaxf(tm, __shfl_xor(tm, 32));
    const float mn = fmaxf(m, tm);
    const float alpha = fexp(m - mn);
    float ps = 0.f;
#pragma unroll
    for (int r = 0; r < 16; ++r) { const float pv = ((vmask >> r) & 1u) ? fexp(sv[r] - mn) : 0.f; sv[r] = pv; ps += pv; }
    l = l * alpha + ps; m = mn;
#pragma unroll
    for (int r = 0; r < 16; ++r) { o[0][r] *= alpha; o[1][r] *= alpha; }
}

DI void nsa_cmp_task(const Params& p, int b, int g, int chunk, int lane) {
    unsigned char* ws = p.ws; unsigned char* dout = (unsigned char*)p.out;
    const int r32 = lane & 31, hi = lane >> 5;
    const int tq0 = chunk * 32, t = tq0 + r32, cur = tq0 >> 6;
    const size_t tok = (size_t)b * T + t;
    const bf16_t* qkv = (const bf16_t*)(ws + WS_QKV);
    const float scale = 0.125f;
    float imp[32];
#pragma unroll
    for (int k = 0; k < 32; ++k) imp[k] = 0.f;
    const bf16_t* kc = (const bf16_t*)(dout + DO_KC) + (size_t)(b * 2 + g) * 256 * 64;
    const bf16_t* vct = (const bf16_t*)(dout + DO_VCT) + (size_t)(b * 2 + g) * 64 * 256;
    int ntile = (tq0 / 16) / 32 + 1; if (ntile > 8) ntile = 8;
#pragma unroll 1
    for (int rr = 0; rr < 3; ++rr) {
        const int head = g * 3 + rr;
        bf16x8 qr[4]; load_q(qr, qkv + tok * LDP_QKV + C_NQ + head * 64, hi);
        const float slope = fexp2(-(8.0f * (float)(head + 1)) / 6.0f);
        float m = -1e30f, l = 0.f;
#pragma unroll 1
        for (int tile = 0; tile < ntile; ++tile) {
            f32x16 s = st_tile(kc + (size_t)tile * 32 * 64, 64, qr, r32, hi);
            float tm = -1e30f;
#pragma unroll
            for (int r = 0; r < 16; ++r) { const int n = tile * 32 + krow(r, hi); const int dist = t - (16 * n + 31); const bool valid = dist >= 0 && n < 255;
                const float sv = valid ? s[r] * scale - slope * (float)dist : -1e30f; s[r] = sv; tm = fmaxf(tm, sv); }
            tm = fmaxf(tm, __shfl_xor(tm, 32));
            const float mn = fmaxf(m, tm);
            float ps = 0.f;
#pragma unroll
            for (int r = 0; r < 16; ++r) ps += (s[r] > -1e29f) ? fexp(s[r] - mn) : 0.f;
            l = l * fexp(m - mn) + ps; m = mn;
        }
        l += __shfl_xor(l, 32);
        const float inv = l > 0.f ? 1.0f / l : 0.f;
        f32x16 oc[2]; zero16(oc[0]); zero16(oc[1]);
#pragma unroll 1
        for (int tile = 0; tile < ntile; ++tile) {
            f32x16 s = st_tile(kc + (size_t)tile * 32 * 64, 64, qr, r32, hi);
#pragma unroll
            for (int r = 0; r < 16; ++r) { const int n = tile * 32 + krow(r, hi); const int dist = t - (16 * n + 31); const bool valid = dist >= 0 && n < 255;
                s[r] = valid ? fexp(s[r] * scale - slope * (float)dist - m) * inv : 0.f; }
#pragma unroll
            for (int k = 0; k < 32; ++k) if ((k >> 2) == tile) { const int mm = k & 3; imp[k] += (s[4 * mm] + s[4 * mm + 1]) + (s[4 * mm + 2] + s[4 * mm + 3]); }
            pv_tile(oc, vct + tile * 32, 256, s, r32, hi);
        }
        const float g_c = ((const float*)(dout + DO_NSAG))[tok * 32 + head * 3];
        bf16_t* orow = (bf16_t*)(ws + WS_H) + tok * D + 384 + head * 64;
#pragma unroll
        for (int db = 0; db < 2; ++db)
#pragma unroll
            for (int mg = 0; mg < 4; ++mg) { f32x4 v = {g_c * oc[db][4 * mg], g_c * oc[db][4 * mg + 1], g_c * oc[db][4 * mg + 2], g_c * oc[db][4 * mg + 3]}; store_bf16x4(orow + 32 * db + 8 * mg + 4 * hi, v); }
    }
    unsigned long long selmask;
    if (cur + 1 <= 16) selmask = (1ull << (cur + 1)) - 1ull;
    else {
#pragma unroll
        for (int k = 0; k < 32; ++k) { const int j = 2 * k + hi; imp[k] = (j == 0 || j == cur || j == cur - 1) ? 1e4f : (j <= cur ? imp[k] : -1.0f); }
        selmask = 0ull;
#pragma unroll 1
        for (int round = 0; round < 16; ++round) {
            float bv = -3.0f; int bj = 1000;
#pragma unroll
            for (int k = 0; k < 32; ++k) { const bool better = imp[k] > bv; bv = better ? imp[k] : bv; bj = better ? (2 * k + hi) : bj; }
            const float pv = __shfl_xor(bv, 32); const int pj = __shfl_xor(bj, 32);
            const bool mine = (bv > pv) || (bv == pv && bj < pj);
            const int wj = mine ? bj : pj;
            selmask |= 1ull << wj;
            const int kill = mine ? bj : -1;
#pragma unroll
            for (int k = 0; k < 32; ++k) imp[k] = ((2 * k + hi) == kill) ? -2.0f : imp[k];
        }
    }
    if (hi == 0) ((unsigned long long*)(dout + DO_SELM))[(size_t)(b * 2 + g) * T + t] = selmask;
}
DI void nsa_main_task(const Params& p, int b, int head, int chunk, int lane) {
    unsigned char* ws = p.ws; unsigned char* dout = (unsigned char*)p.out;
    const int g = head / 3, r32 = lane & 31, hi = lane >> 5;
    const int tq0 = chunk * 32, t = tq0 + r32, cur = tq0 >> 6;
    const size_t tok = (size_t)b * T + t;
    const bf16_t* qkv = (const bf16_t*)(ws + WS_QKV);
    const float scale = 0.125f;
    const float* nsag = (const float*)(dout + DO_NSAG) + tok * 32 + head * 3;
    const float g_s = nsag[1], g_w = nsag[2];
    const unsigned long long selmask = ((const unsigned long long*)(dout + DO_SELM))[(size_t)(b * 2 + g) * T + t];
    bf16_t* orow = (bf16_t*)(ws + WS_H) + tok * D + 384 + head * 64;
    f32x16 oacc[2];
#pragma unroll
    for (int db = 0; db < 2; ++db)
#pragma unroll
        for (int mg = 0; mg < 4; ++mg) { const u32x2 w = *(const u32x2*)(orow + 32 * db + 8 * mg + 4 * hi); oacc[db][4 * mg] = bflo(w.x); oacc[db][4 * mg + 1] = bfhi(w.x); oacc[db][4 * mg + 2] = bflo(w.y); oacc[db][4 * mg + 3] = bfhi(w.y); }
    const float slope = fexp2(-(8.0f * (float)(head + 1)) / 6.0f);
    bf16x8 qme[4]; load_q(qme, qkv + tok * LDP_QKV + C_NQ + head * 64, hi);
    const bf16_t* kbase = qkv + (size_t)b * T * LDP_QKV + C_NKV + g * 64;
    {
        const bf16_t* ks = kbase + 2 * 128; const bf16_t* vt = (const bf16_t*)(dout + DO_VSLC) + (size_t)((b * 2 + g) * 64) * T;
        float m = -1e30f, l = 0.f; f32x16 o[2]; zero16(o[0]); zero16(o[1]);
#pragma unroll 1
        for (int j = 0; j <= cur; ++j) {
            const bool bit = (selmask >> j) & 1ull;
            if (!__any(bit)) continue;
#pragma unroll 1
            for (int half = 0; half < 2; ++half) {
                const int kb = 64 * j + 32 * half;
                if (kb > tq0 + 31) continue;
                f32x16 s = st_tile(ks + (size_t)kb * LDP_QKV, LDP_QKV, qme, r32, hi);
                unsigned vmask = 0u;
#pragma unroll
                for (int r = 0; r < 16; ++r) { const int dist = t - (kb + krow(r, hi)); const bool valid = bit && dist >= 0; s[r] = s[r] * scale - slope * (float)dist; vmask |= valid ? (1u << r) : 0u; }
                softmax_tile(s, vmask, m, l, o);
                pv_tile(o, vt + kb, T, s, r32, hi);
            }
        }
        l += __shfl_xor(l, 32);
        const float f = g_s * (l > 0.f ? 1.0f / l : 0.f);
#pragma unroll
        for (int r = 0; r < 16; ++r) { oacc[0][r] += f * o[0][r]; oacc[1][r] += f * o[1][r]; }
    }
    {
        const bf16_t* kw = kbase + 4 * 128; const bf16_t* vt = (const bf16_t*)(dout + DO_VWIN) + (size_t)((b * 2 + g) * 64) * T;
        float m = -1e30f, l = 0.f; f32x16 o[2]; zero16(o[0]); zero16(o[1]);
        int kb0 = tq0 - 512; if (kb0 < 0) kb0 = 0;
#pragma unroll 1
        for (int kb = kb0; kb <= tq0; kb += 32) {
            f32x16 s = st_tile(kw + (size_t)kb * LDP_QKV, LDP_QKV, qme, r32, hi);
            unsigned vmask = 0u;
#pragma unroll
            for (int r = 0; r < 16; ++r) { const int dist = t - (kb + krow(r, hi)); const bool valid = dist >= 0 && dist < 512; s[r] = s[r] * scale - slope * (float)dist; vmask |= valid ? (1u << r) : 0u; }
            softmax_tile(s, vmask, m, l, o);
            pv_tile(o, vt + kb, T, s, r32, hi);
        }
        l += __shfl_xor(l, 32);
        const float f = g_w * (l > 0.f ? 1.0f / l : 0.f);
#pragma unroll
        for (int r = 0; r < 16; ++r) { oacc[0][r] += f * o[0][r]; oacc[1][r] += f * o[1][r]; }
    }
#pragma unroll
    for (int db = 0; db < 2; ++db)
#pragma unroll
        for (int mg = 0; mg < 4; ++mg) { f32x4 v = {oacc[db][4 * mg], oacc[db][4 * mg + 1], oacc[db][4 * mg + 2], oacc[db][4 * mg + 3]}; store_bf16x4(orow + 32 * db + 8 * mg + 4 * hi, v); }
}

DI void mem_task(const Params& p, int b, int head, int chunk, int lane) {
    unsigned char* ws = p.ws; unsigned char* dout = (unsigned char*)p.out;
    const int r32 = lane & 31, hi = lane >> 5; const size_t tok = (size_t)b * T + chunk * 32 + r32;
    const bf16_t* qkv = (const bf16_t*)(ws + WS_QKV);
    bf16x8 qf[4]; load_q(qf, qkv + tok * LDP_QKV + C_MQ + head * 64, hi);
    const bf16_t* mk = (const bf16_t*)(dout + DO_MKV) + (size_t)b * MEMT * 512 + head * 64;
    const bf16_t* vt = (const bf16_t*)(dout + DO_MVT) + (size_t)((b * 4 + head) * 64) * MEMT;
    float m = -1e30f, l = 0.f; f32x16 o[2]; zero16(o[0]); zero16(o[1]);
#pragma unroll 1
    for (int kb = 0; kb < MEMT; kb += 32) {
        f32x16 s = st_tile(mk + (size_t)kb * 512, 512, qf, r32, hi);
#pragma unroll
        for (int r = 0; r < 16; ++r) s[r] *= 0.125f;
        softmax_tile(s, 0xffffu, m, l, o);
        pv_tile(o, vt + kb, MEMT, s, r32, hi);
    }
    l += __shfl_xor(l, 32);
    const float f = 1.0f / l;
    bf16_t* orow = (bf16_t*)(ws + WS_H) + tok * D + 768 + head * 64;
#pragma unroll
    for (int db = 0; db < 2; ++db)
#pragma unroll
        for (int mg = 0; mg < 4; ++mg) { f32x4 v = {o[db][4 * mg] * f, o[db][4 * mg + 1] * f, o[db][4 * mg + 2] * f, o[db][4 * mg + 3] * f}; store_bf16x4(orow + 32 * db + 8 * mg + 4 * hi, v); }
}

DI void sb_task(const Params& p, int b, int head, int chunk, int lane) {
    unsigned char* ws = p.ws; unsigned char* dout = (unsigned char*)p.out;
    const int r32 = lane & 31, hi = lane >> 5; const int tq0 = chunk * 32, t = tq0 + r32; const size_t tok = (size_t)b * T + t;
    const bf16_t* qkv = (const bf16_t*)(ws + WS_QKV);
    bf16x8 qf[4]; load_q(qf, qkv + tok * LDP_QKV + C_SBQ + head * 64, hi);
    const bf16_t* kk = qkv + (size_t)b * T * LDP_QKV + C_SBK + head * 64;
    const bf16_t* vt = (const bf16_t*)(dout + DO_SBV) + (size_t)((b * 6 + head) * 64) * T;
    f32x16 o[2]; zero16(o[0]); zero16(o[1]);
    float R = 0.f;
#pragma unroll 1
    for (int kb = tq0; kb >= 0; kb -= 32) {
        f32x16 s = st_tile(kk + (size_t)kb * LDP_QKV, LDP_QKV, qf, r32, hi);
        f32x16 L;
#pragma unroll
        for (int r = 0; r < 16; ++r) { const float z = s[r] * 0.125f; const bool valid = (kb + krow(r, hi)) < t;
            const float sp = fmaxf(z, 0.f) + LN2 * flog2(1.0f + fexp(-fabsf(z)));
            s[r] = z; L[r] = valid ? -sp : 0.f; }
        float gs[4], pg[4];
#pragma unroll
        for (int mg = 0; mg < 4; ++mg) { gs[mg] = (L[4 * mg] + L[4 * mg + 1]) + (L[4 * mg + 2] + L[4 * mg + 3]); pg[mg] = __shfl_xor(gs[mg], 32); }
        float off[4]; float run = R;
#pragma unroll
        for (int mg = 3; mg >= 0; --mg) { off[mg] = run + (hi ? 0.f : pg[mg]); run += gs[mg] + pg[mg]; }
#pragma unroll
        for (int mg = 0; mg < 4; ++mg) {
            float e = off[mg];
#pragma unroll
            for (int i = 3; i >= 0; --i) { const int r = 4 * mg + i; const bool valid = (kb + krow(r, hi)) < t;
                const float a = valid ? fexp(s[r] + L[r] + e) : 0.f; e += L[r]; s[r] = a; }
        }
        R = run;
        pv_tile(o, vt + kb, T, s, r32, hi);
        if (__all(R < -104.0f)) break;
    }
    bf16_t* orow = (bf16_t*)(ws + WS_H) + tok * D + head * 64;
#pragma unroll
    for (int db = 0; db < 2; ++db)
#pragma unroll
        for (int mg = 0; mg < 4; ++mg) { f32x4 v = {o[db][4 * mg], o[db][4 * mg + 1], o[db][4 * mg + 2], o[db][4 * mg + 3]}; store_bf16x4(orow + 32 * db + 8 * mg + 4 * hi, v); }
}

constexpr int N_CMP_TASKS = NB * 2 * 128, N_NSA_TASKS = NB * 6 * 128, N_MEM_TASKS = NB * 4 * 128, N_SB_TASKS = NB * 6 * 128;
DI void phase3a(const Params& p) {
    const int lane = threadIdx.x & 63;
    unsigned* ctr = (unsigned*)(p.ws + WS_CTL) + 64;
    for (;;) {
        unsigned tk = 0; if (lane == 0) tk = atomicAdd(ctr, 1u);
        const int task = (int)__builtin_amdgcn_readfirstlane(tk);
        if (task >= N_CMP_TASKS + N_MEM_TASKS + N_SB_TASKS) break;
        if (task < N_CMP_TASKS) { const int chunk = 127 - task / 16, rem = task % 16; nsa_cmp_task(p, rem >> 1, rem & 1, chunk, lane); }
        else if (task < N_CMP_TASKS + N_MEM_TASKS) { const int r = task - N_CMP_TASKS; const int chunk = r / 32, rem = r % 32; mem_task(p, rem / 4, rem % 4, chunk, lane); }
        else { const int r = task - N_CMP_TASKS - N_MEM_TASKS; const int chunk = r / 48, rem = r % 48; sb_task(p, rem / 6, rem % 6, chunk, lane); }
    }
}
DI void phase3b(const Params& p) {
    const int lane = threadIdx.x & 63;
    unsigned* ctr = (unsigned*)(p.ws + WS_CTL) + 128;
    for (;;) {
        unsigned tk = 0; if (lane == 0) tk = atomicAdd(ctr, 1u);
        const int task = (int)__builtin_amdgcn_readfirstlane(tk);
        if (task >= N_NSA_TASKS) break;
        const int chunk = 127 - task / 48, rem = task % 48; nsa_main_task(p, rem / 6, rem % 6, chunk, lane);
    }
}

DI void phase4(const Params& p, bf16_t* lds) {
    unsigned char* ws = p.ws;
    const int lane = threadIdx.x & 63, wid = threadIdx.x >> 6, wr = wid >> 2, wc = wid & 3, fr = lane & 15, fq = lane >> 4;
    const bf16_t* cat = (const bf16_t*)(ws + WS_H); const bf16_t* gates = (const bf16_t*)(ws + WS_GATES); bf16_t* merged = (bf16_t*)(ws + WS_MERGED);
    const int ntn = 8, ntiles = 256 * 8;
    for (int tile = blockIdx.x; tile < ntiles; tile += gridDim.x) {
        int pm, pn; tile_coords(tile, ntn, pm, pn);
        f32x4 msum[4][2]; zero_acc(msum);
#pragma unroll
        for (int br = 0; br < 3; ++br) {
            const int kofs = br == 0 ? 0 : (br == 1 ? 384 : 768), Kb = br == 2 ? 256 : 384;
            const bf16_t* Bt = (const bf16_t*)(ws + (br == 0 ? WS_WSB : (br == 1 ? WS_WNSA : WS_WMEM)));
            f32x4 acc[4][2]; zero_acc(acc);
            gemm_mainloop(cat + (size_t)pm * 128 * D + kofs, D, Bt + (size_t)pn * 128 * Kb, Kb, Kb, acc, lds);
#pragma unroll
            for (int m = 0; m < 4; ++m)
#pragma unroll
                for (int n = 0; n < 2; ++n) { const int row = pm * 128 + wr * 64 + m * 16 + fr, col = pn * 128 + wc * 32 + n * 16 + fq * 4;
                    const u32x2 gw = *(const u32x2*)(gates + (size_t)row * LDG + br * 1024 + col);
                    msum[m][n].x += bflo(gw.x) * acc[m][n].x; msum[m][n].y += bfhi(gw.x) * acc[m][n].y; msum[m][n].z += bflo(gw.y) * acc[m][n].z; msum[m][n].w += bfhi(gw.y) * acc[m][n].w; }
        }
#pragma unroll
        for (int m = 0; m < 4; ++m)
#pragma unroll
            for (int n = 0; n < 2; ++n) { const int row = pm * 128 + wr * 64 + m * 16 + fr, col = pn * 128 + wc * 32 + n * 16 + fq * 4; store_bf16x4(merged + (size_t)row * D + col, msum[m][n]); }
    }
}

DI void phase5(const Params& p, bf16_t* lds) {
    unsigned char* ws = p.ws;
    const int lane = threadIdx.x & 63, wid = threadIdx.x >> 6, wr = wid >> 2, wc = wid & 3, fr = lane & 15, fq = lane >> 4;
    const bf16_t* A = (const bf16_t*)(ws + WS_MERGED); const bf16_t* Bt = (const bf16_t*)(ws + WS_WOUT);
    const float* x = p.in[0]; const float* gf = p.in[15]; float* x2 = p.out; bf16_t* h2 = (bf16_t*)(ws + WS_H2); float* rowss = (float*)(ws + WS_ROWSS);
    const int ntn = 8, ntiles = 256 * 8;
    for (int tile = blockIdx.x; tile < ntiles; tile += gridDim.x) {
        int pm, pn; tile_coords(tile, ntn, pm, pn);
        f32x4 acc[4][2]; zero_acc(acc);
        gemm_mainloop(A + (size_t)pm * 128 * D, D, Bt + (size_t)pn * 128 * D, D, D, acc, lds);
#pragma unroll
        for (int m = 0; m < 4; ++m) {
            const int row = pm * 128 + wr * 64 + m * 16 + fr; float ss = 0.f;
#pragma unroll
            for (int n = 0; n < 2; ++n) { const int col = pn * 128 + wc * 32 + n * 16 + fq * 4;
                const f32x4 xv = *(const f32x4*)(x + (size_t)row * D + col); const f32x4 gg = *(const f32x4*)(gf + col);
                f32x4 v = acc[m][n] + xv; *(f32x4*)(x2 + (size_t)row * D + col) = v;
                ss += (v.x * v.x + v.y * v.y) + (v.z * v.z + v.w * v.w);
                v.x *= gg.x; v.y *= gg.y; v.z *= gg.z; v.w *= gg.w; store_bf16x4(h2 + (size_t)row * D + col, v); }
            ss += __shfl_xor(ss, 16); ss += __shfl_xor(ss, 32);
            if (fq == 0) rowss[(size_t)row * 32 + pn * 4 + wc] = ss;
        }
    }
}

DI void phase6(const Params& p, bf16_t* lds) {
    unsigned char* ws = p.ws;
    const int lane = threadIdx.x & 63, wid = threadIdx.x >> 6, wr = wid >> 2, wc = wid & 3, fr = lane & 15, fq = lane >> 4;
    const bf16_t* A = (const bf16_t*)(ws + WS_H2); const bf16_t* Bt = (const bf16_t*)(ws + WS_WQ); bf16_t* qp = (bf16_t*)(ws + WS_QP);
    const int ntn = 16, ntiles = 256 * 16;
    for (int tile = blockIdx.x; tile < ntiles; tile += gridDim.x) {
        int pm, pn; tile_coords(tile, ntn, pm, pn);
        f32x4 acc[4][2]; zero_acc(acc);
        gemm_mainloop(A + (size_t)pm * 128 * D, D, Bt + (size_t)pn * 128 * D, D, D, acc, lds);
#pragma unroll
        for (int m = 0; m < 4; ++m)
#pragma unroll
            for (int n = 0; n < 2; ++n) { const int row = pm * 128 + wr * 64 + m * 16 + fr, col = pn * 128 + wc * 32 + n * 16 + fq * 4; store_bf16x4(qp + (size_t)row * 2048 + col, acc[m][n]); }
    }
}

DI float row_rstd(const float* rowss, size_t tok) {
    const f32x4* r = (const f32x4*)(rowss + tok * 32); float s = 0.f;
#pragma unroll
    for (int i = 0; i < 8; ++i) { const f32x4 v = r[i]; s += (v.x + v.y) + (v.z + v.w); }
    return 1.0f / sqrtf(s * (1.0f / D) + RMS_EPS);
}
constexpr int ROUTE_LDS_PER_WAVE = (2 * 16 * 32 * 2 + 16 * 32) * 4;
DI void route_task(const Params& p, int chunk, int head, int lane, float* wl) {
    unsigned char* ws = p.ws;
    const int r32 = lane & 31, hi = lane >> 5; const size_t tok = (size_t)chunk * 32 + r32;
    const bf16_t* qp = (const bf16_t*)(ws + WS_QP) + tok * 2048 + head * 256;
    const bf16_t* subk = (const bf16_t*)(ws + WS_SUBK) + (size_t)head * 2 * 128 * 128;
    float* tvl = wl; int* til = (int*)(wl + 2 * 16 * 32); float* bl = wl + 4 * 16 * 32;
#pragma unroll 1
    for (int pp = 0; pp < 2; ++pp) {
        f32x16 sc[4];
#pragma unroll
        for (int tl = 0; tl < 4; ++tl) zero16(sc[tl]);
#pragma unroll
        for (int ks = 0; ks < 8; ++ks) {
            const bf16x8 qv = *(const bf16x8*)(qp + pp * 128 + ks * 16 + hi * 8);
#pragma unroll
            for (int tl = 0; tl < 4; ++tl) { const bf16x8 a = *(const bf16x8*)(subk + (size_t)(pp * 128 + tl * 32 + r32) * 128 + ks * 16 + hi * 8); sc[tl] = MFMA32(a, qv, sc[tl]); }
        }
#pragma unroll 1
        for (int round = 0; round < 16; ++round) {
            float bv = -3.0e38f; int bi = 1000;
#pragma unroll
            for (int tl = 0; tl < 4; ++tl)
#pragma unroll
                for (int r = 0; r < 16; ++r) { const bool better = sc[tl][r] > bv; bv = better ? sc[tl][r] : bv; bi = better ? (tl * 32 + krow(r, hi)) : bi; }
            const float pv = __shfl_xor(bv, 32); const int pi = __shfl_xor(bi, 32);
            const bool mine = (bv > pv) || (bv == pv && bi < pi);
            if (hi == 0) { tvl[(pp * 16 + round) * 32 + r32] = mine ? bv : pv; til[(pp * 16 + round) * 32 + r32] = mine ? bi : pi; }
            const int kill = mine ? bi : -1;
#pragma unroll
            for (int tl = 0; tl < 4; ++tl)
#pragma unroll
                for (int r = 0; r < 16; ++r) sc[tl][r] = ((tl * 32 + krow(r, hi)) == kill) ? -3.0e38f : sc[tl][r];
        }
    }
    __builtin_amdgcn_wave_barrier();
    float t0[16], t1[16];
#pragma unroll
    for (int k = 0; k < 16; ++k) { t0[k] = tvl[k * 32 + r32]; t1[k] = tvl[(16 + k) * 32 + r32]; }
    float cv[50];
    {
        int c = 0;
#pragma unroll
        for (int a = 0; a < 16; ++a)
#pragma unroll
            for (int bb = 0; bb < 16; ++bb) if ((a + 1) * (bb + 1) <= 16) { cv[c] = t0[a] + t1[bb]; ++c; }
    }
    int* ip = (int*)(ws + WS_IDX) + tok * 128 + head * 16;
#pragma unroll 1
    for (int round = 0; round < 16; ++round) {
        float bv = -3.0e38f; int bcode = 0;
        {
            int c = 0;
#pragma unroll
            for (int a = 0; a < 16; ++a)
#pragma unroll
                for (int bb = 0; bb < 16; ++bb) if ((a + 1) * (bb + 1) <= 16) { const bool better = cv[c] > bv; bv = better ? cv[c] : bv; bcode = better ? (a * 16 + bb) : bcode; ++c; }
        }
        {
            int c = 0;
#pragma unroll
            for (int a = 0; a < 16; ++a)
#pragma unroll
                for (int bb = 0; bb < 16; ++bb) if ((a + 1) * (bb + 1) <= 16) { cv[c] = (bcode == a * 16 + bb) ? -3.0e38f : cv[c]; ++c; }
        }
        const int e = til[(bcode >> 4) * 32 + r32] * 128 + til[(16 + (bcode & 15)) * 32 + r32];
        if (hi == 0) { bl[round * 32 + r32] = bv; ip[round] = e; }
    }
    __builtin_amdgcn_wave_barrier();
    const float rstd = row_rstd((const float*)(ws + WS_ROWSS), tok);
    float den = 0.f; float gg[16]; const float b0 = bl[r32];
#pragma unroll
    for (int k = 0; k < 16; ++k) { gg[k] = fexp((bl[k * 32 + r32] - b0) * rstd); den += gg[k]; }
    const float inv = 1.0f / den;
    if (hi == 1) { float* gp = (float*)(ws + WS_GW) + tok * 128 + head * 16;
#pragma unroll
        for (int k = 0; k < 16; k += 4) { f32x4 v = {gg[k] * inv, gg[k + 1] * inv, gg[k + 2] * inv, gg[k + 3] * inv}; *(f32x4*)(gp + k) = v; } }
    __builtin_amdgcn_wave_barrier();
}
DI void phase7(const Params& p, bf16_t* lds) {
    const int lane = threadIdx.x & 63, wid = threadIdx.x >> 6;
    const int gwave = blockIdx.x * NWAVES + wid, nwaves = gridDim.x * NWAVES;
    float* wl = (float*)((unsigned char*)lds + wid * ROUTE_LDS_PER_WAVE);
    for (int task = gwave; task < (NTOK / 32) * 8; task += nwaves) route_task(p, task >> 3, task & 7, lane, wl);
}

DI float gelu_exact(float a) { return 0.5f * a * (1.0f + erff(a * 0.70710678118654752f)); }
DI void phase8(const Params& p) {
    unsigned char* ws = p.ws;
    const int lane = threadIdx.x & 63, wid = threadIdx.x >> 6;
    const int gwave = blockIdx.x * NWAVES + wid, nwaves = gridDim.x * NWAVES;
    const bf16_t* h2 = (const bf16_t*)(ws + WS_H2); const bf16_t* tu = (const bf16_t*)(ws + WS_TABU); const bf16_t* tvv = (const bf16_t*)(ws + WS_TABV);
    const int* idx = (const int*)(ws + WS_IDX); const float* gw = (const float*)(ws + WS_GW);
    const float* gfin = p.in[20];
    for (int tk = gwave; tk < NTOK; tk += nwaves) {
        const size_t tok = (size_t)tk;
        const float rstd = row_rstd((const float*)(ws + WS_ROWSS), tok);
        float hn[16];
        { const u32x4 a = *(const u32x4*)(h2 + tok * D + lane * 8); const u32x4 b = *(const u32x4*)(h2 + tok * D + 512 + lane * 8);
          hn[0] = bflo(a.x) * rstd; hn[1] = bfhi(a.x) * rstd; hn[2] = bflo(a.y) * rstd; hn[3] = bfhi(a.y) * rstd; hn[4] = bflo(a.z) * rstd; hn[5] = bfhi(a.z) * rstd; hn[6] = bflo(a.w) * rstd; hn[7] = bfhi(a.w) * rstd;
          hn[8] = bflo(b.x) * rstd; hn[9] = bfhi(b.x) * rstd; hn[10] = bflo(b.y) * rstd; hn[11] = bfhi(b.y) * rstd; hn[12] = bflo(b.z) * rstd; hn[13] = bfhi(b.z) * rstd; hn[14] = bflo(b.w) * rstd; hn[15] = bfhi(b.w) * rstd; }
        float acc[16];
#pragma unroll
        for (int i = 0; i < 16; ++i) acc[i] = 0.f;
        const int e_lo = idx[tok * 128 + lane], e_hi = idx[tok * 128 + 64 + lane];
        const float g_lo = gw[tok * 128 + lane], g_hi = gw[tok * 128 + 64 + lane];
        for (int hk0 = 0; hk0 < 128; hk0 += 8) {
            u32x4 ua[8], ub[8], va[8], vb[8]; float gk[8];
#pragma unroll
            for (int j = 0; j < 8; ++j) { const int hk = hk0 + j; const int e = hk < 64 ? __shfl(e_lo, hk) : __shfl(e_hi, hk - 64); gk[j] = hk < 64 ? __shfl(g_lo, hk) : __shfl(g_hi, hk - 64);
                const bf16_t* ur = tu + (size_t)e * D; const bf16_t* vr = tvv + (size_t)e * D;
                ua[j] = *(const u32x4*)(ur + lane * 8); ub[j] = *(const u32x4*)(ur + 512 + lane * 8); va[j] = *(const u32x4*)(vr + lane * 8); vb[j] = *(const u32x4*)(vr + 512 + lane * 8); }
#pragma unroll
            for (int j = 0; j < 8; ++j) {
                float d = bflo(ua[j].x) * hn[0] + bfhi(ua[j].x) * hn[1] + bflo(ua[j].y) * hn[2] + bfhi(ua[j].y) * hn[3] + bflo(ua[j].z) * hn[4] + bfhi(ua[j].z) * hn[5] + bflo(ua[j].w) * hn[6] + bfhi(ua[j].w) * hn[7]
                        + bflo(ub[j].x) * hn[8] + bfhi(ub[j].x) * hn[9] + bflo(ub[j].y) * hn[10] + bfhi(ub[j].y) * hn[11] + bflo(ub[j].z) * hn[12] + bfhi(ub[j].z) * hn[13] + bflo(ub[j].w) * hn[14] + bfhi(ub[j].w) * hn[15];
                d = wave_sum(d);
                const float w = gk[j] * gelu_exact(d);
                acc[0] += w * bflo(va[j].x); acc[1] += w * bfhi(va[j].x); acc[2] += w * bflo(va[j].y); acc[3] += w * bfhi(va[j].y); acc[4] += w * bflo(va[j].z); acc[5] += w * bfhi(va[j].z); acc[6] += w * bflo(va[j].w); acc[7] += w * bfhi(va[j].w);
                acc[8] += w * bflo(vb[j].x); acc[9] += w * bfhi(vb[j].x); acc[10] += w * bflo(vb[j].y); acc[11] += w * bfhi(vb[j].y); acc[12] += w * bflo(vb[j].z); acc[13] += w * bfhi(vb[j].z); acc[14] += w * bflo(vb[j].w); acc[15] += w * bfhi(vb[j].w);
            }
        }
        float* orow = p.out + tok * D;
        f32x4 y[4]; float ss = 0.f;
#pragma unroll
        for (int q = 0; q < 4; ++q) { const int c = (q >> 1) * 512 + lane * 8 + (q & 1) * 4; f32x4 v = *(const f32x4*)(orow + c);
            v.x += acc[q * 4]; v.y += acc[q * 4 + 1]; v.z += acc[q * 4 + 2]; v.w += acc[q * 4 + 3]; y[q] = v; ss += (v.x * v.x + v.y * v.y) + (v.z * v.z + v.w * v.w); }
        const float rs = 1.0f / sqrtf(wave_sum(ss) * (1.0f / D) + RMS_EPS);
#pragma unroll
        for (int q = 0; q < 4; ++q) { const int c = (q >> 1) * 512 + lane * 8 + (q & 1) * 4; const f32x4 gg = *(const f32x4*)(gfin + c); f32x4 v = y[q];
            v.x *= rs * gg.x; v.y *= rs * gg.y; v.z *= rs * gg.z; v.w *= rs * gg.w; *(f32x4*)(orow + c) = v; }
    }
}

constexpr int N_PHASES = 10;
__global__ void __launch_bounds__(NTHREADS) mega(Params p) {
    extern __shared__ __attribute__((aligned(16))) unsigned char lds_raw[];
    bf16_t* lds = (bf16_t*)lds_raw;
#if N_LAUNCH_MODE == 1
    cg::grid_group grid = cg::this_grid();
#define SEAM(k) do { if (p.ph_lo <= (k) && (k) + 1 < p.ph_hi) grid.sync(); } while (0)
#else
#define SEAM(k) do { } while (0)
#endif
#ifndef PHASE_MASK
#define PHASE_MASK 0x3ff
#endif
#define IN(k) (((PHASE_MASK >> (k)) & 1) && p.ph_lo <= (k) && (k) < p.ph_hi)
    if (IN(0)) phase0(p);
    SEAM(0);
    if (IN(1)) phase1(p, lds);
    SEAM(1);
    if (IN(2)) phase2(p, lds);
    SEAM(2);
    if (IN(3)) phase3a(p);
    SEAM(3);
    if (IN(4)) phase3b(p);
    SEAM(4);
    if (IN(5)) phase4(p, lds);
    SEAM(5);
    if (IN(6)) phase5(p, lds);
    SEAM(6);
    if (IN(7)) phase6(p, lds);
    SEAM(7);
    if (IN(8)) phase7(p, lds);
    SEAM(8);
    if (IN(9)) phase8(p);
}

extern "C" void kernel_launch(void* const* d_in, const int* in_sizes, int n_in, void* d_out, int out_size, void* d_ws, size_t ws_size, hipStream_t stream) {
    static int grid = 0;
    if (grid == 0) {
        if (n_in != 21 || out_size != NTOK * D || ws_size < WS_END) { fprintf(stderr, "kernel_launch: unexpected shapes: n_in %d out %d ws %zu\n", n_in, out_size, ws_size); grid = -1; return; }
        int dev = 0, cus = 0, per_cu = 0;
        hipGetDevice(&dev);
        hipDeviceGetAttribute(&cus, hipDeviceAttributeMultiprocessorCount, dev);
        hipFuncSetAttribute((const void*)mega, hipFuncAttributeMaxDynamicSharedMemorySize, LDS_BYTES);
        hipOccupancyMaxActiveBlocksPerMultiprocessor(&per_cu, (const void*)mega, NTHREADS, LDS_BYTES);
        if (per_cu < 1) per_cu = 1;
        if (per_cu > 1) per_cu = 1;
        grid = cus * per_cu;
    }
    if (grid < 0) return;
    hipMemsetAsync((char*)d_ws + WS_CTL, 0, 4096, stream);
    Params p{};
    for (int i = 0; i < 21; ++i) p.in[i] = (const float*)d_in[i];
    p.out = (float*)d_out; p.ws = (unsigned char*)d_ws;
#if N_LAUNCH_MODE == 1
    p.ph_lo = 0; p.ph_hi = N_PHASES;
    void* args[] = {&p};
    hipError_t e = hipLaunchCooperativeKernel((const void*)mega, dim3(grid), dim3(NTHREADS), args, LDS_BYTES, stream);
    if (e != hipSuccess) fprintf(stderr, "cooperative launch failed: %s (grid %d)\n", hipGetErrorString(e), grid);
#else
    for (int ph = 0; ph < N_PHASES; ++ph) { p.ph_lo = ph; p.ph_hi = ph + 1; hipLaunchKernelGGL(mega, dim3(grid), dim3(NTHREADS), LDS_BYTES, stream, p); }
#endif
}
```

```cpp
#include <hip/hip_runtime.h>
#include <hip/hip_cooperative_groups.h>
#include <cstdio>
#include <cstdint>
namespace cg = cooperative_groups;

#ifndef N_LAUNCH_MODE
#define N_LAUNCH_MODE 1
#endif

#define REP0 1
#define REP1 1
#define REP2 1
#define REP3 1
#define REP4 1
#define REP5 1
#define REP6 1
#define REP7 1
#define REP8 1
#define REP9 1
#define REP10 1

typedef unsigned short bf16_t;
typedef short bf16x8 __attribute__((ext_vector_type(8)));
typedef short s16x4 __attribute__((ext_vector_type(4)));
typedef float f32x2 __attribute__((ext_vector_type(2)));
typedef float f32x4 __attribute__((ext_vector_type(4)));
typedef float f32x16 __attribute__((ext_vector_type(16)));
typedef unsigned u32x2 __attribute__((ext_vector_type(2)));
typedef unsigned u32x4 __attribute__((ext_vector_type(4)));
typedef int i32x4 __attribute__((ext_vector_type(4)));
typedef __bf16 bf16x2_t __attribute__((ext_vector_type(2)));
#define DI __device__ __forceinline__
#define LAS __attribute__((address_space(3)))

constexpr int NB = 8, T = 4096, D = 1024, NTOK = NB * T;
constexpr int MEMT = 256;
constexpr int NTHREADS = 512, NWAVES = 8;
constexpr int LDP_QKV = 2560;
constexpr int C_SBQ = 0, C_SBK = 384, C_SBV = 768, C_NQ = 1152, C_NKV = 1536, C_MQ = 2304;
constexpr int LDG = 3072;
constexpr int NPROJ = 5888;
constexpr int IN_DIM = 5650;
constexpr float RMS_EPS = 1e-6f;
constexpr float LOG2E = 1.4426950408889634f, LN2 = 0.6931471805599453f;

constexpr size_t MiB = 1u << 20;
constexpr size_t WS_CTL = 0;
constexpr size_t WS_WIN = 1 * MiB;
constexpr size_t WS_WQ = WS_WIN + 12 * MiB;
constexpr size_t WS_WOUT = WS_WQ + 4 * MiB;
constexpr size_t WS_WSB = WS_WOUT + 2 * MiB;
constexpr size_t WS_WNSA = WS_WSB + 1 * MiB;
constexpr size_t WS_WMEM = WS_WNSA + 1 * MiB;
constexpr size_t WS_WMKV = WS_WMEM + 1 * MiB;
constexpr size_t WS_SUBK = WS_WMKV + 1 * MiB;
constexpr size_t WS_CMPW = WS_SUBK + MiB / 2;
constexpr size_t WS_H = 24 * MiB;
constexpr size_t WS_QKV = 88 * MiB;
constexpr size_t WS_MERGED = WS_QKV;
constexpr size_t WS_IDX = WS_QKV + 64 * MiB;
constexpr size_t WS_GW = WS_QKV + 80 * MiB;
constexpr size_t WS_ROWSS = WS_QKV + 96 * MiB;
constexpr size_t WS_GATES = 248 * MiB;
constexpr size_t WS_H2 = WS_GATES;
constexpr size_t WS_QP = WS_GATES + 64 * MiB;
constexpr size_t WS_TABU = 440 * MiB;
constexpr size_t WS_TABV = 456 * MiB;
constexpr size_t WS_PD = WS_GATES + 64 * MiB;
constexpr size_t WS_WPEER = WS_QKV;
constexpr size_t WS_SS = WS_QKV + 32 * MiB;
constexpr size_t WS_X3 = WS_H2;
constexpr size_t WS_H8 = 344 * MiB;
constexpr size_t WS_HSC = 376 * MiB;
constexpr size_t WS_W8 = 377 * MiB;
constexpr size_t WS_W8SC = 384 * MiB;
constexpr size_t WS_WMKV8 = 385 * MiB;
constexpr size_t WS_MEMN8 = 387 * MiB;
constexpr size_t WS_TSCALE = 472 * MiB;
constexpr size_t WS_END = 504 * MiB;
constexpr size_t DO_VSLC = 0;
constexpr size_t DO_VWIN = 8 * MiB;
constexpr size_t DO_SBV = 16 * MiB;
constexpr size_t DO_KC = 40 * MiB;
constexpr size_t DO_VCT = 41 * MiB;
constexpr size_t DO_MEMN = 42 * MiB;
constexpr size_t DO_MKV = 46 * MiB;
constexpr size_t DO_MVT = 48 * MiB;
constexpr size_t DO_NSAG = 50 * MiB;
constexpr size_t DO_SELM = 54 * MiB;
constexpr size_t DO_OC = 56 * MiB;
constexpr size_t DO_KSLC = 80 * MiB;
constexpr size_t DO_KWIN = 88 * MiB;
constexpr size_t DO_MKT = 120 * MiB;
constexpr size_t DO_SBK = 96 * MiB;

constexpr int LDS_MAIN = 131072;
constexpr int LDS_BYTES = 163840;

struct Params {
    const float* in[21];
    float* out;
    unsigned char* ws;
    int ph_lo, ph_hi;
};

DI unsigned f2bf(float f) { unsigned u = __float_as_uint(f); return (u + 0x7fffu + ((u >> 16) & 1u)) >> 16; }
DI unsigned pk2(float lo, float hi) { f32x2 v = {lo, hi}; bf16x2_t b = __builtin_convertvector(v, bf16x2_t); return __builtin_bit_cast(unsigned, b); }
DI float bf2f(unsigned short h) { return __uint_as_float((unsigned)h << 16); }
DI float bflo(unsigned w) { return __uint_as_float(w << 16); }
DI float bfhi(unsigned w) { return __uint_as_float(w & 0xffff0000u); }
DI float wave_sum(float v) {
#pragma unroll
    for (int o = 1; o < 64; o <<= 1) v += __shfl_xor(v, o);
    return v;
}
DI float fexp2(float x) { return __builtin_amdgcn_exp2f(x); }
DI float flog2(float x) { return __builtin_amdgcn_logf(x); }
DI float fexp(float x) { return __builtin_amdgcn_exp2f(x * LOG2E); }
DI float sigmoidf_(float x) { return 1.0f / (1.0f + fexp(-x)); }
DI int krow(int r, int hi) { return (r & 3) + 8 * (r >> 2) + 4 * hi; }
#define MFMA32(a, b, c) __builtin_amdgcn_mfma_f32_32x32x16_bf16((a), (b), (c), 0, 0, 0)
#define MFMA16(a, b, c) __builtin_amdgcn_mfma_f32_16x16x32_bf16((a), (b), (c), 0, 0, 0)

DI void zero16(f32x16& v) {
#pragma unroll
    for (int i = 0; i < 16; ++i) v[i] = 0.f;
}
DI unsigned pack_i8x4(float a, float b, float c, float d) {
    const int ia = (int)__builtin_rintf(a), ib = (int)__builtin_rintf(b), ic = (int)__builtin_rintf(c), id = (int)__builtin_rintf(d);
    return ((unsigned)ia & 0xffu) | (((unsigned)ib & 0xffu) << 8) | (((unsigned)ic & 0xffu) << 16) | ((unsigned)id << 24);
}
DI float wave_max(float v) {
#pragma unroll
    for (int o = 1; o < 64; o <<= 1) v = fmaxf(v, __shfl_xor(v, o));
    return v;
}
DI void rms_row_i8(const float* xrow, const float* g, unsigned* o8row, float* scale, int lane) {
    const f32x4* xr = (const f32x4*)xrow + lane;
    const f32x4* gr = (const f32x4*)g + lane;
    f32x4 v[4]; float s = 0.f;
#pragma unroll
    for (int j = 0; j < 4; ++j) { v[j] = xr[64 * j]; s += (v[j].x * v[j].x + v[j].y * v[j].y) + (v[j].z * v[j].z + v[j].w * v[j].w); }
    const float rstd = 1.0f / sqrtf(wave_sum(s) * (1.0f / D) + RMS_EPS);
    float am = 0.f;
#pragma unroll
    for (int j = 0; j < 4; ++j) { const f32x4 gg = gr[64 * j]; v[j].x *= rstd * gg.x; v[j].y *= rstd * gg.y; v[j].z *= rstd * gg.z; v[j].w *= rstd * gg.w;
        am = fmaxf(am, fmaxf(fmaxf(fabsf(v[j].x), fabsf(v[j].y)), fmaxf(fabsf(v[j].z), fabsf(v[j].w)))); }
    am = wave_max(am);
    const float qs = am > 0.f ? 127.0f / am : 0.f;
#pragma unroll
    for (int j = 0; j < 4; ++j) o8row[lane + 64 * j] = pack_i8x4(v[j].x * qs, v[j].y * qs, v[j].z * qs, v[j].w * qs);
    if (lane == 0) scale[0] = am * (1.0f / 127.0f);
}
template <bool MAP> DI void quant_cols_i8(const float* W, int ldw, int ncol, unsigned char* dst8, float* dsc, float* red) {
    const int c = threadIdx.x & 15, kg = threadIdx.x >> 4;
    for (int cb = blockIdx.x; cb < ncol / 16; cb += gridDim.x) {
        const int col = cb * 16 + c; int srcc = col;
        if (MAP) { if (col < 2304) srcc = col; else if (col < 2560) srcc = 2322 + (col - 2304); else if (col < 5632) srcc = 2578 + (col - 2560); else if (col < 5650) srcc = 2304 + (col - 5632); else srcc = -1; }
        const float* src = W + (size_t)(kg * 32) * ldw + (srcc < 0 ? 0 : srcc);
        float v[32]; float am = 0.f;
#pragma unroll
        for (int i = 0; i < 32; ++i) { v[i] = srcc < 0 ? 0.f : src[(size_t)i * ldw]; am = fmaxf(am, fabsf(v[i])); }
        __syncthreads();
        red[kg * 16 + c] = am;
        __syncthreads();
#pragma unroll
        for (int i = 0; i < 32; ++i) am = fmaxf(am, red[i * 16 + c]);
        const float qs = am > 0.f ? 127.0f / am : 0.f;
        u32x4 w0, w1;
        w0.x = pack_i8x4(v[0] * qs, v[1] * qs, v[2] * qs, v[3] * qs); w0.y = pack_i8x4(v[4] * qs, v[5] * qs, v[6] * qs, v[7] * qs); w0.z = pack_i8x4(v[8] * qs, v[9] * qs, v[10] * qs, v[11] * qs); w0.w = pack_i8x4(v[12] * qs, v[13] * qs, v[14] * qs, v[15] * qs);
        w1.x = pack_i8x4(v[16] * qs, v[17] * qs, v[18] * qs, v[19] * qs); w1.y = pack_i8x4(v[20] * qs, v[21] * qs, v[22] * qs, v[23] * qs); w1.z = pack_i8x4(v[24] * qs, v[25] * qs, v[26] * qs, v[27] * qs); w1.w = pack_i8x4(v[28] * qs, v[29] * qs, v[30] * qs, v[31] * qs);
        u32x4* dst = (u32x4*)(dst8 + (size_t)col * 1024 + kg * 32); dst[0] = w0; dst[1] = w1;
        if (kg == 0) dsc[col] = am * (1.0f / 127.0f);
    }
}
DI void rms_row_bf16(const float* xrow, const float* g, bf16_t* orow, int lane) {
    const f32x4* xr = (const f32x4*)xrow + lane;
    const f32x4* gr = (const f32x4*)g + lane;
    f32x4 v[4]; float s = 0.f;
#pragma unroll
    for (int j = 0; j < 4; ++j) { v[j] = xr[64 * j]; s += (v[j].x * v[j].x + v[j].y * v[j].y) + (v[j].z * v[j].z + v[j].w * v[j].w); }
    const float rstd = 1.0f / sqrtf(wave_sum(s) * (1.0f / D) + RMS_EPS);
    u32x2* o8 = (u32x2*)orow + lane;
#pragma unroll
    for (int j = 0; j < 4; ++j) { const f32x4 gg = gr[64 * j]; u32x2 w; w.x = pk2(v[j].x * rstd * gg.x, v[j].y * rstd * gg.y); w.y = pk2(v[j].z * rstd * gg.z, v[j].w * rstd * gg.w); o8[64 * j] = w; }
}
DI void transpose_w(const float* W, int K, int N, bf16_t* Wt, int gtid, int gthreads, float sc = 1.0f) {
    const int total = (K / 8) * N;
    for (int it = gtid; it < total; it += gthreads) {
        const int n = it % N, k8 = it / N;
        const float* s = W + (size_t)(k8 * 8) * N + n;
        u32x4 o; o.x = pk2(s[0] * sc, s[(size_t)N] * sc); o.y = pk2(s[(size_t)2 * N] * sc, s[(size_t)3 * N] * sc); o.z = pk2(s[(size_t)4 * N] * sc, s[(size_t)5 * N] * sc); o.w = pk2(s[(size_t)6 * N] * sc, s[(size_t)7 * N] * sc);
        *(u32x4*)(Wt + (size_t)n * K + k8 * 8) = o;
    }
}
DI void late_weights(const Params& p, int gtid, int gthreads) {
    unsigned char* ws = p.ws;
    transpose_w(p.in[16], D, 2048, (bf16_t*)(ws + WS_WQ), gtid, gthreads);
    transpose_w(p.in[14], D, D, (bf16_t*)(ws + WS_WOUT), gtid, gthreads);
    transpose_w(p.in[11], 384, D, (bf16_t*)(ws + WS_WSB), gtid, gthreads, 1.0f / 255.0f);
    transpose_w(p.in[12], 384, D, (bf16_t*)(ws + WS_WNSA), gtid, gthreads, 1.0f / 255.0f);
    transpose_w(p.in[13], 256, D, (bf16_t*)(ws + WS_WMEM), gtid, gthreads, 1.0f / 255.0f);
    transpose_w(p.in[8], 2048, 64, (bf16_t*)(ws + WS_CMPW), gtid, gthreads);
    transpose_w(p.in[9], 2048, 64, (bf16_t*)(ws + WS_CMPW) + 64 * 2048, gtid, gthreads);
    {
        const f32x4* s = (const f32x4*)p.in[17]; u32x2* o = (u32x2*)(ws + WS_SUBK);
        for (int i = gtid; i < 8 * 2 * 128 * 128 / 4; i += gthreads) { const f32x4 v = s[i]; u32x2 w; w.x = pk2(v.x, v.y); w.y = pk2(v.z, v.w); o[i] = w; }
    }
}
DI void phase0(const Params& p, unsigned char* lds_raw_) {
    const int gtid = blockIdx.x * NTHREADS + threadIdx.x, gthreads = gridDim.x * NTHREADS;
    const int lane = threadIdx.x & 63, gwave = gtid >> 6, nwaves = gthreads >> 6;
    unsigned char* ws = p.ws;
    quant_cols_i8<true>(p.in[4], IN_DIM, NPROJ, ws + WS_W8, (float*)(ws + WS_W8SC), (float*)lds_raw_);
    quant_cols_i8<false>(p.in[10], 512, 512, ws + WS_WMKV8, (float*)(ws + WS_WMKV8 + MiB), (float*)lds_raw_);
    for (int row = gwave; row < NTOK; row += nwaves) rms_row_i8(p.in[0] + (size_t)row * D, p.in[2], (unsigned*)(ws + WS_H8) + (size_t)row * (D / 4), (float*)(ws + WS_HSC) + row, lane);
    for (int row = gwave; row < NB * MEMT; row += nwaves) rms_row_i8(p.in[1] + (size_t)row * D, p.in[3], (unsigned*)(ws + WS_MEMN8) + (size_t)row * (D / 4), (float*)(ws + WS_MEMN8 + 2 * MiB) + row, lane);
}
DI void peer_table_rows(const Params& p, int lane, int first, int stride) {
    unsigned char* ws = p.ws;
    unsigned char* tabu = ws + WS_TABU; unsigned char* tabv = ws + WS_TABV; float* tsc = (float*)(ws + WS_TSCALE);
#pragma unroll 1
    for (int row0 = first; row0 < 32768; row0 += 4 * stride) {
        f32x4 v[4][4];
#pragma unroll
        for (int q = 0; q < 4; ++q) { const int row = row0 + q * stride < 32768 ? row0 + q * stride : row0; const bool isv = row >= 16384; const int e = row & 16383;
            const f32x4* src = (const f32x4*)((isv ? p.in[19] : p.in[18]) + (size_t)e * 1024 + lane * 16);
#pragma unroll
            for (int j = 0; j < 4; ++j) v[q][j] = src[j]; }
#pragma unroll
        for (int q = 0; q < 4; ++q) { const int row = row0 + q * stride; const bool isv = row >= 16384; const int e = row & 16383;
            float am = 0.f;
#pragma unroll
            for (int j = 0; j < 4; ++j) am = fmaxf(am, fmaxf(fmaxf(fabsf(v[q][j].x), fabsf(v[q][j].y)), fmaxf(fabsf(v[q][j].z), fabsf(v[q][j].w))));
#pragma unroll
            for (int o = 1; o < 64; o <<= 1) am = fmaxf(am, __shfl_xor(am, o));
            const float sc = am > 0.f ? 240.0f / am : 1.0f;
            u32x4 w;
#pragma unroll
            for (int j = 0; j < 4; ++j) { int t = __builtin_amdgcn_cvt_pk_fp8_f32(v[q][j].x * sc, v[q][j].y * sc, 0, false); t = __builtin_amdgcn_cvt_pk_fp8_f32(v[q][j].z * sc, v[q][j].w * sc, t, true); w[j] = (unsigned)t; }
            if (row < 32768) { *(u32x4*)((isv ? tabv : tabu) + (size_t)(lane >> 3) * (16384 * 128) + (size_t)e * 128 + (lane & 7) * 16) = w;
                if (lane == 0) tsc[row] = am > 0.f ? am * (1.0f / 240.0f) : 1.0f; }
        }
    }
}

constexpr int GEMM_LDS_ROW = 72;
constexpr int GEMM_TILE_ELEMS = 128 * GEMM_LDS_ROW;
DI void gemm_mainloop(const bf16_t* __restrict__ Ag, int lda, const bf16_t* __restrict__ Bg, int ldb, int K, f32x4 (&acc)[4][2], bf16_t* lds) {
    const int tid = threadIdx.x, lane = tid & 63, wid = tid >> 6, wr = wid >> 2, wc = wid & 3;
    const int r0 = tid >> 3, kc = tid & 7;
    const bf16_t* ap0 = Ag + (size_t)r0 * lda + kc * 8; const bf16_t* ap1 = ap0 + (size_t)64 * lda;
    const bf16_t* bp0 = Bg + (size_t)r0 * ldb + kc * 8; const bf16_t* bp1 = bp0 + (size_t)64 * ldb;
    const int so0 = r0 * GEMM_LDS_ROW + kc * 8, so1 = so0 + 64 * GEMM_LDS_ROW;
    u32x4 ra0, ra1, rb0, rb1;
    ra0 = *(const u32x4*)ap0; ra1 = *(const u32x4*)ap1; rb0 = *(const u32x4*)bp0; rb1 = *(const u32x4*)bp1;
    __syncthreads();
    {
        bf16_t* As = lds; bf16_t* Bs = lds + GEMM_TILE_ELEMS;
        *(u32x4*)(As + so0) = ra0; *(u32x4*)(As + so1) = ra1; *(u32x4*)(Bs + so0) = rb0; *(u32x4*)(Bs + so1) = rb1;
    }
    __syncthreads();
    const int nk = K / 64;
    const int fr = lane & 15, fq = lane >> 4;
    for (int kt = 0; kt < nk; ++kt) {
        const int buf = kt & 1;
        if (kt + 1 < nk) { const int ko = (kt + 1) * 64; ra0 = *(const u32x4*)(ap0 + ko); ra1 = *(const u32x4*)(ap1 + ko); rb0 = *(const u32x4*)(bp0 + ko); rb1 = *(const u32x4*)(bp1 + ko); }
        const bf16_t* As = lds + buf * 2 * GEMM_TILE_ELEMS; const bf16_t* Bs = As + GEMM_TILE_ELEMS;
#pragma unroll
        for (int kk = 0; kk < 2; ++kk) {
            bf16x8 af[4], bfr[2];
#pragma unroll
            for (int m = 0; m < 4; ++m) af[m] = *(const bf16x8*)(As + (wr * 64 + m * 16 + fr) * GEMM_LDS_ROW + kk * 32 + fq * 8);
#pragma unroll
            for (int n = 0; n < 2; ++n) bfr[n] = *(const bf16x8*)(Bs + (wc * 32 + n * 16 + fr) * GEMM_LDS_ROW + kk * 32 + fq * 8);
#pragma unroll
            for (int m = 0; m < 4; ++m)
#pragma unroll
                for (int n = 0; n < 2; ++n) acc[m][n] = MFMA16(bfr[n], af[m], acc[m][n]);
        }
        if (kt + 1 < nk) {
            bf16_t* An = lds + (buf ^ 1) * 2 * GEMM_TILE_ELEMS; bf16_t* Bn = An + GEMM_TILE_ELEMS;
            *(u32x4*)(An + so0) = ra0; *(u32x4*)(An + so1) = ra1; *(u32x4*)(Bn + so0) = rb0; *(u32x4*)(Bn + so1) = rb1;
        }
        __syncthreads();
    }
}
DI void zero_acc(f32x4 (&acc)[4][2]) {
#pragma unroll
    for (int m = 0; m < 4; ++m)
#pragma unroll
        for (int n = 0; n < 2; ++n) acc[m][n] = (f32x4){0.f, 0.f, 0.f, 0.f};
}
DI void tile_coords(int tile, int ntn, int& pm, int& pn) { const int per = 8 * ntn, g = tile / per, r = tile % per; pm = g * 8 + (r & 7); pn = r >> 3; }
DI void store_bf16x4(bf16_t* p, f32x4 v) { u32x2 w; w.x = pk2(v.x, v.y); w.y = pk2(v.z, v.w); *(u32x2*)p = w; }

namespace pg8 {
#define PG8_LAS __attribute__((address_space(3)))
typedef short bf16x8 __attribute__((ext_vector_type(8)));
typedef float f32x4 __attribute__((ext_vector_type(4)));
typedef unsigned u32x4 __attribute__((ext_vector_type(4)));
typedef int i32x4v __attribute__((ext_vector_type(4)));
constexpr int BM = 256, BK = 64, HALF = 128, HTB = HALF * BK * 2  , STAGE_BYTES = 8 * HTB, NXCD = 8, WGM = 8;

__host__ __device__ __forceinline__ int lds_byte(int r, int c) { const int st = (r >> 4) * 2 + (c >> 5), rr = r & 15, cc = c & 31, ob = rr * 64 + cc * 2; return st * 1024 + (ob ^ (((ob >> 9) & 1) << 5)); }
__host__ __device__ __forceinline__ void stage_rc(int b, int& R, int& C) { const int st = b / 1024, sb = b % 1024, swz = sb ^ (((sb >> 9) & 1) << 5); R = (st >> 1) * 16 + swz / 64; C = (st & 1) * 32 + (swz % 64) / 2; }
__host__ __device__ __forceinline__ int perm32(int rho) { const int n = rho >> 4, i = rho & 15; return 8 * (i >> 2) + 4 * n + (i & 3); }

struct Unit { int pm, pn; };
struct Gemm { const bf16_t* A; const bf16_t* Bt; int M, N, K, lda, ldb; };

struct StaticOrder {
    int nM, nN, nwg, G, c;
    __host__ __device__ void init(int M, int N, int G_, int c_) { nM = M / BM; nN = N / BM; nwg = nM * nN; G = G_; c = c_; }
    __host__ __device__ bool next(int i, Unit& u) const {
        const long L = (long)i * G + c; if (L >= nwg) return false;
        int wgid = (int)L; { const int q = nwg / NXCD, r = nwg % NXCD, xcd = wgid % NXCD, off = wgid / NXCD; wgid = (xcd < r ? xcd * (q + 1) : r * (q + 1) + (xcd - r) * q) + off; }
        const int nig = WGM * nN, gid = wgid / nig, fm = gid * WGM, gsz = (nM - fm) < WGM ? (nM - fm) : WGM;
        u.pm = fm + ((wgid % nig) % gsz); u.pn = (wgid % nig) / gsz; return true;
    }
    __device__ __forceinline__ void a_ready(const Unit&) const {}
    __device__ __forceinline__ void done(const Unit&) const {}
};


template <class Epi, class Sched, bool ALIGN_EPI = false, bool SP2 = false, bool I8 = false>
__device__ __forceinline__ void gemm_phase(PG8_LAS unsigned char* lds, const Gemm g, const Sched& S, const Epi& E) {
    const int tid = threadIdx.x, wid = __builtin_amdgcn_readfirstlane(tid >> 6), lane = tid & 63, wr = wid >> 2, wc = wid & 3, fr = lane & 15, fq = lane >> 4;
    const int K = g.K, nt = K / BK;
    unsigned voffA[2], voffB[2];
#pragma unroll
    for (int i = 0; i < 2; ++i) { int R, C; stage_rc(tid * 16 + i * 8192, R, C); const int Rb = Epi::PERM ? ((R & ~31) + perm32(R & 31)) : R;
        voffA[i] = (unsigned)(R * g.lda + C) * 2u; voffB[i] = (unsigned)(Rb * g.ldb + C) * 2u; }
    const size_t kstep = (size_t)(BK * 2);
    const size_t hstepA = (size_t)HALF * g.lda * 2, hstepB = (size_t)HALF * g.ldb * 2;
    const size_t tstepA = 2 * hstepA, tstepB = 2 * hstepB;
    const unsigned ldsw = (unsigned)wid * 1024u;
    const int aoff = lds_byte(wr * 64 + fr, fq * 8), boff = lds_byte(wc * 32 + fr, fq * 8);
#define PG8_SA(b, h) (((b) * 2 + (h)) * HTB)
#define PG8_SB(b, h) ((4 + (b) * 2 + (h)) * HTB)
#define PG8_STAGE(bufoff, gbase, voff) do { _Pragma("unroll") for (int _i = 0; _i < 2; ++_i) \
        __builtin_amdgcn_global_load_lds((const unsigned*)((const char*)(gbase) + (voff)[_i]), (PG8_LAS unsigned*)(lds + (bufoff) + ldsw + _i * 8192), 16, 0, 0); } while (0)
#define PG8_LDA(dst, b, h) do { _Pragma("unroll") for (int m = 0; m < 4; ++m) _Pragma("unroll") for (int k = 0; k < 2; ++k) dst[m][k] = *(const PG8_LAS bf16x8*)(lds + PG8_SA(b, h) + aoff + m * 2048 + k * 1024); } while (0)
#define PG8_LDB(dst, b, h) do { _Pragma("unroll") for (int n = 0; n < 2; ++n) _Pragma("unroll") for (int k = 0; k < 2; ++k) dst[n][k] = *(const PG8_LAS bf16x8*)(lds + PG8_SB(b, h) + boff + n * 2048 + k * 1024); } while (0)
#define PG8_MMA(ai, bj, At, Bt) do { __builtin_amdgcn_s_setprio(1); _Pragma("unroll") for (int m = 0; m < 4; ++m) _Pragma("unroll") for (int n = 0; n < 2; ++n) _Pragma("unroll") for (int k = 0; k < 2; ++k) \
        { if constexpr (I8) acc[ai][bj][m][n] = __builtin_bit_cast(f32x4, __builtin_amdgcn_mfma_i32_16x16x64_i8(__builtin_bit_cast(i32x4v, Bt[n][k]), __builtin_bit_cast(i32x4v, At[m][k]), __builtin_bit_cast(i32x4v, acc[ai][bj][m][n]), 0, 0, 0)); \
          else acc[ai][bj][m][n] = __builtin_amdgcn_mfma_f32_16x16x32_bf16(Bt[n][k], At[m][k], acc[ai][bj][m][n], 0, 0, 0); } __builtin_amdgcn_s_setprio(0); } while (0)
#define PG8_WAIT_V(n) asm volatile("s_waitcnt vmcnt(" #n ")" ::: "memory")
#define PG8_WAIT_L(n) asm volatile("s_waitcnt lgkmcnt(" #n ")" ::: "memory")
#define PG8_BAR __builtin_amdgcn_s_barrier()
#define PG8_SCHED __builtin_amdgcn_sched_barrier(0)
    Unit cur, nxt; int ui = 0;
    if (!S.next(0, cur)) return;
    f32x4 acc[2][2][4][2];
    if constexpr (Epi::INIT) E.init(acc, cur, wr, wc, fr, fq);
    else {
#pragma unroll
    for (int a = 0; a < 2; ++a)
#pragma unroll
        for (int b = 0; b < 2; ++b)
#pragma unroll
            for (int m = 0; m < 4; ++m)
#pragma unroll
                for (int n = 0; n < 2; ++n) acc[a][b][m][n] = (f32x4){0.f, 0.f, 0.f, 0.f};
    }
    bf16x8 At[4][2], B0[2][2], B1[2][2];
    const char* cA = (const char*)g.A + (size_t)cur.pm * tstepA; const char* cB = (const char*)g.Bt + (size_t)cur.pn * tstepB;
    S.a_ready(cur);
    if constexpr (SP2) {
        PG8_STAGE(PG8_SB(0, 0), cB, voffB); PG8_STAGE(PG8_SB(0, 1), cB + hstepB, voffB); PG8_STAGE(PG8_SA(0, 0), cA, voffA); PG8_STAGE(PG8_SA(0, 1), cA + hstepA, voffA);
        if (wr == 1) PG8_BAR;
        PG8_WAIT_V(2); PG8_BAR;
        PG8_STAGE(PG8_SB(1, 0), cB + kstep, voffB); PG8_STAGE(PG8_SA(1, 0), cA + kstep, voffA); PG8_STAGE(PG8_SB(1, 1), cB + hstepB + kstep, voffB);
        PG8_WAIT_V(6); PG8_BAR;
    } else {
        PG8_STAGE(PG8_SB(0, 0), cB, voffB); PG8_STAGE(PG8_SA(0, 0), cA, voffA); PG8_STAGE(PG8_SB(0, 1), cB + hstepB, voffB); PG8_STAGE(PG8_SA(0, 1), cA + hstepA, voffA);
        if (wr == 1) PG8_BAR;
        PG8_WAIT_V(4); PG8_BAR;
        PG8_STAGE(PG8_SB(1, 0), cB + kstep, voffB); PG8_STAGE(PG8_SA(1, 0), cA + kstep, voffA); PG8_STAGE(PG8_SB(1, 1), cB + hstepB + kstep, voffB);
        PG8_WAIT_V(6); PG8_BAR;
    }
    for (;;) {
        const bool has_next = S.next(ui + 1, nxt);
        const char* nA = has_next ? (const char*)g.A + (size_t)nxt.pm * tstepA : cA; const char* nB = has_next ? (const char*)g.Bt + (size_t)nxt.pn * tstepB : cB;
        for (int t = 0; t < nt; t += 2) {
            const bool last = (t == nt - 2);
            const char* a1 = cA + (size_t)(t + 1) * kstep;
            const char* a2 = last ? nA : cA + (size_t)(t + 2) * kstep; const char* b2 = last ? nB : cB + (size_t)(t + 2) * kstep;
            const char* a3 = a2 + kstep; const char* b3 = b2 + kstep;
            if (last && has_next) S.a_ready(nxt);
            if constexpr (SP2) {
            PG8_LDB(B0, 0, 0); PG8_LDB(B1, 0, 1); PG8_SCHED; PG8_LDA(At, 0, 0); PG8_STAGE(PG8_SA(1, 1), a1 + hstepA, voffA);
            PG8_WAIT_V(8); PG8_WAIT_L(0); PG8_BAR; PG8_MMA(0, 0, At, B0); PG8_MMA(0, 1, At, B1); PG8_BAR; PG8_SCHED;
            PG8_LDA(At, 0, 1); PG8_STAGE(PG8_SB(0, 0), b2, voffB); PG8_STAGE(PG8_SB(0, 1), b2 + hstepB, voffB); PG8_STAGE(PG8_SA(0, 0), a2, voffA);
            PG8_WAIT_V(8); PG8_WAIT_L(0); PG8_BAR; PG8_MMA(1, 0, At, B0); PG8_MMA(1, 1, At, B1); PG8_BAR; PG8_SCHED;
            PG8_LDB(B0, 1, 0); PG8_LDB(B1, 1, 1); PG8_SCHED; PG8_LDA(At, 1, 0); PG8_STAGE(PG8_SA(0, 1), a2 + hstepA, voffA);
            PG8_WAIT_V(8); PG8_WAIT_L(0); PG8_BAR; PG8_MMA(0, 0, At, B0); PG8_MMA(0, 1, At, B1); PG8_BAR; PG8_SCHED;
            PG8_LDA(At, 1, 1); PG8_STAGE(PG8_SB(1, 0), b3, voffB); PG8_STAGE(PG8_SB(1, 1), b3 + hstepB, voffB); PG8_STAGE(PG8_SA(1, 0), a3, voffA);
            PG8_WAIT_V(8); PG8_WAIT_L(0); PG8_BAR; PG8_MMA(1, 0, At, B0); PG8_MMA(1, 1, At, B1); PG8_BAR; PG8_SCHED;
            } else {
            PG8_LDB(B0, 0, 0); PG8_SCHED; PG8_LDA(At, 0, 0); PG8_STAGE(PG8_SA(1, 1), a1 + hstepA, voffA);
            PG8_WAIT_L(8); PG8_BAR; PG8_WAIT_L(0); PG8_MMA(0, 0, At, B0); PG8_BAR; PG8_SCHED;
            PG8_LDB(B1, 0, 1); PG8_STAGE(PG8_SB(0, 0), b2, voffB);
            PG8_BAR; PG8_WAIT_L(0); PG8_MMA(0, 1, At, B1); PG8_BAR;
            PG8_LDA(At, 0, 1); PG8_STAGE(PG8_SA(0, 0), a2, voffA);
            PG8_BAR; PG8_WAIT_L(0); PG8_MMA(1, 0, At, B0); PG8_BAR; PG8_SCHED;
            PG8_STAGE(PG8_SB(0, 1), b2 + hstepB, voffB);
            PG8_WAIT_V(6); PG8_BAR; PG8_MMA(1, 1, At, B1); PG8_BAR;
            PG8_LDB(B0, 1, 0); PG8_SCHED; PG8_LDA(At, 1, 0); PG8_STAGE(PG8_SA(0, 1), a2 + hstepA, voffA);
            PG8_WAIT_L(8); PG8_BAR; PG8_WAIT_L(0); PG8_MMA(0, 0, At, B0); PG8_BAR; PG8_SCHED;
            PG8_LDB(B1, 1, 1); PG8_STAGE(PG8_SB(1, 0), b3, voffB);
            PG8_BAR; PG8_WAIT_L(0); PG8_MMA(0, 1, At, B1); PG8_BAR;
            PG8_LDA(At, 1, 1); PG8_STAGE(PG8_SA(1, 0), a3, voffA);
            PG8_BAR; PG8_WAIT_L(0); PG8_MMA(1, 0, At, B0); PG8_BAR; PG8_SCHED;
            PG8_STAGE(PG8_SB(1, 1), b3 + hstepB, voffB);
            PG8_WAIT_V(6); PG8_BAR; PG8_MMA(1, 1, At, B1); PG8_BAR;
            }
        }
        if constexpr (ALIGN_EPI) { if (wr == 0) PG8_BAR; }
        if constexpr (!Epi::AFTER_DRAIN) { E(acc, cur, wr, wc, fr, fq); S.done(cur); }
        if (!has_next) break;
        if constexpr (Epi::INIT) E.init(acc, nxt, wr, wc, fr, fq);
        else {
#pragma unroll
        for (int a = 0; a < 2; ++a)
#pragma unroll
            for (int b = 0; b < 2; ++b)
#pragma unroll
                for (int m = 0; m < 4; ++m)
#pragma unroll
                    for (int n = 0; n < 2; ++n) acc[a][b][m][n] = (f32x4){0.f, 0.f, 0.f, 0.f};
        }
        cur = nxt; cA = nA; cB = nB; ++ui;
        if constexpr (ALIGN_EPI) { if (wr == 1) PG8_BAR; }
    }
    PG8_WAIT_V(0);
    if constexpr (!ALIGN_EPI) { if (wr == 0) PG8_BAR; }
    PG8_BAR;
    if constexpr (Epi::AFTER_DRAIN) { E.fused(acc, cur, wr, wc, fr, fq, lds, wid, lane); S.done(cur); }
#undef PG8_SA
#undef PG8_SB
#undef PG8_STAGE
#undef PG8_LDA
#undef PG8_LDB
#undef PG8_MMA
#undef PG8_WAIT_V
#undef PG8_WAIT_L
#undef PG8_BAR
#undef PG8_SCHED
}
}

namespace pg8 {
__device__ __forceinline__ unsigned pkbf(float lo, float hi) { f32x2 v = {lo, hi}; bf16x2_t b = __builtin_convertvector(v, bf16x2_t); return __builtin_bit_cast(unsigned, b); }
__device__ __forceinline__ u32x4 pack8bf(const f32x4& v0, const f32x4& v1) { u32x4 w; w.x = pkbf(v0[0], v0[1]); w.y = pkbf(v0[2], v0[3]); w.z = pkbf(v1[0], v1[1]); w.w = pkbf(v1[2], v1[3]); return w; }
__device__ __forceinline__ float sigm(float x) { return __builtin_amdgcn_rcpf(1.0f + __builtin_amdgcn_exp2f(-x * 1.4426950408889634f)); }
__device__ __forceinline__ float sigm255_1(float a, float nb) { const float e = __builtin_amdgcn_exp2f(__builtin_fmaf(a, -1.4426950408889634f, nb)); return __builtin_amdgcn_rcpf(__builtin_fmaf(e, 1.0f / 255.0f, 1.0f / 255.0f)); }
__device__ __forceinline__ f32x4 sigm255(f32x4 a, f32x4 nb) { f32x4 r; r[0] = sigm255_1(a[0], nb[0]); r[1] = sigm255_1(a[1], nb[1]); r[2] = sigm255_1(a[2], nb[2]); r[3] = sigm255_1(a[3], nb[3]); return r; }
__device__ __forceinline__ f32x4 sigm4(f32x4 v) { v[0] = sigm(v[0]); v[1] = sigm(v[1]); v[2] = sigm(v[2]); v[3] = sigm(v[3]); return v; }
struct EpiProj8 { static constexpr bool PERM = true, AFTER_DRAIN = false, INIT = false;
    ::bf16_t* qkv; unsigned char* gates; float* nsag; const float* bm; const float* hsc; const float* wsc;
    __device__ __forceinline__ void operator()(const f32x4 (&acc)[2][2][4][2], const Unit& u, int wr, int wc, int fr, int fq) const {
        const int row0 = u.pm * BM + wr * 64 + fr, colb = u.pn * BM + wc * 32 + 8 * fq;
        f32x4 cs[2][2];
#pragma unroll
        for (int bj = 0; bj < 2; ++bj)
#pragma unroll
            for (int n = 0; n < 2; ++n) cs[bj][n] = *(const f32x4*)(wsc + colb + bj * HALF + n * 4);
        if (u.pn < 10) {
#pragma unroll
            for (int ai = 0; ai < 2; ++ai)
#pragma unroll
                for (int m = 0; m < 4; ++m) { const size_t row = (size_t)(row0 + ai * HALF + m * 16); const float rs = hsc[row];
#pragma unroll
                    for (int bj = 0; bj < 2; ++bj) { f32x4 v[2];
#pragma unroll
                        for (int n = 0; n < 2; ++n) { const i32x4v ia = __builtin_bit_cast(i32x4v, acc[ai][bj][m][n]);
                            v[n][0] = (float)ia[0] * rs * cs[bj][n][0]; v[n][1] = (float)ia[1] * rs * cs[bj][n][1]; v[n][2] = (float)ia[2] * rs * cs[bj][n][2]; v[n][3] = (float)ia[3] * rs * cs[bj][n][3]; }
                        *(u32x4*)(qkv + row * 2560 + colb + bj * HALF) = pack8bf(v[0], v[1]); } }
        } else if (u.pn < 22) {
            f32x4 bb[2][2];
#pragma unroll
            for (int bj = 0; bj < 2; ++bj)
#pragma unroll
                for (int n = 0; n < 2; ++n) { bb[bj][n] = *(const f32x4*)(bm + colb + bj * HALF + n * 4 - 2560) * -1.4426950408889634f; cs[bj][n] *= -1.4426950408889634f; }
#pragma unroll
            for (int ai = 0; ai < 2; ++ai)
#pragma unroll
                for (int m = 0; m < 4; ++m) { const size_t row = (size_t)(row0 + ai * HALF + m * 16); const float rs = hsc[row];
#pragma unroll
                    for (int bj = 0; bj < 2; ++bj) { const int c = colb + bj * HALF - 2560;
                        u32x2 w;
#pragma unroll
                        for (int n = 0; n < 2; ++n) { const i32x4v ia = __builtin_bit_cast(i32x4v, acc[ai][bj][m][n]); float r[4];
#pragma unroll
                            for (int j = 0; j < 4; ++j) { const float e = __builtin_amdgcn_exp2f(__builtin_fmaf((float)ia[j] * rs, cs[bj][n][j], bb[bj][n][j])); r[j] = __builtin_amdgcn_rcpf(__builtin_fmaf(e, 1.0f / 255.0f, 1.0f / 255.0f)); }
                            const unsigned pk = __builtin_amdgcn_cvt_pk_u8_f32(r[3], 3, __builtin_amdgcn_cvt_pk_u8_f32(r[2], 2, __builtin_amdgcn_cvt_pk_u8_f32(r[1], 1, __builtin_amdgcn_cvt_pk_u8_f32(r[0], 0, 0u))));
                            if (n == 0) w.x = pk; else w.y = pk; }
                        *(u32x2*)(gates + row * 3072 + c) = w; } }
        } else {
#pragma unroll
            for (int ai = 0; ai < 2; ++ai)
#pragma unroll
                for (int m = 0; m < 4; ++m) { const size_t row = (size_t)(row0 + ai * HALF + m * 16); const float rs = hsc[row];
                    const int c = colb - 5632; if (c < 32) {
#pragma unroll
                        for (int n = 0; n < 2; ++n) { const i32x4v ia = __builtin_bit_cast(i32x4v, acc[ai][0][m][n]);
                            f32x4 v = {(float)ia[0] * rs * cs[0][n][0], (float)ia[1] * rs * cs[0][n][1], (float)ia[2] * rs * cs[0][n][2], (float)ia[3] * rs * cs[0][n][3]};
                            *(f32x4*)(nsag + row * 32 + c + n * 4) = sigm4(v); } } }
        }
    }
};
struct EpiPlain8 { static constexpr bool PERM = true, AFTER_DRAIN = false, INIT = false;
    ::bf16_t* O; int ldc; const float* hsc; const float* wsc;
    __device__ __forceinline__ void operator()(const f32x4 (&acc)[2][2][4][2], const Unit& u, int wr, int wc, int fr, int fq) const {
        const int row0 = u.pm * BM + wr * 64 + fr, colb = u.pn * BM + wc * 32 + 8 * fq;
        f32x4 cs[2][2];
#pragma unroll
        for (int bj = 0; bj < 2; ++bj)
#pragma unroll
            for (int n = 0; n < 2; ++n) cs[bj][n] = *(const f32x4*)(wsc + colb + bj * HALF + n * 4);
#pragma unroll
        for (int ai = 0; ai < 2; ++ai)
#pragma unroll
            for (int m = 0; m < 4; ++m) { const size_t row = (size_t)(row0 + ai * HALF + m * 16); const float rs = hsc[row];
#pragma unroll
                for (int bj = 0; bj < 2; ++bj) { f32x4 v[2];
#pragma unroll
                    for (int n = 0; n < 2; ++n) { const i32x4v ia = __builtin_bit_cast(i32x4v, acc[ai][bj][m][n]);
                        v[n][0] = (float)ia[0] * rs * cs[bj][n][0]; v[n][1] = (float)ia[1] * rs * cs[bj][n][1]; v[n][2] = (float)ia[2] * rs * cs[bj][n][2]; v[n][3] = (float)ia[3] * rs * cs[bj][n][3]; }
                    *(u32x4*)(O + row * ldc + colb + bj * HALF) = pack8bf(v[0], v[1]); } }
    }
};
struct EpiPlain { static constexpr bool PERM = true, AFTER_DRAIN = false, INIT = false;
    ::bf16_t* O; int ldc;
    __device__ __forceinline__ void operator()(const f32x4 (&acc)[2][2][4][2], const Unit& u, int wr, int wc, int fr, int fq) const {
        const int row0 = u.pm * BM + wr * 64 + fr;
#pragma unroll
        for (int ai = 0; ai < 2; ++ai)
#pragma unroll
            for (int m = 0; m < 4; ++m) { const size_t row = (size_t)(row0 + ai * HALF + m * 16);
#pragma unroll
                for (int bj = 0; bj < 2; ++bj) { const int col8 = u.pn * BM + bj * HALF + wc * 32 + 8 * fq; *(u32x4*)(O + row * ldc + col8) = pack8bf(acc[ai][bj][m][0], acc[ai][bj][m][1]); } }
    }
};
struct EpiMerge { static constexpr bool PERM = true, AFTER_DRAIN = false, INIT = false;
    ::bf16_t* merged; const ::bf16_t* gates; int br;
    __device__ __forceinline__ void operator()(const f32x4 (&acc)[2][2][4][2], const Unit& u, int wr, int wc, int fr, int fq) const {
        const int row0 = u.pm * BM + wr * 64 + fr, colb = u.pn * BM + wc * 32 + 8 * fq;
        u32x2 gw[2][4][2];
#pragma unroll
        for (int ai = 0; ai < 2; ++ai)
#pragma unroll
            for (int m = 0; m < 4; ++m)
#pragma unroll
                for (int bj = 0; bj < 2; ++bj) gw[ai][m][bj] = *(const u32x2*)((const unsigned char*)gates + (size_t)(row0 + ai * HALF + m * 16) * 3072 + br * 1024 + colb + bj * HALF);
#pragma unroll
        for (int ai = 0; ai < 2; ++ai) {
            u32x4 old[4][2];
            if (br != 0) {
#pragma unroll
                for (int m = 0; m < 4; ++m)
#pragma unroll
                    for (int bj = 0; bj < 2; ++bj) old[m][bj] = *(const u32x4*)(merged + (size_t)(row0 + ai * HALF + m * 16) * 1024 + colb + bj * HALF);
            }
#pragma unroll
            for (int m = 0; m < 4; ++m)
#pragma unroll
                for (int bj = 0; bj < 2; ++bj) {
                    const u32x2 g2 = gw[ai][m][bj];
                    f32x4 v0 = acc[ai][bj][m][0], v1 = acc[ai][bj][m][1];
                    v0[0] *= (float)(g2.x & 0xffu); v0[1] *= (float)((g2.x >> 8) & 0xffu); v0[2] *= (float)((g2.x >> 16) & 0xffu); v0[3] *= (float)(g2.x >> 24);
                    v1[0] *= (float)(g2.y & 0xffu); v1[1] *= (float)((g2.y >> 8) & 0xffu); v1[2] *= (float)((g2.y >> 16) & 0xffu); v1[3] *= (float)(g2.y >> 24);
                    if (br != 0) { const u32x4 o = old[m][bj];
                        v0[0] += __uint_as_float(o.x << 16); v0[1] += __uint_as_float(o.x & 0xffff0000u); v0[2] += __uint_as_float(o.y << 16); v0[3] += __uint_as_float(o.y & 0xffff0000u);
                        v1[0] += __uint_as_float(o.z << 16); v1[1] += __uint_as_float(o.z & 0xffff0000u); v1[2] += __uint_as_float(o.w << 16); v1[3] += __uint_as_float(o.w & 0xffff0000u); }
                    *(u32x4*)(merged + (size_t)(row0 + ai * HALF + m * 16) * 1024 + colb + bj * HALF) = pack8bf(v0, v1); }
            asm volatile("" ::: "memory");
        }
    }
};
struct EpiOut { static constexpr bool PERM = false, AFTER_DRAIN = false, INIT = true;
    const float* x; const float* gf; float* x2; ::bf16_t* h2; float* rowss;
    __device__ __forceinline__ void init(f32x4 (&acc)[2][2][4][2], const Unit& u, int wr, int wc, int fr, int fq) const {
        const int row0 = u.pm * BM + wr * 64 + fr, colb = u.pn * BM + wc * 32 + 4 * fq;
#pragma unroll
        for (int ai = 0; ai < 2; ++ai)
#pragma unroll
            for (int bj = 0; bj < 2; ++bj)
#pragma unroll
                for (int m = 0; m < 4; ++m)
#pragma unroll
                    for (int n = 0; n < 2; ++n) acc[ai][bj][m][n] = *(const f32x4*)(x + (size_t)(row0 + ai * HALF + m * 16) * 1024 + colb + bj * HALF + n * 16);
    }
    __device__ __forceinline__ void operator()(const f32x4 (&acc)[2][2][4][2], const Unit& u, int wr, int wc, int fr, int fq) const {
        const int row0 = u.pm * BM + wr * 64 + fr, colb = u.pn * BM + wc * 32 + 4 * fq;
        f32x4 gg[2][2];
#pragma unroll
        for (int bj = 0; bj < 2; ++bj)
#pragma unroll
            for (int n = 0; n < 2; ++n) gg[bj][n] = *(const f32x4*)(gf + colb + bj * HALF + n * 16);
#pragma unroll
        for (int ai = 0; ai < 2; ++ai)
#pragma unroll
            for (int m = 0; m < 4; ++m) { const size_t row = (size_t)(row0 + ai * HALF + m * 16);
#pragma unroll
                for (int bj = 0; bj < 2; ++bj) { float ss = 0.f;
#pragma unroll
                    for (int n = 0; n < 2; ++n) { const int col = colb + bj * HALF + n * 16;
                        const f32x4 v = acc[ai][bj][m][n]; *(f32x4*)(x2 + row * 1024 + col) = v;
                        ss += (v[0] * v[0] + v[1] * v[1]) + (v[2] * v[2] + v[3] * v[3]);
                        const f32x4 g4 = gg[bj][n]; u32x2 w; w.x = pkbf(v[0] * g4[0], v[1] * g4[1]); w.y = pkbf(v[2] * g4[2], v[3] * g4[3]); *(u32x2*)(h2 + row * 1024 + col) = w; }
                    ss += __shfl_xor(ss, 16); ss += __shfl_xor(ss, 32);
                    if (fq == 0) rowss[row * 32 + u.pn * 8 + bj * 4 + wc] = ss; } }
    }
};
}

#define GEMM_PHASE(EPI, g, S, E) pg8::gemm_phase<EPI, pg8::StaticOrder, true, true>((PG8_LAS unsigned char*)lds, g, S, E)
DI void phase1(const Params& p, bf16_t* lds) {
    unsigned char* ws = p.ws;
    {
        pg8::Gemm g{(const bf16_t*)(ws + WS_H8), (const bf16_t*)(ws + WS_W8), NTOK, NPROJ, D / 2, D / 2, D / 2};
        pg8::StaticOrder S; S.init(NTOK, NPROJ, (int)gridDim.x, (int)blockIdx.x);
        pg8::EpiProj8 E{(bf16_t*)(ws + WS_QKV), ws + WS_GATES, (float*)((unsigned char*)p.out + DO_NSAG), p.in[5], (const float*)(ws + WS_HSC), (const float*)(ws + WS_W8SC)};
        pg8::gemm_phase<pg8::EpiProj8, pg8::StaticOrder, true, true, true>((PG8_LAS unsigned char*)lds, g, S, E);
    }
    {
        pg8::Gemm g{(const bf16_t*)(ws + WS_MEMN8), (const bf16_t*)(ws + WS_WMKV8), NB * MEMT, 512, D / 2, D / 2, D / 2};
        const int cm = ((int)gridDim.x == 256 && blockIdx.x >= 128 && blockIdx.x < 144) ? (int)blockIdx.x - 128 : ((int)gridDim.x == 256 ? (1 << 20) : (int)blockIdx.x);
        pg8::StaticOrder S; S.init(NB * MEMT, 512, (int)gridDim.x, cm);
        pg8::EpiPlain8 E{(bf16_t*)((unsigned char*)p.out + DO_MKV), 512, (const float*)(ws + WS_MEMN8 + 2 * MiB), (const float*)(ws + WS_WMKV8 + MiB)};
        pg8::gemm_phase<pg8::EpiPlain8, pg8::StaticOrder, true, true, true>((PG8_LAS unsigned char*)lds, g, S, E);
    }
    if ((int)gridDim.x == 256) { if (blockIdx.x >= 144) late_weights(p, ((int)blockIdx.x - 144) * NTHREADS + (int)threadIdx.x, 112 * NTHREADS); }
    else late_weights(p, (int)(blockIdx.x * NTHREADS + threadIdx.x), (int)(gridDim.x * NTHREADS));
}
DI void transpose64(const bf16_t* src, size_t sp, bf16_t* dst, size_t dp, unsigned short* scr, int lane) {
#pragma unroll
    for (int i = 0; i < 8; ++i) { const int r = i * 8 + (lane >> 3), c8 = lane & 7; const u32x4 v = *(const u32x4*)(src + (size_t)r * sp + c8 * 8);
        unsigned short* s = scr + r * 66 + c8 * 8;
        s[0] = (unsigned short)(v.x & 0xffff); s[1] = (unsigned short)(v.x >> 16); s[2] = (unsigned short)(v.y & 0xffff); s[3] = (unsigned short)(v.y >> 16);
        s[4] = (unsigned short)(v.z & 0xffff); s[5] = (unsigned short)(v.z >> 16); s[6] = (unsigned short)(v.w & 0xffff); s[7] = (unsigned short)(v.w >> 16); }
    __builtin_amdgcn_s_waitcnt(0xc07f);
    __builtin_amdgcn_wave_barrier();
#pragma unroll
    for (int i = 0; i < 8; ++i) { const int c = i * 8 + (lane >> 3), r8 = lane & 7; const unsigned short* s = scr + (r8 * 8) * 66 + c;
        u32x4 o; o.x = (unsigned)s[0] | ((unsigned)s[66] << 16); o.y = (unsigned)s[2 * 66] | ((unsigned)s[3 * 66] << 16); o.z = (unsigned)s[4 * 66] | ((unsigned)s[5 * 66] << 16); o.w = (unsigned)s[6 * 66] | ((unsigned)s[7 * 66] << 16);
        *(u32x4*)(dst + (size_t)c * dp + r8 * 8) = o; }
    __builtin_amdgcn_s_waitcnt(0xc07f);
    __builtin_amdgcn_wave_barrier();
}
DI void transpose64_vtiles(const bf16_t* src, size_t sp, bf16_t* dst  , unsigned short* scr, int lane) {
#pragma unroll
    for (int i = 0; i < 8; ++i) { const int r = i * 8 + (lane >> 3), c8 = lane & 7; const u32x4 v = *(const u32x4*)(src + (size_t)r * sp + c8 * 8);
        unsigned short* sdst = scr + r * 66 + c8 * 8;
        sdst[0] = (unsigned short)(v.x & 0xffff); sdst[1] = (unsigned short)(v.x >> 16); sdst[2] = (unsigned short)(v.y & 0xffff); sdst[3] = (unsigned short)(v.y >> 16);
        sdst[4] = (unsigned short)(v.z & 0xffff); sdst[5] = (unsigned short)(v.z >> 16); sdst[6] = (unsigned short)(v.w & 0xffff); sdst[7] = (unsigned short)(v.w >> 16); }
    __builtin_amdgcn_s_waitcnt(0xc07f);
    __builtin_amdgcn_wave_barrier();
#pragma unroll
    for (int i = 0; i < 8; ++i) { const int d = i * 8 + (lane >> 3), r8 = lane & 7; const unsigned short* sp2 = scr + (r8 * 8) * 66 + d;
        u32x2 lo, hi2; lo.x = (unsigned)sp2[0] | ((unsigned)sp2[66] << 16); lo.y = (unsigned)sp2[2 * 66] | ((unsigned)sp2[3 * 66] << 16); hi2.x = (unsigned)sp2[4 * 66] | ((unsigned)sp2[5 * 66] << 16); hi2.y = (unsigned)sp2[6 * 66] | ((unsigned)sp2[7 * 66] << 16);
        const int half = r8 >> 2, q = 2 * (r8 & 3), msk = (d >> 2) & 7;
        unsigned char* tb = (unsigned char*)dst + half * 4096 + d * 64;
        *(u32x2*)(tb + ((q ^ msk) * 8)) = lo; *(u32x2*)(tb + (((q + 1) ^ msk) * 8)) = hi2; }
    __builtin_amdgcn_s_waitcnt(0xc07f);
    __builtin_amdgcn_wave_barrier();
}
DI void copy64_ktiles(const bf16_t* src, size_t sp, bf16_t* dst, int lane) {
#pragma unroll
    for (int i = 0; i < 8; ++i) { const int r = i * 8 + (lane >> 3), c8 = lane & 7; const u32x4 v = *(const u32x4*)(src + (size_t)r * sp + c8 * 8);
        const int rr = r & 31;
        *(u32x4*)((unsigned char*)dst + (r >> 5) * 4096 + rr * 128 + ((c8 ^ ((rr >> 1) & 7)) * 16)) = v; }
}
DI void phase2(const Params& p, bf16_t* lds) {
    unsigned char* ws = p.ws; unsigned char* dout = (unsigned char*)p.out;
    const int lane = threadIdx.x & 63, wid = threadIdx.x >> 6;
    const int gwave = blockIdx.x * NWAVES + wid, nwaves = gridDim.x * NWAVES;
    unsigned short* scr = (unsigned short*)lds + wid * (64 * 66);
    const bf16_t* qkv = (const bf16_t*)(ws + WS_QKV);
    const int n_items = 1024 + 1024 + 3072 + 128 + 1024 + 1024 + 3072;
    for (int it = gwave; it < n_items; it += nwaves) {
        if (it < 2048) { const int which = it >> 10, r = it & 1023, b = r >> 7, g = (r >> 6) & 1, tt = r & 63;
            const bf16_t* src = qkv + (size_t)(b * T + tt * 64) * LDP_QKV + C_NKV + (which ? 5 : 3) * 128 + g * 64;
            bf16_t* dst = (bf16_t*)(dout + (which ? DO_VWIN : DO_VSLC)) + ((size_t)(b * 2 + g) * 128 + tt * 2) * 2048;
            transpose64_vtiles(src, LDP_QKV, dst, scr, lane);
        } else if (it < 2048 + 3072) { const int r = it - 2048, b = r / 384, hh = (r / 64) % 6, tt = r & 63;
            const bf16_t* src = qkv + (size_t)(b * T + tt * 64) * LDP_QKV + C_SBV + hh * 64;
            bf16_t* dst = (bf16_t*)(dout + DO_SBV) + ((size_t)(b * 6 + hh) * 128 + tt * 2) * 2048;
            transpose64_vtiles(src, LDP_QKV, dst, scr, lane);
        } else if (it < 5248) { const int r = it - 5120, b = r >> 4, hh = (r >> 2) & 3, mt = r & 3;
            const bf16_t* srcv = (const bf16_t*)(dout + DO_MKV) + (size_t)(b * MEMT + mt * 64) * 512 + 256 + hh * 64;
            transpose64_vtiles(srcv, 512, (bf16_t*)(dout + DO_MVT) + ((size_t)(b * 4 + hh) * 8 + mt * 2) * 2048, scr, lane);
            copy64_ktiles(srcv - 256, 512, (bf16_t*)(dout + DO_MKT) + ((size_t)(b * 4 + hh) * 8 + mt * 2) * 2048, lane);
        } else if (it < 5248 + 2048) { const int r0 = it - 5248, which = r0 >> 10, r = r0 & 1023, b = r >> 7, g = (r >> 6) & 1, tt = r & 63;
            const bf16_t* src = qkv + (size_t)(b * T + tt * 64) * LDP_QKV + C_NKV + (which ? 4 : 2) * 128 + g * 64;
            bf16_t* dst = (bf16_t*)(dout + (which ? DO_KWIN : DO_KSLC)) + ((size_t)(b * 2 + g) * 128 + tt * 2) * 2048;
            copy64_ktiles(src, LDP_QKV, dst, lane);
        } else { const int r = it - 7296, b = r / 384, hh = (r / 64) % 6, tt = r & 63;
            const bf16_t* src = qkv + (size_t)(b * T + tt * 64) * LDP_QKV + C_SBK + hh * 64;
            bf16_t* dst = (bf16_t*)(dout + DO_SBK) + ((size_t)(b * 6 + hh) * 128 + tt * 2) * 2048;
            copy64_ktiles(src, LDP_QKV, dst, lane);
        }
    }
    __syncthreads();
    {
        bf16_t* kc = (bf16_t*)(dout + DO_KC); bf16_t* vct = (bf16_t*)(dout + DO_VCT);
        const int r32 = lane & 31, hi = lane >> 5;
        float* red = (float*)lds;
        for (int task = blockIdx.x; task < 2 * 16 * 8; task += gridDim.x) {
            const int which = task >> 7, bg = (task >> 3) & 15, chunk = task & 7, b = bg >> 1, g = bg & 1;
            const bf16_t* wt = (const bf16_t*)(ws + WS_CMPW) + (size_t)which * 64 * 2048;
            const float* pe = p.in[6 + which];
            const int n = chunk * 32 + r32;
            f32x16 acc[2]; zero16(acc[0]); zero16(acc[1]);
#pragma unroll
            for (int li = 0; li < 4; ++li) {
                const int l = wid * 4 + li; int token = 16 * n + l; if (token > T - 1) token = T - 1;
                const bf16_t* xr = qkv + (size_t)(b * T + token) * LDP_QKV + C_NKV + which * 128 + g * 64 + hi * 8;
#pragma unroll
                for (int ds = 0; ds < 4; ++ds) {
                    const bf16x8 xf = *(const bf16x8*)(xr + ds * 16);
                    const f32x4 p0 = *(const f32x4*)(pe + l * 64 + ds * 16 + hi * 8), p1 = *(const f32x4*)(pe + l * 64 + ds * 16 + hi * 8 + 4);
                    u32x4 pw; pw.x = pk2(p0.x, p0.y); pw.y = pk2(p0.z, p0.w); pw.z = pk2(p1.x, p1.y); pw.w = pk2(p1.z, p1.w);
                    const bf16x8 pf = __builtin_bit_cast(bf16x8, pw);
#pragma unroll
                    for (int eb = 0; eb < 2; ++eb) {
                        const bf16x8 wf = *(const bf16x8*)(wt + (size_t)(32 * eb + r32) * 2048 + l * 64 + ds * 16 + hi * 8);
                        if (which == 0) { acc[eb] = MFMA32(wf, xf, acc[eb]); acc[eb] = MFMA32(wf, pf, acc[eb]); }
                        else { acc[eb] = MFMA32(xf, wf, acc[eb]); acc[eb] = MFMA32(pf, wf, acc[eb]); }
                    }
                }
            }
#pragma unroll
            for (int eb = 0; eb < 2; ++eb)
#pragma unroll
                for (int r = 0; r < 16; ++r) red[(wid * 32 + eb * 16 + r) * 64 + lane] = acc[eb][r];
            __syncthreads();
            {
                const int eb = wid >> 2, mg = wid & 3;
                f32x4 v = {0.f, 0.f, 0.f, 0.f};
#pragma unroll
                for (int w2 = 0; w2 < 8; ++w2) { v.x += red[(w2 * 32 + eb * 16 + 4 * mg) * 64 + lane]; v.y += red[(w2 * 32 + eb * 16 + 4 * mg + 1) * 64 + lane]; v.z += red[(w2 * 32 + eb * 16 + 4 * mg + 2) * 64 + lane]; v.w += red[(w2 * 32 + eb * 16 + 4 * mg + 3) * 64 + lane]; }
                if (which == 0) {
                    if (n == 255) v = (f32x4){0.f, 0.f, 0.f, 0.f};
                    store_bf16x4(kc + ((size_t)bg * 256 + n) * 64 + 32 * eb + 8 * mg + 4 * hi, v);
                } else {
                    const int n0 = chunk * 32 + 8 * mg + 4 * hi;
                    if (n0 + 3 == 255) v.w = 0.f;
                    store_bf16x4(vct + ((size_t)bg * 64 + 32 * eb + r32) * 256 + n0, v);
                }
            }
            __syncthreads();
        }
    }
}

DI bf16x8 pack8(const f32x16& p, int base) {
    u32x4 w; w.x = pk2(p[base], p[base + 1]); w.y = pk2(p[base + 2], p[base + 3]); w.z = pk2(p[base + 4], p[base + 5]); w.w = pk2(p[base + 6], p[base + 7]);
    return __builtin_bit_cast(bf16x8, w);
}
DI f32x16 st_tile(const bf16_t* kbase, size_t kpitch, const bf16x8 (&qf)[4], int r32, int hi) {
    f32x16 s;
#pragma unroll
    for (int i = 0; i < 16; ++i) s[i] = 0.f;
    const bf16_t* kp = kbase + (size_t)r32 * kpitch + hi * 8;
#pragma unroll
    for (int ks = 0; ks < 4; ++ks) { const bf16x8 a = *(const bf16x8*)(kp + ks * 16); s = MFMA32(a, qf[ks], s); }
    return s;
}
DI void pv_tile(f32x16 (&o)[2], const bf16_t* vT, size_t vpitch, const f32x16& pr, int r32, int hi) {
    const bf16x8 pf0 = pack8(pr, 0), pf1 = pack8(pr, 8);
#pragma unroll
    for (int db = 0; db < 2; ++db) {
        const bf16_t* vp = vT + (size_t)(32 * db + r32) * vpitch + 4 * hi;
#pragma unroll
        for (int s2 = 0; s2 < 2; ++s2) {
            const s16x4 lo = *(const s16x4*)(vp + 16 * s2); const s16x4 hh = *(const s16x4*)(vp + 16 * s2 + 8);
            const bf16x8 a = {lo[0], lo[1], lo[2], lo[3], hh[0], hh[1], hh[2], hh[3]};
            o[db] = MFMA32(a, s2 ? pf1 : pf0, o[db]);
        }
    }
}
DI void load_q(bf16x8 (&qf)[4], const bf16_t* qrow  , int hi) {
#pragma unroll
    for (int ks = 0; ks < 4; ++ks) qf[ks] = *(const bf16x8*)(qrow + ks * 16 + hi * 8);
}
DI void softmax_tile(f32x16& sv, unsigned vmask, float& m, float& l, f32x16 (&o)[2]) {
    float tm = -1e30f;
#pragma unroll
    for (int r = 0; r < 16; ++r) tm = fmaxf(tm, ((vmask >> r) & 1u) ? sv[r] : -1e30f);
    tm = fmaxf(tm, __shfl_xor(tm, 32));
    const float mn = fmaxf(m, tm);
    const float alpha = fexp(m - mn);
    float ps = 0.f;
#pragma unroll
    for (int r = 0; r < 16; ++r) { const float pv = ((vmask >> r) & 1u) ? fexp(sv[r] - mn) : 0.f; sv[r] = pv; ps += pv; }
    l = l * alpha + ps; m = mn;
#pragma unroll
    for (int r = 0; r < 16; ++r) { o[0][r] *= alpha; o[1][r] *= alpha; }
}

struct KF { bf16x8 k[4]; };
struct VF { s16x4 v[2][2][2]; };
DI void load_kf(KF& f, const bf16_t* kbase, size_t kpitch, int r32, int hi) {
    const bf16_t* kp = kbase + (size_t)r32 * kpitch + hi * 8;
#pragma unroll
    for (int ks = 0; ks < 4; ++ks) f.k[ks] = *(const bf16x8*)(kp + ks * 16);
}
DI void load_vf(VF& f, const bf16_t* vT, size_t vpitch, int r32, int hi) {
#pragma unroll
    for (int db = 0; db < 2; ++db) { const bf16_t* vp = vT + (size_t)(32 * db + r32) * vpitch + 4 * hi;
#pragma unroll
        for (int s2 = 0; s2 < 2; ++s2) { f.v[db][s2][0] = *(const s16x4*)(vp + 16 * s2); f.v[db][s2][1] = *(const s16x4*)(vp + 16 * s2 + 8); } }
}
DI f32x16 qk_frag(const KF& f, const bf16x8 (&qf)[4]) {
    f32x16 s; zero16(s);
#pragma unroll
    for (int ks = 0; ks < 4; ++ks) s = MFMA32(f.k[ks], qf[ks], s);
    return s;
}
DI void pv_frag(f32x16 (&o)[2], const VF& f, const f32x16& pr) {
    const bf16x8 pf0 = pack8(pr, 0), pf1 = pack8(pr, 8);
#pragma unroll
    for (int db = 0; db < 2; ++db)
#pragma unroll
        for (int s2 = 0; s2 < 2; ++s2) { const s16x4 lo = f.v[db][s2][0], hh = f.v[db][s2][1];
            const bf16x8 a = {lo[0], lo[1], lo[2], lo[3], hh[0], hh[1], hh[2], hh[3]};
            o[db] = MFMA32(a, s2 ? pf1 : pf0, o[db]); }
}
template <bool GUARD = false> DI void softmax_core(f32x16& e, float A, float& m, float& l, f32x16 (&o)[2]) {
    float tm = fmaxf(fmaxf(fmaxf(e[0], e[1]), fmaxf(e[2], e[3])), fmaxf(fmaxf(e[4], e[5]), fmaxf(e[6], e[7])));
    tm = fmaxf(tm, fmaxf(fmaxf(fmaxf(e[8], e[9]), fmaxf(e[10], e[11])), fmaxf(fmaxf(e[12], e[13]), fmaxf(e[14], e[15]))));
    tm += A;
    tm = fmaxf(tm, __shfl_xor(tm, 32));
    if (__any(tm > m + 8.0f)) {
        const float mn = fmaxf(m, tm); const float alpha = fexp2(m - mn); l *= alpha; m = mn;
#pragma unroll
        for (int r = 0; r < 16; ++r) { o[0][r] *= alpha; o[1][r] *= alpha; }
    }
    const float c = A - m;
    float ps = 0.f;
#pragma unroll
    for (int r = 0; r < 16; ++r) { float pv = fexp2(e[r] + c); if (GUARD) pv = (e[r] > -1e29f) ? pv : 0.f; e[r] = pv; ps += pv; }
    l += ps;
}
constexpr float SCL2 = 0.125f * LOG2E;

DI void nsa_cmp_task(const Params& p, int b, int g, int chunk, int lane, float* impl  ) {
    unsigned char* ws = p.ws; unsigned char* dout = (unsigned char*)p.out;
    const int r32 = lane & 31, hi = lane >> 5;
    const int tq0 = chunk * 32, t = tq0 + r32, cur = tq0 >> 6;
    const size_t tok = (size_t)b * T + t;
    const bf16_t* qkv = (const bf16_t*)(ws + WS_QKV);
    const float scale = 0.125f;
#pragma unroll
    for (int k = 0; k < 32; ++k) impl[k * 64 + lane] = 0.f;
    const bf16_t* kc = (const bf16_t*)(dout + DO_KC) + (size_t)(b * 2 + g) * 256 * 64;
    const bf16_t* vct = (const bf16_t*)(dout + DO_VCT) + (size_t)(b * 2 + g) * 64 * 256;
    int ntile = (tq0 / 16) / 32 + 1; if (ntile > 8) ntile = 8;
#pragma unroll 1
    for (int rr = 0; rr < 3; ++rr) {
        const int head = g * 3 + rr;
        bf16x8 qr[4]; load_q(qr, qkv + tok * LDP_QKV + C_NQ + head * 64, hi);
        const float slope = fexp2(-(8.0f * (float)(head + 1)) / 6.0f);
        float m = -1e30f, l = 0.f;
        f32x16 oc[2]; zero16(oc[0]); zero16(oc[1]);
        float* tmp = impl + 32 * 64; float* tmpm = impl + 64 * 64;
#pragma unroll 1
        for (int tile = 0; tile < ntile; ++tile) {
            KF kf; VF vf; load_kf(kf, kc + (size_t)tile * 32 * 64, 64, r32, hi); load_vf(vf, vct + tile * 32, 256, r32, hi);
            f32x16 s = qk_frag(kf, qr);
            float tm = -1e30f;
#pragma unroll
            for (int r = 0; r < 16; ++r) { const int n = tile * 32 + krow(r, hi); const int dist = t - (16 * n + 31); const bool valid = dist >= 0 && n < 255;
                const float sv = valid ? s[r] * scale - slope * (float)dist : -1e30f; s[r] = sv; tm = fmaxf(tm, sv); }
            tm = fmaxf(tm, __shfl_xor(tm, 32));
            if (__any(tm > m)) {
                const float mn = fmaxf(m, tm); const float alpha = fexp(m - mn); l *= alpha; m = mn;
#pragma unroll
                for (int r = 0; r < 16; ++r) { oc[0][r] *= alpha; oc[1][r] *= alpha; }
            }
            float ps = 0.f;
#pragma unroll
            for (int r = 0; r < 16; ++r) { const float pv = (s[r] > -1e29f) ? fexp(s[r] - m) : 0.f; s[r] = pv; ps += pv; }
            l += ps;
#pragma unroll
            for (int mm = 0; mm < 4; ++mm) tmp[(tile * 4 + mm) * 64 + lane] = (s[4 * mm] + s[4 * mm + 1]) + (s[4 * mm + 2] + s[4 * mm + 3]);
            tmpm[tile * 64 + lane] = m;
            pv_frag(oc, vf, s);
        }
        l += __shfl_xor(l, 32);
        const float inv = l > 0.f ? 1.0f / l : 0.f;
#pragma unroll 1
        for (int tile = 0; tile < ntile; ++tile) { const float sc = fexp(tmpm[tile * 64 + lane] - m) * inv;
#pragma unroll
            for (int mm = 0; mm < 4; ++mm) impl[(tile * 4 + mm) * 64 + lane] += tmp[(tile * 4 + mm) * 64 + lane] * sc; }
#pragma unroll
        for (int r = 0; r < 16; ++r) { oc[0][r] *= inv; oc[1][r] *= inv; }
        const float g_c = ((const float*)(dout + DO_NSAG))[tok * 32 + head * 3];
        bf16_t* orow = (bf16_t*)(dout + DO_OC) + tok * 384 + head * 64;
#pragma unroll
        for (int db = 0; db < 2; ++db)
#pragma unroll
            for (int mg = 0; mg < 4; ++mg) { f32x4 v = {g_c * oc[db][4 * mg], g_c * oc[db][4 * mg + 1], g_c * oc[db][4 * mg + 2], g_c * oc[db][4 * mg + 3]}; store_bf16x4(orow + 32 * db + 8 * mg + 4 * hi, v); }
    }
    unsigned long long selmask;
    if (cur + 1 <= 16) selmask = (1ull << (cur + 1)) - 1ull;
    else {
        float imp[32];
#pragma unroll
        for (int k = 0; k < 32; ++k) { const int j = 2 * k + hi; const float iv = impl[k * 64 + lane]; imp[k] = (j == 0 || j == cur || j == cur - 1) ? 1e4f : (j <= cur ? iv : -1.0f); }
        selmask = 0ull;
#pragma unroll 1
        for (int round = 0; round < 16; ++round) {
            float bv = -3.0f; int bj = 1000;
#pragma unroll
            for (int k = 0; k < 32; ++k) { const bool better = imp[k] > bv; bv = better ? imp[k] : bv; bj = better ? (2 * k + hi) : bj; }
            const float pv = __shfl_xor(bv, 32); const int pj = __shfl_xor(bj, 32);
            const bool mine = (bv > pv) || (bv == pv && bj < pj);
            const int wj = mine ? bj : pj;
            selmask |= 1ull << wj;
            const int kill = mine ? bj : -1;
#pragma unroll
            for (int k = 0; k < 32; ++k) imp[k] = ((2 * k + hi) == kill) ? -2.0f : imp[k];
        }
    }
    if (hi == 0) ((unsigned long long*)(dout + DO_SELM))[(size_t)(b * 2 + g) * T + t] = selmask;
}
typedef LAS unsigned char* ldsp_t;
DI void dma_k(ldsp_t kbuf  , const bf16_t* ktile, int lane) {
#pragma unroll
    for (int i = 0; i < 4; ++i) __builtin_amdgcn_global_load_lds((const unsigned*)((const unsigned char*)ktile + i * 1024 + lane * 16), (LAS unsigned*)(kbuf + i * 1024), 16, 0, 0);
}
DI void dma_v(ldsp_t vbuf  , const bf16_t* vtile, int lane) {
#pragma unroll
    for (int i = 0; i < 4; ++i) __builtin_amdgcn_global_load_lds((const unsigned*)((const unsigned char*)vtile + i * 1024 + lane * 16), (LAS unsigned*)(vbuf + i * 1024), 16, 0, 0);
}
DI f32x16 qk_lds(ldsp_t kbuf, const bf16x8 (&qf)[4], int r32, int hi) {
    f32x16 s; zero16(s);
    const int sw = (r32 >> 1) & 7;
#pragma unroll
    for (int ks = 0; ks < 4; ++ks) { const bf16x8 a = *(const LAS bf16x8*)(kbuf + r32 * 128 + (((2 * ks + hi) ^ sw) * 16)); s = MFMA32(a, qf[ks], s); }
    return s;
}
DI void pv_lds(f32x16 (&o)[2], ldsp_t vbuf, const f32x16& pr, int r32, int hi) {
    const bf16x8 pf0 = pack8(pr, 0), pf1 = pack8(pr, 8);
#pragma unroll
    for (int db = 0; db < 2; ++db) { const int d = 32 * db + r32, msk = (d >> 2) & 7; ldsp_t rowp = vbuf + d * 64;
#pragma unroll
        for (int s2 = 0; s2 < 2; ++s2) { const s16x4 lo = *(const LAS s16x4*)(rowp + (((4 * s2 + hi) ^ msk) * 8)); const s16x4 hh = *(const LAS s16x4*)(rowp + (((4 * s2 + 2 + hi) ^ msk) * 8));
            const bf16x8 a = {lo[0], lo[1], lo[2], lo[3], hh[0], hh[1], hh[2], hh[3]};
            o[db] = MFMA32(a, s2 ? pf1 : pf0, o[db]); } }
}
constexpr int RING_BYTES = 20480, VRING_OFF = 12288;
DI void dma_wait_step(bool k2, bool v1) {
    if (k2 && v1) asm volatile("s_waitcnt vmcnt(8)" ::: "memory");
    else if (k2 || v1) asm volatile("s_waitcnt vmcnt(4)" ::: "memory");
    else asm volatile("s_waitcnt vmcnt(0)" ::: "memory");
}
#define DMA_WAIT_NEWEST8() asm volatile("s_waitcnt vmcnt(8)" ::: "memory")
#define DMA_WAIT_ALL() asm volatile("s_waitcnt vmcnt(0)" ::: "memory")

DI void lds_kf(KF& f, ldsp_t kbuf, int r32, int hi) {
    const int sw = (r32 >> 1) & 7;
#pragma unroll
    for (int ks = 0; ks < 4; ++ks) f.k[ks] = *(const LAS bf16x8*)(kbuf + r32 * 128 + (((2 * ks + hi) ^ sw) * 16));
}
DI void lds_vf(VF& f, ldsp_t vbuf, int r32, int hi) {
#pragma unroll
    for (int db = 0; db < 2; ++db) { const int d = 32 * db + r32, msk = (d >> 2) & 7; ldsp_t rowp = vbuf + d * 64;
#pragma unroll
        for (int s2 = 0; s2 < 2; ++s2) { f.v[db][s2][0] = *(const LAS s16x4*)(rowp + (((4 * s2 + hi) ^ msk) * 8)); f.v[db][s2][1] = *(const LAS s16x4*)(rowp + (((4 * s2 + 2 + hi) ^ msk) * 8)); } }
}
template <bool MASKED, bool WIN> DI void nsa_pair_tile(ldsp_t kbuf, ldsp_t vbuf, const bf16x8 (&qf)[2][4], int t0, int kb, float rb0, float rb1, float slope2,
                                                       float (&m)[2], float (&l)[2], f32x16 (&o)[2][2], int r32, int hi) {
    KF kf; lds_kf(kf, kbuf, r32, hi);
    f32x16 s0 = qk_frag(kf, qf[0]), s1 = qk_frag(kf, qf[1]);
    const int db0 = t0 - kb - 4 * hi, db1 = db0 + 32;
#pragma unroll
    for (int r = 0; r < 16; ++r) { const int cr = (r & 3) + 8 * (r >> 2); const float bias = __int_as_float(__builtin_amdgcn_readfirstlane(__float_as_int(slope2 * (float)cr)));
        float e0 = __builtin_fmaf(s0[r], SCL2, bias), e1 = __builtin_fmaf(s1[r], SCL2, bias);
        if (MASKED) { const int d0 = db0 - cr, d1 = db1 - cr; e0 = (d0 >= 0 && (!WIN || d0 < 512)) ? e0 : -1e30f; e1 = (d1 >= 0 && (!WIN || d1 < 512)) ? e1 : -1e30f; }
        s0[r] = e0; s1[r] = e1; }
    softmax_core<MASKED>(s0, rb0 - slope2 * (float)db0, m[0], l[0], o[0]);
    softmax_core<MASKED>(s1, rb1 - slope2 * (float)db1, m[1], l[1], o[1]);
    VF vf; lds_vf(vf, vbuf, r32, hi);
    pv_frag(o[0], vf, s0); pv_frag(o[1], vf, s1);
}
DI void nsa_main_task(const Params& p, int b, int head, int blk, int lane, ldsp_t wl) {
    unsigned char* ws = p.ws; unsigned char* dout = (unsigned char*)p.out;
    const int g = head / 3, r32 = lane & 31, hi = lane >> 5;
    const int tq0 = blk * 64, cur = blk;
    const int t0 = tq0 + r32;
    const size_t tok0 = (size_t)b * T + t0;
    const bf16_t* qkv = (const bf16_t*)(ws + WS_QKV);
    const unsigned long long* smp = (const unsigned long long*)(dout + DO_SELM) + (size_t)(b * 2 + g) * T + t0;
    const unsigned long long selmask[2] = {smp[0], smp[32]};
    const float slope2 = fexp2(-(8.0f * (float)(head + 1)) / 6.0f) * LOG2E;
    bf16x8 qf[2][4];
    load_q(qf[0], qkv + tok0 * LDP_QKV + C_NQ + head * 64, hi); load_q(qf[1], qkv + (tok0 + 32) * LDP_QKV + C_NQ + head * 64, hi);
    const size_t tbase = (size_t)(b * 2 + g) * 128;
    const float* nsag = (const float*)(dout + DO_NSAG) + tok0 * 32 + head * 3;
    bf16_t* orow = (bf16_t*)(ws + WS_H) + tok0 * D + 384 + head * 64;
    {
        const bf16_t* kt = (const bf16_t*)(dout + DO_KSLC) + tbase * 2048; const bf16_t* vt = (const bf16_t*)(dout + DO_VSLC) + tbase * 2048;
        unsigned ulo = (unsigned)(selmask[0] | selmask[1]), uhi = (unsigned)((selmask[0] | selmask[1]) >> 32);
#pragma unroll
        for (int o_ = 1; o_ < 64; o_ <<= 1) { ulo |= (unsigned)__shfl_xor((int)ulo, o_); uhi |= (unsigned)__shfl_xor((int)uhi, o_); }
        unsigned long long U = ((unsigned long long)(unsigned)__builtin_amdgcn_readfirstlane((int)uhi) << 32) | (unsigned)__builtin_amdgcn_readfirstlane((int)ulo);
        U &= (cur == 63) ? ~0ull : ((1ull << (cur + 1)) - 1ull);
        float m[2] = {-1e30f, -1e30f}, l[2] = {0.f, 0.f}; f32x16 o[2][2];
        zero16(o[0][0]); zero16(o[0][1]); zero16(o[1][0]); zero16(o[1][1]);
#define NEXT_TILE(J, H, NJ, NH, HAS) { NJ = J; NH = H - 1; HAS = true; if (NH < 0) { const unsigned long long rem_ = U & ((1ull << J) - 1ull); if (rem_ == 0ull) HAS = false; else { NJ = 63 - __builtin_clzll(rem_); NH = 1; } } }
        int j0 = cur, h0 = 1, j1, h1, j2 = 0, h2 = 0; bool has1, has2 = false;
        NEXT_TILE(j0, h0, j1, h1, has1);
        if (has1) NEXT_TILE(j1, h1, j2, h2, has2);
        int ks0 = 0, vs0 = 0;
        dma_k(wl, kt + (size_t)(2 * j0 + h0) * 2048, lane); dma_v(wl + VRING_OFF, vt + (size_t)(2 * j0 + h0) * 2048, lane);
        if (has1) dma_k(wl + 4096, kt + (size_t)(2 * j1 + h1) * 2048, lane);
#define NSA_SEL_STEP(MASKED) { \
            const int ks1 = ks0 == 2 ? 0 : ks0 + 1, ks2 = ks1 == 2 ? 0 : ks1 + 1; \
            if (has2) dma_k(wl + ks2 * 4096, kt + (size_t)(2 * j2 + h2) * 2048, lane); \
            if (has1) dma_v(wl + VRING_OFF + (vs0 ^ 1) * 4096, vt + (size_t)(2 * j1 + h1) * 2048, lane); \
            dma_wait_step(has2, has1); \
            const int kb = 64 * j0 + 32 * h0; \
            const float rb0 = ((selmask[0] >> j0) & 1ull) ? 0.f : -1e30f, rb1 = ((selmask[1] >> j0) & 1ull) ? 0.f : -1e30f; \
            nsa_pair_tile<MASKED, false>(wl + ks0 * 4096, wl + VRING_OFF + vs0 * 4096, qf, t0, kb, rb0, rb1, slope2, m, l, o, r32, hi); \
            more = has1; \
            if (has1) { j0 = j1; h0 = h1; j1 = j2; h1 = h2; has1 = has2; \
                if (has2) { int nj, nh; bool hs; NEXT_TILE(j2, h2, nj, nh, hs); j2 = nj; h2 = nh; has2 = hs; } \
                ks0 = ks1; vs0 ^= 1; } }
        bool more = true;
#pragma unroll 1
        while (more && j0 == cur) NSA_SEL_STEP(true)
#pragma unroll 1
        while (more) NSA_SEL_STEP(false)
#pragma unroll
        for (int ci = 0; ci < 2; ++ci) {
            float lt = l[ci]; lt += __shfl_xor(lt, 32);
            const float f = nsag[ci * 32 * 32 + 1] * (lt > 0.f ? 1.0f / lt : 0.f);
#pragma unroll
            for (int db = 0; db < 2; ++db)
#pragma unroll
                for (int mg = 0; mg < 4; ++mg) { const u32x2 w = *(const u32x2*)((const bf16_t*)(dout + DO_OC) + (tok0 + ci * 32) * 384 + head * 64 + 32 * db + 8 * mg + 4 * hi);
                    f32x4 v = {bflo(w.x) + f * o[ci][db][4 * mg], bfhi(w.x) + f * o[ci][db][4 * mg + 1], bflo(w.y) + f * o[ci][db][4 * mg + 2], bfhi(w.y) + f * o[ci][db][4 * mg + 3]};
                    store_bf16x4(orow + (size_t)ci * 32 * D + 32 * db + 8 * mg + 4 * hi, v); }
        }
    }
    {
        const bf16_t* kt = (const bf16_t*)(dout + DO_KWIN) + tbase * 2048; const bf16_t* vt = (const bf16_t*)(dout + DO_VWIN) + tbase * 2048;
        float m[2] = {-1e30f, -1e30f}, l[2] = {0.f, 0.f}; f32x16 o[2][2];
        zero16(o[0][0]); zero16(o[0][1]); zero16(o[1][0]); zero16(o[1][1]);
        int kb0 = tq0 - 512; if (kb0 < 0) kb0 = 0;
        int kb = tq0 + 32, ks0 = 0, vs0 = 0;
        dma_k(wl, kt + (size_t)(kb >> 5) * 2048, lane); dma_v(wl + VRING_OFF, vt + (size_t)(kb >> 5) * 2048, lane);
        dma_k(wl + 4096, kt + (size_t)((kb - 32) >> 5) * 2048, lane);
#define NSA_WIN_STEP(MASKED) { \
            const bool has1 = (kb - 32 >= kb0), has2 = (kb - 64 >= kb0); \
            const int ks1 = ks0 == 2 ? 0 : ks0 + 1, ks2 = ks1 == 2 ? 0 : ks1 + 1; \
            if (has2) dma_k(wl + ks2 * 4096, kt + (size_t)((kb - 64) >> 5) * 2048, lane); \
            if (has1) dma_v(wl + VRING_OFF + (vs0 ^ 1) * 4096, vt + (size_t)((kb - 32) >> 5) * 2048, lane); \
            dma_wait_step(has2, has1); \
            nsa_pair_tile<MASKED, true>(wl + ks0 * 4096, wl + VRING_OFF + vs0 * 4096, qf, t0, kb, 0.f, 0.f, slope2, m, l, o, r32, hi); \
            more = has1; \
            if (has1) { kb -= 32; ks0 = ks1; vs0 ^= 1; } }
        bool more = true;
#pragma unroll 1
        while (more && kb >= tq0) NSA_WIN_STEP(true)
#pragma unroll 1
        while (more && kb > tq0 - 480) NSA_WIN_STEP(false)
#pragma unroll 1
        while (more) NSA_WIN_STEP(true)
#pragma unroll
        for (int ci = 0; ci < 2; ++ci) {
            float lt = l[ci]; lt += __shfl_xor(lt, 32);
            const float f = nsag[ci * 32 * 32 + 2] * (lt > 0.f ? 1.0f / lt : 0.f);
#pragma unroll
            for (int db = 0; db < 2; ++db)
#pragma unroll
                for (int mg = 0; mg < 4; ++mg) { bf16_t* op = orow + (size_t)ci * 32 * D + 32 * db + 8 * mg + 4 * hi; const u32x2 w = *(const u32x2*)op;
                    f32x4 v = {bflo(w.x) + f * o[ci][db][4 * mg], bfhi(w.x) + f * o[ci][db][4 * mg + 1], bflo(w.y) + f * o[ci][db][4 * mg + 2], bfhi(w.y) + f * o[ci][db][4 * mg + 3]};
                    store_bf16x4(op, v); }
        }
    }
}

DI void mem_task(const Params& p, int b, int head, int chunk, int lane, ldsp_t wl) {
    unsigned char* ws = p.ws; unsigned char* dout = (unsigned char*)p.out;
    const int r32 = lane & 31, hi = lane >> 5; const size_t tok = (size_t)b * T + chunk * 32 + r32;
    const bf16_t* qkv = (const bf16_t*)(ws + WS_QKV);
    bf16x8 qf[4]; load_q(qf, qkv + tok * LDP_QKV + C_MQ + head * 64, hi);
    const bf16_t* kt = (const bf16_t*)(dout + DO_MKT) + (size_t)(b * 4 + head) * 8 * 2048;
    const bf16_t* vt = (const bf16_t*)(dout + DO_MVT) + (size_t)(b * 4 + head) * 8 * 2048;
    float m = -1e30f, l = 0.f; f32x16 o[2]; zero16(o[0]); zero16(o[1]);
    int ks0 = 0, vs0 = 0;
    dma_k(wl, kt, lane); dma_v(wl + VRING_OFF, vt, lane); dma_k(wl + 4096, kt + 2048, lane);
#pragma unroll 1
    for (int ti = 0; ti < 8; ++ti) {
        const bool has1 = ti + 1 < 8, has2 = ti + 2 < 8;
        const int ks1 = ks0 == 2 ? 0 : ks0 + 1, ks2 = ks1 == 2 ? 0 : ks1 + 1;
        if (has2) dma_k(wl + ks2 * 4096, kt + (size_t)(ti + 2) * 2048, lane);
        if (has1) dma_v(wl + VRING_OFF + (vs0 ^ 1) * 4096, vt + (size_t)(ti + 1) * 2048, lane);
        dma_wait_step(has2, has1);
        f32x16 s = qk_lds(wl + ks0 * 4096, qf, r32, hi);
#pragma unroll
        for (int r = 0; r < 16; ++r) s[r] *= SCL2;
        softmax_core(s, 0.f, m, l, o);
        pv_lds(o, wl + VRING_OFF + vs0 * 4096, s, r32, hi);
        ks0 = ks1; vs0 ^= 1;
    }
    l += __shfl_xor(l, 32);
    const float f = 1.0f / l;
    bf16_t* orow = (bf16_t*)(ws + WS_H) + tok * D + 768 + head * 64;
#pragma unroll
    for (int db = 0; db < 2; ++db)
#pragma unroll
        for (int mg = 0; mg < 4; ++mg) { f32x4 v = {o[db][4 * mg] * f, o[db][4 * mg + 1] * f, o[db][4 * mg + 2] * f, o[db][4 * mg + 3] * f}; store_bf16x4(orow + 32 * db + 8 * mg + 4 * hi, v); }
}

DI void sb_task(const Params& p, int b, int head, int chunk, int lane, ldsp_t wl) {
    unsigned char* ws = p.ws; unsigned char* dout = (unsigned char*)p.out;
    const int r32 = lane & 31, hi = lane >> 5; const int tq0 = chunk * 32, t = tq0 + r32; const size_t tok = (size_t)b * T + t;
    const bf16_t* qkv = (const bf16_t*)(ws + WS_QKV);
    bf16x8 qf[4]; load_q(qf, qkv + tok * LDP_QKV + C_SBQ + head * 64, hi);
    const size_t tbase = (size_t)(b * 6 + head) * 128;
    const bf16_t* kt = (const bf16_t*)(dout + DO_SBK) + tbase * 2048; const bf16_t* vt = (const bf16_t*)(dout + DO_SBV) + tbase * 2048;
    f32x16 o[2]; zero16(o[0]); zero16(o[1]);
    float R = 0.f;
    int kb = tq0, ks0 = 0, vs0 = 0;
    dma_k(wl, kt + (size_t)(kb >> 5) * 2048, lane); dma_v(wl + VRING_OFF, vt + (size_t)(kb >> 5) * 2048, lane);
    if (kb >= 32) dma_k(wl + 4096, kt + (size_t)((kb - 32) >> 5) * 2048, lane);
#pragma unroll 1
    for (;;) {
        const bool has1 = kb >= 32, has2 = kb >= 64;
        const int ks1 = ks0 == 2 ? 0 : ks0 + 1, ks2 = ks1 == 2 ? 0 : ks1 + 1;
        if (has2) dma_k(wl + ks2 * 4096, kt + (size_t)((kb - 64) >> 5) * 2048, lane);
        if (has1) dma_v(wl + VRING_OFF + (vs0 ^ 1) * 4096, vt + (size_t)((kb - 32) >> 5) * 2048, lane);
        dma_wait_step(has2, has1);
        f32x16 s = qk_lds(wl + ks0 * 4096, qf, r32, hi);
        f32x16 L;
#pragma unroll
        for (int r = 0; r < 16; ++r) { const float z = s[r] * 0.125f; const bool valid = (kb + krow(r, hi)) < t;
            const float sp = fmaxf(z, 0.f) + LN2 * flog2(1.0f + fexp(-fabsf(z)));
            s[r] = z; L[r] = valid ? -sp : 0.f; }
        float gs[4], pg[4];
#pragma unroll
        for (int mg = 0; mg < 4; ++mg) { gs[mg] = (L[4 * mg] + L[4 * mg + 1]) + (L[4 * mg + 2] + L[4 * mg + 3]); pg[mg] = __shfl_xor(gs[mg], 32); }
        float off[4]; float run = R;
#pragma unroll
        for (int mg = 3; mg >= 0; --mg) { off[mg] = run + (hi ? 0.f : pg[mg]); run += gs[mg] + pg[mg]; }
#pragma unroll
        for (int mg = 0; mg < 4; ++mg) {
            float e = off[mg];
#pragma unroll
            for (int i = 3; i >= 0; --i) { const int r = 4 * mg + i; const bool valid = (kb + krow(r, hi)) < t;
                const float a = valid ? fexp(s[r] + L[r] + e) : 0.f; e += L[r]; s[r] = a; }
        }
        R = run;
        pv_lds(o, wl + VRING_OFF + vs0 * 4096, s, r32, hi);
        if (!has1 || __all(R < -104.0f)) break;
        kb -= 32; ks0 = ks1; vs0 ^= 1;
    }
    DMA_WAIT_ALL();
    bf16_t* orow = (bf16_t*)(ws + WS_H) + tok * D + head * 64;
#pragma unroll
    for (int db = 0; db < 2; ++db)
#pragma unroll
        for (int mg = 0; mg < 4; ++mg) { f32x4 v = {o[db][4 * mg], o[db][4 * mg + 1], o[db][4 * mg + 2], o[db][4 * mg + 3]}; store_bf16x4(orow + 32 * db + 8 * mg + 4 * hi, v); }
}

constexpr int N_CMP_TASKS = NB * 2 * 128, N_NSA_TASKS = NB * 6 * 64, N_MEM_TASKS = NB * 4 * 128, N_SB_TASKS = NB * 6 * 128;
DI void phase3a(const Params& p, int rep, bf16_t* lds) {
    const int lane = threadIdx.x & 63;
    ldsp_t wl = (ldsp_t)(unsigned char*)lds + __builtin_amdgcn_readfirstlane((int)(threadIdx.x >> 6)) * RING_BYTES;
    float* impl = (float*)((unsigned char*)lds + (threadIdx.x >> 6) * RING_BYTES);
    unsigned* ctr = (unsigned*)(p.ws + WS_CTL) + 64 + 256 * rep;
    for (;;) {
        unsigned tk = 0; if (lane == 0) tk = atomicAdd(ctr, 1u);
        const int task = (int)__builtin_amdgcn_readfirstlane(tk);
        if (task >= N_CMP_TASKS + N_MEM_TASKS) break;
        if (task < N_CMP_TASKS) { const int chunk = 127 - task / 16, rem = task % 16; nsa_cmp_task(p, rem >> 1, rem & 1, chunk, lane, impl); }
        else { const int r = task - N_CMP_TASKS; const int chunk = r / 32, rem = r % 32; mem_task(p, rem / 4, rem % 4, chunk, lane, wl); }
    }
}
DI void phase3b(const Params& p, int rep, unsigned char* lds_raw_) {
    const int lane = threadIdx.x & 63;
    ldsp_t wl = (ldsp_t)lds_raw_ + __builtin_amdgcn_readfirstlane((int)(threadIdx.x >> 6)) * RING_BYTES;
    unsigned* ctr = (unsigned*)(p.ws + WS_CTL) + 128 + 256 * rep;
    if (__builtin_amdgcn_readfirstlane((int)(threadIdx.x >> 6)) == NWAVES - 1) peer_table_rows(p, lane, blockIdx.x, gridDim.x);
    for (;;) {
        unsigned tk = 0; if (lane == 0) tk = atomicAdd(ctr, 1u);
        const int task = (int)__builtin_amdgcn_readfirstlane(tk);
        if (task >= N_NSA_TASKS + N_SB_TASKS) break;
        if (task < N_NSA_TASKS) { const int ci = task / 48, rem = task % 48; const int blk = (ci & 1) ? (ci >> 1) : 63 - (ci >> 1); nsa_main_task(p, rem / 6, rem % 6, blk, lane, wl); }
        else { const int r = task - N_NSA_TASKS; const int chunk = r / 48, rem = r % 48; sb_task(p, rem / 6, rem % 6, chunk, lane, wl); }
    }
}

DI void phase4(const Params& p, bf16_t* lds) {
    unsigned char* ws = p.ws;
    const bf16_t* cat = (const bf16_t*)(ws + WS_H); const bf16_t* gates = (const bf16_t*)(ws + WS_GATES); bf16_t* merged = (bf16_t*)(ws + WS_MERGED);
    pg8::StaticOrder S; S.init(NTOK, D, (int)gridDim.x, (int)blockIdx.x);
#pragma unroll 1
    for (int br = 0; br < 3; ++br) {
        const int Kb = br == 2 ? 256 : 384;
        const bf16_t* Bt = (const bf16_t*)(ws + (br == 0 ? WS_WSB : (br == 1 ? WS_WNSA : WS_WMEM)));
        pg8::Gemm g{cat + br * 384, Bt, NTOK, D, Kb, D, Kb}; pg8::EpiMerge E{merged, gates, br}; GEMM_PHASE(pg8::EpiMerge, g, S, E);
    }
}
DI void phase5(const Params& p, bf16_t* lds) {
    unsigned char* ws = p.ws;
    pg8::Gemm g{(const bf16_t*)(ws + WS_MERGED), (const bf16_t*)(ws + WS_WOUT), NTOK, D, D, D, D};
    pg8::StaticOrder S; S.init(NTOK, D, (int)gridDim.x, (int)blockIdx.x);
    pg8::EpiOut E{p.in[0], p.in[15], p.out, (bf16_t*)(ws + WS_H2), (float*)(ws + WS_ROWSS)};
    GEMM_PHASE(pg8::EpiOut, g, S, E);
}
DI void phase6(const Params& p, bf16_t* lds) {
    unsigned char* ws = p.ws;
    pg8::Gemm g{(const bf16_t*)(ws + WS_H2), (const bf16_t*)(ws + WS_WQ), NTOK, 2048, D, D, D};
    pg8::StaticOrder S; S.init(NTOK, 2048, (int)gridDim.x, (int)blockIdx.x);
    pg8::EpiPlain E{(bf16_t*)(ws + WS_QP), 2048};
    GEMM_PHASE(pg8::EpiPlain, g, S, E);
}

DI float row_rstd(const float* rowss, size_t tok) {
    const f32x4* r = (const f32x4*)(rowss + tok * 32); float s = 0.f;
#pragma unroll
    for (int i = 0; i < 8; ++i) { const f32x4 v = r[i]; s += (v.x + v.y) + (v.z + v.w); }
    return 1.0f / sqrtf(s * (1.0f / D) + RMS_EPS);
}
DI int f2key(float v) { const int u = __float_as_int(v); return u ^ ((u >> 31) & 0x7fffffff); }
DI float key2f(int k) { return __int_as_float(k ^ ((k >> 31) & 0x7fffffff)); }
template <int N> DI void bitonic_sort_desc(int (&a)[N]) {
#pragma unroll
    for (int k = 2; k <= N; k <<= 1)
#pragma unroll
        for (int j = k >> 1; j > 0; j >>= 1)
#pragma unroll
            for (int i = 0; i < N; ++i) { const int l = i ^ j; if (l > i) { const bool desc = ((i & k) == 0); const int hi_ = max(a[i], a[l]), lo_ = min(a[i], a[l]); a[i] = desc ? hi_ : lo_; a[l] = desc ? lo_ : hi_; } }
}
DI void top16_merge(int (&a)[16], const int (&b)[16]) {
#pragma unroll
    for (int i = 0; i < 16; ++i) a[i] = max(a[i], b[15 - i]);
#pragma unroll
    for (int j = 8; j > 0; j >>= 1)
#pragma unroll
        for (int i = 0; i < 16; ++i) { const int l = i ^ j; if (l > i) { const int hi_ = max(a[i], a[l]), lo_ = min(a[i], a[l]); a[i] = hi_; a[l] = lo_; } }
}
constexpr int ROUTE_LDS_PER_WAVE = 2 * 16 * 32 * 4;
DI void route_task(const Params& p, int chunk, int head, int lane, float* wl, ldsp_t sk  ) {
    unsigned char* ws = p.ws;
    const int r32 = lane & 31, hi = lane >> 5; const size_t tok = (size_t)chunk * 32 + r32;
    const bf16_t* qp = (const bf16_t*)(ws + WS_QP) + tok * 2048 + head * 256;
    int* til = (int*)wl;
    float tv[2][16];
#pragma unroll
    for (int pp = 0; pp < 2; ++pp) {
        f32x16 sc[4];
#pragma unroll
        for (int tl = 0; tl < 4; ++tl) zero16(sc[tl]);
#pragma unroll
        for (int ks = 0; ks < 8; ++ks) {
            const bf16x8 qv = *(const bf16x8*)(qp + pp * 128 + ks * 16 + hi * 8);
#pragma unroll
            for (int tl = 0; tl < 4; ++tl) { const int row = pp * 128 + tl * 32 + r32; const bf16x8 a = *(const LAS bf16x8*)(sk + row * 256 + (((2 * ks + hi) ^ (row & 15)) * 16)); sc[tl] = MFMA32(a, qv, sc[tl]); }
        }
        int k0[16], k1[16], k2[16], k3[16];
#pragma unroll
        for (int r = 0; r < 16; ++r) { const int kr = krow(r, hi);
            k0[r] = (f2key(sc[0][r]) & ~127) | (127 - kr); k1[r] = (f2key(sc[1][r]) & ~127) | (127 - (32 + kr));
            k2[r] = (f2key(sc[2][r]) & ~127) | (127 - (64 + kr)); k3[r] = (f2key(sc[3][r]) & ~127) | (127 - (96 + kr)); }
        bitonic_sort_desc<16>(k0); bitonic_sort_desc<16>(k1); bitonic_sort_desc<16>(k2); bitonic_sort_desc<16>(k3);
        top16_merge(k0, k1); top16_merge(k2, k3); top16_merge(k0, k2);
        int pb[16];
#pragma unroll
        for (int i = 0; i < 16; ++i) pb[i] = __shfl_xor(k0[i], 32);
        top16_merge(k0, pb);
#pragma unroll
        for (int i = 0; i < 16; ++i) { tv[pp][i] = key2f(k0[i] & ~127); if (hi == 0) til[(pp * 16 + i) * 32 + r32] = 127 - (k0[i] & 127); }
    }
    __builtin_amdgcn_wave_barrier();
    int c0[16], c1[16], c2[16], c3[16];
    {
        int c = 0;
#pragma unroll
        for (int a = 0; a < 16; ++a)
#pragma unroll
            for (int bb = 0; bb < 16; ++bb) if ((a + 1) * (bb + 1) <= 16) {
                const int key = (f2key(tv[0][a] + tv[1][bb]) & ~255) | (255 - (a * 16 + bb));
                if (c < 16) c0[c] = key; else if (c < 32) c1[c - 16] = key; else if (c < 48) c2[c - 32] = key; else c3[c - 48] = key;
                ++c; }
#pragma unroll
        for (int i = 2; i < 16; ++i) c3[i] = (int)0x80000000;
    }
    bitonic_sort_desc<16>(c1); bitonic_sort_desc<16>(c2); bitonic_sort_desc<16>(c3);
    top16_merge(c0, c1); top16_merge(c2, c3); top16_merge(c0, c2);
    const float rstd = row_rstd((const float*)(ws + WS_ROWSS), tok);
    float gg[16]; int ex[16]; float den = 0.f; const float b0 = key2f(c0[0] & ~255);
#pragma unroll
    for (int k = 0; k < 16; ++k) { const int code = 255 - (c0[k] & 255);
        ex[k] = til[(code >> 4) * 32 + r32] * 128 + til[(16 + (code & 15)) * 32 + r32];
        gg[k] = fexp((key2f(c0[k] & ~255) - b0) * rstd); den += gg[k]; }
    const float inv = 1.0f / den;
    if (hi == 0) { unsigned short* ip = (unsigned short*)(ws + WS_IDX) + tok * 128 + head * 16;
        u32x4 w0, w1;
        w0.x = (unsigned)ex[0] | ((unsigned)ex[1] << 16); w0.y = (unsigned)ex[2] | ((unsigned)ex[3] << 16); w0.z = (unsigned)ex[4] | ((unsigned)ex[5] << 16); w0.w = (unsigned)ex[6] | ((unsigned)ex[7] << 16);
        w1.x = (unsigned)ex[8] | ((unsigned)ex[9] << 16); w1.y = (unsigned)ex[10] | ((unsigned)ex[11] << 16); w1.z = (unsigned)ex[12] | ((unsigned)ex[13] << 16); w1.w = (unsigned)ex[14] | ((unsigned)ex[15] << 16);
        *(u32x4*)ip = w0; *(u32x4*)(ip + 8) = w1; }
    else { float* gp = (float*)(ws + WS_GW) + tok * 128 + head * 16;
#pragma unroll
        for (int k = 0; k < 16; k += 4) { f32x4 v = {gg[k] * inv, gg[k + 1] * inv, gg[k + 2] * inv, gg[k + 3] * inv}; *(f32x4*)(gp + k) = v; } }
    __builtin_amdgcn_wave_barrier();
}
DI void phase7(const Params& p, bf16_t* lds) {
    const int lane = threadIdx.x & 63, wid = threadIdx.x >> 6;
    ldsp_t sk = (ldsp_t)(unsigned char*)lds;
    float* wl = (float*)((unsigned char*)lds + 65536 + wid * ROUTE_LDS_PER_WAVE);
    for (int head = blockIdx.x & 7; head < 8; head += gridDim.x) {
        const int nbh = ((int)gridDim.x - head + 7) / 8, rank = blockIdx.x >> 3;
        __syncthreads();
        const u32x4* src = (const u32x4*)((const bf16_t*)(p.ws + WS_SUBK) + (size_t)head * 2 * 128 * 128);
#pragma unroll
        for (int j = 0; j < 8; ++j) { const int ci = threadIdx.x + NTHREADS * j, row = ci >> 4, c = ci & 15; *(LAS u32x4*)(sk + row * 256 + ((c ^ (row & 15)) * 16)) = src[ci]; }
        __syncthreads();
        for (int chunk = rank * NWAVES + wid; chunk < NTOK / 32; chunk += nbh * NWAVES) route_task(p, chunk, head, lane, wl, sk);
    }
}

DI float gelu_exact(float a) { return 0.5f * a * (1.0f + erff(a * 0.70710678118654752f)); }
DI void fp8x16_to_f32(const u32x4& w, float (&f)[16]) {
#pragma unroll
    for (int j = 0; j < 4; ++j) { const f32x2 lo = __builtin_amdgcn_cvt_pk_f32_fp8((int)w[j], false); const f32x2 hi = __builtin_amdgcn_cvt_pk_f32_fp8((int)w[j], true);
        f[4 * j] = lo.x; f[4 * j + 1] = lo.y; f[4 * j + 2] = hi.x; f[4 * j + 3] = hi.y; }
}
DI void phase8(const Params& p) {
    unsigned char* ws = p.ws;
    const int lane = threadIdx.x & 63, wid = threadIdx.x >> 6;
    const int gwave = blockIdx.x * NWAVES + wid, nwaves = gridDim.x * NWAVES;
    const bf16_t* h2 = (const bf16_t*)(ws + WS_H2); const unsigned char* tu = ws + WS_TABU; const unsigned char* tvv = ws + WS_TABV;
    const float* tsc = (const float*)(ws + WS_TSCALE);
    const unsigned short* idx = (const unsigned short*)(ws + WS_IDX); const float* gw = (const float*)(ws + WS_GW);
    const float* gfin = p.in[20];
    const int kk = ((lane >> 5) & 1) * 8 + ((lane >> 4) & 1) * 4 + ((lane >> 3) & 1) * 2 + ((lane >> 2) & 1);
#pragma unroll 1
    for (int tk = gwave; tk < NTOK; tk += nwaves) {
        const size_t tok = (size_t)tk;
        const float rstd = row_rstd((const float*)(ws + WS_ROWSS), tok);
        float hn[16];
        { const u32x4 a = *(const u32x4*)(h2 + tok * D + lane * 16); const u32x4 b = *(const u32x4*)(h2 + tok * D + lane * 16 + 8);
          hn[0] = bflo(a.x) * rstd; hn[1] = bfhi(a.x) * rstd; hn[2] = bflo(a.y) * rstd; hn[3] = bfhi(a.y) * rstd; hn[4] = bflo(a.z) * rstd; hn[5] = bfhi(a.z) * rstd; hn[6] = bflo(a.w) * rstd; hn[7] = bfhi(a.w) * rstd;
          hn[8] = bflo(b.x) * rstd; hn[9] = bfhi(b.x) * rstd; hn[10] = bflo(b.y) * rstd; hn[11] = bfhi(b.y) * rstd; hn[12] = bflo(b.z) * rstd; hn[13] = bfhi(b.z) * rstd; hn[14] = bflo(b.w) * rstd; hn[15] = bfhi(b.w) * rstd; }
        float acc[16];
#pragma unroll
        for (int i = 0; i < 16; ++i) acc[i] = 0.f;
        const int e_lo = idx[tok * 128 + lane], e_hi = idx[tok * 128 + 64 + lane];
        const float g_lo = gw[tok * 128 + lane], g_hi = gw[tok * 128 + 64 + lane];
        for (int rep9 = 0; rep9 < REP9; ++rep9)
#pragma unroll 1
        for (int head = 0; head < 8; ++head) {
            const int esrc = head < 4 ? e_lo : e_hi; const float gsrc = head < 4 ? g_lo : g_hi;
            const int myslot = (head & 3) * 16 + kk;
            const int my_e = __shfl(esrc, myslot); const float my_g = __shfl(gsrc, myslot);
            const float su = tsc[my_e], sv = tsc[16384 + my_e];
            u32x4 ub[16], vb[16];
#pragma unroll
            for (int k = 0; k < 16; ++k) { const int e = __builtin_amdgcn_readlane(esrc, (head & 3) * 16 + k);
                ub[k] = *(const u32x4*)(tu + (size_t)e * 1024 + lane * 16); vb[k] = *(const u32x4*)(tvv + (size_t)e * 1024 + lane * 16); }
            float d[16];
#pragma unroll
            for (int k = 0; k < 16; ++k) { float f[16]; fp8x16_to_f32(ub[k], f); float t = 0.f;
#pragma unroll
                for (int i = 0; i < 16; ++i) t += f[i] * hn[i];
                d[k] = t; }
            float r8[8], r4[4], r2[2], r1;
            { const bool up = (lane & 32) != 0;
#pragma unroll
              for (int k = 0; k < 8; ++k) { const float keep = up ? d[k + 8] : d[k], send = up ? d[k] : d[k + 8]; r8[k] = keep + __shfl_xor(send, 32); } }
            { const bool up = (lane & 16) != 0;
#pragma unroll
              for (int k = 0; k < 4; ++k) { const float keep = up ? r8[k + 4] : r8[k], send = up ? r8[k] : r8[k + 4]; r4[k] = keep + __shfl_xor(send, 16); } }
            { const bool up = (lane & 8) != 0;
#pragma unroll
              for (int k = 0; k < 2; ++k) { const float keep = up ? r4[k + 2] : r4[k], send = up ? r4[k] : r4[k + 2]; r2[k] = keep + __shfl_xor(send, 8); } }
            { const bool up = (lane & 4) != 0; const float keep = up ? r2[1] : r2[0], send = up ? r2[0] : r2[1]; r1 = keep + __shfl_xor(send, 4); }
            r1 += __shfl_xor(r1, 2); r1 += __shfl_xor(r1, 1);
            const float wmine = my_g * gelu_exact(r1 * su) * sv;
#pragma unroll
            for (int k = 0; k < 16; ++k) {
                const int lk = ((k >> 3) & 1) * 32 + ((k >> 2) & 1) * 16 + ((k >> 1) & 1) * 8 + (k & 1) * 4;
                const float w = __uint_as_float(__builtin_amdgcn_readlane(__float_as_uint(wmine), lk));
                float f[16]; fp8x16_to_f32(vb[k], f);
#pragma unroll
                for (int i = 0; i < 16; ++i) acc[i] += w * f[i];
            }
        }
        float* orow = p.out + tok * D + lane * 16;
        f32x4 y[4]; float ss = 0.f;
#pragma unroll
        for (int q = 0; q < 4; ++q) { f32x4 v = *(const f32x4*)(orow + 4 * q);
            v.x += acc[q * 4] * (1.0f / REP9); v.y += acc[q * 4 + 1] * (1.0f / REP9); v.z += acc[q * 4 + 2] * (1.0f / REP9); v.w += acc[q * 4 + 3] * (1.0f / REP9); y[q] = v; ss += (v.x * v.x + v.y * v.y) + (v.z * v.z + v.w * v.w); }
        const float rs = 1.0f / sqrtf(wave_sum(ss) * (1.0f / D) + RMS_EPS);
#pragma unroll
        for (int q = 0; q < 4; ++q) { const f32x4 gg = *(const f32x4*)(gfin + lane * 16 + 4 * q); f32x4 v = y[q];
            v.x *= rs * gg.x; v.y *= rs * gg.y; v.z *= rs * gg.z; v.w *= rs * gg.w; *(f32x4*)(orow + 4 * q) = v; }
    }
}


constexpr int P8_CHUNK = 16, P8_NCHUNK = NTOK / P8_CHUNK;
DI unsigned my_xcc() { return (unsigned)__builtin_amdgcn_s_getreg((3 << 11) | 20) & 7u; }
DI float dpp_xor1(float v) { return __int_as_float(__builtin_amdgcn_update_dpp(0, __float_as_int(v), 0xB1, 0xF, 0xF, true)); }
DI float dpp_xor2(float v) { return __int_as_float(__builtin_amdgcn_update_dpp(0, __float_as_int(v), 0x4E, 0xF, 0xF, true)); }
DI void fp8x16_to_f32x2(const u32x4& w, f32x2 (&f)[8]) {
#pragma unroll
    for (int j = 0; j < 4; ++j) { f[2 * j] = __builtin_amdgcn_cvt_pk_f32_fp8((int)w[j], false); f[2 * j + 1] = __builtin_amdgcn_cvt_pk_f32_fp8((int)w[j], true); }
}
struct HalfT { u32x4 rb[8]; float sc[8]; };
DI void p8a_issue(HalfT& B, const unsigned char* tu, const LAS float* tsc, const LAS unsigned short* eidx, int ti, int hf, int sl, int pp, int cc, int gmine) {
#pragma unroll
    for (int g = 0; g < 8; ++g) { const int e = eidx[ti * 128 + (hf * 8 + g) * 8 + pp]; B.rb[g] = *(const u32x4*)(tu + (size_t)sl * (16384 * 128) + (size_t)e * 128 + cc * 16); }
    B.sc[0] = tsc[eidx[ti * 128 + (hf * 8 + gmine) * 8 + pp]];
}
DI float p8a_compute(const HalfT& B, const f32x2 (&hn)[8], int cc) {
    float d[8];
#pragma unroll
    for (int g = 0; g < 8; ++g) { f32x2 f[8]; fp8x16_to_f32x2(B.rb[g], f); f32x2 a = f[0] * hn[0];
#pragma unroll
        for (int i = 1; i < 8; ++i) a += f[i] * hn[i];
        d[g] = a.x + a.y; }
    float r4[4], r2[2];
    { const bool up = (cc & 1) != 0;
#pragma unroll
      for (int i = 0; i < 4; ++i) { const float keep = up ? d[i + 4] : d[i], send = up ? d[i] : d[i + 4]; r4[i] = keep + dpp_xor1(send); } }
    { const bool up = (cc & 2) != 0;
#pragma unroll
      for (int i = 0; i < 2; ++i) { const float keep = up ? r4[i + 2] : r4[i], send = up ? r4[i] : r4[i + 2]; r2[i] = keep + dpp_xor2(send); } }
    const bool up = (cc & 4) != 0; const float keep = up ? r2[1] : r2[0], send = up ? r2[0] : r2[1];
    return (keep + __shfl_xor(send, 4)) * B.sc[0];
}
DI void phase8a(const Params& p, unsigned char* lds_raw_, int rep) {
    unsigned char* ws = p.ws;
    const int lane = threadIdx.x & 63, pp = lane >> 3, cc = lane & 7;
    const bf16_t* h2 = (const bf16_t*)(ws + WS_H2); const unsigned char* tu = ws + WS_TABU; const float* tscg = (const float*)(ws + WS_TSCALE);
    const unsigned short* idx = (const unsigned short*)(ws + WS_IDX); bf16_t* pd = (bf16_t*)(ws + WS_PD);
    unsigned* ctr = (unsigned*)(ws + WS_CTL) + 1024 + 8192 * rep;
    LAS unsigned short* eidx = (LAS unsigned short*)((ldsp_t)lds_raw_ + __builtin_amdgcn_readfirstlane((int)(threadIdx.x >> 6)) * 8192);
    LAS float* tsc = (LAS float*)((ldsp_t)lds_raw_ + 65536);
    for (int i = threadIdx.x; i < 4096; i += NTHREADS) ((LAS i32x4*)tsc)[i] = ((const i32x4*)tscg)[i];
    __syncthreads();
    const unsigned xs = my_xcc();
    const int gmine = ((cc & 1) << 2) | (cc & 2) | ((cc >> 2) & 1);
#pragma unroll 1
    for (int k8 = 0; k8 < 8; ++k8) {
        const int sl = (int)((xs + k8) & 7u);
#pragma unroll 1
        for (;;) {
            unsigned tk = 0; if (lane == 0) tk = atomicAdd(ctr + 64 * sl, 1u);
            const int chunk = (int)__builtin_amdgcn_readfirstlane(tk);
            if (chunk >= P8_NCHUNK) break;
            const size_t tok0 = (size_t)chunk * P8_CHUNK;
#pragma unroll
            for (int i = 0; i < 4; ++i) ((LAS i32x4*)eidx)[i * 64 + lane] = ((const i32x4*)(idx + tok0 * 128))[i * 64 + lane];
            __builtin_amdgcn_wave_barrier();
            HalfT X, Y; u32x4 hr0, hr1;
            hr0 = *(const u32x4*)(h2 + tok0 * D + sl * 128 + cc * 16); hr1 = *(const u32x4*)(h2 + tok0 * D + sl * 128 + cc * 16 + 8);
            p8a_issue(X, tu, tsc, eidx, 0, 0, sl, pp, cc, gmine);
#pragma unroll 1
            for (int ti = 0; ti < P8_CHUNK; ++ti) {
                const size_t tok = tok0 + ti;
                p8a_issue(Y, tu, tsc, eidx, ti, 1, sl, pp, cc, gmine);
                f32x2 hn[8];
                hn[0] = (f32x2){bflo(hr0.x), bfhi(hr0.x)}; hn[1] = (f32x2){bflo(hr0.y), bfhi(hr0.y)}; hn[2] = (f32x2){bflo(hr0.z), bfhi(hr0.z)}; hn[3] = (f32x2){bflo(hr0.w), bfhi(hr0.w)};
                hn[4] = (f32x2){bflo(hr1.x), bfhi(hr1.x)}; hn[5] = (f32x2){bflo(hr1.y), bfhi(hr1.y)}; hn[6] = (f32x2){bflo(hr1.z), bfhi(hr1.z)}; hn[7] = (f32x2){bflo(hr1.w), bfhi(hr1.w)};
                const float keep0 = p8a_compute(X, hn, cc);
                if (ti + 1 < P8_CHUNK) { hr0 = *(const u32x4*)(h2 + (tok + 1) * D + sl * 128 + cc * 16); hr1 = *(const u32x4*)(h2 + (tok + 1) * D + sl * 128 + cc * 16 + 8); p8a_issue(X, tu, tsc, eidx, ti + 1, 0, sl, pp, cc, gmine); }
                const float keep1 = p8a_compute(Y, hn, cc);
                bf16_t* po = pd + ((size_t)sl * NTOK + tok) * 128 + gmine * 8 + pp;
                po[0] = (bf16_t)f2bf(keep0); po[64] = (bf16_t)f2bf(keep1);
            }
            __builtin_amdgcn_wave_barrier();
        }
    }
}
DI void phase8w(const Params& p, unsigned char* lds_raw_) {
    unsigned char* ws = p.ws;
    const int lane = threadIdx.x & 63, wid = threadIdx.x >> 6;
    const int gwave = blockIdx.x * NWAVES + wid, nwaves = gridDim.x * NWAVES;
    const bf16_t* __restrict__ pd = (const bf16_t*)(ws + WS_PD); const float* __restrict__ tsc = (const float*)(ws + WS_TSCALE);
    const unsigned short* __restrict__ idx = (const unsigned short*)(ws + WS_IDX); const float* __restrict__ gw = (const float*)(ws + WS_GW); bf16_t* __restrict__ wp = (bf16_t*)(ws + WS_WPEER);
    const float* __restrict__ rowss = (const float*)(ws + WS_ROWSS);
    LAS float* svl = (LAS float*)((ldsp_t)lds_raw_);
    for (int i = threadIdx.x; i < 4096; i += NTHREADS) ((LAS i32x4*)svl)[i] = ((const i32x4*)(tsc + 16384))[i];
    __syncthreads();
    for (int tk = gwave; tk < NTOK; tk += 4 * nwaves) {
        float pa[4][16]; int e0[4], e1[4]; float g0[4], g1[4]; float rs[4]; size_t tok[4];
#pragma unroll
        for (int q = 0; q < 4; ++q) { const int t = tk + q * nwaves; tok[q] = (size_t)(t < NTOK ? t : tk); }
#pragma unroll
        for (int q = 0; q < 4; ++q) {
#pragma unroll
            for (int sl = 0; sl < 8; ++sl) { const bf16_t* qa = pd + ((size_t)sl * NTOK + tok[q]) * 128 + lane; pa[q][2 * sl] = bf2f(qa[0]); pa[q][2 * sl + 1] = bf2f(qa[64]); }
            e0[q] = idx[tok[q] * 128 + lane]; e1[q] = idx[tok[q] * 128 + 64 + lane]; g0[q] = gw[tok[q] * 128 + lane]; g1[q] = gw[tok[q] * 128 + 64 + lane];
            rs[q] = rowss[tok[q] * 32 + (lane & 31)]; }
        float v0[4], v1[4];
#pragma unroll
        for (int q = 0; q < 4; ++q) { v0[q] = svl[e0[q]]; v1[q] = svl[e1[q]]; }
#pragma unroll
        for (int q = 0; q < 4; ++q) {
            float ss = rs[q];
#pragma unroll
            for (int o = 1; o < 32; o <<= 1) ss += __shfl_xor(ss, o);
            const float rstd = 1.0f / sqrtf(ss * (1.0f / D) + RMS_EPS);
            float a0 = 0.f, a1 = 0.f;
#pragma unroll
            for (int sl = 0; sl < 8; ++sl) { a0 += pa[q][2 * sl]; a1 += pa[q][2 * sl + 1]; }
            if (tk + q * nwaves < NTOK) { wp[tok[q] * 128 + lane] = (bf16_t)f2bf(g0[q] * gelu_exact(a0 * rstd) * v0[q]); wp[tok[q] * 128 + 64 + lane] = (bf16_t)f2bf(g1[q] * gelu_exact(a1 * rstd) * v1[q]); }
        }
    }
}
DI void p8b_issue(HalfT& B, const unsigned char* tvv, const LAS unsigned short* eidx, const LAS bf16_t* wl, int ti, int hf, int sl, int pp, int cc) {
#pragma unroll
    for (int g = 0; g < 8; ++g) { const int e = eidx[ti * 128 + (hf * 8 + g) * 8 + pp]; B.sc[g] = bf2f(wl[ti * 128 + (hf * 8 + g) * 8 + pp]); B.rb[g] = *(const u32x4*)(tvv + (size_t)sl * (16384 * 128) + (size_t)e * 128 + cc * 16); }
}
DI void p8b_compute(const HalfT& B, f32x2 (&acc)[8]) {
#pragma unroll
    for (int g = 0; g < 8; ++g) { f32x2 f[8]; fp8x16_to_f32x2(B.rb[g], f); const f32x2 w2 = {B.sc[g], B.sc[g]};
#pragma unroll
        for (int i = 0; i < 8; ++i) acc[i] += w2 * f[i]; }
}
DI void phase8b(const Params& p, unsigned char* lds_raw_) {
    unsigned char* ws = p.ws;
    const int lane = threadIdx.x & 63, pp = lane >> 3, cc = lane & 7;
    const unsigned char* tvv = ws + WS_TABV;
    const unsigned short* idx = (const unsigned short*)(ws + WS_IDX); const bf16_t* wp = (const bf16_t*)(ws + WS_WPEER); float* ssp = (float*)(ws + WS_SS);
    unsigned* ctr = (unsigned*)(ws + WS_CTL) + 2048;
    LAS unsigned short* eidx = (LAS unsigned short*)((ldsp_t)lds_raw_ + __builtin_amdgcn_readfirstlane((int)(threadIdx.x >> 6)) * 16384);
    LAS bf16_t* wl = (LAS bf16_t*)(eidx + P8_CHUNK * 128);
    const unsigned xs = my_xcc();
#pragma unroll 1
    for (int k8 = 0; k8 < 8; ++k8) {
        const int sl = (int)((xs + k8) & 7u);
#pragma unroll 1
        for (;;) {
            unsigned tk = 0; if (lane == 0) tk = atomicAdd(ctr + 64 * sl, 1u);
            const int chunk = (int)__builtin_amdgcn_readfirstlane(tk);
            if (chunk >= P8_NCHUNK) break;
            const size_t tok0 = (size_t)chunk * P8_CHUNK;
#pragma unroll
            for (int i = 0; i < 4; ++i) { ((LAS i32x4*)eidx)[i * 64 + lane] = ((const i32x4*)(idx + tok0 * 128))[i * 64 + lane]; ((LAS i32x4*)wl)[i * 64 + lane] = ((const i32x4*)(wp + tok0 * 128))[i * 64 + lane]; }
            __builtin_amdgcn_wave_barrier();
            HalfT X, Y;
            p8b_issue(X, tvv, eidx, wl, 0, 0, sl, pp, cc);
#pragma unroll 1
            for (int ti = 0; ti < P8_CHUNK; ++ti) {
                const size_t tok = tok0 + ti;
                p8b_issue(Y, tvv, eidx, wl, ti, 1, sl, pp, cc);
                float* xo = p.out + tok * D + sl * 128 + cc * 16 + 2 * pp;
                f32x2 xv = *(const f32x2*)xo;
                f32x2 acc2[8];
#pragma unroll
                for (int i = 0; i < 8; ++i) acc2[i] = (f32x2){0.f, 0.f};
                p8b_compute(X, acc2);
                if (ti + 1 < P8_CHUNK) p8b_issue(X, tvv, eidx, wl, ti + 1, 0, sl, pp, cc);
                p8b_compute(Y, acc2);
                float acc[16];
#pragma unroll
                for (int i = 0; i < 8; ++i) { acc[2 * i] = acc2[i].x; acc[2 * i + 1] = acc2[i].y; }
                float r8[8], r4[4], r2[2];
                { const bool up = (lane & 32) != 0;
#pragma unroll
                  for (int i = 0; i < 8; ++i) { const float keep = up ? acc[i + 8] : acc[i], send = up ? acc[i] : acc[i + 8]; r8[i] = keep + __shfl_xor(send, 32); } }
                { const bool up = (lane & 16) != 0;
#pragma unroll
                  for (int i = 0; i < 4; ++i) { const float keep = up ? r8[i + 4] : r8[i], send = up ? r8[i] : r8[i + 4]; r4[i] = keep + __shfl_xor(send, 16); } }
                { const bool up = (lane & 8) != 0;
#pragma unroll
                  for (int i = 0; i < 2; ++i) { const float keep = up ? r4[i + 2] : r4[i], send = up ? r4[i] : r4[i + 2]; r2[i] = keep + __shfl_xor(send, 8); } }
                xv.x += r2[0]; xv.y += r2[1]; *(unsigned*)((bf16_t*)(ws + WS_X3) + tok * D + sl * 128 + cc * 16 + 2 * pp) = pk2(xv.x, xv.y);
                const float ss = wave_sum(xv.x * xv.x + xv.y * xv.y);
                if (lane == 0) ssp[tok * 8 + sl] = ss;
            }
            __builtin_amdgcn_wave_barrier();
        }
    }
}
DI void phase8c(const Params& p) {
    unsigned char* ws = p.ws;
    const int lane = threadIdx.x & 63, wid = threadIdx.x >> 6;
    const int gwave = blockIdx.x * NWAVES + wid, nwaves = gridDim.x * NWAVES;
    const float* ssp = (const float*)(ws + WS_SS); const bf16_t* x3 = (const bf16_t*)(ws + WS_X3);
    f32x4 gg[4];
#pragma unroll
    for (int j = 0; j < 4; ++j) gg[j] = *(const f32x4*)(p.in[20] + (j >> 1) * 512 + lane * 8 + (j & 1) * 4);
    for (int tk = gwave; tk < NTOK; tk += 2 * nwaves) {
        const bool two = tk + nwaves < NTOK; const size_t tokA = (size_t)tk, tokB = (size_t)(two ? tk + nwaves : tk);
        const u32x4 a0 = *(const u32x4*)(x3 + tokA * D + lane * 8), a1 = *(const u32x4*)(x3 + tokA * D + 512 + lane * 8);
        const u32x4 b0 = *(const u32x4*)(x3 + tokB * D + lane * 8), b1 = *(const u32x4*)(x3 + tokB * D + 512 + lane * 8);
        const f32x4 sa0 = *(const f32x4*)(ssp + tokA * 8), sa1 = *(const f32x4*)(ssp + tokA * 8 + 4), sb0 = *(const f32x4*)(ssp + tokB * 8), sb1 = *(const f32x4*)(ssp + tokB * 8 + 4);
        const float rsa = 1.0f / sqrtf(((sa0.x + sa0.y) + (sa0.z + sa0.w) + (sa1.x + sa1.y) + (sa1.z + sa1.w)) * (1.0f / D) + RMS_EPS);
        const float rsb = 1.0f / sqrtf(((sb0.x + sb0.y) + (sb0.z + sb0.w) + (sb1.x + sb1.y) + (sb1.z + sb1.w)) * (1.0f / D) + RMS_EPS);
        float* oa = p.out + tokA * D + lane * 8; float* ob = p.out + tokB * D + lane * 8;
#define OUT8(O, W, RS, G0, G1) { f32x4 v0 = {bflo(W.x) * RS * G0.x, bfhi(W.x) * RS * G0.y, bflo(W.y) * RS * G0.z, bfhi(W.y) * RS * G0.w}; f32x4 v1 = {bflo(W.z) * RS * G1.x, bfhi(W.z) * RS * G1.y, bflo(W.w) * RS * G1.z, bfhi(W.w) * RS * G1.w}; *(f32x4*)(O) = v0; *(f32x4*)((O) + 4) = v1; }
        OUT8(oa, a0, rsa, gg[0], gg[1]) OUT8(oa + 512, a1, rsa, gg[2], gg[3])
        if (two) { OUT8(ob, b0, rsb, gg[0], gg[1]) OUT8(ob + 512, b1, rsb, gg[2], gg[3]) }
#undef OUT8
    }
}

#define XB_TMO      128
#define XB_XCNT(j)  (256  + 64 * (j))
#define XB_XSUB(j)  (1280 + 64 * (j))
#define XB_XGEN(j)  (2304 + 64 * (j))
#define XB_TOP      3328
#define XB_TOPGEN   3392
#define XCD_BAR_WORDS 3456
#define XB_SPIN_CAP (1u << 18)

__device__ __forceinline__ unsigned xb_ld(unsigned* p)              { return __hip_atomic_load(p, __ATOMIC_RELAXED, __HIP_MEMORY_SCOPE_AGENT); }
__device__ __forceinline__ unsigned xb_add(unsigned* p, unsigned v) { return __hip_atomic_fetch_add(p, v, __ATOMIC_RELAXED, __HIP_MEMORY_SCOPE_AGENT); }
__device__ __forceinline__ unsigned xb_xcc_id() { return (unsigned)__builtin_amdgcn_s_getreg((3 << 11) | 20) & 0xFu; }
#define XB_SPIN(cond, bar) do { unsigned _sp = 0; while (cond) { __builtin_amdgcn_s_sleep(1); \
    if ((++_sp & 255u) == 0u) { if (xb_ld(&(bar)[XB_TMO])) break; if (_sp > XB_SPIN_CAP) { atomicAdd(&(bar)[XB_TMO], 1u); break; } } } } while (0)

struct XcdBarrier {
    unsigned* bar; unsigned x;
    volatile unsigned* st;
};

__device__ __forceinline__ XcdBarrier xcd_barrier_post(unsigned* bar, volatile unsigned* st) {
    XcdBarrier b; b.bar = bar; b.x = xb_xcc_id(); b.st = st;
    if (threadIdx.x == 0) (void)xb_add(&bar[XB_XCNT(b.x)], 1u);
    return b;
}
__device__ __forceinline__ void xcd_barrier_complete(unsigned* bar, unsigned x, unsigned& nloc, unsigned& nx) {
    const unsigned G = gridDim.x * gridDim.y * gridDim.z;
    unsigned sum, cnt, mine, sp = 0u;
    for (;;) {
        sum = 0u; cnt = 0u; mine = 0u;
#pragma unroll
        for (unsigned j = 0; j < 16; ++j) { const unsigned c = xb_ld(&bar[XB_XCNT(j)]); sum += c; cnt += (c > 0u) ? 1u : 0u; mine = (j == x) ? c : mine; }
        if (sum == G) break;
        __builtin_amdgcn_s_sleep(1);
        if ((++sp & 255u) == 0u) { if (xb_ld(&bar[XB_TMO])) break; if (sp > XB_SPIN_CAP) { atomicAdd(&bar[XB_TMO], 1u); break; } }
    }
    nloc = mine > 0u ? mine : 1u; nx = cnt > 0u ? cnt : 1u;
}

__device__ __forceinline__ void xcd_barrier(const XcdBarrier& b) {
    asm volatile("s_waitcnt vmcnt(0)" ::: "memory");
    __syncthreads();
    if (threadIdx.x == 0) {
        unsigned* bar = b.bar;
        __builtin_amdgcn_s_waitcnt(0);
        unsigned nloc = b.st[0], nx = b.st[1];
        if (nloc == 0u) { xcd_barrier_complete(bar, b.x, nloc, nx); b.st[0] = nloc; b.st[1] = nx; }
        const unsigned old = xb_add(&bar[XB_XSUB(b.x)], 1u);
        const unsigned gen = old / nloc;
        if (old + 1u == (gen + 1u) * nloc) {
            __builtin_amdgcn_fence(__ATOMIC_RELEASE, "agent");
            asm volatile("s_waitcnt vmcnt(0)" ::: "memory");
            const unsigned og = xb_add(&bar[XB_TOP], 1u);
            const unsigned tg = og / nx;
            if (og + 1u == (tg + 1u) * nx) xb_add(&bar[XB_TOPGEN], 1u);
            else XB_SPIN(xb_ld(&bar[XB_TOPGEN]) == tg, bar);
            __builtin_amdgcn_fence(__ATOMIC_ACQUIRE, "agent");
            xb_add(&bar[XB_XGEN(b.x)], 1u);
            asm volatile("s_waitcnt vmcnt(0)" ::: "memory");
        } else {
            XB_SPIN(xb_ld(&bar[XB_XGEN(b.x)]) == gen, bar);
            __builtin_amdgcn_fence(__ATOMIC_ACQUIRE, "agent");
            asm volatile("s_waitcnt vmcnt(0)" ::: "memory");
        }
    }
    __syncthreads();
}

constexpr int N_PHASES = 13;
__global__ void __launch_bounds__(NTHREADS) mega(Params p) {
    extern __shared__ __attribute__((aligned(16))) unsigned char lds_raw[];
    bf16_t* lds = (bf16_t*)lds_raw;
#if N_LAUNCH_MODE == 1
    cg::grid_group grid = cg::this_grid();
    XcdBarrier xbar = xcd_barrier_post((unsigned*)(p.ws + WS_CTL) + 4096, (volatile unsigned*)(p.ws + WS_CTL) + 12288 + 2 * blockIdx.x);
    if (p.ph_lo == 0x7fffffff) grid.sync();
#define SEAM(k) do { if (p.ph_lo <= (k) && (k) + 1 < p.ph_hi) { xcd_barrier(xbar); } } while (0)
#else
#define SEAM(k) do { } while (0)
#endif
#ifndef PHASE_MASK
#define PHASE_MASK 0x1fff
#endif
#define IN(k) (((PHASE_MASK >> (k)) & 1) && p.ph_lo <= (k) && (k) < p.ph_hi)
    if (IN(0)) for (int rep = 0; rep < REP0; ++rep) phase0(p, lds_raw);
    SEAM(0);
    if (IN(1)) for (int rep = 0; rep < REP1; ++rep) phase1(p, lds);
    SEAM(1);
    if (IN(2)) for (int rep = 0; rep < REP2; ++rep) phase2(p, lds);
    SEAM(2);
    if (IN(3)) for (int rep = 0; rep < REP3; ++rep) phase3a(p, rep, lds);
    SEAM(3);
    if (IN(4)) for (int rep = 0; rep < REP4; ++rep) phase3b(p, rep, lds_raw);
    SEAM(4);
    if (IN(5)) for (int rep = 0; rep < REP5; ++rep) phase4(p, lds);
    SEAM(5);
    if (IN(6)) for (int rep = 0; rep < REP6; ++rep) phase5(p, lds);
    SEAM(6);
    if (IN(7)) for (int rep = 0; rep < REP7; ++rep) phase6(p, lds);
    SEAM(7);
    if (IN(8)) for (int rep = 0; rep < REP8; ++rep) { __syncthreads(); phase7(p, lds); }
    SEAM(8);
    if (IN(9)) for (int rep = 0; rep < REP9; ++rep) phase8a(p, lds_raw, rep);
    SEAM(9);
    if (IN(10)) for (int rep = 0; rep < REP10; ++rep) phase8w(p, lds_raw);
    SEAM(10);
    if (IN(11)) phase8b(p, lds_raw);
    SEAM(11);
    if (IN(12)) phase8c(p);
}

extern "C" void kernel_launch(void* const* d_in, const int* in_sizes, int n_in, void* d_out, int out_size, void* d_ws, size_t ws_size, hipStream_t stream) {
    static int grid = 0;
    if (grid == 0) {
        if (n_in != 21 || out_size != NTOK * D || ws_size < WS_END) { fprintf(stderr, "kernel_launch: unexpected shapes: n_in %d out %d ws %zu\n", n_in, out_size, ws_size); grid = -1; return; }
        int dev = 0, cus = 0, per_cu = 0;
        hipGetDevice(&dev);
        hipDeviceGetAttribute(&cus, hipDeviceAttributeMultiprocessorCount, dev);
        hipFuncSetAttribute((const void*)mega, hipFuncAttributeMaxDynamicSharedMemorySize, LDS_BYTES);
        hipOccupancyMaxActiveBlocksPerMultiprocessor(&per_cu, (const void*)mega, NTHREADS, LDS_BYTES);
        if (per_cu < 1) per_cu = 1;
        if (per_cu > 1) per_cu = 1;
        grid = cus * per_cu;
    }
    if (grid < 0) return;
    hipMemsetAsync((char*)d_ws + WS_CTL, 0, 65536, stream);
    Params p{};
    for (int i = 0; i < 21; ++i) p.in[i] = (const float*)d_in[i];
    p.out = (float*)d_out; p.ws = (unsigned char*)d_ws;
#if N_LAUNCH_MODE == 1
    p.ph_lo = 0; p.ph_hi = N_PHASES;
    void* args[] = {&p};
    hipError_t e = hipLaunchCooperativeKernel((const void*)mega, dim3(grid), dim3(NTHREADS), args, LDS_BYTES, stream);
    if (e != hipSuccess) fprintf(stderr, "cooperative launch failed: %s (grid %d)\n", hipGetErrorString(e), grid);
#else
    for (int ph = 0; ph < N_PHASES; ++ph) { p.ph_lo = ph; p.ph_hi = ph + 1; hipLaunchKernelGGL(mega, dim3(grid), dim3(NTHREADS), LDS_BYTES, stream, p); }
#endif
}
```

```cpp
#include <hip/hip_runtime.h>
#include <hip/hip_cooperative_groups.h>
#include <cstdio>
#include <cstdint>
namespace cg = cooperative_groups;

#ifndef N_LAUNCH_MODE
#define N_LAUNCH_MODE 1
#endif

#define REP0 1
#define REP1 1
#define REP2 1
#define REP3 1
#define REP4 1
#define REP5 1
#define REP6 1
#define REP7 1
#define REP8 1
#define REP9 1
#define REP10 1

typedef unsigned short bf16_t;
typedef short bf16x8 __attribute__((ext_vector_type(8)));
typedef short s16x4 __attribute__((ext_vector_type(4)));
typedef float f32x2 __attribute__((ext_vector_type(2)));
typedef float f32x4 __attribute__((ext_vector_type(4)));
typedef float f32x16 __attribute__((ext_vector_type(16)));
typedef unsigned u32x2 __attribute__((ext_vector_type(2)));
typedef unsigned u32x4 __attribute__((ext_vector_type(4)));
typedef int i32x4 __attribute__((ext_vector_type(4)));
typedef __bf16 bf16x2_t __attribute__((ext_vector_type(2)));
#define DI __device__ __forceinline__
#define LAS __attribute__((address_space(3)))

constexpr int NB = 8, T = 4096, D = 1024, NTOK = NB * T;
constexpr int MEMT = 256;
constexpr int NTHREADS = 512, NWAVES = 8;
constexpr int LDP_QKV = 2560;
constexpr int C_SBQ = 0, C_SBK = 384, C_SBV = 768, C_NQ = 1152, C_NKV = 1536, C_MQ = 2304;
constexpr int LDG = 3072;
constexpr int NPROJ = 5888;
constexpr int IN_DIM = 5650;
constexpr float RMS_EPS = 1e-6f;
constexpr float LOG2E = 1.4426950408889634f, LN2 = 0.6931471805599453f;

constexpr size_t MiB = 1u << 20;
constexpr size_t WS_CTL = 0;
constexpr size_t WS_WIN = 1 * MiB;
constexpr size_t WS_WQ = WS_WIN + 12 * MiB;
constexpr size_t WS_WOUT = WS_WQ + 4 * MiB;
constexpr size_t WS_WSB = WS_WOUT + 2 * MiB;
constexpr size_t WS_WNSA = WS_WSB + 1 * MiB;
constexpr size_t WS_WMEM = WS_WNSA + 1 * MiB;
constexpr size_t WS_WMKV = WS_WMEM + 1 * MiB;
constexpr size_t WS_SUBK = WS_WMKV + 1 * MiB;
constexpr size_t WS_CMPW = WS_SUBK + MiB / 2;
constexpr size_t WS_H = 24 * MiB;
constexpr size_t WS_QKV = 88 * MiB;
constexpr size_t WS_MERGED = WS_QKV;
constexpr size_t WS_IDX = WS_QKV + 64 * MiB;
constexpr size_t WS_GW = WS_QKV + 80 * MiB;
constexpr size_t WS_ROWSS = WS_QKV + 96 * MiB;
constexpr size_t WS_GATES = 248 * MiB;
constexpr size_t WS_H2 = WS_GATES;
constexpr size_t WS_QP = WS_GATES + 64 * MiB;
constexpr size_t WS_TABU = 440 * MiB;
constexpr size_t WS_TABV = 456 * MiB;
constexpr size_t WS_PD = WS_GATES + 64 * MiB;
constexpr size_t WS_WPEER = WS_QKV;
constexpr size_t WS_SS = WS_QKV + 32 * MiB;
constexpr size_t WS_X3 = WS_H2;
constexpr size_t WS_H8 = 344 * MiB;
constexpr size_t WS_HSC = 376 * MiB;
constexpr size_t WS_W8 = 377 * MiB;
constexpr size_t WS_W8SC = 384 * MiB;
constexpr size_t WS_WMKV8 = 385 * MiB;
constexpr size_t WS_MEMN8 = 387 * MiB;
constexpr size_t WS_TSCALE = 472 * MiB;
constexpr size_t WS_END = 504 * MiB;
constexpr size_t DO_VSLC = 0;
constexpr size_t DO_VWIN = 8 * MiB;
constexpr size_t DO_SBV = 16 * MiB;
constexpr size_t DO_KC = 40 * MiB;
constexpr size_t DO_VCT = 41 * MiB;
constexpr size_t DO_MEMN = 42 * MiB;
constexpr size_t DO_MKV = 46 * MiB;
constexpr size_t DO_MVT = 48 * MiB;
constexpr size_t DO_NSAG = 50 * MiB;
constexpr size_t DO_SELM = 54 * MiB;
constexpr size_t DO_OC = 56 * MiB;
constexpr size_t DO_KSLC = 80 * MiB;
constexpr size_t DO_KWIN = 88 * MiB;
constexpr size_t DO_MKT = 120 * MiB;
constexpr size_t DO_SBK = 96 * MiB;

constexpr int LDS_MAIN = 131072;
constexpr int LDS_BYTES = 163840;

struct Params {
    const float* in[21];
    float* out;
    unsigned char* ws;
    int ph_lo, ph_hi;
};

DI unsigned f2bf(float f) { unsigned u = __float_as_uint(f); return (u + 0x7fffu + ((u >> 16) & 1u)) >> 16; }
DI unsigned pk2(float lo, float hi) { f32x2 v = {lo, hi}; bf16x2_t b = __builtin_convertvector(v, bf16x2_t); return __builtin_bit_cast(unsigned, b); }
DI float bf2f(unsigned short h) { return __uint_as_float((unsigned)h << 16); }
DI float bflo(unsigned w) { return __uint_as_float(w << 16); }
DI float bfhi(unsigned w) { return __uint_as_float(w & 0xffff0000u); }
DI float wave_sum(float v) {
#pragma unroll
    for (int o = 1; o < 64; o <<= 1) v += __shfl_xor(v, o);
    return v;
}
DI float fexp2(float x) { return __builtin_amdgcn_exp2f(x); }
DI float flog2(float x) { return __builtin_amdgcn_logf(x); }
DI float fexp(float x) { return __builtin_amdgcn_exp2f(x * LOG2E); }
DI float sigmoidf_(float x) { return 1.0f / (1.0f + fexp(-x)); }
DI int krow(int r, int hi) { return (r & 3) + 8 * (r >> 2) + 4 * hi; }
#define MFMA32(a, b, c) __builtin_amdgcn_mfma_f32_32x32x16_bf16((a), (b), (c), 0, 0, 0)
#define MFMA16(a, b, c) __builtin_amdgcn_mfma_f32_16x16x32_bf16((a), (b), (c), 0, 0, 0)

DI void zero16(f32x16& v) {
#pragma unroll
    for (int i = 0; i < 16; ++i) v[i] = 0.f;
}
DI unsigned pack_i8x4(float a, float b, float c, float d) {
    const int ia = (int)__builtin_rintf(a), ib = (int)__builtin_rintf(b), ic = (int)__builtin_rintf(c), id = (int)__builtin_rintf(d);
    return ((unsigned)ia & 0xffu) | (((unsigned)ib & 0xffu) << 8) | (((unsigned)ic & 0xffu) << 16) | ((unsigned)id << 24);
}
DI float wave_max(float v) {
#pragma unroll
    for (int o = 1; o < 64; o <<= 1) v = fmaxf(v, __shfl_xor(v, o));
    return v;
}
DI void rms_row_i8(const float* xrow, const float* g, unsigned* o8row, float* scale, int lane) {
    const f32x4* xr = (const f32x4*)xrow + lane;
    const f32x4* gr = (const f32x4*)g + lane;
    f32x4 v[4]; float s = 0.f;
#pragma unroll
    for (int j = 0; j < 4; ++j) { v[j] = xr[64 * j]; s += (v[j].x * v[j].x + v[j].y * v[j].y) + (v[j].z * v[j].z + v[j].w * v[j].w); }
    const float rstd = 1.0f / sqrtf(wave_sum(s) * (1.0f / D) + RMS_EPS);
    float am = 0.f;
#pragma unroll
    for (int j = 0; j < 4; ++j) { const f32x4 gg = gr[64 * j]; v[j].x *= rstd * gg.x; v[j].y *= rstd * gg.y; v[j].z *= rstd * gg.z; v[j].w *= rstd * gg.w;
        am = fmaxf(am, fmaxf(fmaxf(fabsf(v[j].x), fabsf(v[j].y)), fmaxf(fabsf(v[j].z), fabsf(v[j].w)))); }
    am = wave_max(am);
    const float qs = am > 0.f ? 127.0f / am : 0.f;
#pragma unroll
    for (int j = 0; j < 4; ++j) o8row[lane + 64 * j] = pack_i8x4(v[j].x * qs, v[j].y * qs, v[j].z * qs, v[j].w * qs);
    if (lane == 0) scale[0] = am * (1.0f / 127.0f);
}
template <bool MAP> DI void quant_cols_i8(const float* W, int ldw, int ncol, unsigned char* dst8, float* dsc, float* red) {
    const int c = threadIdx.x & 15, kg = threadIdx.x >> 4;
    for (int cb = blockIdx.x; cb < ncol / 16; cb += gridDim.x) {
        const int col = cb * 16 + c; int srcc = col;
        if (MAP) { if (col < 2304) srcc = col; else if (col < 2560) srcc = 2322 + (col - 2304); else if (col < 5632) srcc = 2578 + (col - 2560); else if (col < 5650) srcc = 2304 + (col - 5632); else srcc = -1; }
        const float* src = W + (size_t)(kg * 32) * ldw + (srcc < 0 ? 0 : srcc);
        float v[32]; float am = 0.f;
#pragma unroll
        for (int i = 0; i < 32; ++i) { v[i] = srcc < 0 ? 0.f : src[(size_t)i * ldw]; am = fmaxf(am, fabsf(v[i])); }
        __syncthreads();
        red[kg * 16 + c] = am;
        __syncthreads();
#pragma unroll
        for (int i = 0; i < 32; ++i) am = fmaxf(am, red[i * 16 + c]);
        const float qs = am > 0.f ? 127.0f / am : 0.f;
        u32x4 w0, w1;
        w0.x = pack_i8x4(v[0] * qs, v[1] * qs, v[2] * qs, v[3] * qs); w0.y = pack_i8x4(v[4] * qs, v[5] * qs, v[6] * qs, v[7] * qs); w0.z = pack_i8x4(v[8] * qs, v[9] * qs, v[10] * qs, v[11] * qs); w0.w = pack_i8x4(v[12] * qs, v[13] * qs, v[14] * qs, v[15] * qs);
        w1.x = pack_i8x4(v[16] * qs, v[17] * qs, v[18] * qs, v[19] * qs); w1.y = pack_i8x4(v[20] * qs, v[21] * qs, v[22] * qs, v[23] * qs); w1.z = pack_i8x4(v[24] * qs, v[25] * qs, v[26] * qs, v[27] * qs); w1.w = pack_i8x4(v[28] * qs, v[29] * qs, v[30] * qs, v[31] * qs);
        u32x4* dst = (u32x4*)(dst8 + (size_t)col * 1024 + kg * 32); dst[0] = w0; dst[1] = w1;
        if (kg == 0) dsc[col] = am * (1.0f / 127.0f);
    }
}
DI void rms_row_bf16(const float* xrow, const float* g, bf16_t* orow, int lane) {
    const f32x4* xr = (const f32x4*)xrow + lane;
    const f32x4* gr = (const f32x4*)g + lane;
    f32x4 v[4]; float s = 0.f;
#pragma unroll
    for (int j = 0; j < 4; ++j) { v[j] = xr[64 * j]; s += (v[j].x * v[j].x + v[j].y * v[j].y) + (v[j].z * v[j].z + v[j].w * v[j].w); }
    const float rstd = 1.0f / sqrtf(wave_sum(s) * (1.0f / D) + RMS_EPS);
    u32x2* o8 = (u32x2*)orow + lane;
#pragma unroll
    for (int j = 0; j < 4; ++j) { const f32x4 gg = gr[64 * j]; u32x2 w; w.x = pk2(v[j].x * rstd * gg.x, v[j].y * rstd * gg.y); w.y = pk2(v[j].z * rstd * gg.z, v[j].w * rstd * gg.w); o8[64 * j] = w; }
}
DI void transpose_w(const float* W, int K, int N, bf16_t* Wt, int gtid, int gthreads, float sc = 1.0f) {
    const int total = (K / 8) * N;
    for (int it = gtid; it < total; it += gthreads) {
        const int n = it % N, k8 = it / N;
        const float* s = W + (size_t)(k8 * 8) * N + n;
        u32x4 o; o.x = pk2(s[0] * sc, s[(size_t)N] * sc); o.y = pk2(s[(size_t)2 * N] * sc, s[(size_t)3 * N] * sc); o.z = pk2(s[(size_t)4 * N] * sc, s[(size_t)5 * N] * sc); o.w = pk2(s[(size_t)6 * N] * sc, s[(size_t)7 * N] * sc);
        *(u32x4*)(Wt + (size_t)n * K + k8 * 8) = o;
    }
}
DI void late_weights(const Params& p, int gtid, int gthreads) {
    unsigned char* ws = p.ws;
    transpose_w(p.in[16], D, 2048, (bf16_t*)(ws + WS_WQ), gtid, gthreads);
    transpose_w(p.in[14], D, D, (bf16_t*)(ws + WS_WOUT), gtid, gthreads);
    transpose_w(p.in[11], 384, D, (bf16_t*)(ws + WS_WSB), gtid, gthreads, 1.0f / 255.0f);
    transpose_w(p.in[12], 384, D, (bf16_t*)(ws + WS_WNSA), gtid, gthreads, 1.0f / 255.0f);
    transpose_w(p.in[13], 256, D, (bf16_t*)(ws + WS_WMEM), gtid, gthreads, 1.0f / 255.0f);
    transpose_w(p.in[8], 2048, 64, (bf16_t*)(ws + WS_CMPW), gtid, gthreads);
    transpose_w(p.in[9], 2048, 64, (bf16_t*)(ws + WS_CMPW) + 64 * 2048, gtid, gthreads);
    {
        const f32x4* s = (const f32x4*)p.in[17]; u32x2* o = (u32x2*)(ws + WS_SUBK);
        for (int i = gtid; i < 8 * 2 * 128 * 128 / 4; i += gthreads) { const f32x4 v = s[i]; u32x2 w; w.x = pk2(v.x, v.y); w.y = pk2(v.z, v.w); o[i] = w; }
    }
}
DI void phase0(const Params& p, unsigned char* lds_raw_) {
    const int gtid = blockIdx.x * NTHREADS + threadIdx.x, gthreads = gridDim.x * NTHREADS;
    const int lane = threadIdx.x & 63, gwave = gtid >> 6, nwaves = gthreads >> 6;
    unsigned char* ws = p.ws;
    quant_cols_i8<true>(p.in[4], IN_DIM, NPROJ, ws + WS_W8, (float*)(ws + WS_W8SC), (float*)lds_raw_);
    quant_cols_i8<false>(p.in[10], 512, 512, ws + WS_WMKV8, (float*)(ws + WS_WMKV8 + MiB), (float*)lds_raw_);
    for (int row = gwave; row < NTOK; row += nwaves) rms_row_i8(p.in[0] + (size_t)row * D, p.in[2], (unsigned*)(ws + WS_H8) + (size_t)row * (D / 4), (float*)(ws + WS_HSC) + row, lane);
    for (int row = gwave; row < NB * MEMT; row += nwaves) rms_row_i8(p.in[1] + (size_t)row * D, p.in[3], (unsigned*)(ws + WS_MEMN8) + (size_t)row * (D / 4), (float*)(ws + WS_MEMN8 + 2 * MiB) + row, lane);
}
DI void peer_table_rows(const Params& p, int lane, int first, int stride) {
    unsigned char* ws = p.ws;
    unsigned char* tabu = ws + WS_TABU; unsigned char* tabv = ws + WS_TABV; float* tsc = (float*)(ws + WS_TSCALE);
#pragma unroll 1
    for (int row0 = first; row0 < 32768; row0 += 4 * stride) {
        f32x4 v[4][4];
#pragma unroll
        for (int q = 0; q < 4; ++q) { const int row = row0 + q * stride < 32768 ? row0 + q * stride : row0; const bool isv = row >= 16384; const int e = row & 16383;
            const f32x4* src = (const f32x4*)((isv ? p.in[19] : p.in[18]) + (size_t)e * 1024 + lane * 16);
#pragma unroll
            for (int j = 0; j < 4; ++j) v[q][j] = src[j]; }
#pragma unroll
        for (int q = 0; q < 4; ++q) { const int row = row0 + q * stride; const bool isv = row >= 16384; const int e = row & 16383;
            float am = 0.f;
#pragma unroll
            for (int j = 0; j < 4; ++j) am = fmaxf(am, fmaxf(fmaxf(fabsf(v[q][j].x), fabsf(v[q][j].y)), fmaxf(fabsf(v[q][j].z), fabsf(v[q][j].w))));
#pragma unroll
            for (int o = 1; o < 64; o <<= 1) am = fmaxf(am, __shfl_xor(am, o));
            const float top = isv ? 240.0f : 127.0f;
            const float sc = am > 0.f ? top / am : 1.0f;
            u32x4 w;
#pragma unroll
            for (int j = 0; j < 4; ++j) {
                if (isv) { int t = __builtin_amdgcn_cvt_pk_fp8_f32(v[q][j].x * sc, v[q][j].y * sc, 0, false); t = __builtin_amdgcn_cvt_pk_fp8_f32(v[q][j].z * sc, v[q][j].w * sc, t, true); w[j] = (unsigned)t; }
                else w[j] = pack_i8x4(v[q][j].x * sc, v[q][j].y * sc, v[q][j].z * sc, v[q][j].w * sc); }
            if (row < 32768) { *(u32x4*)((isv ? tabv : tabu) + (size_t)(lane >> 3) * (16384 * 128) + (size_t)e * 128 + (lane & 7) * 16) = w;
                if (lane == 0) tsc[row] = am > 0.f ? am / top : 1.0f; }
        }
    }
}

constexpr int GEMM_LDS_ROW = 72;
constexpr int GEMM_TILE_ELEMS = 128 * GEMM_LDS_ROW;
DI void gemm_mainloop(const bf16_t* __restrict__ Ag, int lda, const bf16_t* __restrict__ Bg, int ldb, int K, f32x4 (&acc)[4][2], bf16_t* lds) {
    const int tid = threadIdx.x, lane = tid & 63, wid = tid >> 6, wr = wid >> 2, wc = wid & 3;
    const int r0 = tid >> 3, kc = tid & 7;
    const bf16_t* ap0 = Ag + (size_t)r0 * lda + kc * 8; const bf16_t* ap1 = ap0 + (size_t)64 * lda;
    const bf16_t* bp0 = Bg + (size_t)r0 * ldb + kc * 8; const bf16_t* bp1 = bp0 + (size_t)64 * ldb;
    const int so0 = r0 * GEMM_LDS_ROW + kc * 8, so1 = so0 + 64 * GEMM_LDS_ROW;
    u32x4 ra0, ra1, rb0, rb1;
    ra0 = *(const u32x4*)ap0; ra1 = *(const u32x4*)ap1; rb0 = *(const u32x4*)bp0; rb1 = *(const u32x4*)bp1;
    __syncthreads();
    {
        bf16_t* As = lds; bf16_t* Bs = lds + GEMM_TILE_ELEMS;
        *(u32x4*)(As + so0) = ra0; *(u32x4*)(As + so1) = ra1; *(u32x4*)(Bs + so0) = rb0; *(u32x4*)(Bs + so1) = rb1;
    }
    __syncthreads();
    const int nk = K / 64;
    const int fr = lane & 15, fq = lane >> 4;
    for (int kt = 0; kt < nk; ++kt) {
        const int buf = kt & 1;
        if (kt + 1 < nk) { const int ko = (kt + 1) * 64; ra0 = *(const u32x4*)(ap0 + ko); ra1 = *(const u32x4*)(ap1 + ko); rb0 = *(const u32x4*)(bp0 + ko); rb1 = *(const u32x4*)(bp1 + ko); }
        const bf16_t* As = lds + buf * 2 * GEMM_TILE_ELEMS; const bf16_t* Bs = As + GEMM_TILE_ELEMS;
#pragma unroll
        for (int kk = 0; kk < 2; ++kk) {
            bf16x8 af[4], bfr[2];
#pragma unroll
            for (int m = 0; m < 4; ++m) af[m] = *(const bf16x8*)(As + (wr * 64 + m * 16 + fr) * GEMM_LDS_ROW + kk * 32 + fq * 8);
#pragma unroll
            for (int n = 0; n < 2; ++n) bfr[n] = *(const bf16x8*)(Bs + (wc * 32 + n * 16 + fr) * GEMM_LDS_ROW + kk * 32 + fq * 8);
#pragma unroll
            for (int m = 0; m < 4; ++m)
#pragma unroll
                for (int n = 0; n < 2; ++n) acc[m][n] = MFMA16(bfr[n], af[m], acc[m][n]);
        }
        if (kt + 1 < nk) {
            bf16_t* An = lds + (buf ^ 1) * 2 * GEMM_TILE_ELEMS; bf16_t* Bn = An + GEMM_TILE_ELEMS;
            *(u32x4*)(An + so0) = ra0; *(u32x4*)(An + so1) = ra1; *(u32x4*)(Bn + so0) = rb0; *(u32x4*)(Bn + so1) = rb1;
        }
        __syncthreads();
    }
}
DI void zero_acc(f32x4 (&acc)[4][2]) {
#pragma unroll
    for (int m = 0; m < 4; ++m)
#pragma unroll
        for (int n = 0; n < 2; ++n) acc[m][n] = (f32x4){0.f, 0.f, 0.f, 0.f};
}
DI void tile_coords(int tile, int ntn, int& pm, int& pn) { const int per = 8 * ntn, g = tile / per, r = tile % per; pm = g * 8 + (r & 7); pn = r >> 3; }
DI void store_bf16x4(bf16_t* p, f32x4 v) { u32x2 w; w.x = pk2(v.x, v.y); w.y = pk2(v.z, v.w); *(u32x2*)p = w; }

namespace pg8 {
#define PG8_LAS __attribute__((address_space(3)))
typedef short bf16x8 __attribute__((ext_vector_type(8)));
typedef float f32x4 __attribute__((ext_vector_type(4)));
typedef unsigned u32x4 __attribute__((ext_vector_type(4)));
typedef int i32x4v __attribute__((ext_vector_type(4)));
constexpr int BM = 256, BK = 64, HALF = 128, HTB = HALF * BK * 2  , STAGE_BYTES = 8 * HTB, NXCD = 8, WGM = 8;

__host__ __device__ __forceinline__ int lds_byte(int r, int c) { const int st = (r >> 4) * 2 + (c >> 5), rr = r & 15, cc = c & 31, ob = rr * 64 + cc * 2; return st * 1024 + (ob ^ (((ob >> 9) & 1) << 5)); }
__host__ __device__ __forceinline__ void stage_rc(int b, int& R, int& C) { const int st = b / 1024, sb = b % 1024, swz = sb ^ (((sb >> 9) & 1) << 5); R = (st >> 1) * 16 + swz / 64; C = (st & 1) * 32 + (swz % 64) / 2; }
__host__ __device__ __forceinline__ int perm32(int rho) { const int n = rho >> 4, i = rho & 15; return 8 * (i >> 2) + 4 * n + (i & 3); }

struct Unit { int pm, pn; };
struct Gemm { const bf16_t* A; const bf16_t* Bt; int M, N, K, lda, ldb; };

struct StaticOrder {
    int nM, nN, nwg, G, c;
    __host__ __device__ void init(int M, int N, int G_, int c_) { nM = M / BM; nN = N / BM; nwg = nM * nN; G = G_; c = c_; }
    __host__ __device__ bool next(int i, Unit& u) const {
        const long L = (long)i * G + c; if (L >= nwg) return false;
        int wgid = (int)L; { const int q = nwg / NXCD, r = nwg % NXCD, xcd = wgid % NXCD, off = wgid / NXCD; wgid = (xcd < r ? xcd * (q + 1) : r * (q + 1) + (xcd - r) * q) + off; }
        const int nig = WGM * nN, gid = wgid / nig, fm = gid * WGM, gsz = (nM - fm) < WGM ? (nM - fm) : WGM;
        u.pm = fm + ((wgid % nig) % gsz); u.pn = (wgid % nig) / gsz; return true;
    }
    __device__ __forceinline__ void a_ready(const Unit&) const {}
    __device__ __forceinline__ void done(const Unit&) const {}
};


template <class Epi, class Sched, bool ALIGN_EPI = false, bool SP2 = false, bool I8 = false>
__device__ __forceinline__ void gemm_phase(PG8_LAS unsigned char* lds, const Gemm g, const Sched& S, const Epi& E) {
    const int tid = threadIdx.x, wid = __builtin_amdgcn_readfirstlane(tid >> 6), lane = tid & 63, wr = wid >> 2, wc = wid & 3, fr = lane & 15, fq = lane >> 4;
    const int K = g.K, nt = K / BK;
    unsigned voffA[2], voffB[2];
#pragma unroll
    for (int i = 0; i < 2; ++i) { int R, C; stage_rc(tid * 16 + i * 8192, R, C); const int Rb = Epi::PERM ? ((R & ~31) + perm32(R & 31)) : R;
        voffA[i] = (unsigned)(R * g.lda + C) * 2u; voffB[i] = (unsigned)(Rb * g.ldb + C) * 2u; }
    const size_t kstep = (size_t)(BK * 2);
    const size_t hstepA = (size_t)HALF * g.lda * 2, hstepB = (size_t)HALF * g.ldb * 2;
    const size_t tstepA = 2 * hstepA, tstepB = 2 * hstepB;
    const unsigned ldsw = (unsigned)wid * 1024u;
    const int aoff = lds_byte(wr * 64 + fr, fq * 8), boff = lds_byte(wc * 32 + fr, fq * 8);
#define PG8_SA(b, h) (((b) * 2 + (h)) * HTB)
#define PG8_SB(b, h) ((4 + (b) * 2 + (h)) * HTB)
#define PG8_STAGE(bufoff, gbase, voff) do { _Pragma("unroll") for (int _i = 0; _i < 2; ++_i) \
        __builtin_amdgcn_global_load_lds((const unsigned*)((const char*)(gbase) + (voff)[_i]), (PG8_LAS unsigned*)(lds + (bufoff) + ldsw + _i * 8192), 16, 0, 0); } while (0)
#define PG8_LDA(dst, b, h) do { _Pragma("unroll") for (int m = 0; m < 4; ++m) _Pragma("unroll") for (int k = 0; k < 2; ++k) dst[m][k] = *(const PG8_LAS bf16x8*)(lds + PG8_SA(b, h) + aoff + m * 2048 + k * 1024); } while (0)
#define PG8_LDB(dst, b, h) do { _Pragma("unroll") for (int n = 0; n < 2; ++n) _Pragma("unroll") for (int k = 0; k < 2; ++k) dst[n][k] = *(const PG8_LAS bf16x8*)(lds + PG8_SB(b, h) + boff + n * 2048 + k * 1024); } while (0)
#define PG8_MMA(ai, bj, At, Bt) do { __builtin_amdgcn_s_setprio(1); _Pragma("unroll") for (int m = 0; m < 4; ++m) _Pragma("unroll") for (int n = 0; n < 2; ++n) _Pragma("unroll") for (int k = 0; k < 2; ++k) \
        { if constexpr (I8) acc[ai][bj][m][n] = __builtin_bit_cast(f32x4, __builtin_amdgcn_mfma_i32_16x16x64_i8(__builtin_bit_cast(i32x4v, Bt[n][k]), __builtin_bit_cast(i32x4v, At[m][k]), __builtin_bit_cast(i32x4v, acc[ai][bj][m][n]), 0, 0, 0)); \
          else acc[ai][bj][m][n] = __builtin_amdgcn_mfma_f32_16x16x32_bf16(Bt[n][k], At[m][k], acc[ai][bj][m][n], 0, 0, 0); } __builtin_amdgcn_s_setprio(0); } while (0)
#define PG8_WAIT_V(n) asm volatile("s_waitcnt vmcnt(" #n ")" ::: "memory")
#define PG8_WAIT_L(n) asm volatile("s_waitcnt lgkmcnt(" #n ")" ::: "memory")
#define PG8_BAR __builtin_amdgcn_s_barrier()
#define PG8_SCHED __builtin_amdgcn_sched_barrier(0)
    Unit cur, nxt; int ui = 0;
    if (!S.next(0, cur)) return;
    f32x4 acc[2][2][4][2];
    if constexpr (Epi::INIT) E.init(acc, cur, wr, wc, fr, fq);
    else {
#pragma unroll
    for (int a = 0; a < 2; ++a)
#pragma unroll
        for (int b = 0; b < 2; ++b)
#pragma unroll
            for (int m = 0; m < 4; ++m)
#pragma unroll
                for (int n = 0; n < 2; ++n) acc[a][b][m][n] = (f32x4){0.f, 0.f, 0.f, 0.f};
    }
    bf16x8 At[4][2], B0[2][2], B1[2][2];
    const char* cA = (const char*)g.A + (size_t)cur.pm * tstepA; const char* cB = (const char*)g.Bt + (size_t)cur.pn * tstepB;
    S.a_ready(cur);
    if constexpr (SP2) {
        PG8_STAGE(PG8_SB(0, 0), cB, voffB); PG8_STAGE(PG8_SB(0, 1), cB + hstepB, voffB); PG8_STAGE(PG8_SA(0, 0), cA, voffA); PG8_STAGE(PG8_SA(0, 1), cA + hstepA, voffA);
        if (wr == 1) PG8_BAR;
        PG8_WAIT_V(2); PG8_BAR;
        PG8_STAGE(PG8_SB(1, 0), cB + kstep, voffB); PG8_STAGE(PG8_SA(1, 0), cA + kstep, voffA); PG8_STAGE(PG8_SB(1, 1), cB + hstepB + kstep, voffB);
        PG8_WAIT_V(6); PG8_BAR;
    } else {
        PG8_STAGE(PG8_SB(0, 0), cB, voffB); PG8_STAGE(PG8_SA(0, 0), cA, voffA); PG8_STAGE(PG8_SB(0, 1), cB + hstepB, voffB); PG8_STAGE(PG8_SA(0, 1), cA + hstepA, voffA);
        if (wr == 1) PG8_BAR;
        PG8_WAIT_V(4); PG8_BAR;
        PG8_STAGE(PG8_SB(1, 0), cB + kstep, voffB); PG8_STAGE(PG8_SA(1, 0), cA + kstep, voffA); PG8_STAGE(PG8_SB(1, 1), cB + hstepB + kstep, voffB);
        PG8_WAIT_V(6); PG8_BAR;
    }
    for (;;) {
        const bool has_next = S.next(ui + 1, nxt);
        const char* nA = has_next ? (const char*)g.A + (size_t)nxt.pm * tstepA : cA; const char* nB = has_next ? (const char*)g.Bt + (size_t)nxt.pn * tstepB : cB;
        for (int t = 0; t < nt; t += 2) {
            const bool last = (t == nt - 2);
            const char* a1 = cA + (size_t)(t + 1) * kstep;
            const char* a2 = last ? nA : cA + (size_t)(t + 2) * kstep; const char* b2 = last ? nB : cB + (size_t)(t + 2) * kstep;
            const char* a3 = a2 + kstep; const char* b3 = b2 + kstep;
            if (last && has_next) S.a_ready(nxt);
            if constexpr (SP2) {
            PG8_LDB(B0, 0, 0); PG8_LDB(B1, 0, 1); PG8_SCHED; PG8_LDA(At, 0, 0); PG8_STAGE(PG8_SA(1, 1), a1 + hstepA, voffA);
            PG8_WAIT_V(8); PG8_WAIT_L(0); PG8_BAR; PG8_MMA(0, 0, At, B0); PG8_MMA(0, 1, At, B1); PG8_BAR; PG8_SCHED;
            PG8_LDA(At, 0, 1); PG8_STAGE(PG8_SB(0, 0), b2, voffB); PG8_STAGE(PG8_SB(0, 1), b2 + hstepB, voffB); PG8_STAGE(PG8_SA(0, 0), a2, voffA);
            PG8_WAIT_V(8); PG8_WAIT_L(0); PG8_BAR; PG8_MMA(1, 0, At, B0); PG8_MMA(1, 1, At, B1); PG8_BAR; PG8_SCHED;
            PG8_LDB(B0, 1, 0); PG8_LDB(B1, 1, 1); PG8_SCHED; PG8_LDA(At, 1, 0); PG8_STAGE(PG8_SA(0, 1), a2 + hstepA, voffA);
            PG8_WAIT_V(8); PG8_WAIT_L(0); PG8_BAR; PG8_MMA(0, 0, At, B0); PG8_MMA(0, 1, At, B1); PG8_BAR; PG8_SCHED;
            PG8_LDA(At, 1, 1); PG8_STAGE(PG8_SB(1, 0), b3, voffB); PG8_STAGE(PG8_SB(1, 1), b3 + hstepB, voffB); PG8_STAGE(PG8_SA(1, 0), a3, voffA);
            PG8_WAIT_V(8); PG8_WAIT_L(0); PG8_BAR; PG8_MMA(1, 0, At, B0); PG8_MMA(1, 1, At, B1); PG8_BAR; PG8_SCHED;
            } else {
            PG8_LDB(B0, 0, 0); PG8_SCHED; PG8_LDA(At, 0, 0); PG8_STAGE(PG8_SA(1, 1), a1 + hstepA, voffA);
            PG8_WAIT_L(8); PG8_BAR; PG8_WAIT_L(0); PG8_MMA(0, 0, At, B0); PG8_BAR; PG8_SCHED;
            PG8_LDB(B1, 0, 1); PG8_STAGE(PG8_SB(0, 0), b2, voffB);
            PG8_BAR; PG8_WAIT_L(0); PG8_MMA(0, 1, At, B1); PG8_BAR;
            PG8_LDA(At, 0, 1); PG8_STAGE(PG8_SA(0, 0), a2, voffA);
            PG8_BAR; PG8_WAIT_L(0); PG8_MMA(1, 0, At, B0); PG8_BAR; PG8_SCHED;
            PG8_STAGE(PG8_SB(0, 1), b2 + hstepB, voffB);
            PG8_WAIT_V(6); PG8_BAR; PG8_MMA(1, 1, At, B1); PG8_BAR;
            PG8_LDB(B0, 1, 0); PG8_SCHED; PG8_LDA(At, 1, 0); PG8_STAGE(PG8_SA(0, 1), a2 + hstepA, voffA);
            PG8_WAIT_L(8); PG8_BAR; PG8_WAIT_L(0); PG8_MMA(0, 0, At, B0); PG8_BAR; PG8_SCHED;
            PG8_LDB(B1, 1, 1); PG8_STAGE(PG8_SB(1, 0), b3, voffB);
            PG8_BAR; PG8_WAIT_L(0); PG8_MMA(0, 1, At, B1); PG8_BAR;
            PG8_LDA(At, 1, 1); PG8_STAGE(PG8_SA(1, 0), a3, voffA);
            PG8_BAR; PG8_WAIT_L(0); PG8_MMA(1, 0, At, B0); PG8_BAR; PG8_SCHED;
            PG8_STAGE(PG8_SB(1, 1), b3 + hstepB, voffB);
            PG8_WAIT_V(6); PG8_BAR; PG8_MMA(1, 1, At, B1); PG8_BAR;
            }
        }
        if constexpr (ALIGN_EPI) { if (wr == 0) PG8_BAR; }
        if constexpr (!Epi::AFTER_DRAIN) { E(acc, cur, wr, wc, fr, fq); S.done(cur); }
        if (!has_next) break;
        if constexpr (Epi::INIT) E.init(acc, nxt, wr, wc, fr, fq);
        else {
#pragma unroll
        for (int a = 0; a < 2; ++a)
#pragma unroll
            for (int b = 0; b < 2; ++b)
#pragma unroll
                for (int m = 0; m < 4; ++m)
#pragma unroll
                    for (int n = 0; n < 2; ++n) acc[a][b][m][n] = (f32x4){0.f, 0.f, 0.f, 0.f};
        }
        cur = nxt; cA = nA; cB = nB; ++ui;
        if constexpr (ALIGN_EPI) { if (wr == 1) PG8_BAR; }
    }
    PG8_WAIT_V(0);
    if constexpr (!ALIGN_EPI) { if (wr == 0) PG8_BAR; }
    PG8_BAR;
    if constexpr (Epi::AFTER_DRAIN) { E.fused(acc, cur, wr, wc, fr, fq, lds, wid, lane); S.done(cur); }
#undef PG8_SA
#undef PG8_SB
#undef PG8_STAGE
#undef PG8_LDA
#undef PG8_LDB
#undef PG8_MMA
#undef PG8_WAIT_V
#undef PG8_WAIT_L
#undef PG8_BAR
#undef PG8_SCHED
}
}

namespace pg8 {
__device__ __forceinline__ unsigned pkbf(float lo, float hi) { f32x2 v = {lo, hi}; bf16x2_t b = __builtin_convertvector(v, bf16x2_t); return __builtin_bit_cast(unsigned, b); }
__device__ __forceinline__ u32x4 pack8bf(const f32x4& v0, const f32x4& v1) { u32x4 w; w.x = pkbf(v0[0], v0[1]); w.y = pkbf(v0[2], v0[3]); w.z = pkbf(v1[0], v1[1]); w.w = pkbf(v1[2], v1[3]); return w; }
__device__ __forceinline__ float sigm(float x) { return __builtin_amdgcn_rcpf(1.0f + __builtin_amdgcn_exp2f(-x * 1.4426950408889634f)); }
__device__ __forceinline__ float sigm255_1(float a, float nb) { const float e = __builtin_amdgcn_exp2f(__builtin_fmaf(a, -1.4426950408889634f, nb)); return __builtin_amdgcn_rcpf(__builtin_fmaf(e, 1.0f / 255.0f, 1.0f / 255.0f)); }
__device__ __forceinline__ f32x4 sigm255(f32x4 a, f32x4 nb) { f32x4 r; r[0] = sigm255_1(a[0], nb[0]); r[1] = sigm255_1(a[1], nb[1]); r[2] = sigm255_1(a[2], nb[2]); r[3] = sigm255_1(a[3], nb[3]); return r; }
__device__ __forceinline__ f32x4 sigm4(f32x4 v) { v[0] = sigm(v[0]); v[1] = sigm(v[1]); v[2] = sigm(v[2]); v[3] = sigm(v[3]); return v; }
struct EpiProj8 { static constexpr bool PERM = true, AFTER_DRAIN = false, INIT = false;
    ::bf16_t* qkv; unsigned char* gates; float* nsag; const float* bm; const float* hsc; const float* wsc;
    __device__ __forceinline__ void operator()(const f32x4 (&acc)[2][2][4][2], const Unit& u, int wr, int wc, int fr, int fq) const {
        const int row0 = u.pm * BM + wr * 64 + fr, colb = u.pn * BM + wc * 32 + 8 * fq;
        f32x4 cs[2][2];
#pragma unroll
        for (int bj = 0; bj < 2; ++bj)
#pragma unroll
            for (int n = 0; n < 2; ++n) cs[bj][n] = *(const f32x4*)(wsc + colb + bj * HALF + n * 4);
        if (u.pn < 10) {
#pragma unroll
            for (int ai = 0; ai < 2; ++ai)
#pragma unroll
                for (int m = 0; m < 4; ++m) { const size_t row = (size_t)(row0 + ai * HALF + m * 16); const float rs = hsc[row];
#pragma unroll
                    for (int bj = 0; bj < 2; ++bj) { f32x4 v[2];
#pragma unroll
                        for (int n = 0; n < 2; ++n) { const i32x4v ia = __builtin_bit_cast(i32x4v, acc[ai][bj][m][n]);
                            v[n][0] = (float)ia[0] * rs * cs[bj][n][0]; v[n][1] = (float)ia[1] * rs * cs[bj][n][1]; v[n][2] = (float)ia[2] * rs * cs[bj][n][2]; v[n][3] = (float)ia[3] * rs * cs[bj][n][3]; }
                        *(u32x4*)(qkv + row * 2560 + colb + bj * HALF) = pack8bf(v[0], v[1]); } }
        } else if (u.pn < 22) {
            f32x4 bb[2][2];
#pragma unroll
            for (int bj = 0; bj < 2; ++bj)
#pragma unroll
                for (int n = 0; n < 2; ++n) { bb[bj][n] = *(const f32x4*)(bm + colb + bj * HALF + n * 4 - 2560) * -1.4426950408889634f; cs[bj][n] *= -1.4426950408889634f; }
#pragma unroll
            for (int ai = 0; ai < 2; ++ai)
#pragma unroll
                for (int m = 0; m < 4; ++m) { const size_t row = (size_t)(row0 + ai * HALF + m * 16); const float rs = hsc[row];
#pragma unroll
                    for (int bj = 0; bj < 2; ++bj) { const int c = colb + bj * HALF - 2560;
                        u32x2 w;
#pragma unroll
                        for (int n = 0; n < 2; ++n) { const i32x4v ia = __builtin_bit_cast(i32x4v, acc[ai][bj][m][n]); float r[4];
#pragma unroll
                            for (int j = 0; j < 4; ++j) { const float e = __builtin_amdgcn_exp2f(__builtin_fmaf((float)ia[j] * rs, cs[bj][n][j], bb[bj][n][j])); r[j] = __builtin_amdgcn_rcpf(__builtin_fmaf(e, 1.0f / 255.0f, 1.0f / 255.0f)); }
                            const unsigned pk = __builtin_amdgcn_cvt_pk_u8_f32(r[3], 3, __builtin_amdgcn_cvt_pk_u8_f32(r[2], 2, __builtin_amdgcn_cvt_pk_u8_f32(r[1], 1, __builtin_amdgcn_cvt_pk_u8_f32(r[0], 0, 0u))));
                            if (n == 0) w.x = pk; else w.y = pk; }
                        *(u32x2*)(gates + row * 3072 + c) = w; } }
        } else {
#pragma unroll
            for (int ai = 0; ai < 2; ++ai)
#pragma unroll
                for (int m = 0; m < 4; ++m) { const size_t row = (size_t)(row0 + ai * HALF + m * 16); const float rs = hsc[row];
                    const int c = colb - 5632; if (c < 32) {
#pragma unroll
                        for (int n = 0; n < 2; ++n) { const i32x4v ia = __builtin_bit_cast(i32x4v, acc[ai][0][m][n]);
                            f32x4 v = {(float)ia[0] * rs * cs[0][n][0], (float)ia[1] * rs * cs[0][n][1], (float)ia[2] * rs * cs[0][n][2], (float)ia[3] * rs * cs[0][n][3]};
                            *(f32x4*)(nsag + row * 32 + c + n * 4) = sigm4(v); } } }
        }
    }
};
struct EpiPlain8 { static constexpr bool PERM = true, AFTER_DRAIN = false, INIT = false;
    ::bf16_t* O; int ldc; const float* hsc; const float* wsc;
    __device__ __forceinline__ void operator()(const f32x4 (&acc)[2][2][4][2], const Unit& u, int wr, int wc, int fr, int fq) const {
        const int row0 = u.pm * BM + wr * 64 + fr, colb = u.pn * BM + wc * 32 + 8 * fq;
        f32x4 cs[2][2];
#pragma unroll
        for (int bj = 0; bj < 2; ++bj)
#pragma unroll
            for (int n = 0; n < 2; ++n) cs[bj][n] = *(const f32x4*)(wsc + colb + bj * HALF + n * 4);
#pragma unroll
        for (int ai = 0; ai < 2; ++ai)
#pragma unroll
            for (int m = 0; m < 4; ++m) { const size_t row = (size_t)(row0 + ai * HALF + m * 16); const float rs = hsc[row];
#pragma unroll
                for (int bj = 0; bj < 2; ++bj) { f32x4 v[2];
#pragma unroll
                    for (int n = 0; n < 2; ++n) { const i32x4v ia = __builtin_bit_cast(i32x4v, acc[ai][bj][m][n]);
                        v[n][0] = (float)ia[0] * rs * cs[bj][n][0]; v[n][1] = (float)ia[1] * rs * cs[bj][n][1]; v[n][2] = (float)ia[2] * rs * cs[bj][n][2]; v[n][3] = (float)ia[3] * rs * cs[bj][n][3]; }
                    *(u32x4*)(O + row * ldc + colb + bj * HALF) = pack8bf(v[0], v[1]); } }
    }
};
struct EpiPlain { static constexpr bool PERM = true, AFTER_DRAIN = false, INIT = false;
    ::bf16_t* O; int ldc;
    __device__ __forceinline__ void operator()(const f32x4 (&acc)[2][2][4][2], const Unit& u, int wr, int wc, int fr, int fq) const {
        const int row0 = u.pm * BM + wr * 64 + fr;
#pragma unroll
        for (int ai = 0; ai < 2; ++ai)
#pragma unroll
            for (int m = 0; m < 4; ++m) { const size_t row = (size_t)(row0 + ai * HALF + m * 16);
#pragma unroll
                for (int bj = 0; bj < 2; ++bj) { const int col8 = u.pn * BM + bj * HALF + wc * 32 + 8 * fq; *(u32x4*)(O + row * ldc + col8) = pack8bf(acc[ai][bj][m][0], acc[ai][bj][m][1]); } }
    }
};
struct EpiMerge { static constexpr bool PERM = true, AFTER_DRAIN = false, INIT = false;
    ::bf16_t* merged; const ::bf16_t* gates; int br;
    __device__ __forceinline__ void operator()(const f32x4 (&acc)[2][2][4][2], const Unit& u, int wr, int wc, int fr, int fq) const {
        const int row0 = u.pm * BM + wr * 64 + fr, colb = u.pn * BM + wc * 32 + 8 * fq;
        u32x2 gw[2][4][2];
#pragma unroll
        for (int ai = 0; ai < 2; ++ai)
#pragma unroll
            for (int m = 0; m < 4; ++m)
#pragma unroll
                for (int bj = 0; bj < 2; ++bj) gw[ai][m][bj] = *(const u32x2*)((const unsigned char*)gates + (size_t)(row0 + ai * HALF + m * 16) * 3072 + br * 1024 + colb + bj * HALF);
#pragma unroll
        for (int ai = 0; ai < 2; ++ai) {
            u32x4 old[4][2];
            if (br != 0) {
#pragma unroll
                for (int m = 0; m < 4; ++m)
#pragma unroll
                    for (int bj = 0; bj < 2; ++bj) old[m][bj] = *(const u32x4*)(merged + (size_t)(row0 + ai * HALF + m * 16) * 1024 + colb + bj * HALF);
            }
#pragma unroll
            for (int m = 0; m < 4; ++m)
#pragma unroll
                for (int bj = 0; bj < 2; ++bj) {
                    const u32x2 g2 = gw[ai][m][bj];
                    f32x4 v0 = acc[ai][bj][m][0], v1 = acc[ai][bj][m][1];
                    v0[0] *= (float)(g2.x & 0xffu); v0[1] *= (float)((g2.x >> 8) & 0xffu); v0[2] *= (float)((g2.x >> 16) & 0xffu); v0[3] *= (float)(g2.x >> 24);
                    v1[0] *= (float)(g2.y & 0xffu); v1[1] *= (float)((g2.y >> 8) & 0xffu); v1[2] *= (float)((g2.y >> 16) & 0xffu); v1[3] *= (float)(g2.y >> 24);
                    if (br != 0) { const u32x4 o = old[m][bj];
                        v0[0] += __uint_as_float(o.x << 16); v0[1] += __uint_as_float(o.x & 0xffff0000u); v0[2] += __uint_as_float(o.y << 16); v0[3] += __uint_as_float(o.y & 0xffff0000u);
                        v1[0] += __uint_as_float(o.z << 16); v1[1] += __uint_as_float(o.z & 0xffff0000u); v1[2] += __uint_as_float(o.w << 16); v1[3] += __uint_as_float(o.w & 0xffff0000u); }
                    *(u32x4*)(merged + (size_t)(row0 + ai * HALF + m * 16) * 1024 + colb + bj * HALF) = pack8bf(v0, v1); }
            asm volatile("" ::: "memory");
        }
    }
};
struct EpiOut { static constexpr bool PERM = false, AFTER_DRAIN = false, INIT = true;
    const float* x; const float* gf; float* x2; ::bf16_t* h2; float* rowss;
    __device__ __forceinline__ void init(f32x4 (&acc)[2][2][4][2], const Unit& u, int wr, int wc, int fr, int fq) const {
        const int row0 = u.pm * BM + wr * 64 + fr, colb = u.pn * BM + wc * 32 + 4 * fq;
#pragma unroll
        for (int ai = 0; ai < 2; ++ai)
#pragma unroll
            for (int bj = 0; bj < 2; ++bj)
#pragma unroll
                for (int m = 0; m < 4; ++m)
#pragma unroll
                    for (int n = 0; n < 2; ++n) acc[ai][bj][m][n] = *(const f32x4*)(x + (size_t)(row0 + ai * HALF + m * 16) * 1024 + colb + bj * HALF + n * 16);
    }
    __device__ __forceinline__ void operator()(const f32x4 (&acc)[2][2][4][2], const Unit& u, int wr, int wc, int fr, int fq) const {
        const int row0 = u.pm * BM + wr * 64 + fr, colb = u.pn * BM + wc * 32 + 4 * fq;
        f32x4 gg[2][2];
#pragma unroll
        for (int bj = 0; bj < 2; ++bj)
#pragma unroll
            for (int n = 0; n < 2; ++n) gg[bj][n] = *(const f32x4*)(gf + colb + bj * HALF + n * 16);
#pragma unroll
        for (int ai = 0; ai < 2; ++ai)
#pragma unroll
            for (int m = 0; m < 4; ++m) { const size_t row = (size_t)(row0 + ai * HALF + m * 16);
#pragma unroll
                for (int bj = 0; bj < 2; ++bj) { float ss = 0.f;
#pragma unroll
                    for (int n = 0; n < 2; ++n) { const int col = colb + bj * HALF + n * 16;
                        const f32x4 v = acc[ai][bj][m][n]; *(f32x4*)(x2 + row * 1024 + col) = v;
                        ss += (v[0] * v[0] + v[1] * v[1]) + (v[2] * v[2] + v[3] * v[3]);
                        const f32x4 g4 = gg[bj][n]; u32x2 w; w.x = pkbf(v[0] * g4[0], v[1] * g4[1]); w.y = pkbf(v[2] * g4[2], v[3] * g4[3]); *(u32x2*)(h2 + row * 1024 + col) = w; }
                    ss += __shfl_xor(ss, 16); ss += __shfl_xor(ss, 32);
                    if (fq == 0) rowss[row * 32 + u.pn * 8 + bj * 4 + wc] = ss; } }
    }
};
}

#define GEMM_PHASE(EPI, g, S, E) pg8::gemm_phase<EPI, pg8::StaticOrder, true, true>((PG8_LAS unsigned char*)lds, g, S, E)
DI void phase1(const Params& p, bf16_t* lds) {
    unsigned char* ws = p.ws;
    {
        pg8::Gemm g{(const bf16_t*)(ws + WS_H8), (const bf16_t*)(ws + WS_W8), NTOK, NPROJ, D / 2, D / 2, D / 2};
        pg8::StaticOrder S; S.init(NTOK, NPROJ, (int)gridDim.x, (int)blockIdx.x);
        pg8::EpiProj8 E{(bf16_t*)(ws + WS_QKV), ws + WS_GATES, (float*)((unsigned char*)p.out + DO_NSAG), p.in[5], (const float*)(ws + WS_HSC), (const float*)(ws + WS_W8SC)};
        pg8::gemm_phase<pg8::EpiProj8, pg8::StaticOrder, true, true, true>((PG8_LAS unsigned char*)lds, g, S, E);
    }
    {
        pg8::Gemm g{(const bf16_t*)(ws + WS_MEMN8), (const bf16_t*)(ws + WS_WMKV8), NB * MEMT, 512, D / 2, D / 2, D / 2};
        const int cm = ((int)gridDim.x == 256 && blockIdx.x >= 128 && blockIdx.x < 144) ? (int)blockIdx.x - 128 : ((int)gridDim.x == 256 ? (1 << 20) : (int)blockIdx.x);
        pg8::StaticOrder S; S.init(NB * MEMT, 512, (int)gridDim.x, cm);
        pg8::EpiPlain8 E{(bf16_t*)((unsigned char*)p.out + DO_MKV), 512, (const float*)(ws + WS_MEMN8 + 2 * MiB), (const float*)(ws + WS_WMKV8 + MiB)};
        pg8::gemm_phase<pg8::EpiPlain8, pg8::StaticOrder, true, true, true>((PG8_LAS unsigned char*)lds, g, S, E);
    }
    if ((int)gridDim.x == 256) { if (blockIdx.x >= 144) late_weights(p, ((int)blockIdx.x - 144) * NTHREADS + (int)threadIdx.x, 112 * NTHREADS); }
    else late_weights(p, (int)(blockIdx.x * NTHREADS + threadIdx.x), (int)(gridDim.x * NTHREADS));
}
DI void transpose64(const bf16_t* src, size_t sp, bf16_t* dst, size_t dp, unsigned short* scr, int lane) {
#pragma unroll
    for (int i = 0; i < 8; ++i) { const int r = i * 8 + (lane >> 3), c8 = lane & 7; const u32x4 v = *(const u32x4*)(src + (size_t)r * sp + c8 * 8);
        unsigned short* s = scr + r * 66 + c8 * 8;
        s[0] = (unsigned short)(v.x & 0xffff); s[1] = (unsigned short)(v.x >> 16); s[2] = (unsigned short)(v.y & 0xffff); s[3] = (unsigned short)(v.y >> 16);
        s[4] = (unsigned short)(v.z & 0xffff); s[5] = (unsigned short)(v.z >> 16); s[6] = (unsigned short)(v.w & 0xffff); s[7] = (unsigned short)(v.w >> 16); }
    __builtin_amdgcn_s_waitcnt(0xc07f);
    __builtin_amdgcn_wave_barrier();
#pragma unroll
    for (int i = 0; i < 8; ++i) { const int c = i * 8 + (lane >> 3), r8 = lane & 7; const unsigned short* s = scr + (r8 * 8) * 66 + c;
        u32x4 o; o.x = (unsigned)s[0] | ((unsigned)s[66] << 16); o.y = (unsigned)s[2 * 66] | ((unsigned)s[3 * 66] << 16); o.z = (unsigned)s[4 * 66] | ((unsigned)s[5 * 66] << 16); o.w = (unsigned)s[6 * 66] | ((unsigned)s[7 * 66] << 16);
        *(u32x4*)(dst + (size_t)c * dp + r8 * 8) = o; }
    __builtin_amdgcn_s_waitcnt(0xc07f);
    __builtin_amdgcn_wave_barrier();
}
DI void transpose64_vtiles(const bf16_t* src, size_t sp, bf16_t* dst  , unsigned short* scr, int lane) {
#pragma unroll
    for (int i = 0; i < 8; ++i) { const int r = i * 8 + (lane >> 3), c8 = lane & 7; const u32x4 v = *(const u32x4*)(src + (size_t)r * sp + c8 * 8);
        unsigned short* sdst = scr + r * 66 + c8 * 8;
        sdst[0] = (unsigned short)(v.x & 0xffff); sdst[1] = (unsigned short)(v.x >> 16); sdst[2] = (unsigned short)(v.y & 0xffff); sdst[3] = (unsigned short)(v.y >> 16);
        sdst[4] = (unsigned short)(v.z & 0xffff); sdst[5] = (unsigned short)(v.z >> 16); sdst[6] = (unsigned short)(v.w & 0xffff); sdst[7] = (unsigned short)(v.w >> 16); }
    __builtin_amdgcn_s_waitcnt(0xc07f);
    __builtin_amdgcn_wave_barrier();
#pragma unroll
    for (int i = 0; i < 8; ++i) { const int d = i * 8 + (lane >> 3), r8 = lane & 7; const unsigned short* sp2 = scr + (r8 * 8) * 66 + d;
        u32x2 lo, hi2; lo.x = (unsigned)sp2[0] | ((unsigned)sp2[66] << 16); lo.y = (unsigned)sp2[2 * 66] | ((unsigned)sp2[3 * 66] << 16); hi2.x = (unsigned)sp2[4 * 66] | ((unsigned)sp2[5 * 66] << 16); hi2.y = (unsigned)sp2[6 * 66] | ((unsigned)sp2[7 * 66] << 16);
        const int half = r8 >> 2, q = 2 * (r8 & 3), msk = (d >> 2) & 7;
        unsigned char* tb = (unsigned char*)dst + half * 4096 + d * 64;
        *(u32x2*)(tb + ((q ^ msk) * 8)) = lo; *(u32x2*)(tb + (((q + 1) ^ msk) * 8)) = hi2; }
    __builtin_amdgcn_s_waitcnt(0xc07f);
    __builtin_amdgcn_wave_barrier();
}
DI void copy64_ktiles(const bf16_t* src, size_t sp, bf16_t* dst, int lane) {
#pragma unroll
    for (int i = 0; i < 8; ++i) { const int r = i * 8 + (lane >> 3), c8 = lane & 7; const u32x4 v = *(const u32x4*)(src + (size_t)r * sp + c8 * 8);
        const int rr = r & 31;
        *(u32x4*)((unsigned char*)dst + (r >> 5) * 4096 + rr * 128 + ((c8 ^ ((rr >> 1) & 7)) * 16)) = v; }
}
DI void phase2(const Params& p, bf16_t* lds) {
    unsigned char* ws = p.ws; unsigned char* dout = (unsigned char*)p.out;
    const int lane = threadIdx.x & 63, wid = threadIdx.x >> 6;
    const int gwave = blockIdx.x * NWAVES + wid, nwaves = gridDim.x * NWAVES;
    unsigned short* scr = (unsigned short*)lds + wid * (64 * 66);
    const bf16_t* qkv = (const bf16_t*)(ws + WS_QKV);
    const int n_items = 1024 + 1024 + 3072 + 128 + 1024 + 1024 + 3072;
    for (int it = gwave; it < n_items; it += nwaves) {
        if (it < 2048) { const int which = it >> 10, r = it & 1023, b = r >> 7, g = (r >> 6) & 1, tt = r & 63;
            const bf16_t* src = qkv + (size_t)(b * T + tt * 64) * LDP_QKV + C_NKV + (which ? 5 : 3) * 128 + g * 64;
            bf16_t* dst = (bf16_t*)(dout + (which ? DO_VWIN : DO_VSLC)) + ((size_t)(b * 2 + g) * 128 + tt * 2) * 2048;
            transpose64_vtiles(src, LDP_QKV, dst, scr, lane);
        } else if (it < 2048 + 3072) { const int r = it - 2048, b = r / 384, hh = (r / 64) % 6, tt = r & 63;
            const bf16_t* src = qkv + (size_t)(b * T + tt * 64) * LDP_QKV + C_SBV + hh * 64;
            bf16_t* dst = (bf16_t*)(dout + DO_SBV) + ((size_t)(b * 6 + hh) * 128 + tt * 2) * 2048;
            transpose64_vtiles(src, LDP_QKV, dst, scr, lane);
        } else if (it < 5248) { const int r = it - 5120, b = r >> 4, hh = (r >> 2) & 3, mt = r & 3;
            const bf16_t* srcv = (const bf16_t*)(dout + DO_MKV) + (size_t)(b * MEMT + mt * 64) * 512 + 256 + hh * 64;
            transpose64_vtiles(srcv, 512, (bf16_t*)(dout + DO_MVT) + ((size_t)(b * 4 + hh) * 8 + mt * 2) * 2048, scr, lane);
            copy64_ktiles(srcv - 256, 512, (bf16_t*)(dout + DO_MKT) + ((size_t)(b * 4 + hh) * 8 + mt * 2) * 2048, lane);
        } else if (it < 5248 + 2048) { const int r0 = it - 5248, which = r0 >> 10, r = r0 & 1023, b = r >> 7, g = (r >> 6) & 1, tt = r & 63;
            const bf16_t* src = qkv + (size_t)(b * T + tt * 64) * LDP_QKV + C_NKV + (which ? 4 : 2) * 128 + g * 64;
            bf16_t* dst = (bf16_t*)(dout + (which ? DO_KWIN : DO_KSLC)) + ((size_t)(b * 2 + g) * 128 + tt * 2) * 2048;
            copy64_ktiles(src, LDP_QKV, dst, lane);
        } else { const int r = it - 7296, b = r / 384, hh = (r / 64) % 6, tt = r & 63;
            const bf16_t* src = qkv + (size_t)(b * T + tt * 64) * LDP_QKV + C_SBK + hh * 64;
            bf16_t* dst = (bf16_t*)(dout + DO_SBK) + ((size_t)(b * 6 + hh) * 128 + tt * 2) * 2048;
            copy64_ktiles(src, LDP_QKV, dst, lane);
        }
    }
    __syncthreads();
    {
        bf16_t* kc = (bf16_t*)(dout + DO_KC); bf16_t* vct = (bf16_t*)(dout + DO_VCT);
        const int r32 = lane & 31, hi = lane >> 5;
        float* red = (float*)lds;
        for (int task = blockIdx.x; task < 2 * 16 * 8; task += gridDim.x) {
            const int which = task >> 7, bg = (task >> 3) & 15, chunk = task & 7, b = bg >> 1, g = bg & 1;
            const bf16_t* wt = (const bf16_t*)(ws + WS_CMPW) + (size_t)which * 64 * 2048;
            const float* pe = p.in[6 + which];
            const int n = chunk * 32 + r32;
            f32x16 acc[2]; zero16(acc[0]); zero16(acc[1]);
#pragma unroll
            for (int li = 0; li < 4; ++li) {
                const int l = wid * 4 + li; int token = 16 * n + l; if (token > T - 1) token = T - 1;
                const bf16_t* xr = qkv + (size_t)(b * T + token) * LDP_QKV + C_NKV + which * 128 + g * 64 + hi * 8;
#pragma unroll
                for (int ds = 0; ds < 4; ++ds) {
                    const bf16x8 xf = *(const bf16x8*)(xr + ds * 16);
                    const f32x4 p0 = *(const f32x4*)(pe + l * 64 + ds * 16 + hi * 8), p1 = *(const f32x4*)(pe + l * 64 + ds * 16 + hi * 8 + 4);
                    u32x4 pw; pw.x = pk2(p0.x, p0.y); pw.y = pk2(p0.z, p0.w); pw.z = pk2(p1.x, p1.y); pw.w = pk2(p1.z, p1.w);
                    const bf16x8 pf = __builtin_bit_cast(bf16x8, pw);
#pragma unroll
                    for (int eb = 0; eb < 2; ++eb) {
                        const bf16x8 wf = *(const bf16x8*)(wt + (size_t)(32 * eb + r32) * 2048 + l * 64 + ds * 16 + hi * 8);
                        if (which == 0) { acc[eb] = MFMA32(wf, xf, acc[eb]); acc[eb] = MFMA32(wf, pf, acc[eb]); }
                        else { acc[eb] = MFMA32(xf, wf, acc[eb]); acc[eb] = MFMA32(pf, wf, acc[eb]); }
                    }
                }
            }
#pragma unroll
            for (int eb = 0; eb < 2; ++eb)
#pragma unroll
                for (int r = 0; r < 16; ++r) red[(wid * 32 + eb * 16 + r) * 64 + lane] = acc[eb][r];
            __syncthreads();
            {
                const int eb = wid >> 2, mg = wid & 3;
                f32x4 v = {0.f, 0.f, 0.f, 0.f};
#pragma unroll
                for (int w2 = 0; w2 < 8; ++w2) { v.x += red[(w2 * 32 + eb * 16 + 4 * mg) * 64 + lane]; v.y += red[(w2 * 32 + eb * 16 + 4 * mg + 1) * 64 + lane]; v.z += red[(w2 * 32 + eb * 16 + 4 * mg + 2) * 64 + lane]; v.w += red[(w2 * 32 + eb * 16 + 4 * mg + 3) * 64 + lane]; }
                if (which == 0) {
                    if (n == 255) v = (f32x4){0.f, 0.f, 0.f, 0.f};
                    store_bf16x4(kc + ((size_t)bg * 256 + n) * 64 + 32 * eb + 8 * mg + 4 * hi, v);
                } else {
                    const int n0 = chunk * 32 + 8 * mg + 4 * hi;
                    if (n0 + 3 == 255) v.w = 0.f;
                    store_bf16x4(vct + ((size_t)bg * 64 + 32 * eb + r32) * 256 + n0, v);
                }
            }
            __syncthreads();
        }
    }
}

DI bf16x8 pack8(const f32x16& p, int base) {
    u32x4 w; w.x = pk2(p[base], p[base + 1]); w.y = pk2(p[base + 2], p[base + 3]); w.z = pk2(p[base + 4], p[base + 5]); w.w = pk2(p[base + 6], p[base + 7]);
    return __builtin_bit_cast(bf16x8, w);
}
DI f32x16 st_tile(const bf16_t* kbase, size_t kpitch, const bf16x8 (&qf)[4], int r32, int hi) {
    f32x16 s;
#pragma unroll
    for (int i = 0; i < 16; ++i) s[i] = 0.f;
    const bf16_t* kp = kbase + (size_t)r32 * kpitch + hi * 8;
#pragma unroll
    for (int ks = 0; ks < 4; ++ks) { const bf16x8 a = *(const bf16x8*)(kp + ks * 16); s = MFMA32(a, qf[ks], s); }
    return s;
}
DI void pv_tile(f32x16 (&o)[2], const bf16_t* vT, size_t vpitch, const f32x16& pr, int r32, int hi) {
    const bf16x8 pf0 = pack8(pr, 0), pf1 = pack8(pr, 8);
#pragma unroll
    for (int db = 0; db < 2; ++db) {
        const bf16_t* vp = vT + (size_t)(32 * db + r32) * vpitch + 4 * hi;
#pragma unroll
        for (int s2 = 0; s2 < 2; ++s2) {
            const s16x4 lo = *(const s16x4*)(vp + 16 * s2); const s16x4 hh = *(const s16x4*)(vp + 16 * s2 + 8);
            const bf16x8 a = {lo[0], lo[1], lo[2], lo[3], hh[0], hh[1], hh[2], hh[3]};
            o[db] = MFMA32(a, s2 ? pf1 : pf0, o[db]);
        }
    }
}
DI void load_q(bf16x8 (&qf)[4], const bf16_t* qrow  , int hi) {
#pragma unroll
    for (int ks = 0; ks < 4; ++ks) qf[ks] = *(const bf16x8*)(qrow + ks * 16 + hi * 8);
}
DI void softmax_tile(f32x16& sv, unsigned vmask, float& m, float& l, f32x16 (&o)[2]) {
    float tm = -1e30f;
#pragma unroll
    for (int r = 0; r < 16; ++r) tm = fmaxf(tm, ((vmask >> r) & 1u) ? sv[r] : -1e30f);
    tm = fmaxf(tm, __shfl_xor(tm, 32));
    const float mn = fmaxf(m, tm);
    const float alpha = fexp(m - mn);
    float ps = 0.f;
#pragma unroll
    for (int r = 0; r < 16; ++r) { const float pv = ((vmask >> r) & 1u) ? fexp(sv[r] - mn) : 0.f; sv[r] = pv; ps += pv; }
    l = l * alpha + ps; m = mn;
#pragma unroll
    for (int r = 0; r < 16; ++r) { o[0][r] *= alpha; o[1][r] *= alpha; }
}

struct KF { bf16x8 k[4]; };
struct VF { s16x4 v[2][2][2]; };
DI void load_kf(KF& f, const bf16_t* kbase, size_t kpitch, int r32, int hi) {
    const bf16_t* kp = kbase + (size_t)r32 * kpitch + hi * 8;
#pragma unroll
    for (int ks = 0; ks < 4; ++ks) f.k[ks] = *(const bf16x8*)(kp + ks * 16);
}
DI void load_vf(VF& f, const bf16_t* vT, size_t vpitch, int r32, int hi) {
#pragma unroll
    for (int db = 0; db < 2; ++db) { const bf16_t* vp = vT + (size_t)(32 * db + r32) * vpitch + 4 * hi;
#pragma unroll
        for (int s2 = 0; s2 < 2; ++s2) { f.v[db][s2][0] = *(const s16x4*)(vp + 16 * s2); f.v[db][s2][1] = *(const s16x4*)(vp + 16 * s2 + 8); } }
}
DI f32x16 qk_frag(const KF& f, const bf16x8 (&qf)[4]) {
    f32x16 s; zero16(s);
#pragma unroll
    for (int ks = 0; ks < 4; ++ks) s = MFMA32(f.k[ks], qf[ks], s);
    return s;
}
DI void pv_frag(f32x16 (&o)[2], const VF& f, const f32x16& pr) {
    const bf16x8 pf0 = pack8(pr, 0), pf1 = pack8(pr, 8);
#pragma unroll
    for (int db = 0; db < 2; ++db)
#pragma unroll
        for (int s2 = 0; s2 < 2; ++s2) { const s16x4 lo = f.v[db][s2][0], hh = f.v[db][s2][1];
            const bf16x8 a = {lo[0], lo[1], lo[2], lo[3], hh[0], hh[1], hh[2], hh[3]};
            o[db] = MFMA32(a, s2 ? pf1 : pf0, o[db]); }
}
template <bool GUARD = false> DI void softmax_core(f32x16& e, float A, float& m, float& l, f32x16 (&o)[2]) {
    float tm = fmaxf(fmaxf(fmaxf(e[0], e[1]), fmaxf(e[2], e[3])), fmaxf(fmaxf(e[4], e[5]), fmaxf(e[6], e[7])));
    tm = fmaxf(tm, fmaxf(fmaxf(fmaxf(e[8], e[9]), fmaxf(e[10], e[11])), fmaxf(fmaxf(e[12], e[13]), fmaxf(e[14], e[15]))));
    tm += A;
    tm = fmaxf(tm, __shfl_xor(tm, 32));
    if (__any(tm > m + 8.0f)) {
        const float mn = fmaxf(m, tm); const float alpha = fexp2(m - mn); l *= alpha; m = mn;
#pragma unroll
        for (int r = 0; r < 16; ++r) { o[0][r] *= alpha; o[1][r] *= alpha; }
    }
    const float c = A - m;
    float ps = 0.f;
#pragma unroll
    for (int r = 0; r < 16; ++r) { float pv = fexp2(e[r] + c); if (GUARD) pv = (e[r] > -1e29f) ? pv : 0.f; e[r] = pv; ps += pv; }
    l += ps;
}
constexpr float SCL2 = 0.125f * LOG2E;

DI int f2key(float v) { const int u = __float_as_int(v); return u ^ ((u >> 31) & 0x7fffffff); }
DI float key2f(int k) { return __int_as_float(k ^ ((k >> 31) & 0x7fffffff)); }
template <int N> DI void bitonic_sort_desc(int (&a)[N]) {
#pragma unroll
    for (int k = 2; k <= N; k <<= 1)
#pragma unroll
        for (int j = k >> 1; j > 0; j >>= 1)
#pragma unroll
            for (int i = 0; i < N; ++i) { const int l = i ^ j; if (l > i) { const bool desc = ((i & k) == 0); const int hi_ = max(a[i], a[l]), lo_ = min(a[i], a[l]); a[i] = desc ? hi_ : lo_; a[l] = desc ? lo_ : hi_; } }
}
DI void top16_merge(int (&a)[16], const int (&b)[16]) {
#pragma unroll
    for (int i = 0; i < 16; ++i) a[i] = max(a[i], b[15 - i]);
#pragma unroll
    for (int j = 8; j > 0; j >>= 1)
#pragma unroll
        for (int i = 0; i < 16; ++i) { const int l = i ^ j; if (l > i) { const int hi_ = max(a[i], a[l]), lo_ = min(a[i], a[l]); a[i] = hi_; a[l] = lo_; } }
}
DI void nsa_cmp_task(const Params& p, int b, int g, int chunk, int lane, float* impl  ) {
    unsigned char* ws = p.ws; unsigned char* dout = (unsigned char*)p.out;
    const int r32 = lane & 31, hi = lane >> 5;
    const int tq0 = chunk * 32, t = tq0 + r32, cur = tq0 >> 6;
    const size_t tok = (size_t)b * T + t;
    const bf16_t* qkv = (const bf16_t*)(ws + WS_QKV);
    const float scale = 0.125f;
#pragma unroll
    for (int k = 0; k < 32; ++k) impl[k * 64 + lane] = 0.f;
    const bf16_t* kc = (const bf16_t*)(dout + DO_KC) + (size_t)(b * 2 + g) * 256 * 64;
    const bf16_t* vct = (const bf16_t*)(dout + DO_VCT) + (size_t)(b * 2 + g) * 64 * 256;
    int ntile = (tq0 / 16) / 32 + 1; if (ntile > 8) ntile = 8;
#pragma unroll 1
    for (int rr = 0; rr < 3; ++rr) {
        const int head = g * 3 + rr;
        bf16x8 qr[4]; load_q(qr, qkv + tok * LDP_QKV + C_NQ + head * 64, hi);
        const float slope = fexp2(-(8.0f * (float)(head + 1)) / 6.0f);
        float m = -1e30f, l = 0.f;
        f32x16 oc[2]; zero16(oc[0]); zero16(oc[1]);
        float* tmp = impl + 32 * 64; float* tmpm = impl + 64 * 64;
#pragma unroll 1
        for (int tile = 0; tile < ntile; ++tile) {
            KF kf; VF vf; load_kf(kf, kc + (size_t)tile * 32 * 64, 64, r32, hi); load_vf(vf, vct + tile * 32, 256, r32, hi);
            f32x16 s = qk_frag(kf, qr);
            float tm = -1e30f;
#pragma unroll
            for (int r = 0; r < 16; ++r) { const int n = tile * 32 + krow(r, hi); const int dist = t - (16 * n + 31); const bool valid = dist >= 0 && n < 255;
                const float sv = valid ? s[r] * scale - slope * (float)dist : -1e30f; s[r] = sv; tm = fmaxf(tm, sv); }
            tm = fmaxf(tm, __shfl_xor(tm, 32));
            if (__any(tm > m)) {
                const float mn = fmaxf(m, tm); const float alpha = fexp(m - mn); l *= alpha; m = mn;
#pragma unroll
                for (int r = 0; r < 16; ++r) { oc[0][r] *= alpha; oc[1][r] *= alpha; }
            }
            float ps = 0.f;
#pragma unroll
            for (int r = 0; r < 16; ++r) { const float pv = (s[r] > -1e29f) ? fexp(s[r] - m) : 0.f; s[r] = pv; ps += pv; }
            l += ps;
#pragma unroll
            for (int mm = 0; mm < 4; ++mm) tmp[(tile * 4 + mm) * 64 + lane] = (s[4 * mm] + s[4 * mm + 1]) + (s[4 * mm + 2] + s[4 * mm + 3]);
            tmpm[tile * 64 + lane] = m;
            pv_frag(oc, vf, s);
        }
        l += __shfl_xor(l, 32);
        const float inv = l > 0.f ? 1.0f / l : 0.f;
#pragma unroll 1
        for (int tile = 0; tile < ntile; ++tile) { const float sc = fexp(tmpm[tile * 64 + lane] - m) * inv;
#pragma unroll
            for (int mm = 0; mm < 4; ++mm) impl[(tile * 4 + mm) * 64 + lane] += tmp[(tile * 4 + mm) * 64 + lane] * sc; }
#pragma unroll
        for (int r = 0; r < 16; ++r) { oc[0][r] *= inv; oc[1][r] *= inv; }
        const float g_c = ((const float*)(dout + DO_NSAG))[tok * 32 + head * 3];
        bf16_t* orow = (bf16_t*)(dout + DO_OC) + tok * 384 + head * 64;
#pragma unroll
        for (int db = 0; db < 2; ++db)
#pragma unroll
            for (int mg = 0; mg < 4; ++mg) { f32x4 v = {g_c * oc[db][4 * mg], g_c * oc[db][4 * mg + 1], g_c * oc[db][4 * mg + 2], g_c * oc[db][4 * mg + 3]}; store_bf16x4(orow + 32 * db + 8 * mg + 4 * hi, v); }
    }
    unsigned long long selmask;
    if (cur + 1 <= 16) selmask = (1ull << (cur + 1)) - 1ull;
    else {
        int k0[16], k1[16];
#pragma unroll
        for (int k = 0; k < 32; ++k) { const int j = 2 * k + hi; const float iv = impl[k * 64 + lane]; const float v = (j == 0 || j == cur || j == cur - 1) ? 1e4f : (j <= cur ? iv : -1.0f);
            const int key = (__float_as_int(v) & ~63) | (63 - j);
            if (k < 16) k0[k] = key; else k1[k - 16] = key; }
        bitonic_sort_desc<16>(k0); bitonic_sort_desc<16>(k1); top16_merge(k0, k1);
        int pb[16];
#pragma unroll
        for (int i = 0; i < 16; ++i) pb[i] = __shfl_xor(k0[i], 32);
        top16_merge(k0, pb);
        selmask = 0ull;
#pragma unroll
        for (int i = 0; i < 16; ++i) selmask |= 1ull << (63 - (k0[i] & 63));
    }
    if (hi == 0) ((unsigned long long*)(dout + DO_SELM))[(size_t)(b * 2 + g) * T + t] = selmask;
}
typedef LAS unsigned char* ldsp_t;
DI void dma_k(ldsp_t kbuf  , const bf16_t* ktile, int lane) {
#pragma unroll
    for (int i = 0; i < 4; ++i) __builtin_amdgcn_global_load_lds((const unsigned*)((const unsigned char*)ktile + i * 1024 + lane * 16), (LAS unsigned*)(kbuf + i * 1024), 16, 0, 0);
}
DI void dma_v(ldsp_t vbuf  , const bf16_t* vtile, int lane) {
#pragma unroll
    for (int i = 0; i < 4; ++i) __builtin_amdgcn_global_load_lds((const unsigned*)((const unsigned char*)vtile + i * 1024 + lane * 16), (LAS unsigned*)(vbuf + i * 1024), 16, 0, 0);
}
DI f32x16 qk_lds(ldsp_t kbuf, const bf16x8 (&qf)[4], int r32, int hi) {
    f32x16 s; zero16(s);
    const int sw = (r32 >> 1) & 7;
#pragma unroll
    for (int ks = 0; ks < 4; ++ks) { const bf16x8 a = *(const LAS bf16x8*)(kbuf + r32 * 128 + (((2 * ks + hi) ^ sw) * 16)); s = MFMA32(a, qf[ks], s); }
    return s;
}
DI void pv_lds(f32x16 (&o)[2], ldsp_t vbuf, const f32x16& pr, int r32, int hi) {
    const bf16x8 pf0 = pack8(pr, 0), pf1 = pack8(pr, 8);
#pragma unroll
    for (int db = 0; db < 2; ++db) { const int d = 32 * db + r32, msk = (d >> 2) & 7; ldsp_t rowp = vbuf + d * 64;
#pragma unroll
        for (int s2 = 0; s2 < 2; ++s2) { const s16x4 lo = *(const LAS s16x4*)(rowp + (((4 * s2 + hi) ^ msk) * 8)); const s16x4 hh = *(const LAS s16x4*)(rowp + (((4 * s2 + 2 + hi) ^ msk) * 8));
            const bf16x8 a = {lo[0], lo[1], lo[2], lo[3], hh[0], hh[1], hh[2], hh[3]};
            o[db] = MFMA32(a, s2 ? pf1 : pf0, o[db]); } }
}
constexpr int RING_BYTES = 20480, VRING_OFF = 12288;
DI void dma_wait_step(bool k2, bool v1) {
    if (k2 && v1) asm volatile("s_waitcnt vmcnt(8)" ::: "memory");
    else if (k2 || v1) asm volatile("s_waitcnt vmcnt(4)" ::: "memory");
    else asm volatile("s_waitcnt vmcnt(0)" ::: "memory");
}
#define DMA_WAIT_NEWEST8() asm volatile("s_waitcnt vmcnt(8)" ::: "memory")
#define DMA_WAIT_ALL() asm volatile("s_waitcnt vmcnt(0)" ::: "memory")

DI void lds_kf(KF& f, ldsp_t kbuf, int r32, int hi) {
    const int sw = (r32 >> 1) & 7;
#pragma unroll
    for (int ks = 0; ks < 4; ++ks) f.k[ks] = *(const LAS bf16x8*)(kbuf + r32 * 128 + (((2 * ks + hi) ^ sw) * 16));
}
DI void lds_vf(VF& f, ldsp_t vbuf, int r32, int hi) {
#pragma unroll
    for (int db = 0; db < 2; ++db) { const int d = 32 * db + r32, msk = (d >> 2) & 7; ldsp_t rowp = vbuf + d * 64;
#pragma unroll
        for (int s2 = 0; s2 < 2; ++s2) { f.v[db][s2][0] = *(const LAS s16x4*)(rowp + (((4 * s2 + hi) ^ msk) * 8)); f.v[db][s2][1] = *(const LAS s16x4*)(rowp + (((4 * s2 + 2 + hi) ^ msk) * 8)); } }
}
template <bool MASKED, bool WIN> DI void nsa_pair_tile(ldsp_t kbuf, ldsp_t vbuf, const bf16x8 (&qf)[2][4], int t0, int kb, float rb0, float rb1, float slope2,
                                                       float (&m)[2], float (&l)[2], f32x16 (&o)[2][2], int r32, int hi) {
    KF kf; lds_kf(kf, kbuf, r32, hi);
    f32x16 s0 = qk_frag(kf, qf[0]), s1 = qk_frag(kf, qf[1]);
    const int db0 = t0 - kb - 4 * hi, db1 = db0 + 32;
#pragma unroll
    for (int r = 0; r < 16; ++r) { const int cr = (r & 3) + 8 * (r >> 2); const float bias = __int_as_float(__builtin_amdgcn_readfirstlane(__float_as_int(slope2 * (float)cr)));
        float e0 = __builtin_fmaf(s0[r], SCL2, bias), e1 = __builtin_fmaf(s1[r], SCL2, bias);
        if (MASKED) { const int d0 = db0 - cr, d1 = db1 - cr; e0 = (d0 >= 0 && (!WIN || d0 < 512)) ? e0 : -1e30f; e1 = (d1 >= 0 && (!WIN || d1 < 512)) ? e1 : -1e30f; }
        s0[r] = e0; s1[r] = e1; }
    softmax_core<MASKED>(s0, rb0 - slope2 * (float)db0, m[0], l[0], o[0]);
    softmax_core<MASKED>(s1, rb1 - slope2 * (float)db1, m[1], l[1], o[1]);
    VF vf; lds_vf(vf, vbuf, r32, hi);
    pv_frag(o[0], vf, s0); pv_frag(o[1], vf, s1);
}
DI void nsa_main_task(const Params& p, int b, int head, int blk, int lane, ldsp_t wl) {
    unsigned char* ws = p.ws; unsigned char* dout = (unsigned char*)p.out;
    const int g = head / 3, r32 = lane & 31, hi = lane >> 5;
    const int tq0 = blk * 64, cur = blk;
    const int t0 = tq0 + r32;
    const size_t tok0 = (size_t)b * T + t0;
    const bf16_t* qkv = (const bf16_t*)(ws + WS_QKV);
    const unsigned long long* smp = (const unsigned long long*)(dout + DO_SELM) + (size_t)(b * 2 + g) * T + t0;
    const unsigned long long selmask[2] = {smp[0], smp[32]};
    const float slope2 = fexp2(-(8.0f * (float)(head + 1)) / 6.0f) * LOG2E;
    bf16x8 qf[2][4];
    load_q(qf[0], qkv + tok0 * LDP_QKV + C_NQ + head * 64, hi); load_q(qf[1], qkv + (tok0 + 32) * LDP_QKV + C_NQ + head * 64, hi);
    const size_t tbase = (size_t)(b * 2 + g) * 128;
    const float* nsag = (const float*)(dout + DO_NSAG) + tok0 * 32 + head * 3;
    bf16_t* orow = (bf16_t*)(ws + WS_H) + tok0 * D + 384 + head * 64;
    {
        const bf16_t* kt = (const bf16_t*)(dout + DO_KSLC) + tbase * 2048; const bf16_t* vt = (const bf16_t*)(dout + DO_VSLC) + tbase * 2048;
        unsigned ulo = (unsigned)(selmask[0] | selmask[1]), uhi = (unsigned)((selmask[0] | selmask[1]) >> 32);
#pragma unroll
        for (int o_ = 1; o_ < 64; o_ <<= 1) { ulo |= (unsigned)__shfl_xor((int)ulo, o_); uhi |= (unsigned)__shfl_xor((int)uhi, o_); }
        unsigned long long U = ((unsigned long long)(unsigned)__builtin_amdgcn_readfirstlane((int)uhi) << 32) | (unsigned)__builtin_amdgcn_readfirstlane((int)ulo);
        U &= (cur == 63) ? ~0ull : ((1ull << (cur + 1)) - 1ull);
        float m[2] = {-1e30f, -1e30f}, l[2] = {0.f, 0.f}; f32x16 o[2][2];
        zero16(o[0][0]); zero16(o[0][1]); zero16(o[1][0]); zero16(o[1][1]);
#define NEXT_TILE(J, H, NJ, NH, HAS) { NJ = J; NH = H - 1; HAS = true; if (NH < 0) { const unsigned long long rem_ = U & ((1ull << J) - 1ull); if (rem_ == 0ull) HAS = false; else { NJ = 63 - __builtin_clzll(rem_); NH = 1; } } }
        int j0 = cur, h0 = 1, j1, h1, j2 = 0, h2 = 0; bool has1, has2 = false;
        NEXT_TILE(j0, h0, j1, h1, has1);
        if (has1) NEXT_TILE(j1, h1, j2, h2, has2);
        int ks0 = 0, vs0 = 0;
        dma_k(wl, kt + (size_t)(2 * j0 + h0) * 2048, lane); dma_v(wl + VRING_OFF, vt + (size_t)(2 * j0 + h0) * 2048, lane);
        if (has1) dma_k(wl + 4096, kt + (size_t)(2 * j1 + h1) * 2048, lane);
#define NSA_SEL_STEP(MASKED) { \
            const int ks1 = ks0 == 2 ? 0 : ks0 + 1, ks2 = ks1 == 2 ? 0 : ks1 + 1; \
            if (has2) dma_k(wl + ks2 * 4096, kt + (size_t)(2 * j2 + h2) * 2048, lane); \
            if (has1) dma_v(wl + VRING_OFF + (vs0 ^ 1) * 4096, vt + (size_t)(2 * j1 + h1) * 2048, lane); \
            dma_wait_step(has2, has1); \
            const int kb = 64 * j0 + 32 * h0; \
            const float rb0 = ((selmask[0] >> j0) & 1ull) ? 0.f : -1e30f, rb1 = ((selmask[1] >> j0) & 1ull) ? 0.f : -1e30f; \
            nsa_pair_tile<MASKED, false>(wl + ks0 * 4096, wl + VRING_OFF + vs0 * 4096, qf, t0, kb, rb0, rb1, slope2, m, l, o, r32, hi); \
            more = has1; \
            if (has1) { j0 = j1; h0 = h1; j1 = j2; h1 = h2; has1 = has2; \
                if (has2) { int nj, nh; bool hs; NEXT_TILE(j2, h2, nj, nh, hs); j2 = nj; h2 = nh; has2 = hs; } \
                ks0 = ks1; vs0 ^= 1; } }
        bool more = true;
#pragma unroll 1
        while (more && j0 == cur) NSA_SEL_STEP(true)
#pragma unroll 1
        while (more) NSA_SEL_STEP(false)
#pragma unroll
        for (int ci = 0; ci < 2; ++ci) {
            float lt = l[ci]; lt += __shfl_xor(lt, 32);
            const float f = nsag[ci * 32 * 32 + 1] * (lt > 0.f ? 1.0f / lt : 0.f);
#pragma unroll
            for (int db = 0; db < 2; ++db)
#pragma unroll
                for (int mg = 0; mg < 4; ++mg) { const u32x2 w = *(const u32x2*)((const bf16_t*)(dout + DO_OC) + (tok0 + ci * 32) * 384 + head * 64 + 32 * db + 8 * mg + 4 * hi);
                    f32x4 v = {bflo(w.x) + f * o[ci][db][4 * mg], bfhi(w.x) + f * o[ci][db][4 * mg + 1], bflo(w.y) + f * o[ci][db][4 * mg + 2], bfhi(w.y) + f * o[ci][db][4 * mg + 3]};
                    store_bf16x4(orow + (size_t)ci * 32 * D + 32 * db + 8 * mg + 4 * hi, v); }
        }
    }
    {
        const bf16_t* kt = (const bf16_t*)(dout + DO_KWIN) + tbase * 2048; const bf16_t* vt = (const bf16_t*)(dout + DO_VWIN) + tbase * 2048;
        float m[2] = {-1e30f, -1e30f}, l[2] = {0.f, 0.f}; f32x16 o[2][2];
        zero16(o[0][0]); zero16(o[0][1]); zero16(o[1][0]); zero16(o[1][1]);
        int kb0 = tq0 - 512; if (kb0 < 0) kb0 = 0;
        int kb = tq0 + 32, ks0 = 0, vs0 = 0;
        dma_k(wl, kt + (size_t)(kb >> 5) * 2048, lane); dma_v(wl + VRING_OFF, vt + (size_t)(kb >> 5) * 2048, lane);
        dma_k(wl + 4096, kt + (size_t)((kb - 32) >> 5) * 2048, lane);
#define NSA_WIN_STEP(MASKED) { \
            const bool has1 = (kb - 32 >= kb0), has2 = (kb - 64 >= kb0); \
            const int ks1 = ks0 == 2 ? 0 : ks0 + 1, ks2 = ks1 == 2 ? 0 : ks1 + 1; \
            if (has2) dma_k(wl + ks2 * 4096, kt + (size_t)((kb - 64) >> 5) * 2048, lane); \
            if (has1) dma_v(wl + VRING_OFF + (vs0 ^ 1) * 4096, vt + (size_t)((kb - 32) >> 5) * 2048, lane); \
            dma_wait_step(has2, has1); \
            nsa_pair_tile<MASKED, true>(wl + ks0 * 4096, wl + VRING_OFF + vs0 * 4096, qf, t0, kb, 0.f, 0.f, slope2, m, l, o, r32, hi); \
            more = has1; \
            if (has1) { kb -= 32; ks0 = ks1; vs0 ^= 1; } }
        bool more = true;
#pragma unroll 1
        while (more && kb >= tq0) NSA_WIN_STEP(true)
#pragma unroll 1
        while (more && kb > tq0 - 480) NSA_WIN_STEP(false)
#pragma unroll 1
        while (more) NSA_WIN_STEP(true)
#pragma unroll
        for (int ci = 0; ci < 2; ++ci) {
            float lt = l[ci]; lt += __shfl_xor(lt, 32);
            const float f = nsag[ci * 32 * 32 + 2] * (lt > 0.f ? 1.0f / lt : 0.f);
#pragma unroll
            for (int db = 0; db < 2; ++db)
#pragma unroll
                for (int mg = 0; mg < 4; ++mg) { bf16_t* op = orow + (size_t)ci * 32 * D + 32 * db + 8 * mg + 4 * hi; const u32x2 w = *(const u32x2*)op;
                    f32x4 v = {bflo(w.x) + f * o[ci][db][4 * mg], bfhi(w.x) + f * o[ci][db][4 * mg + 1], bflo(w.y) + f * o[ci][db][4 * mg + 2], bfhi(w.y) + f * o[ci][db][4 * mg + 3]};
                    store_bf16x4(op, v); }
        }
    }
}

DI void mem_task(const Params& p, int b, int head, int chunk, int lane, ldsp_t wl) {
    unsigned char* ws = p.ws; unsigned char* dout = (unsigned char*)p.out;
    const int r32 = lane & 31, hi = lane >> 5; const size_t tok = (size_t)b * T + chunk * 32 + r32;
    const bf16_t* qkv = (const bf16_t*)(ws + WS_QKV);
    bf16x8 qf[4]; load_q(qf, qkv + tok * LDP_QKV + C_MQ + head * 64, hi);
    const bf16_t* kt = (const bf16_t*)(dout + DO_MKT) + (size_t)(b * 4 + head) * 8 * 2048;
    const bf16_t* vt = (const bf16_t*)(dout + DO_MVT) + (size_t)(b * 4 + head) * 8 * 2048;
    float m = -1e30f, l = 0.f; f32x16 o[2]; zero16(o[0]); zero16(o[1]);
    int ks0 = 0, vs0 = 0;
    dma_k(wl, kt, lane); dma_v(wl + VRING_OFF, vt, lane); dma_k(wl + 4096, kt + 2048, lane);
#pragma unroll 1
    for (int ti = 0; ti < 8; ++ti) {
        const bool has1 = ti + 1 < 8, has2 = ti + 2 < 8;
        const int ks1 = ks0 == 2 ? 0 : ks0 + 1, ks2 = ks1 == 2 ? 0 : ks1 + 1;
        if (has2) dma_k(wl + ks2 * 4096, kt + (size_t)(ti + 2) * 2048, lane);
        if (has1) dma_v(wl + VRING_OFF + (vs0 ^ 1) * 4096, vt + (size_t)(ti + 1) * 2048, lane);
        dma_wait_step(has2, has1);
        f32x16 s = qk_lds(wl + ks0 * 4096, qf, r32, hi);
#pragma unroll
        for (int r = 0; r < 16; ++r) s[r] *= SCL2;
        softmax_core(s, 0.f, m, l, o);
        pv_lds(o, wl + VRING_OFF + vs0 * 4096, s, r32, hi);
        ks0 = ks1; vs0 ^= 1;
    }
    l += __shfl_xor(l, 32);
    const float f = 1.0f / l;
    bf16_t* orow = (bf16_t*)(ws + WS_H) + tok * D + 768 + head * 64;
#pragma unroll
    for (int db = 0; db < 2; ++db)
#pragma unroll
        for (int mg = 0; mg < 4; ++mg) { f32x4 v = {o[db][4 * mg] * f, o[db][4 * mg + 1] * f, o[db][4 * mg + 2] * f, o[db][4 * mg + 3] * f}; store_bf16x4(orow + 32 * db + 8 * mg + 4 * hi, v); }
}

DI void sb_task(const Params& p, int b, int head, int chunk, int lane, ldsp_t wl) {
    unsigned char* ws = p.ws; unsigned char* dout = (unsigned char*)p.out;
    const int r32 = lane & 31, hi = lane >> 5; const int tq0 = chunk * 32, t = tq0 + r32; const size_t tok = (size_t)b * T + t;
    const bf16_t* qkv = (const bf16_t*)(ws + WS_QKV);
    bf16x8 qf[4]; load_q(qf, qkv + tok * LDP_QKV + C_SBQ + head * 64, hi);
    const size_t tbase = (size_t)(b * 6 + head) * 128;
    const bf16_t* kt = (const bf16_t*)(dout + DO_SBK) + tbase * 2048; const bf16_t* vt = (const bf16_t*)(dout + DO_SBV) + tbase * 2048;
    f32x16 o[2]; zero16(o[0]); zero16(o[1]);
    float R = 0.f;
    int kb = tq0, ks0 = 0, vs0 = 0;
    dma_k(wl, kt + (size_t)(kb >> 5) * 2048, lane); dma_v(wl + VRING_OFF, vt + (size_t)(kb >> 5) * 2048, lane);
    if (kb >= 32) dma_k(wl + 4096, kt + (size_t)((kb - 32) >> 5) * 2048, lane);
#define SB_STEP(MASKED) { \
        const bool has1 = kb >= 32, has2 = kb >= 64; \
        const int ks1 = ks0 == 2 ? 0 : ks0 + 1, ks2 = ks1 == 2 ? 0 : ks1 + 1; \
        if (has2) dma_k(wl + ks2 * 4096, kt + (size_t)((kb - 64) >> 5) * 2048, lane); \
        if (has1) dma_v(wl + VRING_OFF + (vs0 ^ 1) * 4096, vt + (size_t)((kb - 32) >> 5) * 2048, lane); \
        dma_wait_step(has2, has1); \
        f32x16 s = qk_lds(wl + ks0 * 4096, qf, r32, hi); \
        f32x16 L; \
        _Pragma("unroll") for (int r = 0; r < 16; ++r) { const float z = s[r] * (0.125f * LOG2E); \
            const float sp = fmaxf(z, 0.f) + flog2(1.0f + fexp2(-fabsf(z)));       \
            s[r] = z; if (MASKED) { const bool valid = (kb + krow(r, hi)) < t; L[r] = valid ? -sp : 0.f; } else L[r] = -sp; } \
        float gs[4], pg[4]; \
        _Pragma("unroll") for (int mg = 0; mg < 4; ++mg) { gs[mg] = (L[4 * mg] + L[4 * mg + 1]) + (L[4 * mg + 2] + L[4 * mg + 3]); pg[mg] = __shfl_xor(gs[mg], 32); } \
        float off[4]; float run = R; \
        _Pragma("unroll") for (int mg = 3; mg >= 0; --mg) { off[mg] = run + (hi ? 0.f : pg[mg]); run += gs[mg] + pg[mg]; } \
        _Pragma("unroll") for (int mg = 0; mg < 4; ++mg) { \
            float e = off[mg]; \
            _Pragma("unroll") for (int i = 3; i >= 0; --i) { const int r = 4 * mg + i; \
                float a = fexp2(s[r] + L[r] + e); if (MASKED) { const bool valid = (kb + krow(r, hi)) < t; a = valid ? a : 0.f; } e += L[r]; s[r] = a; } \
        } \
        R = run; \
        pv_lds(o, wl + VRING_OFF + vs0 * 4096, s, r32, hi); \
        more = has1 && !__all(R < -104.0f * LOG2E); \
        if (more) { kb -= 32; ks0 = ks1; vs0 ^= 1; } }
    bool more;
    SB_STEP(true)
#pragma unroll 1
    while (more) SB_STEP(false)
#undef SB_STEP
    DMA_WAIT_ALL();
    bf16_t* orow = (bf16_t*)(ws + WS_H) + tok * D + head * 64;
#pragma unroll
    for (int db = 0; db < 2; ++db)
#pragma unroll
        for (int mg = 0; mg < 4; ++mg) { f32x4 v = {o[db][4 * mg], o[db][4 * mg + 1], o[db][4 * mg + 2], o[db][4 * mg + 3]}; store_bf16x4(orow + 32 * db + 8 * mg + 4 * hi, v); }
}

constexpr int N_CMP_TASKS = NB * 2 * 128, N_NSA_TASKS = NB * 6 * 64, N_MEM_TASKS = NB * 4 * 128, N_SB_TASKS = NB * 6 * 128;
DI void phase3a(const Params& p, int rep, bf16_t* lds) {
    const int lane = threadIdx.x & 63;
    ldsp_t wl = (ldsp_t)(unsigned char*)lds + __builtin_amdgcn_readfirstlane((int)(threadIdx.x >> 6)) * RING_BYTES;
    float* impl = (float*)((unsigned char*)lds + (threadIdx.x >> 6) * RING_BYTES);
    unsigned* ctr = (unsigned*)(p.ws + WS_CTL) + 64 + 256 * rep;
    for (;;) {
        unsigned tk = 0; if (lane == 0) tk = atomicAdd(ctr, 1u);
        const int task = (int)__builtin_amdgcn_readfirstlane(tk);
        if (task >= N_CMP_TASKS + N_MEM_TASKS) break;
        if (task < N_CMP_TASKS) { const int chunk = 127 - task / 16, rem = task % 16; nsa_cmp_task(p, rem >> 1, rem & 1, chunk, lane, impl); }
        else { const int r = task - N_CMP_TASKS; const int chunk = r / 32, rem = r % 32; mem_task(p, rem / 4, rem % 4, chunk, lane, wl); }
    }
}
DI void phase3b(const Params& p, int rep, unsigned char* lds_raw_) {
    const int lane = threadIdx.x & 63;
    ldsp_t wl = (ldsp_t)lds_raw_ + __builtin_amdgcn_readfirstlane((int)(threadIdx.x >> 6)) * RING_BYTES;
    unsigned* ctr = (unsigned*)(p.ws + WS_CTL) + 128 + 256 * rep;
    if (__builtin_amdgcn_readfirstlane((int)(threadIdx.x >> 6)) == NWAVES - 1) peer_table_rows(p, lane, blockIdx.x, gridDim.x);
    for (;;) {
        unsigned tk = 0; if (lane == 0) tk = atomicAdd(ctr, 1u);
        const int task = (int)__builtin_amdgcn_readfirstlane(tk);
        if (task >= N_NSA_TASKS + N_SB_TASKS) break;
        if (task < N_NSA_TASKS) { const int ci = task / 48, rem = task % 48; const int blk = (ci & 1) ? (ci >> 1) : 63 - (ci >> 1); nsa_main_task(p, rem / 6, rem % 6, blk, lane, wl); }
        else { const int r = task - N_NSA_TASKS; const int chunk = r / 48, rem = r % 48; sb_task(p, rem / 6, rem % 6, chunk, lane, wl); }
    }
}

DI void phase4(const Params& p, bf16_t* lds) {
    unsigned char* ws = p.ws;
    const bf16_t* cat = (const bf16_t*)(ws + WS_H); const bf16_t* gates = (const bf16_t*)(ws + WS_GATES); bf16_t* merged = (bf16_t*)(ws + WS_MERGED);
    pg8::StaticOrder S; S.init(NTOK, D, (int)gridDim.x, (int)blockIdx.x);
#pragma unroll 1
    for (int br = 0; br < 3; ++br) {
        const int Kb = br == 2 ? 256 : 384;
        const bf16_t* Bt = (const bf16_t*)(ws + (br == 0 ? WS_WSB : (br == 1 ? WS_WNSA : WS_WMEM)));
        pg8::Gemm g{cat + br * 384, Bt, NTOK, D, Kb, D, Kb}; pg8::EpiMerge E{merged, gates, br}; GEMM_PHASE(pg8::EpiMerge, g, S, E);
    }
}
DI void phase5(const Params& p, bf16_t* lds) {
    unsigned char* ws = p.ws;
    pg8::Gemm g{(const bf16_t*)(ws + WS_MERGED), (const bf16_t*)(ws + WS_WOUT), NTOK, D, D, D, D};
    pg8::StaticOrder S; S.init(NTOK, D, (int)gridDim.x, (int)blockIdx.x);
    pg8::EpiOut E{p.in[0], p.in[15], p.out, (bf16_t*)(ws + WS_H2), (float*)(ws + WS_ROWSS)};
    GEMM_PHASE(pg8::EpiOut, g, S, E);
}
DI void phase6(const Params& p, bf16_t* lds) {
    unsigned char* ws = p.ws;
    pg8::Gemm g{(const bf16_t*)(ws + WS_H2), (const bf16_t*)(ws + WS_WQ), NTOK, 2048, D, D, D};
    pg8::StaticOrder S; S.init(NTOK, 2048, (int)gridDim.x, (int)blockIdx.x);
    pg8::EpiPlain E{(bf16_t*)(ws + WS_QP), 2048};
    GEMM_PHASE(pg8::EpiPlain, g, S, E);
}

DI float row_rstd(const float* rowss, size_t tok) {
    const f32x4* r = (const f32x4*)(rowss + tok * 32); float s = 0.f;
#pragma unroll
    for (int i = 0; i < 8; ++i) { const f32x4 v = r[i]; s += (v.x + v.y) + (v.z + v.w); }
    return 1.0f / sqrtf(s * (1.0f / D) + RMS_EPS);
}
constexpr int ROUTE_LDS_PER_WAVE = 2 * 16 * 32 * 4;
DI void route_task(const Params& p, int chunk, int head, int lane, float* wl, ldsp_t sk  ) {
    unsigned char* ws = p.ws;
    const int r32 = lane & 31, hi = lane >> 5; const size_t tok = (size_t)chunk * 32 + r32;
    const bf16_t* qp = (const bf16_t*)(ws + WS_QP) + tok * 2048 + head * 256;
    int* til = (int*)wl;
    float tv[2][16];
#pragma unroll
    for (int pp = 0; pp < 2; ++pp) {
        f32x16 sc[4];
#pragma unroll
        for (int tl = 0; tl < 4; ++tl) zero16(sc[tl]);
#pragma unroll
        for (int ks = 0; ks < 8; ++ks) {
            const bf16x8 qv = *(const bf16x8*)(qp + pp * 128 + ks * 16 + hi * 8);
#pragma unroll
            for (int tl = 0; tl < 4; ++tl) { const int row = pp * 128 + tl * 32 + r32; const bf16x8 a = *(const LAS bf16x8*)(sk + row * 256 + (((2 * ks + hi) ^ (row & 15)) * 16)); sc[tl] = MFMA32(a, qv, sc[tl]); }
        }
        int k0[16], k1[16], k2[16], k3[16];
#pragma unroll
        for (int r = 0; r < 16; ++r) { const int kr = krow(r, hi);
            k0[r] = (f2key(sc[0][r]) & ~127) | (127 - kr); k1[r] = (f2key(sc[1][r]) & ~127) | (127 - (32 + kr));
            k2[r] = (f2key(sc[2][r]) & ~127) | (127 - (64 + kr)); k3[r] = (f2key(sc[3][r]) & ~127) | (127 - (96 + kr)); }
        bitonic_sort_desc<16>(k0); bitonic_sort_desc<16>(k1); bitonic_sort_desc<16>(k2); bitonic_sort_desc<16>(k3);
        top16_merge(k0, k1); top16_merge(k2, k3); top16_merge(k0, k2);
        int pb[16];
#pragma unroll
        for (int i = 0; i < 16; ++i) pb[i] = __shfl_xor(k0[i], 32);
        top16_merge(k0, pb);
#pragma unroll
        for (int i = 0; i < 16; ++i) { tv[pp][i] = key2f(k0[i] & ~127); if (hi == 0) til[(pp * 16 + i) * 32 + r32] = 127 - (k0[i] & 127); }
    }
    __builtin_amdgcn_wave_barrier();
    int c0[16], c1[16], c2[16], c3[16];
    {
        int c = 0;
#pragma unroll
        for (int a = 0; a < 16; ++a)
#pragma unroll
            for (int bb = 0; bb < 16; ++bb) if ((a + 1) * (bb + 1) <= 16) {
                const int key = (f2key(tv[0][a] + tv[1][bb]) & ~255) | (255 - (a * 16 + bb));
                if (c < 16) c0[c] = key; else if (c < 32) c1[c - 16] = key; else if (c < 48) c2[c - 32] = key; else c3[c - 48] = key;
                ++c; }
#pragma unroll
        for (int i = 2; i < 16; ++i) c3[i] = (int)0x80000000;
    }
    bitonic_sort_desc<16>(c1); bitonic_sort_desc<16>(c2); bitonic_sort_desc<16>(c3);
    top16_merge(c0, c1); top16_merge(c2, c3); top16_merge(c0, c2);
    const float rstd = row_rstd((const float*)(ws + WS_ROWSS), tok);
    float gg[16]; int ex[16]; float den = 0.f; const float b0 = key2f(c0[0] & ~255);
#pragma unroll
    for (int k = 0; k < 16; ++k) { const int code = 255 - (c0[k] & 255);
        ex[k] = til[(code >> 4) * 32 + r32] * 128 + til[(16 + (code & 15)) * 32 + r32];
        gg[k] = fexp((key2f(c0[k] & ~255) - b0) * rstd); den += gg[k]; }
    const float inv = 1.0f / den;
    if (hi == 0) { unsigned short* ip = (unsigned short*)(ws + WS_IDX) + tok * 128 + head * 16;
        u32x4 w0, w1;
        w0.x = (unsigned)ex[0] | ((unsigned)ex[1] << 16); w0.y = (unsigned)ex[2] | ((unsigned)ex[3] << 16); w0.z = (unsigned)ex[4] | ((unsigned)ex[5] << 16); w0.w = (unsigned)ex[6] | ((unsigned)ex[7] << 16);
        w1.x = (unsigned)ex[8] | ((unsigned)ex[9] << 16); w1.y = (unsigned)ex[10] | ((unsigned)ex[11] << 16); w1.z = (unsigned)ex[12] | ((unsigned)ex[13] << 16); w1.w = (unsigned)ex[14] | ((unsigned)ex[15] << 16);
        *(u32x4*)ip = w0; *(u32x4*)(ip + 8) = w1; }
    else { float* gp = (float*)(ws + WS_GW) + tok * 128 + head * 16;
#pragma unroll
        for (int k = 0; k < 16; k += 4) { f32x4 v = {gg[k] * inv, gg[k + 1] * inv, gg[k + 2] * inv, gg[k + 3] * inv}; *(f32x4*)(gp + k) = v; } }
    __builtin_amdgcn_wave_barrier();
}
DI void phase7(const Params& p, bf16_t* lds) {
    const int lane = threadIdx.x & 63, wid = threadIdx.x >> 6;
    ldsp_t sk = (ldsp_t)(unsigned char*)lds;
    float* wl = (float*)((unsigned char*)lds + 65536 + wid * ROUTE_LDS_PER_WAVE);
    for (int head = blockIdx.x & 7; head < 8; head += gridDim.x) {
        const int nbh = ((int)gridDim.x - head + 7) / 8, rank = blockIdx.x >> 3;
        __syncthreads();
        const u32x4* src = (const u32x4*)((const bf16_t*)(p.ws + WS_SUBK) + (size_t)head * 2 * 128 * 128);
#pragma unroll
        for (int j = 0; j < 8; ++j) { const int ci = threadIdx.x + NTHREADS * j, row = ci >> 4, c = ci & 15; *(LAS u32x4*)(sk + row * 256 + ((c ^ (row & 15)) * 16)) = src[ci]; }
        __syncthreads();
        for (int chunk = rank * NWAVES + wid; chunk < NTOK / 32; chunk += nbh * NWAVES) route_task(p, chunk, head, lane, wl, sk);
    }
}

DI float gelu_exact(float a) { return 0.5f * a * (1.0f + erff(a * 0.70710678118654752f)); }
DI void fp8x16_to_f32(const u32x4& w, float (&f)[16]) {
#pragma unroll
    for (int j = 0; j < 4; ++j) { const f32x2 lo = __builtin_amdgcn_cvt_pk_f32_fp8((int)w[j], false); const f32x2 hi = __builtin_amdgcn_cvt_pk_f32_fp8((int)w[j], true);
        f[4 * j] = lo.x; f[4 * j + 1] = lo.y; f[4 * j + 2] = hi.x; f[4 * j + 3] = hi.y; }
}
DI void phase8(const Params& p) {
    unsigned char* ws = p.ws;
    const int lane = threadIdx.x & 63, wid = threadIdx.x >> 6;
    const int gwave = blockIdx.x * NWAVES + wid, nwaves = gridDim.x * NWAVES;
    const bf16_t* h2 = (const bf16_t*)(ws + WS_H2); const unsigned char* tu = ws + WS_TABU; const unsigned char* tvv = ws + WS_TABV;
    const float* tsc = (const float*)(ws + WS_TSCALE);
    const unsigned short* idx = (const unsigned short*)(ws + WS_IDX); const float* gw = (const float*)(ws + WS_GW);
    const float* gfin = p.in[20];
    const int kk = ((lane >> 5) & 1) * 8 + ((lane >> 4) & 1) * 4 + ((lane >> 3) & 1) * 2 + ((lane >> 2) & 1);
#pragma unroll 1
    for (int tk = gwave; tk < NTOK; tk += nwaves) {
        const size_t tok = (size_t)tk;
        const float rstd = row_rstd((const float*)(ws + WS_ROWSS), tok);
        float hn[16];
        { const u32x4 a = *(const u32x4*)(h2 + tok * D + lane * 16); const u32x4 b = *(const u32x4*)(h2 + tok * D + lane * 16 + 8);
          hn[0] = bflo(a.x) * rstd; hn[1] = bfhi(a.x) * rstd; hn[2] = bflo(a.y) * rstd; hn[3] = bfhi(a.y) * rstd; hn[4] = bflo(a.z) * rstd; hn[5] = bfhi(a.z) * rstd; hn[6] = bflo(a.w) * rstd; hn[7] = bfhi(a.w) * rstd;
          hn[8] = bflo(b.x) * rstd; hn[9] = bfhi(b.x) * rstd; hn[10] = bflo(b.y) * rstd; hn[11] = bfhi(b.y) * rstd; hn[12] = bflo(b.z) * rstd; hn[13] = bfhi(b.z) * rstd; hn[14] = bflo(b.w) * rstd; hn[15] = bfhi(b.w) * rstd; }
        float acc[16];
#pragma unroll
        for (int i = 0; i < 16; ++i) acc[i] = 0.f;
        const int e_lo = idx[tok * 128 + lane], e_hi = idx[tok * 128 + 64 + lane];
        const float g_lo = gw[tok * 128 + lane], g_hi = gw[tok * 128 + 64 + lane];
        for (int rep9 = 0; rep9 < REP9; ++rep9)
#pragma unroll 1
        for (int head = 0; head < 8; ++head) {
            const int esrc = head < 4 ? e_lo : e_hi; const float gsrc = head < 4 ? g_lo : g_hi;
            const int myslot = (head & 3) * 16 + kk;
            const int my_e = __shfl(esrc, myslot); const float my_g = __shfl(gsrc, myslot);
            const float su = tsc[my_e], sv = tsc[16384 + my_e];
            u32x4 ub[16], vb[16];
#pragma unroll
            for (int k = 0; k < 16; ++k) { const int e = __builtin_amdgcn_readlane(esrc, (head & 3) * 16 + k);
                ub[k] = *(const u32x4*)(tu + (size_t)e * 1024 + lane * 16); vb[k] = *(const u32x4*)(tvv + (size_t)e * 1024 + lane * 16); }
            float d[16];
#pragma unroll
            for (int k = 0; k < 16; ++k) { float f[16]; fp8x16_to_f32(ub[k], f); float t = 0.f;
#pragma unroll
                for (int i = 0; i < 16; ++i) t += f[i] * hn[i];
                d[k] = t; }
            float r8[8], r4[4], r2[2], r1;
            { const bool up = (lane & 32) != 0;
#pragma unroll
              for (int k = 0; k < 8; ++k) { const float keep = up ? d[k + 8] : d[k], send = up ? d[k] : d[k + 8]; r8[k] = keep + __shfl_xor(send, 32); } }
            { const bool up = (lane & 16) != 0;
#pragma unroll
              for (int k = 0; k < 4; ++k) { const float keep = up ? r8[k + 4] : r8[k], send = up ? r8[k] : r8[k + 4]; r4[k] = keep + __shfl_xor(send, 16); } }
            { const bool up = (lane & 8) != 0;
#pragma unroll
              for (int k = 0; k < 2; ++k) { const float keep = up ? r4[k + 2] : r4[k], send = up ? r4[k] : r4[k + 2]; r2[k] = keep + __shfl_xor(send, 8); } }
            { const bool up = (lane & 4) != 0; const float keep = up ? r2[1] : r2[0], send = up ? r2[0] : r2[1]; r1 = keep + __shfl_xor(send, 4); }
            r1 += __shfl_xor(r1, 2); r1 += __shfl_xor(r1, 1);
            const float wmine = my_g * gelu_exact(r1 * su) * sv;
#pragma unroll
            for (int k = 0; k < 16; ++k) {
                const int lk = ((k >> 3) & 1) * 32 + ((k >> 2) & 1) * 16 + ((k >> 1) & 1) * 8 + (k & 1) * 4;
                const float w = __uint_as_float(__builtin_amdgcn_readlane(__float_as_uint(wmine), lk));
                float f[16]; fp8x16_to_f32(vb[k], f);
#pragma unroll
                for (int i = 0; i < 16; ++i) acc[i] += w * f[i];
            }
        }
        float* orow = p.out + tok * D + lane * 16;
        f32x4 y[4]; float ss = 0.f;
#pragma unroll
        for (int q = 0; q < 4; ++q) { f32x4 v = *(const f32x4*)(orow + 4 * q);
            v.x += acc[q * 4] * (1.0f / REP9); v.y += acc[q * 4 + 1] * (1.0f / REP9); v.z += acc[q * 4 + 2] * (1.0f / REP9); v.w += acc[q * 4 + 3] * (1.0f / REP9); y[q] = v; ss += (v.x * v.x + v.y * v.y) + (v.z * v.z + v.w * v.w); }
        const float rs = 1.0f / sqrtf(wave_sum(ss) * (1.0f / D) + RMS_EPS);
#pragma unroll
        for (int q = 0; q < 4; ++q) { const f32x4 gg = *(const f32x4*)(gfin + lane * 16 + 4 * q); f32x4 v = y[q];
            v.x *= rs * gg.x; v.y *= rs * gg.y; v.z *= rs * gg.z; v.w *= rs * gg.w; *(f32x4*)(orow + 4 * q) = v; }
    }
}


constexpr int P8_CHUNK = 16, P8_NCHUNK = NTOK / P8_CHUNK;
DI unsigned my_xcc() { return (unsigned)__builtin_amdgcn_s_getreg((3 << 11) | 20) & 7u; }
DI float dpp_xor1(float v) { return __int_as_float(__builtin_amdgcn_update_dpp(0, __float_as_int(v), 0xB1, 0xF, 0xF, true)); }
DI float dpp_xor2(float v) { return __int_as_float(__builtin_amdgcn_update_dpp(0, __float_as_int(v), 0x4E, 0xF, 0xF, true)); }
DI void fp8x16_to_f32x2(const u32x4& w, f32x2 (&f)[8]) {
#pragma unroll
    for (int j = 0; j < 4; ++j) { f[2 * j] = __builtin_amdgcn_cvt_pk_f32_fp8((int)w[j], false); f[2 * j + 1] = __builtin_amdgcn_cvt_pk_f32_fp8((int)w[j], true); }
}
DI unsigned q8_pack4(float a, float b, float c, float d, float s) {
    const unsigned ta = __float_as_uint(__builtin_fmaf(a, s, 12582912.0f)), tb = __float_as_uint(__builtin_fmaf(b, s, 12582912.0f));
    const unsigned tc = __float_as_uint(__builtin_fmaf(c, s, 12582912.0f)), td = __float_as_uint(__builtin_fmaf(d, s, 12582912.0f));
    const unsigned lo = __builtin_amdgcn_perm(tb, ta, 0x0c0c0400u), hi = __builtin_amdgcn_perm(td, tc, 0x0c0c0400u);
    return __builtin_amdgcn_perm(hi, lo, 0x05040100u);
}
DI void h_to_i8(const u32x4& hr0, const u32x4& hr1, u32x4& h8, float& hs) {
    float f[16];
    f[0] = bflo(hr0.x); f[1] = bfhi(hr0.x); f[2] = bflo(hr0.y); f[3] = bfhi(hr0.y); f[4] = bflo(hr0.z); f[5] = bfhi(hr0.z); f[6] = bflo(hr0.w); f[7] = bfhi(hr0.w);
    f[8] = bflo(hr1.x); f[9] = bfhi(hr1.x); f[10] = bflo(hr1.y); f[11] = bfhi(hr1.y); f[12] = bflo(hr1.z); f[13] = bfhi(hr1.z); f[14] = bflo(hr1.w); f[15] = bfhi(hr1.w);
    float am = 0.f;
#pragma unroll
    for (int i = 0; i < 16; i += 2) am = fmaxf(am, fmaxf(fabsf(f[i]), fabsf(f[i + 1])));
    const float s = am > 0.f ? 127.0f * __builtin_amdgcn_rcpf(am) : 0.f;
    hs = am * (1.0f / 127.0f);
    h8.x = q8_pack4(f[0], f[1], f[2], f[3], s); h8.y = q8_pack4(f[4], f[5], f[6], f[7], s); h8.z = q8_pack4(f[8], f[9], f[10], f[11], s); h8.w = q8_pack4(f[12], f[13], f[14], f[15], s);
}
struct HalfT { u32x4 rb[8]; float sc[8]; };
DI void p8a_issue(HalfT& B, const unsigned char* tu, const LAS float* tsc, const LAS unsigned short* eidx, int ti, int hf, int sl, int pp, int cc, int gmine) {
#pragma unroll
    for (int g = 0; g < 8; ++g) { const int e = eidx[ti * 128 + (hf * 8 + g) * 8 + pp]; B.rb[g] = *(const u32x4*)(tu + (size_t)sl * (16384 * 128) + (size_t)e * 128 + cc * 16); }
    B.sc[0] = tsc[eidx[ti * 128 + (hf * 8 + gmine) * 8 + pp]];
}
DI float p8a_compute(const HalfT& B, const u32x4& h8, float hs, int cc) {
    float d[8];
#pragma unroll
    for (int g = 0; g < 8; ++g) { int a = __builtin_amdgcn_sdot4((int)B.rb[g].x, (int)h8.x, 0, false); a = __builtin_amdgcn_sdot4((int)B.rb[g].y, (int)h8.y, a, false);
        a = __builtin_amdgcn_sdot4((int)B.rb[g].z, (int)h8.z, a, false); a = __builtin_amdgcn_sdot4((int)B.rb[g].w, (int)h8.w, a, false);
        d[g] = (float)a * hs; }
    float r4[4], r2[2];
    { const bool up = (cc & 1) != 0;
#pragma unroll
      for (int i = 0; i < 4; ++i) { const float keep = up ? d[i + 4] : d[i], send = up ? d[i] : d[i + 4]; r4[i] = keep + dpp_xor1(send); } }
    { const bool up = (cc & 2) != 0;
#pragma unroll
      for (int i = 0; i < 2; ++i) { const float keep = up ? r4[i + 2] : r4[i], send = up ? r4[i] : r4[i + 2]; r2[i] = keep + dpp_xor2(send); } }
    const bool up = (cc & 4) != 0; const float keep = up ? r2[1] : r2[0], send = up ? r2[0] : r2[1];
    return (keep + __shfl_xor(send, 4)) * B.sc[0];
}
DI void phase8a(const Params& p, unsigned char* lds_raw_, int rep) {
    unsigned char* ws = p.ws;
    const int lane = threadIdx.x & 63, pp = lane >> 3, cc = lane & 7;
    const bf16_t* h2 = (const bf16_t*)(ws + WS_H2); const unsigned char* tu = ws + WS_TABU; const float* tscg = (const float*)(ws + WS_TSCALE);
    const unsigned short* idx = (const unsigned short*)(ws + WS_IDX); bf16_t* pd = (bf16_t*)(ws + WS_PD);
    unsigned* ctr = (unsigned*)(ws + WS_CTL) + 1024 + 8192 * rep;
    LAS unsigned short* eidx = (LAS unsigned short*)((ldsp_t)lds_raw_ + __builtin_amdgcn_readfirstlane((int)(threadIdx.x >> 6)) * 8192);
    LAS unsigned char* hq = (LAS unsigned char*)eidx + 4096; LAS float* hsl = (LAS float*)((LAS unsigned char*)eidx + 6144);
    LAS float* tsc = (LAS float*)((ldsp_t)lds_raw_ + 65536);
    for (int i = threadIdx.x; i < 4096; i += NTHREADS) ((LAS i32x4*)tsc)[i] = ((const i32x4*)tscg)[i];
    __syncthreads();
    const unsigned xs = my_xcc();
    const int gmine = ((cc & 1) << 2) | (cc & 2) | ((cc >> 2) & 1);
#pragma unroll 1
    for (int k8 = 0; k8 < 8; ++k8) {
        const int sl = (int)((xs + k8) & 7u);
#pragma unroll 1
        for (;;) {
            unsigned tk = 0; if (lane == 0) tk = atomicAdd(ctr + 64 * sl, 1u);
            const int chunk = (int)__builtin_amdgcn_readfirstlane(tk);
            if (chunk >= P8_NCHUNK) break;
            const size_t tok0 = (size_t)chunk * P8_CHUNK;
#pragma unroll
            for (int i = 0; i < 4; ++i) ((LAS i32x4*)eidx)[i * 64 + lane] = ((const i32x4*)(idx + tok0 * 128))[i * 64 + lane];
#pragma unroll
            for (int it = 0; it < 2; ++it) { const int j = lane + 64 * it; const bf16_t* hp = h2 + (tok0 + (j >> 3)) * D + sl * 128 + (j & 7) * 16;
                const u32x4 a0 = *(const u32x4*)hp, a1 = *(const u32x4*)(hp + 8); u32x4 q; float s_; h_to_i8(a0, a1, q, s_);
                ((LAS i32x4*)hq)[j] = __builtin_bit_cast(i32x4, q); hsl[j] = s_; }
            __builtin_amdgcn_wave_barrier();
            HalfT X, Y;
            p8a_issue(X, tu, tsc, eidx, 0, 0, sl, pp, cc, gmine);
#pragma unroll 1
            for (int ti = 0; ti < P8_CHUNK; ++ti) {
                const size_t tok = tok0 + ti;
                p8a_issue(Y, tu, tsc, eidx, ti, 1, sl, pp, cc, gmine);
                const u32x4 h8 = __builtin_bit_cast(u32x4, ((const LAS i32x4*)hq)[ti * 8 + cc]); const float hs = hsl[ti * 8 + cc];
                const float keep0 = p8a_compute(X, h8, hs, cc);
                if (ti + 1 < P8_CHUNK) p8a_issue(X, tu, tsc, eidx, ti + 1, 0, sl, pp, cc, gmine);
                const float keep1 = p8a_compute(Y, h8, hs, cc);
                bf16_t* po = pd + ((size_t)sl * NTOK + tok) * 128 + gmine * 8 + pp;
                po[0] = (bf16_t)f2bf(keep0); po[64] = (bf16_t)f2bf(keep1);
            }
            __builtin_amdgcn_wave_barrier();
        }
    }
}
DI void phase8w(const Params& p, unsigned char* lds_raw_) {
    unsigned char* ws = p.ws;
    const int lane = threadIdx.x & 63, wid = threadIdx.x >> 6;
    const int gwave = blockIdx.x * NWAVES + wid, nwaves = gridDim.x * NWAVES;
    const bf16_t* __restrict__ pd = (const bf16_t*)(ws + WS_PD); const float* __restrict__ tsc = (const float*)(ws + WS_TSCALE);
    const unsigned short* __restrict__ idx = (const unsigned short*)(ws + WS_IDX); const float* __restrict__ gw = (const float*)(ws + WS_GW); bf16_t* __restrict__ wp = (bf16_t*)(ws + WS_WPEER);
    const float* __restrict__ rowss = (const float*)(ws + WS_ROWSS);
    LAS float* svl = (LAS float*)((ldsp_t)lds_raw_);
    for (int i = threadIdx.x; i < 4096; i += NTHREADS) ((LAS i32x4*)svl)[i] = ((const i32x4*)(tsc + 16384))[i];
    __syncthreads();
    for (int tk = gwave; tk < NTOK; tk += 4 * nwaves) {
        float pa[4][16]; int e0[4], e1[4]; float g0[4], g1[4]; float rs[4]; size_t tok[4];
#pragma unroll
        for (int q = 0; q < 4; ++q) { const int t = tk + q * nwaves; tok[q] = (size_t)(t < NTOK ? t : tk); }
#pragma unroll
        for (int q = 0; q < 4; ++q) {
#pragma unroll
            for (int sl = 0; sl < 8; ++sl) { const bf16_t* qa = pd + ((size_t)sl * NTOK + tok[q]) * 128 + lane; pa[q][2 * sl] = bf2f(qa[0]); pa[q][2 * sl + 1] = bf2f(qa[64]); }
            e0[q] = idx[tok[q] * 128 + lane]; e1[q] = idx[tok[q] * 128 + 64 + lane]; g0[q] = gw[tok[q] * 128 + lane]; g1[q] = gw[tok[q] * 128 + 64 + lane];
            rs[q] = rowss[tok[q] * 32 + (lane & 31)]; }
        float v0[4], v1[4];
#pragma unroll
        for (int q = 0; q < 4; ++q) { v0[q] = svl[e0[q]]; v1[q] = svl[e1[q]]; }
#pragma unroll
        for (int q = 0; q < 4; ++q) {
            float ss = rs[q];
#pragma unroll
            for (int o = 1; o < 32; o <<= 1) ss += __shfl_xor(ss, o);
            const float rstd = 1.0f / sqrtf(ss * (1.0f / D) + RMS_EPS);
            float a0 = 0.f, a1 = 0.f;
#pragma unroll
            for (int sl = 0; sl < 8; ++sl) { a0 += pa[q][2 * sl]; a1 += pa[q][2 * sl + 1]; }
            if (tk + q * nwaves < NTOK) { wp[tok[q] * 128 + lane] = (bf16_t)f2bf(g0[q] * gelu_exact(a0 * rstd) * v0[q]); wp[tok[q] * 128 + 64 + lane] = (bf16_t)f2bf(g1[q] * gelu_exact(a1 * rstd) * v1[q]); }
        }
    }
}
DI void p8b_issue(HalfT& B, const unsigned char* tvv, const LAS unsigned short* eidx, const LAS bf16_t* wl, int tl, int step, int sl, int cc) {
#pragma unroll
    for (int j = 0; j < 8; ++j) { const int k = tl * 128 + step * 8 + j; const int e = eidx[k]; B.sc[j] = bf2f(wl[k]); B.rb[j] = *(const u32x4*)(tvv + (size_t)sl * (16384 * 128) + (size_t)e * 128 + cc * 16); }
}
DI void p8b_compute(const HalfT& B, f32x2 (&acc)[8]) {
#pragma unroll
    for (int g = 0; g < 8; ++g) { f32x2 f[8]; fp8x16_to_f32x2(B.rb[g], f); const f32x2 w2 = {B.sc[g], B.sc[g]};
#pragma unroll
        for (int i = 0; i < 8; ++i) acc[i] += w2 * f[i]; }
}
DI void phase8b(const Params& p, unsigned char* lds_raw_) {
    unsigned char* ws = p.ws;
    const int lane = threadIdx.x & 63, pp = lane >> 3, cc = lane & 7;
    const unsigned char* tvv = ws + WS_TABV;
    const unsigned short* idx = (const unsigned short*)(ws + WS_IDX); const bf16_t* wp = (const bf16_t*)(ws + WS_WPEER); float* ssp = (float*)(ws + WS_SS);
    unsigned* ctr = (unsigned*)(ws + WS_CTL) + 2048;
    LAS unsigned short* eidx = (LAS unsigned short*)((ldsp_t)lds_raw_ + __builtin_amdgcn_readfirstlane((int)(threadIdx.x >> 6)) * 16384);
    LAS bf16_t* wl = (LAS bf16_t*)(eidx + P8_CHUNK * 128);
    const unsigned xs = my_xcc();
#pragma unroll 1
    for (int k8 = 0; k8 < 8; ++k8) {
        const int sl = (int)((xs + k8) & 7u);
#pragma unroll 1
        for (;;) {
            unsigned tk = 0; if (lane == 0) tk = atomicAdd(ctr + 64 * sl, 1u);
            const int chunk = (int)__builtin_amdgcn_readfirstlane(tk);
            if (chunk >= P8_NCHUNK) break;
            const size_t tok0 = (size_t)chunk * P8_CHUNK;
#pragma unroll
            for (int i = 0; i < 4; ++i) { ((LAS i32x4*)eidx)[i * 64 + lane] = ((const i32x4*)(idx + tok0 * 128))[i * 64 + lane]; ((LAS i32x4*)wl)[i * 64 + lane] = ((const i32x4*)(wp + tok0 * 128))[i * 64 + lane]; }
            __builtin_amdgcn_wave_barrier();
#pragma unroll 1
            for (int grp = 0; grp < P8_CHUNK / 8; ++grp) {
                const int tl = grp * 8 + pp; const size_t tok = tok0 + tl;
                HalfT X, Y;
                p8b_issue(X, tvv, eidx, wl, tl, 0, sl, cc);
                const float* xo = p.out + tok * D + sl * 128 + cc * 16;
                f32x4 xv[4];
#pragma unroll
                for (int i = 0; i < 4; ++i) xv[i] = *(const f32x4*)(xo + 4 * i);
                f32x2 acc2[8];
#pragma unroll
                for (int i = 0; i < 8; ++i) acc2[i] = (f32x2){0.f, 0.f};
#pragma unroll 1
                for (int step = 0; step < 16; step += 2) {
                    p8b_issue(Y, tvv, eidx, wl, tl, step + 1, sl, cc);
                    p8b_compute(X, acc2);
                    if (step + 2 < 16) p8b_issue(X, tvv, eidx, wl, tl, step + 2, sl, cc);
                    p8b_compute(Y, acc2);
                }
                float v[16]; float ss = 0.f;
#pragma unroll
                for (int i = 0; i < 4; ++i) { v[4 * i] = xv[i].x + acc2[2 * i].x; v[4 * i + 1] = xv[i].y + acc2[2 * i].y; v[4 * i + 2] = xv[i].z + acc2[2 * i + 1].x; v[4 * i + 3] = xv[i].w + acc2[2 * i + 1].y; }
#pragma unroll
                for (int i = 0; i < 16; ++i) ss += v[i] * v[i];
                u32x4 o0, o1;
                o0.x = pk2(v[0], v[1]); o0.y = pk2(v[2], v[3]); o0.z = pk2(v[4], v[5]); o0.w = pk2(v[6], v[7]); o1.x = pk2(v[8], v[9]); o1.y = pk2(v[10], v[11]); o1.z = pk2(v[12], v[13]); o1.w = pk2(v[14], v[15]);
                bf16_t* x3 = (bf16_t*)(ws + WS_X3) + tok * D + sl * 128 + cc * 16;
                *(u32x4*)x3 = o0; *(u32x4*)(x3 + 8) = o1;
                ss += dpp_xor1(ss); ss += dpp_xor2(ss); ss += __shfl_xor(ss, 4);
                if (cc == 0) ssp[tok * 8 + sl] = ss;
            }
            __builtin_amdgcn_wave_barrier();
        }
    }
}
DI void phase8c(const Params& p) {
    unsigned char* ws = p.ws;
    const int lane = threadIdx.x & 63, wid = threadIdx.x >> 6;
    const int gwave = blockIdx.x * NWAVES + wid, nwaves = gridDim.x * NWAVES;
    const float* ssp = (const float*)(ws + WS_SS); const bf16_t* x3 = (const bf16_t*)(ws + WS_X3);
    f32x4 gg[4];
#pragma unroll
    for (int j = 0; j < 4; ++j) gg[j] = *(const f32x4*)(p.in[20] + (j >> 1) * 512 + lane * 8 + (j & 1) * 4);
    for (int tk = gwave; tk < NTOK; tk += 2 * nwaves) {
        const bool two = tk + nwaves < NTOK; const size_t tokA = (size_t)tk, tokB = (size_t)(two ? tk + nwaves : tk);
        const u32x4 a0 = *(const u32x4*)(x3 + tokA * D + lane * 8), a1 = *(const u32x4*)(x3 + tokA * D + 512 + lane * 8);
        const u32x4 b0 = *(const u32x4*)(x3 + tokB * D + lane * 8), b1 = *(const u32x4*)(x3 + tokB * D + 512 + lane * 8);
        const f32x4 sa0 = *(const f32x4*)(ssp + tokA * 8), sa1 = *(const f32x4*)(ssp + tokA * 8 + 4), sb0 = *(const f32x4*)(ssp + tokB * 8), sb1 = *(const f32x4*)(ssp + tokB * 8 + 4);
        const float rsa = 1.0f / sqrtf(((sa0.x + sa0.y) + (sa0.z + sa0.w) + (sa1.x + sa1.y) + (sa1.z + sa1.w)) * (1.0f / D) + RMS_EPS);
        const float rsb = 1.0f / sqrtf(((sb0.x + sb0.y) + (sb0.z + sb0.w) + (sb1.x + sb1.y) + (sb1.z + sb1.w)) * (1.0f / D) + RMS_EPS);
        float* oa = p.out + tokA * D + lane * 8; float* ob = p.out + tokB * D + lane * 8;
#define OUT8(O, W, RS, G0, G1) { f32x4 v0 = {bflo(W.x) * RS * G0.x, bfhi(W.x) * RS * G0.y, bflo(W.y) * RS * G0.z, bfhi(W.y) * RS * G0.w}; f32x4 v1 = {bflo(W.z) * RS * G1.x, bfhi(W.z) * RS * G1.y, bflo(W.w) * RS * G1.z, bfhi(W.w) * RS * G1.w}; *(f32x4*)(O) = v0; *(f32x4*)((O) + 4) = v1; }
        OUT8(oa, a0, rsa, gg[0], gg[1]) OUT8(oa + 512, a1, rsa, gg[2], gg[3])
        if (two) { OUT8(ob, b0, rsb, gg[0], gg[1]) OUT8(ob + 512, b1, rsb, gg[2], gg[3]) }
#undef OUT8
    }
}

#define XB_TMO      128
#define XB_XCNT(j)  (256  + 64 * (j))
#define XB_XSUB(j)  (1280 + 64 * (j))
#define XB_XGEN(j)  (2304 + 64 * (j))
#define XB_TOP      3328
#define XB_TOPGEN   3392
#define XCD_BAR_WORDS 3456
#define XB_SPIN_CAP (1u << 18)

__device__ __forceinline__ unsigned xb_ld(unsigned* p)              { return __hip_atomic_load(p, __ATOMIC_RELAXED, __HIP_MEMORY_SCOPE_AGENT); }
__device__ __forceinline__ unsigned xb_add(unsigned* p, unsigned v) { return __hip_atomic_fetch_add(p, v, __ATOMIC_RELAXED, __HIP_MEMORY_SCOPE_AGENT); }
__device__ __forceinline__ unsigned xb_xcc_id() { return (unsigned)__builtin_amdgcn_s_getreg((3 << 11) | 20) & 0xFu; }
#define XB_SPIN(cond, bar) do { unsigned _sp = 0; while (cond) { __builtin_amdgcn_s_sleep(1); \
    if ((++_sp & 255u) == 0u) { if (xb_ld(&(bar)[XB_TMO])) break; if (_sp > XB_SPIN_CAP) { atomicAdd(&(bar)[XB_TMO], 1u); break; } } } } while (0)

struct XcdBarrier {
    unsigned* bar; unsigned x;
    volatile unsigned* st;
};

__device__ __forceinline__ XcdBarrier xcd_barrier_post(unsigned* bar, volatile unsigned* st) {
    XcdBarrier b; b.bar = bar; b.x = xb_xcc_id(); b.st = st;
    if (threadIdx.x == 0) (void)xb_add(&bar[XB_XCNT(b.x)], 1u);
    return b;
}
__device__ __forceinline__ void xcd_barrier_complete(unsigned* bar, unsigned x, unsigned& nloc, unsigned& nx) {
    const unsigned G = gridDim.x * gridDim.y * gridDim.z;
    unsigned sum, cnt, mine, sp = 0u;
    for (;;) {
        sum = 0u; cnt = 0u; mine = 0u;
#pragma unroll
        for (unsigned j = 0; j < 16; ++j) { const unsigned c = xb_ld(&bar[XB_XCNT(j)]); sum += c; cnt += (c > 0u) ? 1u : 0u; mine = (j == x) ? c : mine; }
        if (sum == G) break;
        __builtin_amdgcn_s_sleep(1);
        if ((++sp & 255u) == 0u) { if (xb_ld(&bar[XB_TMO])) break; if (sp > XB_SPIN_CAP) { atomicAdd(&bar[XB_TMO], 1u); break; } }
    }
    nloc = mine > 0u ? mine : 1u; nx = cnt > 0u ? cnt : 1u;
}

__device__ __forceinline__ void xcd_barrier(const XcdBarrier& b) {
    asm volatile("s_waitcnt vmcnt(0)" ::: "memory");
    __syncthreads();
    if (threadIdx.x == 0) {
        unsigned* bar = b.bar;
        __builtin_amdgcn_s_waitcnt(0);
        unsigned nloc = b.st[0], nx = b.st[1];
        if (nloc == 0u) { xcd_barrier_complete(bar, b.x, nloc, nx); b.st[0] = nloc; b.st[1] = nx; }
        const unsigned old = xb_add(&bar[XB_XSUB(b.x)], 1u);
        const unsigned gen = old / nloc;
        if (old + 1u == (gen + 1u) * nloc) {
            __builtin_amdgcn_fence(__ATOMIC_RELEASE, "agent");
            asm volatile("s_waitcnt vmcnt(0)" ::: "memory");
            const unsigned og = xb_add(&bar[XB_TOP], 1u);
            const unsigned tg = og / nx;
            if (og + 1u == (tg + 1u) * nx) xb_add(&bar[XB_TOPGEN], 1u);
            else XB_SPIN(xb_ld(&bar[XB_TOPGEN]) == tg, bar);
            __builtin_amdgcn_fence(__ATOMIC_ACQUIRE, "agent");
            xb_add(&bar[XB_XGEN(b.x)], 1u);
            asm volatile("s_waitcnt vmcnt(0)" ::: "memory");
        } else {
            XB_SPIN(xb_ld(&bar[XB_XGEN(b.x)]) == gen, bar);
            __builtin_amdgcn_fence(__ATOMIC_ACQUIRE, "agent");
            asm volatile("s_waitcnt vmcnt(0)" ::: "memory");
        }
    }
    __syncthreads();
}

constexpr int N_PHASES = 13;
__global__ void __launch_bounds__(NTHREADS) mega(Params p) {
    extern __shared__ __attribute__((aligned(16))) unsigned char lds_raw[];
    bf16_t* lds = (bf16_t*)lds_raw;
#if N_LAUNCH_MODE == 1
    cg::grid_group grid = cg::this_grid();
    XcdBarrier xbar = xcd_barrier_post((unsigned*)(p.ws + WS_CTL) + 4096, (volatile unsigned*)(p.ws + WS_CTL) + 12288 + 2 * blockIdx.x);
    if (p.ph_lo == 0x7fffffff) grid.sync();
#define SEAM(k) do { if (p.ph_lo <= (k) && (k) + 1 < p.ph_hi) { xcd_barrier(xbar); } } while (0)
#else
#define SEAM(k) do { } while (0)
#endif
#ifndef PHASE_MASK
#define PHASE_MASK 0x1fff
#endif
#define IN(k) (((PHASE_MASK >> (k)) & 1) && p.ph_lo <= (k) && (k) < p.ph_hi)
    if (IN(0)) for (int rep = 0; rep < REP0; ++rep) phase0(p, lds_raw);
    SEAM(0);
    if (IN(1)) for (int rep = 0; rep < REP1; ++rep) phase1(p, lds);
    SEAM(1);
    if (IN(2)) for (int rep = 0; rep < REP2; ++rep) phase2(p, lds);
    SEAM(2);
    if (IN(3)) for (int rep = 0; rep < REP3; ++rep) phase3a(p, rep, lds);
    SEAM(3);
    if (IN(4)) for (int rep = 0; rep < REP4; ++rep) phase3b(p, rep, lds_raw);
    SEAM(4);
    if (IN(5)) for (int rep = 0; rep < REP5; ++rep) phase4(p, lds);
    SEAM(5);
    if (IN(6)) for (int rep = 0; rep < REP6; ++rep) phase5(p, lds);
    SEAM(6);
    if (IN(7)) for (int rep = 0; rep < REP7; ++rep) phase6(p, lds);
    SEAM(7);
    if (IN(8)) for (int rep = 0; rep < REP8; ++rep) { __syncthreads(); phase7(p, lds); }
    SEAM(8);
    if (IN(9)) for (int rep = 0; rep < REP9; ++rep) phase8a(p, lds_raw, rep);
    SEAM(9);
    if (IN(10)) for (int rep = 0; rep < REP10; ++rep) phase8w(p, lds_raw);
    SEAM(10);
    if (IN(11)) phase8b(p, lds_raw);
    SEAM(11);
    if (IN(12)) phase8c(p);
}

extern "C" void kernel_launch(void* const* d_in, const int* in_sizes, int n_in, void* d_out, int out_size, void* d_ws, size_t ws_size, hipStream_t stream) {
    static int grid = 0;
    if (grid == 0) {
        if (n_in != 21 || out_size != NTOK * D || ws_size < WS_END) { fprintf(stderr, "kernel_launch: unexpected shapes: n_in %d out %d ws %zu\n", n_in, out_size, ws_size); grid = -1; return; }
        int dev = 0, cus = 0, per_cu = 0;
        hipGetDevice(&dev);
        hipDeviceGetAttribute(&cus, hipDeviceAttributeMultiprocessorCount, dev);
        hipFuncSetAttribute((const void*)mega, hipFuncAttributeMaxDynamicSharedMemorySize, LDS_BYTES);
        hipOccupancyMaxActiveBlocksPerMultiprocessor(&per_cu, (const void*)mega, NTHREADS, LDS_BYTES);
        if (per_cu < 1) per_cu = 1;
        if (per_cu > 1) per_cu = 1;
        grid = cus * per_cu;
    }
    if (grid < 0) return;
    hipMemsetAsync((char*)d_ws + WS_CTL, 0, 65536, stream);
    Params p{};
    for (int i = 0; i < 21; ++i) p.in[i] = (const float*)d_in[i];
    p.out = (float*)d_out; p.ws = (unsigned char*)d_ws;
#if N_LAUNCH_MODE == 1
    p.ph_lo = 0; p.ph_hi = N_PHASES;
    void* args[] = {&p};
    hipError_t e = hipLaunchCooperativeKernel((const void*)mega, dim3(grid), dim3(NTHREADS), args, LDS_BYTES, stream);
    if (e != hipSuccess) fprintf(stderr, "cooperative launch failed: %s (grid %d)\n", hipGetErrorString(e), grid);
#else
    for (int ph = 0; ph < N_PHASES; ++ph) { p.ph_lo = ph; p.ph_hi = ph + 1; hipLaunchKernelGGL(mega, dim3(grid), dim3(NTHREADS), LDS_BYTES, stream, p); }
#endif
}
```

```cpp
#include <hip/hip_runtime.h>
#include <hip/hip_cooperative_groups.h>
#include <cstdio>
#include <cstdint>
namespace cg = cooperative_groups;

#ifndef N_LAUNCH_MODE
#define N_LAUNCH_MODE 1
#endif

#define REP0 1
#define REP1 1
#define REP2 1
#define REP3 1
#define REP4 1
#define REP5 1
#define REP6 1
#define REP7 1
#define REP8 1
#define REP9 1
#define REP10 1

typedef unsigned short bf16_t;
typedef short bf16x8 __attribute__((ext_vector_type(8)));
typedef short s16x4 __attribute__((ext_vector_type(4)));
typedef float f32x2 __attribute__((ext_vector_type(2)));
typedef float f32x4 __attribute__((ext_vector_type(4)));
typedef float f32x16 __attribute__((ext_vector_type(16)));
typedef unsigned u32x2 __attribute__((ext_vector_type(2)));
typedef unsigned u32x4 __attribute__((ext_vector_type(4)));
typedef int i32x4 __attribute__((ext_vector_type(4)));
typedef __bf16 bf16x2_t __attribute__((ext_vector_type(2)));
#define DI __device__ __forceinline__
#define LAS __attribute__((address_space(3)))

constexpr int NB = 8, T = 4096, D = 1024, NTOK = NB * T;
constexpr int MEMT = 256;
constexpr int NTHREADS = 512, NWAVES = 8;
constexpr int LDP_QKV = 2560;
constexpr int C_SBQ = 0, C_SBK = 384, C_SBV = 768, C_NQ = 1152, C_NKV = 1536, C_MQ = 2304;
constexpr int LDG = 3072;
constexpr int NPROJ = 5888;
constexpr int IN_DIM = 5650;
constexpr float RMS_EPS = 1e-6f;
constexpr float LOG2E = 1.4426950408889634f, LN2 = 0.6931471805599453f;

constexpr size_t MiB = 1u << 20;
constexpr size_t WS_CTL = 0;
constexpr size_t WS_WIN = 1 * MiB;
constexpr size_t WS_WQ = WS_WIN + 12 * MiB;
constexpr size_t WS_WOUT = WS_WQ + 4 * MiB;
constexpr size_t WS_WSB = WS_WOUT + 2 * MiB;
constexpr size_t WS_WNSA = WS_WSB + 1 * MiB;
constexpr size_t WS_WMEM = WS_WNSA + 1 * MiB;
constexpr size_t WS_WMKV = WS_WMEM + 1 * MiB;
constexpr size_t WS_SUBK = WS_WMKV + 1 * MiB;
constexpr size_t WS_CMPW = WS_SUBK + MiB / 2;
constexpr size_t WS_H = 24 * MiB;
constexpr size_t WS_QKV = 88 * MiB;
constexpr size_t WS_MERGED = WS_QKV;
constexpr size_t WS_IDX = WS_QKV + 64 * MiB;
constexpr size_t WS_GW = WS_QKV + 80 * MiB;
constexpr size_t WS_ROWSS = WS_QKV + 96 * MiB;
constexpr size_t WS_GATES = 248 * MiB;
constexpr size_t WS_H2 = WS_GATES;
constexpr size_t WS_QP = WS_GATES + 64 * MiB;
constexpr size_t WS_TABU = 440 * MiB;
constexpr size_t WS_TABV = 456 * MiB;
constexpr size_t WS_PD = WS_GATES + 64 * MiB;
constexpr size_t WS_WPEER = WS_QKV;
constexpr size_t WS_SS = WS_QKV + 32 * MiB;
constexpr size_t WS_X3 = WS_H2;
constexpr size_t WS_H8 = 344 * MiB;
constexpr size_t WS_HSC = 376 * MiB;
constexpr size_t WS_W8 = 377 * MiB;
constexpr size_t WS_W8SC = 384 * MiB;
constexpr size_t WS_WMKV8 = 385 * MiB;
constexpr size_t WS_MEMN8 = 387 * MiB;
constexpr size_t WS_TSCALE = 472 * MiB;
constexpr size_t WS_END = 504 * MiB;
constexpr size_t DO_VSLC = 0;
constexpr size_t DO_VWIN = 8 * MiB;
constexpr size_t DO_SBV = 16 * MiB;
constexpr size_t DO_KC = 40 * MiB;
constexpr size_t DO_VCT = 41 * MiB;
constexpr size_t DO_MEMN = 42 * MiB;
constexpr size_t DO_MKV = 46 * MiB;
constexpr size_t DO_MVT = 48 * MiB;
constexpr size_t DO_NSAG = 50 * MiB;
constexpr size_t DO_SELM = 54 * MiB;
constexpr size_t DO_OC = 56 * MiB;
constexpr size_t DO_KSLC = 80 * MiB;
constexpr size_t DO_KWIN = 88 * MiB;
constexpr size_t DO_MKT = 120 * MiB;
constexpr size_t DO_SBK = 96 * MiB;

constexpr int LDS_MAIN = 131072;
constexpr int LDS_BYTES = 163840;

struct Params {
    const float* in[21];
    float* out;
    unsigned char* ws;
    int ph_lo, ph_hi;
};

DI unsigned f2bf(float f) { unsigned u = __float_as_uint(f); return (u + 0x7fffu + ((u >> 16) & 1u)) >> 16; }
DI unsigned pk2(float lo, float hi) { f32x2 v = {lo, hi}; bf16x2_t b = __builtin_convertvector(v, bf16x2_t); return __builtin_bit_cast(unsigned, b); }
DI float bf2f(unsigned short h) { return __uint_as_float((unsigned)h << 16); }
DI float bflo(unsigned w) { return __uint_as_float(w << 16); }
DI float bfhi(unsigned w) { return __uint_as_float(w & 0xffff0000u); }
DI float wave_sum(float v) {
#pragma unroll
    for (int o = 1; o < 64; o <<= 1) v += __shfl_xor(v, o);
    return v;
}
DI float fexp2(float x) { return __builtin_amdgcn_exp2f(x); }
DI float flog2(float x) { return __builtin_amdgcn_logf(x); }
DI float fexp(float x) { return __builtin_amdgcn_exp2f(x * LOG2E); }
DI float sigmoidf_(float x) { return 1.0f / (1.0f + fexp(-x)); }
DI int krow(int r, int hi) { return (r & 3) + 8 * (r >> 2) + 4 * hi; }
#define MFMA32(a, b, c) __builtin_amdgcn_mfma_f32_32x32x16_bf16((a), (b), (c), 0, 0, 0)
#define MFMA16(a, b, c) __builtin_amdgcn_mfma_f32_16x16x32_bf16((a), (b), (c), 0, 0, 0)

DI void zero16(f32x16& v) {
#pragma unroll
    for (int i = 0; i < 16; ++i) v[i] = 0.f;
}
DI unsigned pack_i8x4(float a, float b, float c, float d) {
    const int ia = (int)__builtin_rintf(a), ib = (int)__builtin_rintf(b), ic = (int)__builtin_rintf(c), id = (int)__builtin_rintf(d);
    return ((unsigned)ia & 0xffu) | (((unsigned)ib & 0xffu) << 8) | (((unsigned)ic & 0xffu) << 16) | ((unsigned)id << 24);
}
DI float wave_max(float v) {
#pragma unroll
    for (int o = 1; o < 64; o <<= 1) v = fmaxf(v, __shfl_xor(v, o));
    return v;
}
DI void rms_row_i8(const float* xrow, const float* g, unsigned* o8row, float* scale, int lane) {
    const f32x4* xr = (const f32x4*)xrow + lane;
    const f32x4* gr = (const f32x4*)g + lane;
    f32x4 v[4]; float s = 0.f;
#pragma unroll
    for (int j = 0; j < 4; ++j) { v[j] = xr[64 * j]; s += (v[j].x * v[j].x + v[j].y * v[j].y) + (v[j].z * v[j].z + v[j].w * v[j].w); }
    const float rstd = 1.0f / sqrtf(wave_sum(s) * (1.0f / D) + RMS_EPS);
    float am = 0.f;
#pragma unroll
    for (int j = 0; j < 4; ++j) { const f32x4 gg = gr[64 * j]; v[j].x *= rstd * gg.x; v[j].y *= rstd * gg.y; v[j].z *= rstd * gg.z; v[j].w *= rstd * gg.w;
        am = fmaxf(am, fmaxf(fmaxf(fabsf(v[j].x), fabsf(v[j].y)), fmaxf(fabsf(v[j].z), fabsf(v[j].w)))); }
    am = wave_max(am);
    const float qs = am > 0.f ? 127.0f / am : 0.f;
#pragma unroll
    for (int j = 0; j < 4; ++j) o8row[lane + 64 * j] = pack_i8x4(v[j].x * qs, v[j].y * qs, v[j].z * qs, v[j].w * qs);
    if (lane == 0) scale[0] = am * (1.0f / 127.0f);
}
template <bool MAP> DI void quant_cols_i8(const float* W, int ldw, int ncol, unsigned char* dst8, float* dsc, float* red) {
    const int c = threadIdx.x & 15, kg = threadIdx.x >> 4;
    for (int cb = blockIdx.x; cb < ncol / 16; cb += gridDim.x) {
        const int col = cb * 16 + c; int srcc = col;
        if (MAP) { if (col < 2304) srcc = col; else if (col < 2560) srcc = 2322 + (col - 2304); else if (col < 5632) srcc = 2578 + (col - 2560); else if (col < 5650) srcc = 2304 + (col - 5632); else srcc = -1; }
        const float* src = W + (size_t)(kg * 32) * ldw + (srcc < 0 ? 0 : srcc);
        float v[32]; float am = 0.f;
#pragma unroll
        for (int i = 0; i < 32; ++i) { v[i] = srcc < 0 ? 0.f : src[(size_t)i * ldw]; am = fmaxf(am, fabsf(v[i])); }
        __syncthreads();
        red[kg * 16 + c] = am;
        __syncthreads();
#pragma unroll
        for (int i = 0; i < 32; ++i) am = fmaxf(am, red[i * 16 + c]);
        const float qs = am > 0.f ? 127.0f / am : 0.f;
        u32x4 w0, w1;
        w0.x = pack_i8x4(v[0] * qs, v[1] * qs, v[2] * qs, v[3] * qs); w0.y = pack_i8x4(v[4] * qs, v[5] * qs, v[6] * qs, v[7] * qs); w0.z = pack_i8x4(v[8] * qs, v[9] * qs, v[10] * qs, v[11] * qs); w0.w = pack_i8x4(v[12] * qs, v[13] * qs, v[14] * qs, v[15] * qs);
        w1.x = pack_i8x4(v[16] * qs, v[17] * qs, v[18] * qs, v[19] * qs); w1.y = pack_i8x4(v[20] * qs, v[21] * qs, v[22] * qs, v[23] * qs); w1.z = pack_i8x4(v[24] * qs, v[25] * qs, v[26] * qs, v[27] * qs); w1.w = pack_i8x4(v[28] * qs, v[29] * qs, v[30] * qs, v[31] * qs);
        u32x4* dst = (u32x4*)(dst8 + (size_t)col * 1024 + kg * 32); dst[0] = w0; dst[1] = w1;
        if (kg == 0) dsc[col] = am * (1.0f / 127.0f);
    }
}
DI void rms_row_bf16(const float* xrow, const float* g, bf16_t* orow, int lane) {
    const f32x4* xr = (const f32x4*)xrow + lane;
    const f32x4* gr = (const f32x4*)g + lane;
    f32x4 v[4]; float s = 0.f;
#pragma unroll
    for (int j = 0; j < 4; ++j) { v[j] = xr[64 * j]; s += (v[j].x * v[j].x + v[j].y * v[j].y) + (v[j].z * v[j].z + v[j].w * v[j].w); }
    const float rstd = 1.0f / sqrtf(wave_sum(s) * (1.0f / D) + RMS_EPS);
    u32x2* o8 = (u32x2*)orow + lane;
#pragma unroll
    for (int j = 0; j < 4; ++j) { const f32x4 gg = gr[64 * j]; u32x2 w; w.x = pk2(v[j].x * rstd * gg.x, v[j].y * rstd * gg.y); w.y = pk2(v[j].z * rstd * gg.z, v[j].w * rstd * gg.w); o8[64 * j] = w; }
}
DI void transpose_w(const float* W, int K, int N, bf16_t* Wt, int gtid, int gthreads, float sc = 1.0f) {
    const int total = (K / 8) * N;
    for (int it = gtid; it < total; it += gthreads) {
        const int n = it % N, k8 = it / N;
        const float* s = W + (size_t)(k8 * 8) * N + n;
        u32x4 o; o.x = pk2(s[0] * sc, s[(size_t)N] * sc); o.y = pk2(s[(size_t)2 * N] * sc, s[(size_t)3 * N] * sc); o.z = pk2(s[(size_t)4 * N] * sc, s[(size_t)5 * N] * sc); o.w = pk2(s[(size_t)6 * N] * sc, s[(size_t)7 * N] * sc);
        *(u32x4*)(Wt + (size_t)n * K + k8 * 8) = o;
    }
}
DI void late_weights(const Params& p, int gtid, int gthreads) {
    unsigned char* ws = p.ws;
    transpose_w(p.in[16], D, 2048, (bf16_t*)(ws + WS_WQ), gtid, gthreads);
    transpose_w(p.in[14], D, D, (bf16_t*)(ws + WS_WOUT), gtid, gthreads);
    transpose_w(p.in[11], 384, D, (bf16_t*)(ws + WS_WSB), gtid, gthreads, 1.0f / 255.0f);
    transpose_w(p.in[12], 384, D, (bf16_t*)(ws + WS_WNSA), gtid, gthreads, 1.0f / 255.0f);
    transpose_w(p.in[13], 256, D, (bf16_t*)(ws + WS_WMEM), gtid, gthreads, 1.0f / 255.0f);
    transpose_w(p.in[8], 2048, 64, (bf16_t*)(ws + WS_CMPW), gtid, gthreads);
    transpose_w(p.in[9], 2048, 64, (bf16_t*)(ws + WS_CMPW) + 64 * 2048, gtid, gthreads);
    {
        const f32x4* s = (const f32x4*)p.in[17]; u32x2* o = (u32x2*)(ws + WS_SUBK);
        for (int i = gtid; i < 8 * 2 * 128 * 128 / 4; i += gthreads) { const f32x4 v = s[i]; u32x2 w; w.x = pk2(v.x, v.y); w.y = pk2(v.z, v.w); o[i] = w; }
    }
}
DI void phase0(const Params& p, unsigned char* lds_raw_) {
    const int gtid = blockIdx.x * NTHREADS + threadIdx.x, gthreads = gridDim.x * NTHREADS;
    const int lane = threadIdx.x & 63, gwave = gtid >> 6, nwaves = gthreads >> 6;
    unsigned char* ws = p.ws;
    quant_cols_i8<true>(p.in[4], IN_DIM, NPROJ, ws + WS_W8, (float*)(ws + WS_W8SC), (float*)lds_raw_);
    quant_cols_i8<false>(p.in[10], 512, 512, ws + WS_WMKV8, (float*)(ws + WS_WMKV8 + MiB), (float*)lds_raw_);
    for (int row = gwave; row < NTOK; row += nwaves) rms_row_i8(p.in[0] + (size_t)row * D, p.in[2], (unsigned*)(ws + WS_H8) + (size_t)row * (D / 4), (float*)(ws + WS_HSC) + row, lane);
    for (int row = gwave; row < NB * MEMT; row += nwaves) rms_row_i8(p.in[1] + (size_t)row * D, p.in[3], (unsigned*)(ws + WS_MEMN8) + (size_t)row * (D / 4), (float*)(ws + WS_MEMN8 + 2 * MiB) + row, lane);
}
DI void peer_table_rows(const Params& p, int lane, int first, int stride) {
    unsigned char* ws = p.ws;
    unsigned char* tabu = ws + WS_TABU; unsigned char* tabv = ws + WS_TABV; float* tsc = (float*)(ws + WS_TSCALE);
#pragma unroll 1
    for (int row0 = first; row0 < 32768; row0 += 4 * stride) {
        f32x4 v[4][4];
#pragma unroll
        for (int q = 0; q < 4; ++q) { const int row = row0 + q * stride < 32768 ? row0 + q * stride : row0; const bool isv = row >= 16384; const int e = row & 16383;
            const f32x4* src = (const f32x4*)((isv ? p.in[19] : p.in[18]) + (size_t)e * 1024 + lane * 16);
#pragma unroll
            for (int j = 0; j < 4; ++j) v[q][j] = src[j]; }
#pragma unroll
        for (int q = 0; q < 4; ++q) { const int row = row0 + q * stride; const bool isv = row >= 16384; const int e = row & 16383;
            float am = 0.f;
#pragma unroll
            for (int j = 0; j < 4; ++j) am = fmaxf(am, fmaxf(fmaxf(fabsf(v[q][j].x), fabsf(v[q][j].y)), fmaxf(fabsf(v[q][j].z), fabsf(v[q][j].w))));
#pragma unroll
            for (int o = 1; o < 64; o <<= 1) am = fmaxf(am, __shfl_xor(am, o));
            const float top = 127.0f;
            const float sc = am > 0.f ? top / am : 1.0f;
            u32x4 w;
#pragma unroll
            for (int j = 0; j < 4; ++j) w[j] = pack_i8x4(v[q][j].x * sc, v[q][j].y * sc, v[q][j].z * sc, v[q][j].w * sc);
            if (row < 32768) { *(u32x4*)((isv ? tabv : tabu) + (size_t)(lane >> 3) * (16384 * 128) + (size_t)e * 128 + (lane & 7) * 16) = w;
                if (lane == 0) tsc[row] = am > 0.f ? am / top : 1.0f; }
        }
    }
}

constexpr int GEMM_LDS_ROW = 72;
constexpr int GEMM_TILE_ELEMS = 128 * GEMM_LDS_ROW;
DI void gemm_mainloop(const bf16_t* __restrict__ Ag, int lda, const bf16_t* __restrict__ Bg, int ldb, int K, f32x4 (&acc)[4][2], bf16_t* lds) {
    const int tid = threadIdx.x, lane = tid & 63, wid = tid >> 6, wr = wid >> 2, wc = wid & 3;
    const int r0 = tid >> 3, kc = tid & 7;
    const bf16_t* ap0 = Ag + (size_t)r0 * lda + kc * 8; const bf16_t* ap1 = ap0 + (size_t)64 * lda;
    const bf16_t* bp0 = Bg + (size_t)r0 * ldb + kc * 8; const bf16_t* bp1 = bp0 + (size_t)64 * ldb;
    const int so0 = r0 * GEMM_LDS_ROW + kc * 8, so1 = so0 + 64 * GEMM_LDS_ROW;
    u32x4 ra0, ra1, rb0, rb1;
    ra0 = *(const u32x4*)ap0; ra1 = *(const u32x4*)ap1; rb0 = *(const u32x4*)bp0; rb1 = *(const u32x4*)bp1;
    __syncthreads();
    {
        bf16_t* As = lds; bf16_t* Bs = lds + GEMM_TILE_ELEMS;
        *(u32x4*)(As + so0) = ra0; *(u32x4*)(As + so1) = ra1; *(u32x4*)(Bs + so0) = rb0; *(u32x4*)(Bs + so1) = rb1;
    }
    __syncthreads();
    const int nk = K / 64;
    const int fr = lane & 15, fq = lane >> 4;
    for (int kt = 0; kt < nk; ++kt) {
        const int buf = kt & 1;
        if (kt + 1 < nk) { const int ko = (kt + 1) * 64; ra0 = *(const u32x4*)(ap0 + ko); ra1 = *(const u32x4*)(ap1 + ko); rb0 = *(const u32x4*)(bp0 + ko); rb1 = *(const u32x4*)(bp1 + ko); }
        const bf16_t* As = lds + buf * 2 * GEMM_TILE_ELEMS; const bf16_t* Bs = As + GEMM_TILE_ELEMS;
#pragma unroll
        for (int kk = 0; kk < 2; ++kk) {
            bf16x8 af[4], bfr[2];
#pragma unroll
            for (int m = 0; m < 4; ++m) af[m] = *(const bf16x8*)(As + (wr * 64 + m * 16 + fr) * GEMM_LDS_ROW + kk * 32 + fq * 8);
#pragma unroll
            for (int n = 0; n < 2; ++n) bfr[n] = *(const bf16x8*)(Bs + (wc * 32 + n * 16 + fr) * GEMM_LDS_ROW + kk * 32 + fq * 8);
#pragma unroll
            for (int m = 0; m < 4; ++m)
#pragma unroll
                for (int n = 0; n < 2; ++n) acc[m][n] = MFMA16(bfr[n], af[m], acc[m][n]);
        }
        if (kt + 1 < nk) {
            bf16_t* An = lds + (buf ^ 1) * 2 * GEMM_TILE_ELEMS; bf16_t* Bn = An + GEMM_TILE_ELEMS;
            *(u32x4*)(An + so0) = ra0; *(u32x4*)(An + so1) = ra1; *(u32x4*)(Bn + so0) = rb0; *(u32x4*)(Bn + so1) = rb1;
        }
        __syncthreads();
    }
}
DI void zero_acc(f32x4 (&acc)[4][2]) {
#pragma unroll
    for (int m = 0; m < 4; ++m)
#pragma unroll
        for (int n = 0; n < 2; ++n) acc[m][n] = (f32x4){0.f, 0.f, 0.f, 0.f};
}
DI void tile_coords(int tile, int ntn, int& pm, int& pn) { const int per = 8 * ntn, g = tile / per, r = tile % per; pm = g * 8 + (r & 7); pn = r >> 3; }
DI void store_bf16x4(bf16_t* p, f32x4 v) { u32x2 w; w.x = pk2(v.x, v.y); w.y = pk2(v.z, v.w); *(u32x2*)p = w; }

namespace pg8 {
#define PG8_LAS __attribute__((address_space(3)))
typedef short bf16x8 __attribute__((ext_vector_type(8)));
typedef float f32x4 __attribute__((ext_vector_type(4)));
typedef unsigned u32x4 __attribute__((ext_vector_type(4)));
typedef int i32x4v __attribute__((ext_vector_type(4)));
constexpr int BM = 256, BK = 64, HALF = 128, HTB = HALF * BK * 2  , STAGE_BYTES = 8 * HTB, NXCD = 8, WGM = 8;

__host__ __device__ __forceinline__ int lds_byte(int r, int c) { const int st = (r >> 4) * 2 + (c >> 5), rr = r & 15, cc = c & 31, ob = rr * 64 + cc * 2; return st * 1024 + (ob ^ (((ob >> 9) & 1) << 5)); }
__host__ __device__ __forceinline__ void stage_rc(int b, int& R, int& C) { const int st = b / 1024, sb = b % 1024, swz = sb ^ (((sb >> 9) & 1) << 5); R = (st >> 1) * 16 + swz / 64; C = (st & 1) * 32 + (swz % 64) / 2; }
__host__ __device__ __forceinline__ int perm32(int rho) { const int n = rho >> 4, i = rho & 15; return 8 * (i >> 2) + 4 * n + (i & 3); }

struct Unit { int pm, pn; };
struct Gemm { const bf16_t* A; const bf16_t* Bt; int M, N, K, lda, ldb; };

struct StaticOrder {
    int nM, nN, nwg, G, c;
    __host__ __device__ void init(int M, int N, int G_, int c_) { nM = M / BM; nN = N / BM; nwg = nM * nN; G = G_; c = c_; }
    __host__ __device__ bool next(int i, Unit& u) const {
        const long L = (long)i * G + c; if (L >= nwg) return false;
        int wgid = (int)L; { const int q = nwg / NXCD, r = nwg % NXCD, xcd = wgid % NXCD, off = wgid / NXCD; wgid = (xcd < r ? xcd * (q + 1) : r * (q + 1) + (xcd - r) * q) + off; }
        const int nig = WGM * nN, gid = wgid / nig, fm = gid * WGM, gsz = (nM - fm) < WGM ? (nM - fm) : WGM;
        u.pm = fm + ((wgid % nig) % gsz); u.pn = (wgid % nig) / gsz; return true;
    }
    __device__ __forceinline__ void a_ready(const Unit&) const {}
    __device__ __forceinline__ void done(const Unit&) const {}
};


template <class Epi, class Sched, bool ALIGN_EPI = false, bool SP2 = false, bool I8 = false>
__device__ __forceinline__ void gemm_phase(PG8_LAS unsigned char* lds, const Gemm g, const Sched& S, const Epi& E) {
    const int tid = threadIdx.x, wid = __builtin_amdgcn_readfirstlane(tid >> 6), lane = tid & 63, wr = wid >> 2, wc = wid & 3, fr = lane & 15, fq = lane >> 4;
    const int K = g.K, nt = K / BK;
    unsigned voffA[2], voffB[2];
#pragma unroll
    for (int i = 0; i < 2; ++i) { int R, C; stage_rc(tid * 16 + i * 8192, R, C); const int Rb = Epi::PERM ? ((R & ~31) + perm32(R & 31)) : R;
        voffA[i] = (unsigned)(R * g.lda + C) * 2u; voffB[i] = (unsigned)(Rb * g.ldb + C) * 2u; }
    const size_t kstep = (size_t)(BK * 2);
    const size_t hstepA = (size_t)HALF * g.lda * 2, hstepB = (size_t)HALF * g.ldb * 2;
    const size_t tstepA = 2 * hstepA, tstepB = 2 * hstepB;
    const unsigned ldsw = (unsigned)wid * 1024u;
    const int aoff = lds_byte(wr * 64 + fr, fq * 8), boff = lds_byte(wc * 32 + fr, fq * 8);
#define PG8_SA(b, h) (((b) * 2 + (h)) * HTB)
#define PG8_SB(b, h) ((4 + (b) * 2 + (h)) * HTB)
#define PG8_STAGE(bufoff, gbase, voff) do { _Pragma("unroll") for (int _i = 0; _i < 2; ++_i) \
        __builtin_amdgcn_global_load_lds((const unsigned*)((const char*)(gbase) + (voff)[_i]), (PG8_LAS unsigned*)(lds + (bufoff) + ldsw + _i * 8192), 16, 0, 0); } while (0)
#define PG8_LDA(dst, b, h) do { _Pragma("unroll") for (int m = 0; m < 4; ++m) _Pragma("unroll") for (int k = 0; k < 2; ++k) dst[m][k] = *(const PG8_LAS bf16x8*)(lds + PG8_SA(b, h) + aoff + m * 2048 + k * 1024); } while (0)
#define PG8_LDB(dst, b, h) do { _Pragma("unroll") for (int n = 0; n < 2; ++n) _Pragma("unroll") for (int k = 0; k < 2; ++k) dst[n][k] = *(const PG8_LAS bf16x8*)(lds + PG8_SB(b, h) + boff + n * 2048 + k * 1024); } while (0)
#define PG8_MMA(ai, bj, At, Bt) do { __builtin_amdgcn_s_setprio(1); _Pragma("unroll") for (int m = 0; m < 4; ++m) _Pragma("unroll") for (int n = 0; n < 2; ++n) _Pragma("unroll") for (int k = 0; k < 2; ++k) \
        { if constexpr (I8) acc[ai][bj][m][n] = __builtin_bit_cast(f32x4, __builtin_amdgcn_mfma_i32_16x16x64_i8(__builtin_bit_cast(i32x4v, Bt[n][k]), __builtin_bit_cast(i32x4v, At[m][k]), __builtin_bit_cast(i32x4v, acc[ai][bj][m][n]), 0, 0, 0)); \
          else acc[ai][bj][m][n] = __builtin_amdgcn_mfma_f32_16x16x32_bf16(Bt[n][k], At[m][k], acc[ai][bj][m][n], 0, 0, 0); } __builtin_amdgcn_s_setprio(0); } while (0)
#define PG8_WAIT_V(n) asm volatile("s_waitcnt vmcnt(" #n ")" ::: "memory")
#define PG8_WAIT_L(n) asm volatile("s_waitcnt lgkmcnt(" #n ")" ::: "memory")
#define PG8_BAR __builtin_amdgcn_s_barrier()
#define PG8_SCHED __builtin_amdgcn_sched_barrier(0)
    Unit cur, nxt; int ui = 0;
    if (!S.next(0, cur)) return;
    f32x4 acc[2][2][4][2];
    if constexpr (Epi::INIT) E.init(acc, cur, wr, wc, fr, fq);
    else {
#pragma unroll
    for (int a = 0; a < 2; ++a)
#pragma unroll
        for (int b = 0; b < 2; ++b)
#pragma unroll
            for (int m = 0; m < 4; ++m)
#pragma unroll
                for (int n = 0; n < 2; ++n) acc[a][b][m][n] = (f32x4){0.f, 0.f, 0.f, 0.f};
    }
    bf16x8 At[4][2], B0[2][2], B1[2][2];
    const char* cA = (const char*)g.A + (size_t)cur.pm * tstepA; const char* cB = (const char*)g.Bt + (size_t)cur.pn * tstepB;
    S.a_ready(cur);
    if constexpr (SP2) {
        PG8_STAGE(PG8_SB(0, 0), cB, voffB); PG8_STAGE(PG8_SB(0, 1), cB + hstepB, voffB); PG8_STAGE(PG8_SA(0, 0), cA, voffA); PG8_STAGE(PG8_SA(0, 1), cA + hstepA, voffA);
        if (wr == 1) PG8_BAR;
        PG8_WAIT_V(2); PG8_BAR;
        PG8_STAGE(PG8_SB(1, 0), cB + kstep, voffB); PG8_STAGE(PG8_SA(1, 0), cA + kstep, voffA); PG8_STAGE(PG8_SB(1, 1), cB + hstepB + kstep, voffB);
        PG8_WAIT_V(6); PG8_BAR;
    } else {
        PG8_STAGE(PG8_SB(0, 0), cB, voffB); PG8_STAGE(PG8_SA(0, 0), cA, voffA); PG8_STAGE(PG8_SB(0, 1), cB + hstepB, voffB); PG8_STAGE(PG8_SA(0, 1), cA + hstepA, voffA);
        if (wr == 1) PG8_BAR;
        PG8_WAIT_V(4); PG8_BAR;
        PG8_STAGE(PG8_SB(1, 0), cB + kstep, voffB); PG8_STAGE(PG8_SA(1, 0), cA + kstep, voffA); PG8_STAGE(PG8_SB(1, 1), cB + hstepB + kstep, voffB);
        PG8_WAIT_V(6); PG8_BAR;
    }
    for (;;) {
        const bool has_next = S.next(ui + 1, nxt);
        const char* nA = has_next ? (const char*)g.A + (size_t)nxt.pm * tstepA : cA; const char* nB = has_next ? (const char*)g.Bt + (size_t)nxt.pn * tstepB : cB;
        for (int t = 0; t < nt; t += 2) {
            const bool last = (t == nt - 2);
            const char* a1 = cA + (size_t)(t + 1) * kstep;
            const char* a2 = last ? nA : cA + (size_t)(t + 2) * kstep; const char* b2 = last ? nB : cB + (size_t)(t + 2) * kstep;
            const char* a3 = a2 + kstep; const char* b3 = b2 + kstep;
            if (last && has_next) S.a_ready(nxt);
            if constexpr (SP2) {
            PG8_LDB(B0, 0, 0); PG8_LDB(B1, 0, 1); PG8_SCHED; PG8_LDA(At, 0, 0); PG8_STAGE(PG8_SA(1, 1), a1 + hstepA, voffA);
            PG8_WAIT_V(8); PG8_WAIT_L(0); PG8_BAR; PG8_MMA(0, 0, At, B0); PG8_MMA(0, 1, At, B1); PG8_BAR; PG8_SCHED;
            PG8_LDA(At, 0, 1); PG8_STAGE(PG8_SB(0, 0), b2, voffB); PG8_STAGE(PG8_SB(0, 1), b2 + hstepB, voffB); PG8_STAGE(PG8_SA(0, 0), a2, voffA);
            PG8_WAIT_V(8); PG8_WAIT_L(0); PG8_BAR; PG8_MMA(1, 0, At, B0); PG8_MMA(1, 1, At, B1); PG8_BAR; PG8_SCHED;
            PG8_LDB(B0, 1, 0); PG8_LDB(B1, 1, 1); PG8_SCHED; PG8_LDA(At, 1, 0); PG8_STAGE(PG8_SA(0, 1), a2 + hstepA, voffA);
            PG8_WAIT_V(8); PG8_WAIT_L(0); PG8_BAR; PG8_MMA(0, 0, At, B0); PG8_MMA(0, 1, At, B1); PG8_BAR; PG8_SCHED;
            PG8_LDA(At, 1, 1); PG8_STAGE(PG8_SB(1, 0), b3, voffB); PG8_STAGE(PG8_SB(1, 1), b3 + hstepB, voffB); PG8_STAGE(PG8_SA(1, 0), a3, voffA);
            PG8_WAIT_V(8); PG8_WAIT_L(0); PG8_BAR; PG8_MMA(1, 0, At, B0); PG8_MMA(1, 1, At, B1); PG8_BAR; PG8_SCHED;
            } else {
            PG8_LDB(B0, 0, 0); PG8_SCHED; PG8_LDA(At, 0, 0); PG8_STAGE(PG8_SA(1, 1), a1 + hstepA, voffA);
            PG8_WAIT_L(8); PG8_BAR; PG8_WAIT_L(0); PG8_MMA(0, 0, At, B0); PG8_BAR; PG8_SCHED;
            PG8_LDB(B1, 0, 1); PG8_STAGE(PG8_SB(0, 0), b2, voffB);
            PG8_BAR; PG8_WAIT_L(0); PG8_MMA(0, 1, At, B1); PG8_BAR;
            PG8_LDA(At, 0, 1); PG8_STAGE(PG8_SA(0, 0), a2, voffA);
            PG8_BAR; PG8_WAIT_L(0); PG8_MMA(1, 0, At, B0); PG8_BAR; PG8_SCHED;
            PG8_STAGE(PG8_SB(0, 1), b2 + hstepB, voffB);
            PG8_WAIT_V(6); PG8_BAR; PG8_MMA(1, 1, At, B1); PG8_BAR;
            PG8_LDB(B0, 1, 0); PG8_SCHED; PG8_LDA(At, 1, 0); PG8_STAGE(PG8_SA(0, 1), a2 + hstepA, voffA);
            PG8_WAIT_L(8); PG8_BAR; PG8_WAIT_L(0); PG8_MMA(0, 0, At, B0); PG8_BAR; PG8_SCHED;
            PG8_LDB(B1, 1, 1); PG8_STAGE(PG8_SB(1, 0), b3, voffB);
            PG8_BAR; PG8_WAIT_L(0); PG8_MMA(0, 1, At, B1); PG8_BAR;
            PG8_LDA(At, 1, 1); PG8_STAGE(PG8_SA(1, 0), a3, voffA);
            PG8_BAR; PG8_WAIT_L(0); PG8_MMA(1, 0, At, B0); PG8_BAR; PG8_SCHED;
            PG8_STAGE(PG8_SB(1, 1), b3 + hstepB, voffB);
            PG8_WAIT_V(6); PG8_BAR; PG8_MMA(1, 1, At, B1); PG8_BAR;
            }
        }
        if constexpr (ALIGN_EPI) { if (wr == 0) PG8_BAR; }
        if constexpr (!Epi::AFTER_DRAIN) { E(acc, cur, wr, wc, fr, fq); S.done(cur); }
        if (!has_next) break;
        if constexpr (Epi::INIT) E.init(acc, nxt, wr, wc, fr, fq);
        else {
#pragma unroll
        for (int a = 0; a < 2; ++a)
#pragma unroll
            for (int b = 0; b < 2; ++b)
#pragma unroll
                for (int m = 0; m < 4; ++m)
#pragma unroll
                    for (int n = 0; n < 2; ++n) acc[a][b][m][n] = (f32x4){0.f, 0.f, 0.f, 0.f};
        }
        cur = nxt; cA = nA; cB = nB; ++ui;
        if constexpr (ALIGN_EPI) { if (wr == 1) PG8_BAR; }
    }
    PG8_WAIT_V(0);
    if constexpr (!ALIGN_EPI) { if (wr == 0) PG8_BAR; }
    PG8_BAR;
    if constexpr (Epi::AFTER_DRAIN) { E.fused(acc, cur, wr, wc, fr, fq, lds, wid, lane); S.done(cur); }
#undef PG8_SA
#undef PG8_SB
#undef PG8_STAGE
#undef PG8_LDA
#undef PG8_LDB
#undef PG8_MMA
#undef PG8_WAIT_V
#undef PG8_WAIT_L
#undef PG8_BAR
#undef PG8_SCHED
}
}

namespace pg8 {
__device__ __forceinline__ unsigned pkbf(float lo, float hi) { f32x2 v = {lo, hi}; bf16x2_t b = __builtin_convertvector(v, bf16x2_t); return __builtin_bit_cast(unsigned, b); }
__device__ __forceinline__ u32x4 pack8bf(const f32x4& v0, const f32x4& v1) { u32x4 w; w.x = pkbf(v0[0], v0[1]); w.y = pkbf(v0[2], v0[3]); w.z = pkbf(v1[0], v1[1]); w.w = pkbf(v1[2], v1[3]); return w; }
__device__ __forceinline__ float sigm(float x) { return __builtin_amdgcn_rcpf(1.0f + __builtin_amdgcn_exp2f(-x * 1.4426950408889634f)); }
__device__ __forceinline__ float sigm255_1(float a, float nb) { const float e = __builtin_amdgcn_exp2f(__builtin_fmaf(a, -1.4426950408889634f, nb)); return __builtin_amdgcn_rcpf(__builtin_fmaf(e, 1.0f / 255.0f, 1.0f / 255.0f)); }
__device__ __forceinline__ f32x4 sigm255(f32x4 a, f32x4 nb) { f32x4 r; r[0] = sigm255_1(a[0], nb[0]); r[1] = sigm255_1(a[1], nb[1]); r[2] = sigm255_1(a[2], nb[2]); r[3] = sigm255_1(a[3], nb[3]); return r; }
__device__ __forceinline__ f32x4 sigm4(f32x4 v) { v[0] = sigm(v[0]); v[1] = sigm(v[1]); v[2] = sigm(v[2]); v[3] = sigm(v[3]); return v; }
struct EpiProj8 { static constexpr bool PERM = true, AFTER_DRAIN = false, INIT = false;
    ::bf16_t* qkv; unsigned char* gates; float* nsag; const float* bm; const float* hsc; const float* wsc;
    __device__ __forceinline__ void operator()(const f32x4 (&acc)[2][2][4][2], const Unit& u, int wr, int wc, int fr, int fq) const {
        const int row0 = u.pm * BM + wr * 64 + fr, colb = u.pn * BM + wc * 32 + 8 * fq;
        f32x4 cs[2][2];
#pragma unroll
        for (int bj = 0; bj < 2; ++bj)
#pragma unroll
            for (int n = 0; n < 2; ++n) cs[bj][n] = *(const f32x4*)(wsc + colb + bj * HALF + n * 4);
        if (u.pn < 10) {
#pragma unroll
            for (int ai = 0; ai < 2; ++ai)
#pragma unroll
                for (int m = 0; m < 4; ++m) { const size_t row = (size_t)(row0 + ai * HALF + m * 16); const float rs = hsc[row];
#pragma unroll
                    for (int bj = 0; bj < 2; ++bj) { f32x4 v[2];
#pragma unroll
                        for (int n = 0; n < 2; ++n) { const i32x4v ia = __builtin_bit_cast(i32x4v, acc[ai][bj][m][n]);
                            v[n][0] = (float)ia[0] * rs * cs[bj][n][0]; v[n][1] = (float)ia[1] * rs * cs[bj][n][1]; v[n][2] = (float)ia[2] * rs * cs[bj][n][2]; v[n][3] = (float)ia[3] * rs * cs[bj][n][3]; }
                        *(u32x4*)(qkv + row * 2560 + colb + bj * HALF) = pack8bf(v[0], v[1]); } }
        } else if (u.pn < 22) {
            f32x4 bb[2][2];
#pragma unroll
            for (int bj = 0; bj < 2; ++bj)
#pragma unroll
                for (int n = 0; n < 2; ++n) { bb[bj][n] = *(const f32x4*)(bm + colb + bj * HALF + n * 4 - 2560) * -1.4426950408889634f; cs[bj][n] *= -1.4426950408889634f; }
#pragma unroll
            for (int ai = 0; ai < 2; ++ai)
#pragma unroll
                for (int m = 0; m < 4; ++m) { const size_t row = (size_t)(row0 + ai * HALF + m * 16); const float rs = hsc[row];
#pragma unroll
                    for (int bj = 0; bj < 2; ++bj) { const int c = colb + bj * HALF - 2560;
                        u32x2 w;
#pragma unroll
                        for (int n = 0; n < 2; ++n) { const i32x4v ia = __builtin_bit_cast(i32x4v, acc[ai][bj][m][n]); float r[4];
#pragma unroll
                            for (int j = 0; j < 4; ++j) { const float e = __builtin_amdgcn_exp2f(__builtin_fmaf((float)ia[j] * rs, cs[bj][n][j], bb[bj][n][j])); r[j] = __builtin_amdgcn_rcpf(__builtin_fmaf(e, 1.0f / 255.0f, 1.0f / 255.0f)); }
                            const unsigned pk = __builtin_amdgcn_cvt_pk_u8_f32(r[3], 3, __builtin_amdgcn_cvt_pk_u8_f32(r[2], 2, __builtin_amdgcn_cvt_pk_u8_f32(r[1], 1, __builtin_amdgcn_cvt_pk_u8_f32(r[0], 0, 0u))));
                            if (n == 0) w.x = pk; else w.y = pk; }
                        *(u32x2*)(gates + row * 3072 + c) = w; } }
        } else {
#pragma unroll
            for (int ai = 0; ai < 2; ++ai)
#pragma unroll
                for (int m = 0; m < 4; ++m) { const size_t row = (size_t)(row0 + ai * HALF + m * 16); const float rs = hsc[row];
                    const int c = colb - 5632; if (c < 32) {
#pragma unroll
                        for (int n = 0; n < 2; ++n) { const i32x4v ia = __builtin_bit_cast(i32x4v, acc[ai][0][m][n]);
                            f32x4 v = {(float)ia[0] * rs * cs[0][n][0], (float)ia[1] * rs * cs[0][n][1], (float)ia[2] * rs * cs[0][n][2], (float)ia[3] * rs * cs[0][n][3]};
                            *(f32x4*)(nsag + row * 32 + c + n * 4) = sigm4(v); } } }
        }
    }
};
struct EpiPlain8 { static constexpr bool PERM = true, AFTER_DRAIN = false, INIT = false;
    ::bf16_t* O; int ldc; const float* hsc; const float* wsc;
    __device__ __forceinline__ void operator()(const f32x4 (&acc)[2][2][4][2], const Unit& u, int wr, int wc, int fr, int fq) const {
        const int row0 = u.pm * BM + wr * 64 + fr, colb = u.pn * BM + wc * 32 + 8 * fq;
        f32x4 cs[2][2];
#pragma unroll
        for (int bj = 0; bj < 2; ++bj)
#pragma unroll
            for (int n = 0; n < 2; ++n) cs[bj][n] = *(const f32x4*)(wsc + colb + bj * HALF + n * 4);
#pragma unroll
        for (int ai = 0; ai < 2; ++ai)
#pragma unroll
            for (int m = 0; m < 4; ++m) { const size_t row = (size_t)(row0 + ai * HALF + m * 16); const float rs = hsc[row];
#pragma unroll
                for (int bj = 0; bj < 2; ++bj) { f32x4 v[2];
#pragma unroll
                    for (int n = 0; n < 2; ++n) { const i32x4v ia = __builtin_bit_cast(i32x4v, acc[ai][bj][m][n]);
                        v[n][0] = (float)ia[0] * rs * cs[bj][n][0]; v[n][1] = (float)ia[1] * rs * cs[bj][n][1]; v[n][2] = (float)ia[2] * rs * cs[bj][n][2]; v[n][3] = (float)ia[3] * rs * cs[bj][n][3]; }
                    *(u32x4*)(O + row * ldc + colb + bj * HALF) = pack8bf(v[0], v[1]); } }
    }
};
struct EpiPlain { static constexpr bool PERM = true, AFTER_DRAIN = false, INIT = false;
    ::bf16_t* O; int ldc;
    __device__ __forceinline__ void operator()(const f32x4 (&acc)[2][2][4][2], const Unit& u, int wr, int wc, int fr, int fq) const {
        const int row0 = u.pm * BM + wr * 64 + fr;
#pragma unroll
        for (int ai = 0; ai < 2; ++ai)
#pragma unroll
            for (int m = 0; m < 4; ++m) { const size_t row = (size_t)(row0 + ai * HALF + m * 16);
#pragma unroll
                for (int bj = 0; bj < 2; ++bj) { const int col8 = u.pn * BM + bj * HALF + wc * 32 + 8 * fq; *(u32x4*)(O + row * ldc + col8) = pack8bf(acc[ai][bj][m][0], acc[ai][bj][m][1]); } }
    }
};
struct EpiMerge { static constexpr bool PERM = true, AFTER_DRAIN = false, INIT = false;
    ::bf16_t* merged; const ::bf16_t* gates; int br;
    __device__ __forceinline__ void operator()(const f32x4 (&acc)[2][2][4][2], const Unit& u, int wr, int wc, int fr, int fq) const {
        const int row0 = u.pm * BM + wr * 64 + fr, colb = u.pn * BM + wc * 32 + 8 * fq;
        u32x2 gw[2][4][2];
#pragma unroll
        for (int ai = 0; ai < 2; ++ai)
#pragma unroll
            for (int m = 0; m < 4; ++m)
#pragma unroll
                for (int bj = 0; bj < 2; ++bj) gw[ai][m][bj] = *(const u32x2*)((const unsigned char*)gates + (size_t)(row0 + ai * HALF + m * 16) * 3072 + br * 1024 + colb + bj * HALF);
#pragma unroll
        for (int ai = 0; ai < 2; ++ai) {
            u32x4 old[4][2];
            if (br != 0) {
#pragma unroll
                for (int m = 0; m < 4; ++m)
#pragma unroll
                    for (int bj = 0; bj < 2; ++bj) old[m][bj] = *(const u32x4*)(merged + (size_t)(row0 + ai * HALF + m * 16) * 1024 + colb + bj * HALF);
            }
#pragma unroll
            for (int m = 0; m < 4; ++m)
#pragma unroll
                for (int bj = 0; bj < 2; ++bj) {
                    const u32x2 g2 = gw[ai][m][bj];
                    f32x4 v0 = acc[ai][bj][m][0], v1 = acc[ai][bj][m][1];
                    v0[0] *= (float)(g2.x & 0xffu); v0[1] *= (float)((g2.x >> 8) & 0xffu); v0[2] *= (float)((g2.x >> 16) & 0xffu); v0[3] *= (float)(g2.x >> 24);
                    v1[0] *= (float)(g2.y & 0xffu); v1[1] *= (float)((g2.y >> 8) & 0xffu); v1[2] *= (float)((g2.y >> 16) & 0xffu); v1[3] *= (float)(g2.y >> 24);
                    if (br != 0) { const u32x4 o = old[m][bj];
                        v0[0] += __uint_as_float(o.x << 16); v0[1] += __uint_as_float(o.x & 0xffff0000u); v0[2] += __uint_as_float(o.y << 16); v0[3] += __uint_as_float(o.y & 0xffff0000u);
                        v1[0] += __uint_as_float(o.z << 16); v1[1] += __uint_as_float(o.z & 0xffff0000u); v1[2] += __uint_as_float(o.w << 16); v1[3] += __uint_as_float(o.w & 0xffff0000u); }
                    *(u32x4*)(merged + (size_t)(row0 + ai * HALF + m * 16) * 1024 + colb + bj * HALF) = pack8bf(v0, v1); }
            asm volatile("" ::: "memory");
        }
    }
};
struct EpiOut { static constexpr bool PERM = false, AFTER_DRAIN = false, INIT = true;
    const float* x; const float* gf; float* x2; ::bf16_t* h2; float* rowss;
    __device__ __forceinline__ void init(f32x4 (&acc)[2][2][4][2], const Unit& u, int wr, int wc, int fr, int fq) const {
        const int row0 = u.pm * BM + wr * 64 + fr, colb = u.pn * BM + wc * 32 + 4 * fq;
#pragma unroll
        for (int ai = 0; ai < 2; ++ai)
#pragma unroll
            for (int bj = 0; bj < 2; ++bj)
#pragma unroll
                for (int m = 0; m < 4; ++m)
#pragma unroll
                    for (int n = 0; n < 2; ++n) acc[ai][bj][m][n] = *(const f32x4*)(x + (size_t)(row0 + ai * HALF + m * 16) * 1024 + colb + bj * HALF + n * 16);
    }
    __device__ __forceinline__ void operator()(const f32x4 (&acc)[2][2][4][2], const Unit& u, int wr, int wc, int fr, int fq) const {
        const int row0 = u.pm * BM + wr * 64 + fr, colb = u.pn * BM + wc * 32 + 4 * fq;
        f32x4 gg[2][2];
#pragma unroll
        for (int bj = 0; bj < 2; ++bj)
#pragma unroll
            for (int n = 0; n < 2; ++n) gg[bj][n] = *(const f32x4*)(gf + colb + bj * HALF + n * 16);
#pragma unroll
        for (int ai = 0; ai < 2; ++ai)
#pragma unroll
            for (int m = 0; m < 4; ++m) { const size_t row = (size_t)(row0 + ai * HALF + m * 16);
#pragma unroll
                for (int bj = 0; bj < 2; ++bj) { float ss = 0.f;
#pragma unroll
                    for (int n = 0; n < 2; ++n) { const int col = colb + bj * HALF + n * 16;
                        const f32x4 v = acc[ai][bj][m][n]; *(f32x4*)(x2 + row * 1024 + col) = v;
                        ss += (v[0] * v[0] + v[1] * v[1]) + (v[2] * v[2] + v[3] * v[3]);
                        const f32x4 g4 = gg[bj][n]; u32x2 w; w.x = pkbf(v[0] * g4[0], v[1] * g4[1]); w.y = pkbf(v[2] * g4[2], v[3] * g4[3]); *(u32x2*)(h2 + row * 1024 + col) = w; }
                    ss += __shfl_xor(ss, 16); ss += __shfl_xor(ss, 32);
                    if (fq == 0) rowss[row * 32 + u.pn * 8 + bj * 4 + wc] = ss; } }
    }
};
}

#define GEMM_PHASE(EPI, g, S, E) pg8::gemm_phase<EPI, pg8::StaticOrder, true, true>((PG8_LAS unsigned char*)lds, g, S, E)
DI void phase1(const Params& p, bf16_t* lds) {
    unsigned char* ws = p.ws;
    {
        pg8::Gemm g{(const bf16_t*)(ws + WS_H8), (const bf16_t*)(ws + WS_W8), NTOK, NPROJ, D / 2, D / 2, D / 2};
        pg8::StaticOrder S; S.init(NTOK, NPROJ, (int)gridDim.x, (int)blockIdx.x);
        pg8::EpiProj8 E{(bf16_t*)(ws + WS_QKV), ws + WS_GATES, (float*)((unsigned char*)p.out + DO_NSAG), p.in[5], (const float*)(ws + WS_HSC), (const float*)(ws + WS_W8SC)};
        pg8::gemm_phase<pg8::EpiProj8, pg8::StaticOrder, true, true, true>((PG8_LAS unsigned char*)lds, g, S, E);
    }
    {
        pg8::Gemm g{(const bf16_t*)(ws + WS_MEMN8), (const bf16_t*)(ws + WS_WMKV8), NB * MEMT, 512, D / 2, D / 2, D / 2};
        const int cm = ((int)gridDim.x == 256 && blockIdx.x >= 128 && blockIdx.x < 144) ? (int)blockIdx.x - 128 : ((int)gridDim.x == 256 ? (1 << 20) : (int)blockIdx.x);
        pg8::StaticOrder S; S.init(NB * MEMT, 512, (int)gridDim.x, cm);
        pg8::EpiPlain8 E{(bf16_t*)((unsigned char*)p.out + DO_MKV), 512, (const float*)(ws + WS_MEMN8 + 2 * MiB), (const float*)(ws + WS_WMKV8 + MiB)};
        pg8::gemm_phase<pg8::EpiPlain8, pg8::StaticOrder, true, true, true>((PG8_LAS unsigned char*)lds, g, S, E);
    }
    if ((int)gridDim.x == 256) { if (blockIdx.x >= 144) late_weights(p, ((int)blockIdx.x - 144) * NTHREADS + (int)threadIdx.x, 112 * NTHREADS); }
    else late_weights(p, (int)(blockIdx.x * NTHREADS + threadIdx.x), (int)(gridDim.x * NTHREADS));
}
DI void transpose64(const bf16_t* src, size_t sp, bf16_t* dst, size_t dp, unsigned short* scr, int lane) {
#pragma unroll
    for (int i = 0; i < 8; ++i) { const int r = i * 8 + (lane >> 3), c8 = lane & 7; const u32x4 v = *(const u32x4*)(src + (size_t)r * sp + c8 * 8);
        unsigned short* s = scr + r * 66 + c8 * 8;
        s[0] = (unsigned short)(v.x & 0xffff); s[1] = (unsigned short)(v.x >> 16); s[2] = (unsigned short)(v.y & 0xffff); s[3] = (unsigned short)(v.y >> 16);
        s[4] = (unsigned short)(v.z & 0xffff); s[5] = (unsigned short)(v.z >> 16); s[6] = (unsigned short)(v.w & 0xffff); s[7] = (unsigned short)(v.w >> 16); }
    __builtin_amdgcn_s_waitcnt(0xc07f);
    __builtin_amdgcn_wave_barrier();
#pragma unroll
    for (int i = 0; i < 8; ++i) { const int c = i * 8 + (lane >> 3), r8 = lane & 7; const unsigned short* s = scr + (r8 * 8) * 66 + c;
        u32x4 o; o.x = (unsigned)s[0] | ((unsigned)s[66] << 16); o.y = (unsigned)s[2 * 66] | ((unsigned)s[3 * 66] << 16); o.z = (unsigned)s[4 * 66] | ((unsigned)s[5 * 66] << 16); o.w = (unsigned)s[6 * 66] | ((unsigned)s[7 * 66] << 16);
        *(u32x4*)(dst + (size_t)c * dp + r8 * 8) = o; }
    __builtin_amdgcn_s_waitcnt(0xc07f);
    __builtin_amdgcn_wave_barrier();
}
DI void transpose64_vtiles(const bf16_t* src, size_t sp, bf16_t* dst  , unsigned short* scr, int lane) {
#pragma unroll
    for (int i = 0; i < 8; ++i) { const int r = i * 8 + (lane >> 3), c8 = lane & 7; const u32x4 v = *(const u32x4*)(src + (size_t)r * sp + c8 * 8);
        unsigned short* sdst = scr + r * 66 + c8 * 8;
        sdst[0] = (unsigned short)(v.x & 0xffff); sdst[1] = (unsigned short)(v.x >> 16); sdst[2] = (unsigned short)(v.y & 0xffff); sdst[3] = (unsigned short)(v.y >> 16);
        sdst[4] = (unsigned short)(v.z & 0xffff); sdst[5] = (unsigned short)(v.z >> 16); sdst[6] = (unsigned short)(v.w & 0xffff); sdst[7] = (unsigned short)(v.w >> 16); }
    __builtin_amdgcn_s_waitcnt(0xc07f);
    __builtin_amdgcn_wave_barrier();
#pragma unroll
    for (int i = 0; i < 8; ++i) { const int d = i * 8 + (lane >> 3), r8 = lane & 7; const unsigned short* sp2 = scr + (r8 * 8) * 66 + d;
        u32x2 lo, hi2; lo.x = (unsigned)sp2[0] | ((unsigned)sp2[66] << 16); lo.y = (unsigned)sp2[2 * 66] | ((unsigned)sp2[3 * 66] << 16); hi2.x = (unsigned)sp2[4 * 66] | ((unsigned)sp2[5 * 66] << 16); hi2.y = (unsigned)sp2[6 * 66] | ((unsigned)sp2[7 * 66] << 16);
        const int half = r8 >> 2, q = 2 * (r8 & 3), msk = (d >> 2) & 7;
        unsigned char* tb = (unsigned char*)dst + half * 4096 + d * 64;
        *(u32x2*)(tb + ((q ^ msk) * 8)) = lo; *(u32x2*)(tb + (((q + 1) ^ msk) * 8)) = hi2; }
    __builtin_amdgcn_s_waitcnt(0xc07f);
    __builtin_amdgcn_wave_barrier();
}
DI void copy64_ktiles(const bf16_t* src, size_t sp, bf16_t* dst, int lane) {
#pragma unroll
    for (int i = 0; i < 8; ++i) { const int r = i * 8 + (lane >> 3), c8 = lane & 7; const u32x4 v = *(const u32x4*)(src + (size_t)r * sp + c8 * 8);
        const int rr = r & 31;
        *(u32x4*)((unsigned char*)dst + (r >> 5) * 4096 + rr * 128 + ((c8 ^ ((rr >> 1) & 7)) * 16)) = v; }
}
DI void phase2(const Params& p, bf16_t* lds) {
    unsigned char* ws = p.ws; unsigned char* dout = (unsigned char*)p.out;
    const int lane = threadIdx.x & 63, wid = threadIdx.x >> 6;
    const int gwave = blockIdx.x * NWAVES + wid, nwaves = gridDim.x * NWAVES;
    unsigned short* scr = (unsigned short*)lds + wid * (64 * 66);
    const bf16_t* qkv = (const bf16_t*)(ws + WS_QKV);
    const int n_items = 1024 + 1024 + 3072 + 128 + 1024 + 1024 + 3072;
    for (int it = gwave; it < n_items; it += nwaves) {
        if (it < 2048) { const int which = it >> 10, r = it & 1023, b = r >> 7, g = (r >> 6) & 1, tt = r & 63;
            const bf16_t* src = qkv + (size_t)(b * T + tt * 64) * LDP_QKV + C_NKV + (which ? 5 : 3) * 128 + g * 64;
            bf16_t* dst = (bf16_t*)(dout + (which ? DO_VWIN : DO_VSLC)) + ((size_t)(b * 2 + g) * 128 + tt * 2) * 2048;
            transpose64_vtiles(src, LDP_QKV, dst, scr, lane);
        } else if (it < 2048 + 3072) { const int r = it - 2048, b = r / 384, hh = (r / 64) % 6, tt = r & 63;
            const bf16_t* src = qkv + (size_t)(b * T + tt * 64) * LDP_QKV + C_SBV + hh * 64;
            bf16_t* dst = (bf16_t*)(dout + DO_SBV) + ((size_t)(b * 6 + hh) * 128 + tt * 2) * 2048;
            transpose64_vtiles(src, LDP_QKV, dst, scr, lane);
        } else if (it < 5248) { const int r = it - 5120, b = r >> 4, hh = (r >> 2) & 3, mt = r & 3;
            const bf16_t* srcv = (const bf16_t*)(dout + DO_MKV) + (size_t)(b * MEMT + mt * 64) * 512 + 256 + hh * 64;
            transpose64_vtiles(srcv, 512, (bf16_t*)(dout + DO_MVT) + ((size_t)(b * 4 + hh) * 8 + mt * 2) * 2048, scr, lane);
            copy64_ktiles(srcv - 256, 512, (bf16_t*)(dout + DO_MKT) + ((size_t)(b * 4 + hh) * 8 + mt * 2) * 2048, lane);
        } else if (it < 5248 + 2048) { const int r0 = it - 5248, which = r0 >> 10, r = r0 & 1023, b = r >> 7, g = (r >> 6) & 1, tt = r & 63;
            const bf16_t* src = qkv + (size_t)(b * T + tt * 64) * LDP_QKV + C_NKV + (which ? 4 : 2) * 128 + g * 64;
            bf16_t* dst = (bf16_t*)(dout + (which ? DO_KWIN : DO_KSLC)) + ((size_t)(b * 2 + g) * 128 + tt * 2) * 2048;
            copy64_ktiles(src, LDP_QKV, dst, lane);
        } else { const int r = it - 7296, b = r / 384, hh = (r / 64) % 6, tt = r & 63;
            const bf16_t* src = qkv + (size_t)(b * T + tt * 64) * LDP_QKV + C_SBK + hh * 64;
            bf16_t* dst = (bf16_t*)(dout + DO_SBK) + ((size_t)(b * 6 + hh) * 128 + tt * 2) * 2048;
            copy64_ktiles(src, LDP_QKV, dst, lane);
        }
    }
    __syncthreads();
    {
        bf16_t* kc = (bf16_t*)(dout + DO_KC); bf16_t* vct = (bf16_t*)(dout + DO_VCT);
        const int r32 = lane & 31, hi = lane >> 5;
        float* red = (float*)lds;
        for (int task = blockIdx.x; task < 2 * 16 * 8; task += gridDim.x) {
            const int which = task >> 7, bg = (task >> 3) & 15, chunk = task & 7, b = bg >> 1, g = bg & 1;
            const bf16_t* wt = (const bf16_t*)(ws + WS_CMPW) + (size_t)which * 64 * 2048;
            const float* pe = p.in[6 + which];
            const int n = chunk * 32 + r32;
            f32x16 acc[2]; zero16(acc[0]); zero16(acc[1]);
#pragma unroll
            for (int li = 0; li < 4; ++li) {
                const int l = wid * 4 + li; int token = 16 * n + l; if (token > T - 1) token = T - 1;
                const bf16_t* xr = qkv + (size_t)(b * T + token) * LDP_QKV + C_NKV + which * 128 + g * 64 + hi * 8;
#pragma unroll
                for (int ds = 0; ds < 4; ++ds) {
                    const bf16x8 xf = *(const bf16x8*)(xr + ds * 16);
                    const f32x4 p0 = *(const f32x4*)(pe + l * 64 + ds * 16 + hi * 8), p1 = *(const f32x4*)(pe + l * 64 + ds * 16 + hi * 8 + 4);
                    u32x4 pw; pw.x = pk2(p0.x, p0.y); pw.y = pk2(p0.z, p0.w); pw.z = pk2(p1.x, p1.y); pw.w = pk2(p1.z, p1.w);
                    const bf16x8 pf = __builtin_bit_cast(bf16x8, pw);
#pragma unroll
                    for (int eb = 0; eb < 2; ++eb) {
                        const bf16x8 wf = *(const bf16x8*)(wt + (size_t)(32 * eb + r32) * 2048 + l * 64 + ds * 16 + hi * 8);
                        if (which == 0) { acc[eb] = MFMA32(wf, xf, acc[eb]); acc[eb] = MFMA32(wf, pf, acc[eb]); }
                        else { acc[eb] = MFMA32(xf, wf, acc[eb]); acc[eb] = MFMA32(pf, wf, acc[eb]); }
                    }
                }
            }
#pragma unroll
            for (int eb = 0; eb < 2; ++eb)
#pragma unroll
                for (int r = 0; r < 16; ++r) red[(wid * 32 + eb * 16 + r) * 64 + lane] = acc[eb][r];
            __syncthreads();
            {
                const int eb = wid >> 2, mg = wid & 3;
                f32x4 v = {0.f, 0.f, 0.f, 0.f};
#pragma unroll
                for (int w2 = 0; w2 < 8; ++w2) { v.x += red[(w2 * 32 + eb * 16 + 4 * mg) * 64 + lane]; v.y += red[(w2 * 32 + eb * 16 + 4 * mg + 1) * 64 + lane]; v.z += red[(w2 * 32 + eb * 16 + 4 * mg + 2) * 64 + lane]; v.w += red[(w2 * 32 + eb * 16 + 4 * mg + 3) * 64 + lane]; }
                if (which == 0) {
                    if (n == 255) v = (f32x4){0.f, 0.f, 0.f, 0.f};
                    store_bf16x4(kc + ((size_t)bg * 256 + n) * 64 + 32 * eb + 8 * mg + 4 * hi, v);
                } else {
                    const int n0 = chunk * 32 + 8 * mg + 4 * hi;
                    if (n0 + 3 == 255) v.w = 0.f;
                    store_bf16x4(vct + ((size_t)bg * 64 + 32 * eb + r32) * 256 + n0, v);
                }
            }
            __syncthreads();
        }
    }
}

DI bf16x8 pack8(const f32x16& p, int base) {
    u32x4 w; w.x = pk2(p[base], p[base + 1]); w.y = pk2(p[base + 2], p[base + 3]); w.z = pk2(p[base + 4], p[base + 5]); w.w = pk2(p[base + 6], p[base + 7]);
    return __builtin_bit_cast(bf16x8, w);
}
DI f32x16 st_tile(const bf16_t* kbase, size_t kpitch, const bf16x8 (&qf)[4], int r32, int hi) {
    f32x16 s;
#pragma unroll
    for (int i = 0; i < 16; ++i) s[i] = 0.f;
    const bf16_t* kp = kbase + (size_t)r32 * kpitch + hi * 8;
#pragma unroll
    for (int ks = 0; ks < 4; ++ks) { const bf16x8 a = *(const bf16x8*)(kp + ks * 16); s = MFMA32(a, qf[ks], s); }
    return s;
}
DI void pv_tile(f32x16 (&o)[2], const bf16_t* vT, size_t vpitch, const f32x16& pr, int r32, int hi) {
    const bf16x8 pf0 = pack8(pr, 0), pf1 = pack8(pr, 8);
#pragma unroll
    for (int db = 0; db < 2; ++db) {
        const bf16_t* vp = vT + (size_t)(32 * db + r32) * vpitch + 4 * hi;
#pragma unroll
        for (int s2 = 0; s2 < 2; ++s2) {
            const s16x4 lo = *(const s16x4*)(vp + 16 * s2); const s16x4 hh = *(const s16x4*)(vp + 16 * s2 + 8);
            const bf16x8 a = {lo[0], lo[1], lo[2], lo[3], hh[0], hh[1], hh[2], hh[3]};
            o[db] = MFMA32(a, s2 ? pf1 : pf0, o[db]);
        }
    }
}
DI void load_q(bf16x8 (&qf)[4], const bf16_t* qrow  , int hi) {
#pragma unroll
    for (int ks = 0; ks < 4; ++ks) qf[ks] = *(const bf16x8*)(qrow + ks * 16 + hi * 8);
}
DI void softmax_tile(f32x16& sv, unsigned vmask, float& m, float& l, f32x16 (&o)[2]) {
    float tm = -1e30f;
#pragma unroll
    for (int r = 0; r < 16; ++r) tm = fmaxf(tm, ((vmask >> r) & 1u) ? sv[r] : -1e30f);
    tm = fmaxf(tm, __shfl_xor(tm, 32));
    const float mn = fmaxf(m, tm);
    const float alpha = fexp(m - mn);
    float ps = 0.f;
#pragma unroll
    for (int r = 0; r < 16; ++r) { const float pv = ((vmask >> r) & 1u) ? fexp(sv[r] - mn) : 0.f; sv[r] = pv; ps += pv; }
    l = l * alpha + ps; m = mn;
#pragma unroll
    for (int r = 0; r < 16; ++r) { o[0][r] *= alpha; o[1][r] *= alpha; }
}

struct KF { bf16x8 k[4]; };
struct VF { s16x4 v[2][2][2]; };
DI void load_kf(KF& f, const bf16_t* kbase, size_t kpitch, int r32, int hi) {
    const bf16_t* kp = kbase + (size_t)r32 * kpitch + hi * 8;
#pragma unroll
    for (int ks = 0; ks < 4; ++ks) f.k[ks] = *(const bf16x8*)(kp + ks * 16);
}
DI void load_vf(VF& f, const bf16_t* vT, size_t vpitch, int r32, int hi) {
#pragma unroll
    for (int db = 0; db < 2; ++db) { const bf16_t* vp = vT + (size_t)(32 * db + r32) * vpitch + 4 * hi;
#pragma unroll
        for (int s2 = 0; s2 < 2; ++s2) { f.v[db][s2][0] = *(const s16x4*)(vp + 16 * s2); f.v[db][s2][1] = *(const s16x4*)(vp + 16 * s2 + 8); } }
}
DI f32x16 qk_frag(const KF& f, const bf16x8 (&qf)[4]) {
    f32x16 s; zero16(s);
#pragma unroll
    for (int ks = 0; ks < 4; ++ks) s = MFMA32(f.k[ks], qf[ks], s);
    return s;
}
DI void pv_frag(f32x16 (&o)[2], const VF& f, const f32x16& pr) {
    const bf16x8 pf0 = pack8(pr, 0), pf1 = pack8(pr, 8);
#pragma unroll
    for (int db = 0; db < 2; ++db)
#pragma unroll
        for (int s2 = 0; s2 < 2; ++s2) { const s16x4 lo = f.v[db][s2][0], hh = f.v[db][s2][1];
            const bf16x8 a = {lo[0], lo[1], lo[2], lo[3], hh[0], hh[1], hh[2], hh[3]};
            o[db] = MFMA32(a, s2 ? pf1 : pf0, o[db]); }
}
template <bool GUARD = false> DI void softmax_core(f32x16& e, float A, float& m, float& l, f32x16 (&o)[2]) {
    float tm = fmaxf(fmaxf(fmaxf(e[0], e[1]), fmaxf(e[2], e[3])), fmaxf(fmaxf(e[4], e[5]), fmaxf(e[6], e[7])));
    tm = fmaxf(tm, fmaxf(fmaxf(fmaxf(e[8], e[9]), fmaxf(e[10], e[11])), fmaxf(fmaxf(e[12], e[13]), fmaxf(e[14], e[15]))));
    tm += A;
    tm = fmaxf(tm, __shfl_xor(tm, 32));
    if (__any(tm > m + 8.0f)) {
        const float mn = fmaxf(m, tm); const float alpha = fexp2(m - mn); l *= alpha; m = mn;
#pragma unroll
        for (int r = 0; r < 16; ++r) { o[0][r] *= alpha; o[1][r] *= alpha; }
    }
    const float c = A - m;
    float ps = 0.f;
#pragma unroll
    for (int r = 0; r < 16; ++r) { float pv = fexp2(e[r] + c); if (GUARD) pv = (e[r] > -1e29f) ? pv : 0.f; e[r] = pv; ps += pv; }
    l += ps;
}
constexpr float SCL2 = 0.125f * LOG2E;

DI int f2key(float v) { const int u = __float_as_int(v); return u ^ ((u >> 31) & 0x7fffffff); }
DI float key2f(int k) { return __int_as_float(k ^ ((k >> 31) & 0x7fffffff)); }
template <int N> DI void bitonic_sort_desc(int (&a)[N]) {
#pragma unroll
    for (int k = 2; k <= N; k <<= 1)
#pragma unroll
        for (int j = k >> 1; j > 0; j >>= 1)
#pragma unroll
            for (int i = 0; i < N; ++i) { const int l = i ^ j; if (l > i) { const bool desc = ((i & k) == 0); const int hi_ = max(a[i], a[l]), lo_ = min(a[i], a[l]); a[i] = desc ? hi_ : lo_; a[l] = desc ? lo_ : hi_; } }
}
DI void top16_merge(int (&a)[16], const int (&b)[16]) {
#pragma unroll
    for (int i = 0; i < 16; ++i) a[i] = max(a[i], b[15 - i]);
#pragma unroll
    for (int j = 8; j > 0; j >>= 1)
#pragma unroll
        for (int i = 0; i < 16; ++i) { const int l = i ^ j; if (l > i) { const int hi_ = max(a[i], a[l]), lo_ = min(a[i], a[l]); a[i] = hi_; a[l] = lo_; } }
}
DI void nsa_cmp_task(const Params& p, int b, int g, int chunk, int lane, float* impl  ) {
    unsigned char* ws = p.ws; unsigned char* dout = (unsigned char*)p.out;
    const int r32 = lane & 31, hi = lane >> 5;
    const int tq0 = chunk * 32, t = tq0 + r32, cur = tq0 >> 6;
    const size_t tok = (size_t)b * T + t;
    const bf16_t* qkv = (const bf16_t*)(ws + WS_QKV);
    const float scale = 0.125f;
#pragma unroll
    for (int k = 0; k < 32; ++k) impl[k * 64 + lane] = 0.f;
    const bf16_t* kc = (const bf16_t*)(dout + DO_KC) + (size_t)(b * 2 + g) * 256 * 64;
    const bf16_t* vct = (const bf16_t*)(dout + DO_VCT) + (size_t)(b * 2 + g) * 64 * 256;
    int ntile = (tq0 / 16) / 32 + 1; if (ntile > 8) ntile = 8;
#pragma unroll 1
    for (int rr = 0; rr < 3; ++rr) {
        const int head = g * 3 + rr;
        bf16x8 qr[4]; load_q(qr, qkv + tok * LDP_QKV + C_NQ + head * 64, hi);
        const float slope = fexp2(-(8.0f * (float)(head + 1)) / 6.0f);
        float m = -1e30f, l = 0.f;
        f32x16 oc[2]; zero16(oc[0]); zero16(oc[1]);
        float* tmp = impl + 32 * 64; float* tmpm = impl + 64 * 64;
#pragma unroll 1
        for (int tile = 0; tile < ntile; ++tile) {
            KF kf; VF vf; load_kf(kf, kc + (size_t)tile * 32 * 64, 64, r32, hi); load_vf(vf, vct + tile * 32, 256, r32, hi);
            f32x16 s = qk_frag(kf, qr);
            float tm = -1e30f;
#pragma unroll
            for (int r = 0; r < 16; ++r) { const int n = tile * 32 + krow(r, hi); const int dist = t - (16 * n + 31); const bool valid = dist >= 0 && n < 255;
                const float sv = valid ? s[r] * scale - slope * (float)dist : -1e30f; s[r] = sv; tm = fmaxf(tm, sv); }
            tm = fmaxf(tm, __shfl_xor(tm, 32));
            if (__any(tm > m)) {
                const float mn = fmaxf(m, tm); const float alpha = fexp(m - mn); l *= alpha; m = mn;
#pragma unroll
                for (int r = 0; r < 16; ++r) { oc[0][r] *= alpha; oc[1][r] *= alpha; }
            }
            float ps = 0.f;
#pragma unroll
            for (int r = 0; r < 16; ++r) { const float pv = (s[r] > -1e29f) ? fexp(s[r] - m) : 0.f; s[r] = pv; ps += pv; }
            l += ps;
#pragma unroll
            for (int mm = 0; mm < 4; ++mm) tmp[(tile * 4 + mm) * 64 + lane] = (s[4 * mm] + s[4 * mm + 1]) + (s[4 * mm + 2] + s[4 * mm + 3]);
            tmpm[tile * 64 + lane] = m;
            pv_frag(oc, vf, s);
        }
        l += __shfl_xor(l, 32);
        const float inv = l > 0.f ? 1.0f / l : 0.f;
#pragma unroll 1
        for (int tile = 0; tile < ntile; ++tile) { const float sc = fexp(tmpm[tile * 64 + lane] - m) * inv;
#pragma unroll
            for (int mm = 0; mm < 4; ++mm) impl[(tile * 4 + mm) * 64 + lane] += tmp[(tile * 4 + mm) * 64 + lane] * sc; }
#pragma unroll
        for (int r = 0; r < 16; ++r) { oc[0][r] *= inv; oc[1][r] *= inv; }
        const float g_c = ((const float*)(dout + DO_NSAG))[tok * 32 + head * 3];
        bf16_t* orow = (bf16_t*)(dout + DO_OC) + tok * 384 + head * 64;
#pragma unroll
        for (int db = 0; db < 2; ++db)
#pragma unroll
            for (int mg = 0; mg < 4; ++mg) { f32x4 v = {g_c * oc[db][4 * mg], g_c * oc[db][4 * mg + 1], g_c * oc[db][4 * mg + 2], g_c * oc[db][4 * mg + 3]}; store_bf16x4(orow + 32 * db + 8 * mg + 4 * hi, v); }
    }
    unsigned long long selmask;
    if (cur + 1 <= 16) selmask = (1ull << (cur + 1)) - 1ull;
    else {
        int k0[16], k1[16];
#pragma unroll
        for (int k = 0; k < 32; ++k) { const int j = 2 * k + hi; const float iv = impl[k * 64 + lane]; const float v = (j == 0 || j == cur || j == cur - 1) ? 1e4f : (j <= cur ? iv : -1.0f);
            const int key = (__float_as_int(v) & ~63) | (63 - j);
            if (k < 16) k0[k] = key; else k1[k - 16] = key; }
        bitonic_sort_desc<16>(k0); bitonic_sort_desc<16>(k1); top16_merge(k0, k1);
        int pb[16];
#pragma unroll
        for (int i = 0; i < 16; ++i) pb[i] = __shfl_xor(k0[i], 32);
        top16_merge(k0, pb);
        selmask = 0ull;
#pragma unroll
        for (int i = 0; i < 16; ++i) selmask |= 1ull << (63 - (k0[i] & 63));
    }
    if (hi == 0) ((unsigned long long*)(dout + DO_SELM))[(size_t)(b * 2 + g) * T + t] = selmask;
}
typedef LAS unsigned char* ldsp_t;
DI void dma_k(ldsp_t kbuf  , const bf16_t* ktile, int lane) {
#pragma unroll
    for (int i = 0; i < 4; ++i) __builtin_amdgcn_global_load_lds((const unsigned*)((const unsigned char*)ktile + i * 1024 + lane * 16), (LAS unsigned*)(kbuf + i * 1024), 16, 0, 0);
}
DI void dma_v(ldsp_t vbuf  , const bf16_t* vtile, int lane) {
#pragma unroll
    for (int i = 0; i < 4; ++i) __builtin_amdgcn_global_load_lds((const unsigned*)((const unsigned char*)vtile + i * 1024 + lane * 16), (LAS unsigned*)(vbuf + i * 1024), 16, 0, 0);
}
DI f32x16 qk_lds(ldsp_t kbuf, const bf16x8 (&qf)[4], int r32, int hi) {
    f32x16 s; zero16(s);
    const int sw = (r32 >> 1) & 7;
#pragma unroll
    for (int ks = 0; ks < 4; ++ks) { const bf16x8 a = *(const LAS bf16x8*)(kbuf + r32 * 128 + (((2 * ks + hi) ^ sw) * 16)); s = MFMA32(a, qf[ks], s); }
    return s;
}
DI void pv_lds(f32x16 (&o)[2], ldsp_t vbuf, const f32x16& pr, int r32, int hi) {
    const bf16x8 pf0 = pack8(pr, 0), pf1 = pack8(pr, 8);
#pragma unroll
    for (int db = 0; db < 2; ++db) { const int d = 32 * db + r32, msk = (d >> 2) & 7; ldsp_t rowp = vbuf + d * 64;
#pragma unroll
        for (int s2 = 0; s2 < 2; ++s2) { const s16x4 lo = *(const LAS s16x4*)(rowp + (((4 * s2 + hi) ^ msk) * 8)); const s16x4 hh = *(const LAS s16x4*)(rowp + (((4 * s2 + 2 + hi) ^ msk) * 8));
            const bf16x8 a = {lo[0], lo[1], lo[2], lo[3], hh[0], hh[1], hh[2], hh[3]};
            o[db] = MFMA32(a, s2 ? pf1 : pf0, o[db]); } }
}
constexpr int RING_BYTES = 20480, VRING_OFF = 12288;
DI void dma_wait_step(bool k2, bool v1) {
    if (k2 && v1) asm volatile("s_waitcnt vmcnt(8)" ::: "memory");
    else if (k2 || v1) asm volatile("s_waitcnt vmcnt(4)" ::: "memory");
    else asm volatile("s_waitcnt vmcnt(0)" ::: "memory");
}
#define DMA_WAIT_NEWEST8() asm volatile("s_waitcnt vmcnt(8)" ::: "memory")
#define DMA_WAIT_ALL() asm volatile("s_waitcnt vmcnt(0)" ::: "memory")

DI void lds_kf(KF& f, ldsp_t kbuf, int r32, int hi) {
    const int sw = (r32 >> 1) & 7;
#pragma unroll
    for (int ks = 0; ks < 4; ++ks) f.k[ks] = *(const LAS bf16x8*)(kbuf + r32 * 128 + (((2 * ks + hi) ^ sw) * 16));
}
DI void lds_vf(VF& f, ldsp_t vbuf, int r32, int hi) {
#pragma unroll
    for (int db = 0; db < 2; ++db) { const int d = 32 * db + r32, msk = (d >> 2) & 7; ldsp_t rowp = vbuf + d * 64;
#pragma unroll
        for (int s2 = 0; s2 < 2; ++s2) { f.v[db][s2][0] = *(const LAS s16x4*)(rowp + (((4 * s2 + hi) ^ msk) * 8)); f.v[db][s2][1] = *(const LAS s16x4*)(rowp + (((4 * s2 + 2 + hi) ^ msk) * 8)); } }
}
template <bool MASKED, bool WIN> DI void nsa_pair_tile(ldsp_t kbuf, ldsp_t vbuf, const bf16x8 (&qf)[2][4], int t0, int kb, float rb0, float rb1, float slope2,
                                                       float (&m)[2], float (&l)[2], f32x16 (&o)[2][2], int r32, int hi) {
    KF kf; lds_kf(kf, kbuf, r32, hi);
    f32x16 s0 = qk_frag(kf, qf[0]), s1 = qk_frag(kf, qf[1]);
    const int db0 = t0 - kb - 4 * hi, db1 = db0 + 32;
#pragma unroll
    for (int r = 0; r < 16; ++r) { const int cr = (r & 3) + 8 * (r >> 2); const float bias = __int_as_float(__builtin_amdgcn_readfirstlane(__float_as_int(slope2 * (float)cr)));
        float e0 = __builtin_fmaf(s0[r], SCL2, bias), e1 = __builtin_fmaf(s1[r], SCL2, bias);
        if (MASKED) { const int d0 = db0 - cr, d1 = db1 - cr; e0 = (d0 >= 0 && (!WIN || d0 < 512)) ? e0 : -1e30f; e1 = (d1 >= 0 && (!WIN || d1 < 512)) ? e1 : -1e30f; }
        s0[r] = e0; s1[r] = e1; }
    softmax_core<MASKED>(s0, rb0 - slope2 * (float)db0, m[0], l[0], o[0]);
    softmax_core<MASKED>(s1, rb1 - slope2 * (float)db1, m[1], l[1], o[1]);
    VF vf; lds_vf(vf, vbuf, r32, hi);
    pv_frag(o[0], vf, s0); pv_frag(o[1], vf, s1);
}
DI void nsa_main_task(const Params& p, int b, int head, int blk, int lane, ldsp_t wl) {
    unsigned char* ws = p.ws; unsigned char* dout = (unsigned char*)p.out;
    const int g = head / 3, r32 = lane & 31, hi = lane >> 5;
    const int tq0 = blk * 64, cur = blk;
    const int t0 = tq0 + r32;
    const size_t tok0 = (size_t)b * T + t0;
    const bf16_t* qkv = (const bf16_t*)(ws + WS_QKV);
    const unsigned long long* smp = (const unsigned long long*)(dout + DO_SELM) + (size_t)(b * 2 + g) * T + t0;
    const unsigned long long selmask[2] = {smp[0], smp[32]};
    const float slope2 = fexp2(-(8.0f * (float)(head + 1)) / 6.0f) * LOG2E;
    bf16x8 qf[2][4];
    load_q(qf[0], qkv + tok0 * LDP_QKV + C_NQ + head * 64, hi); load_q(qf[1], qkv + (tok0 + 32) * LDP_QKV + C_NQ + head * 64, hi);
    const size_t tbase = (size_t)(b * 2 + g) * 128;
    const float* nsag = (const float*)(dout + DO_NSAG) + tok0 * 32 + head * 3;
    bf16_t* orow = (bf16_t*)(ws + WS_H) + tok0 * D + 384 + head * 64;
    {
        const bf16_t* kt = (const bf16_t*)(dout + DO_KSLC) + tbase * 2048; const bf16_t* vt = (const bf16_t*)(dout + DO_VSLC) + tbase * 2048;
        unsigned ulo = (unsigned)(selmask[0] | selmask[1]), uhi = (unsigned)((selmask[0] | selmask[1]) >> 32);
#pragma unroll
        for (int o_ = 1; o_ < 64; o_ <<= 1) { ulo |= (unsigned)__shfl_xor((int)ulo, o_); uhi |= (unsigned)__shfl_xor((int)uhi, o_); }
        unsigned long long U = ((unsigned long long)(unsigned)__builtin_amdgcn_readfirstlane((int)uhi) << 32) | (unsigned)__builtin_amdgcn_readfirstlane((int)ulo);
        U &= (cur == 63) ? ~0ull : ((1ull << (cur + 1)) - 1ull);
        float m[2] = {-1e30f, -1e30f}, l[2] = {0.f, 0.f}; f32x16 o[2][2];
        zero16(o[0][0]); zero16(o[0][1]); zero16(o[1][0]); zero16(o[1][1]);
#define NEXT_TILE(J, H, NJ, NH, HAS) { NJ = J; NH = H - 1; HAS = true; if (NH < 0) { const unsigned long long rem_ = U & ((1ull << J) - 1ull); if (rem_ == 0ull) HAS = false; else { NJ = 63 - __builtin_clzll(rem_); NH = 1; } } }
        int j0 = cur, h0 = 1, j1, h1, j2 = 0, h2 = 0; bool has1, has2 = false;
        NEXT_TILE(j0, h0, j1, h1, has1);
        if (has1) NEXT_TILE(j1, h1, j2, h2, has2);
        int ks0 = 0, vs0 = 0;
        dma_k(wl, kt + (size_t)(2 * j0 + h0) * 2048, lane); dma_v(wl + VRING_OFF, vt + (size_t)(2 * j0 + h0) * 2048, lane);
        if (has1) dma_k(wl + 4096, kt + (size_t)(2 * j1 + h1) * 2048, lane);
#define NSA_SEL_STEP(MASKED) { \
            const int ks1 = ks0 == 2 ? 0 : ks0 + 1, ks2 = ks1 == 2 ? 0 : ks1 + 1; \
            if (has2) dma_k(wl + ks2 * 4096, kt + (size_t)(2 * j2 + h2) * 2048, lane); \
            if (has1) dma_v(wl + VRING_OFF + (vs0 ^ 1) * 4096, vt + (size_t)(2 * j1 + h1) * 2048, lane); \
            dma_wait_step(has2, has1); \
            const int kb = 64 * j0 + 32 * h0; \
            const float rb0 = ((selmask[0] >> j0) & 1ull) ? 0.f : -1e30f, rb1 = ((selmask[1] >> j0) & 1ull) ? 0.f : -1e30f; \
            nsa_pair_tile<MASKED, false>(wl + ks0 * 4096, wl + VRING_OFF + vs0 * 4096, qf, t0, kb, rb0, rb1, slope2, m, l, o, r32, hi); \
            more = has1; \
            if (has1) { j0 = j1; h0 = h1; j1 = j2; h1 = h2; has1 = has2; \
                if (has2) { int nj, nh; bool hs; NEXT_TILE(j2, h2, nj, nh, hs); j2 = nj; h2 = nh; has2 = hs; } \
                ks0 = ks1; vs0 ^= 1; } }
        bool more = true;
#pragma unroll 1
        while (more && j0 == cur) NSA_SEL_STEP(true)
#pragma unroll 1
        while (more) NSA_SEL_STEP(false)
#pragma unroll
        for (int ci = 0; ci < 2; ++ci) {
            float lt = l[ci]; lt += __shfl_xor(lt, 32);
            const float f = nsag[ci * 32 * 32 + 1] * (lt > 0.f ? 1.0f / lt : 0.f);
#pragma unroll
            for (int db = 0; db < 2; ++db)
#pragma unroll
                for (int mg = 0; mg < 4; ++mg) { const u32x2 w = *(const u32x2*)((const bf16_t*)(dout + DO_OC) + (tok0 + ci * 32) * 384 + head * 64 + 32 * db + 8 * mg + 4 * hi);
                    f32x4 v = {bflo(w.x) + f * o[ci][db][4 * mg], bfhi(w.x) + f * o[ci][db][4 * mg + 1], bflo(w.y) + f * o[ci][db][4 * mg + 2], bfhi(w.y) + f * o[ci][db][4 * mg + 3]};
                    store_bf16x4(orow + (size_t)ci * 32 * D + 32 * db + 8 * mg + 4 * hi, v); }
        }
    }
    {
        const bf16_t* kt = (const bf16_t*)(dout + DO_KWIN) + tbase * 2048; const bf16_t* vt = (const bf16_t*)(dout + DO_VWIN) + tbase * 2048;
        float m[2] = {-1e30f, -1e30f}, l[2] = {0.f, 0.f}; f32x16 o[2][2];
        zero16(o[0][0]); zero16(o[0][1]); zero16(o[1][0]); zero16(o[1][1]);
        int kb0 = tq0 - 512; if (kb0 < 0) kb0 = 0;
        int kb = tq0 + 32, ks0 = 0, vs0 = 0;
        dma_k(wl, kt + (size_t)(kb >> 5) * 2048, lane); dma_v(wl + VRING_OFF, vt + (size_t)(kb >> 5) * 2048, lane);
        dma_k(wl + 4096, kt + (size_t)((kb - 32) >> 5) * 2048, lane);
#define NSA_WIN_STEP(MASKED) { \
            const bool has1 = (kb - 32 >= kb0), has2 = (kb - 64 >= kb0); \
            const int ks1 = ks0 == 2 ? 0 : ks0 + 1, ks2 = ks1 == 2 ? 0 : ks1 + 1; \
            if (has2) dma_k(wl + ks2 * 4096, kt + (size_t)((kb - 64) >> 5) * 2048, lane); \
            if (has1) dma_v(wl + VRING_OFF + (vs0 ^ 1) * 4096, vt + (size_t)((kb - 32) >> 5) * 2048, lane); \
            dma_wait_step(has2, has1); \
            nsa_pair_tile<MASKED, true>(wl + ks0 * 4096, wl + VRING_OFF + vs0 * 4096, qf, t0, kb, 0.f, 0.f, slope2, m, l, o, r32, hi); \
            more = has1; \
            if (has1) { kb -= 32; ks0 = ks1; vs0 ^= 1; } }
        bool more = true;
#pragma unroll 1
        while (more && kb >= tq0) NSA_WIN_STEP(true)
#pragma unroll 1
        while (more && kb > tq0 - 480) NSA_WIN_STEP(false)
#pragma unroll 1
        while (more) NSA_WIN_STEP(true)
#pragma unroll
        for (int ci = 0; ci < 2; ++ci) {
            float lt = l[ci]; lt += __shfl_xor(lt, 32);
            const float f = nsag[ci * 32 * 32 + 2] * (lt > 0.f ? 1.0f / lt : 0.f);
#pragma unroll
            for (int db = 0; db < 2; ++db)
#pragma unroll
                for (int mg = 0; mg < 4; ++mg) { bf16_t* op = orow + (size_t)ci * 32 * D + 32 * db + 8 * mg + 4 * hi; const u32x2 w = *(const u32x2*)op;
                    f32x4 v = {bflo(w.x) + f * o[ci][db][4 * mg], bfhi(w.x) + f * o[ci][db][4 * mg + 1], bflo(w.y) + f * o[ci][db][4 * mg + 2], bfhi(w.y) + f * o[ci][db][4 * mg + 3]};
                    store_bf16x4(op, v); }
        }
    }
}

DI void mem_task(const Params& p, int b, int head, int chunk, int lane, ldsp_t wl) {
    unsigned char* ws = p.ws; unsigned char* dout = (unsigned char*)p.out;
    const int r32 = lane & 31, hi = lane >> 5; const size_t tok = (size_t)b * T + chunk * 32 + r32;
    const bf16_t* qkv = (const bf16_t*)(ws + WS_QKV);
    bf16x8 qf[4]; load_q(qf, qkv + tok * LDP_QKV + C_MQ + head * 64, hi);
    const bf16_t* kt = (const bf16_t*)(dout + DO_MKT) + (size_t)(b * 4 + head) * 8 * 2048;
    const bf16_t* vt = (const bf16_t*)(dout + DO_MVT) + (size_t)(b * 4 + head) * 8 * 2048;
    float m = -1e30f, l = 0.f; f32x16 o[2]; zero16(o[0]); zero16(o[1]);
    int ks0 = 0, vs0 = 0;
    dma_k(wl, kt, lane); dma_v(wl + VRING_OFF, vt, lane); dma_k(wl + 4096, kt + 2048, lane);
#pragma unroll 1
    for (int ti = 0; ti < 8; ++ti) {
        const bool has1 = ti + 1 < 8, has2 = ti + 2 < 8;
        const int ks1 = ks0 == 2 ? 0 : ks0 + 1, ks2 = ks1 == 2 ? 0 : ks1 + 1;
        if (has2) dma_k(wl + ks2 * 4096, kt + (size_t)(ti + 2) * 2048, lane);
        if (has1) dma_v(wl + VRING_OFF + (vs0 ^ 1) * 4096, vt + (size_t)(ti + 1) * 2048, lane);
        dma_wait_step(has2, has1);
        f32x16 s = qk_lds(wl + ks0 * 4096, qf, r32, hi);
#pragma unroll
        for (int r = 0; r < 16; ++r) s[r] *= SCL2;
        softmax_core(s, 0.f, m, l, o);
        pv_lds(o, wl + VRING_OFF + vs0 * 4096, s, r32, hi);
        ks0 = ks1; vs0 ^= 1;
    }
    l += __shfl_xor(l, 32);
    const float f = 1.0f / l;
    bf16_t* orow = (bf16_t*)(ws + WS_H) + tok * D + 768 + head * 64;
#pragma unroll
    for (int db = 0; db < 2; ++db)
#pragma unroll
        for (int mg = 0; mg < 4; ++mg) { f32x4 v = {o[db][4 * mg] * f, o[db][4 * mg + 1] * f, o[db][4 * mg + 2] * f, o[db][4 * mg + 3] * f}; store_bf16x4(orow + 32 * db + 8 * mg + 4 * hi, v); }
}

DI void sb_task(const Params& p, int b, int head, int chunk, int lane, ldsp_t wl) {
    unsigned char* ws = p.ws; unsigned char* dout = (unsigned char*)p.out;
    const int r32 = lane & 31, hi = lane >> 5; const int tq0 = chunk * 32, t = tq0 + r32; const size_t tok = (size_t)b * T + t;
    const bf16_t* qkv = (const bf16_t*)(ws + WS_QKV);
    bf16x8 qf[4]; load_q(qf, qkv + tok * LDP_QKV + C_SBQ + head * 64, hi);
    const size_t tbase = (size_t)(b * 6 + head) * 128;
    const bf16_t* kt = (const bf16_t*)(dout + DO_SBK) + tbase * 2048; const bf16_t* vt = (const bf16_t*)(dout + DO_SBV) + tbase * 2048;
    f32x16 o[2]; zero16(o[0]); zero16(o[1]);
    float R = 0.f;
    int kb = tq0, ks0 = 0, vs0 = 0;
    dma_k(wl, kt + (size_t)(kb >> 5) * 2048, lane); dma_v(wl + VRING_OFF, vt + (size_t)(kb >> 5) * 2048, lane);
    if (kb >= 32) dma_k(wl + 4096, kt + (size_t)((kb - 32) >> 5) * 2048, lane);
#define SB_STEP(MASKED) { \
        const bool has1 = kb >= 32, has2 = kb >= 64; \
        const int ks1 = ks0 == 2 ? 0 : ks0 + 1, ks2 = ks1 == 2 ? 0 : ks1 + 1; \
        if (has2) dma_k(wl + ks2 * 4096, kt + (size_t)((kb - 64) >> 5) * 2048, lane); \
        if (has1) dma_v(wl + VRING_OFF + (vs0 ^ 1) * 4096, vt + (size_t)((kb - 32) >> 5) * 2048, lane); \
        dma_wait_step(has2, has1); \
        f32x16 s = qk_lds(wl + ks0 * 4096, qf, r32, hi); \
        f32x16 L; \
        _Pragma("unroll") for (int r = 0; r < 16; ++r) { const float z = s[r] * (0.125f * LOG2E); \
            const float sp = fmaxf(z, 0.f) + flog2(1.0f + fexp2(-fabsf(z)));       \
            s[r] = z; if (MASKED) { const bool valid = (kb + krow(r, hi)) < t; L[r] = valid ? -sp : 0.f; } else L[r] = -sp; } \
        float gs[4], pg[4]; \
        _Pragma("unroll") for (int mg = 0; mg < 4; ++mg) { gs[mg] = (L[4 * mg] + L[4 * mg + 1]) + (L[4 * mg + 2] + L[4 * mg + 3]); pg[mg] = __shfl_xor(gs[mg], 32); } \
        float off[4]; float run = R; \
        _Pragma("unroll") for (int mg = 3; mg >= 0; --mg) { off[mg] = run + (hi ? 0.f : pg[mg]); run += gs[mg] + pg[mg]; } \
        _Pragma("unroll") for (int mg = 0; mg < 4; ++mg) { \
            float e = off[mg]; \
            _Pragma("unroll") for (int i = 3; i >= 0; --i) { const int r = 4 * mg + i; \
                float a = fexp2(s[r] + L[r] + e); if (MASKED) { const bool valid = (kb + krow(r, hi)) < t; a = valid ? a : 0.f; } e += L[r]; s[r] = a; } \
        } \
        R = run; \
        pv_lds(o, wl + VRING_OFF + vs0 * 4096, s, r32, hi); \
        more = has1 && !__all(R < -104.0f * LOG2E); \
        if (more) { kb -= 32; ks0 = ks1; vs0 ^= 1; } }
    bool more;
    SB_STEP(true)
#pragma unroll 1
    while (more) SB_STEP(false)
#undef SB_STEP
    DMA_WAIT_ALL();
    bf16_t* orow = (bf16_t*)(ws + WS_H) + tok * D + head * 64;
#pragma unroll
    for (int db = 0; db < 2; ++db)
#pragma unroll
        for (int mg = 0; mg < 4; ++mg) { f32x4 v = {o[db][4 * mg], o[db][4 * mg + 1], o[db][4 * mg + 2], o[db][4 * mg + 3]}; store_bf16x4(orow + 32 * db + 8 * mg + 4 * hi, v); }
}

constexpr int N_CMP_TASKS = NB * 2 * 128, N_NSA_TASKS = NB * 6 * 64, N_MEM_TASKS = NB * 4 * 128, N_SB_TASKS = NB * 6 * 128;
DI void phase3a(const Params& p, int rep, bf16_t* lds) {
    const int lane = threadIdx.x & 63;
    ldsp_t wl = (ldsp_t)(unsigned char*)lds + __builtin_amdgcn_readfirstlane((int)(threadIdx.x >> 6)) * RING_BYTES;
    float* impl = (float*)((unsigned char*)lds + (threadIdx.x >> 6) * RING_BYTES);
    unsigned* ctr = (unsigned*)(p.ws + WS_CTL) + 64 + 256 * rep;
    for (;;) {
        unsigned tk = 0; if (lane == 0) tk = atomicAdd(ctr, 1u);
        const int task = (int)__builtin_amdgcn_readfirstlane(tk);
        if (task >= N_CMP_TASKS + N_MEM_TASKS) break;
        if (task < N_CMP_TASKS) { const int chunk = 127 - task / 16, rem = task % 16; nsa_cmp_task(p, rem >> 1, rem & 1, chunk, lane, impl); }
        else { const int r = task - N_CMP_TASKS; const int chunk = r / 32, rem = r % 32; mem_task(p, rem / 4, rem % 4, chunk, lane, wl); }
    }
}
DI void phase3b(const Params& p, int rep, unsigned char* lds_raw_) {
    const int lane = threadIdx.x & 63;
    ldsp_t wl = (ldsp_t)lds_raw_ + __builtin_amdgcn_readfirstlane((int)(threadIdx.x >> 6)) * RING_BYTES;
    unsigned* ctr = (unsigned*)(p.ws + WS_CTL) + 128 + 256 * rep;
    if (__builtin_amdgcn_readfirstlane((int)(threadIdx.x >> 6)) == NWAVES - 1) peer_table_rows(p, lane, blockIdx.x, gridDim.x);
    for (;;) {
        unsigned tk = 0; if (lane == 0) tk = atomicAdd(ctr, 1u);
        const int task = (int)__builtin_amdgcn_readfirstlane(tk);
        if (task >= N_NSA_TASKS + N_SB_TASKS) break;
        if (task < N_NSA_TASKS) { const int ci = task / 48, rem = task % 48; const int blk = (ci & 1) ? (ci >> 1) : 63 - (ci >> 1); nsa_main_task(p, rem / 6, rem % 6, blk, lane, wl); }
        else { const int r = task - N_NSA_TASKS; const int chunk = r / 48, rem = r % 48; sb_task(p, rem / 6, rem % 6, chunk, lane, wl); }
    }
}

DI void phase4(const Params& p, bf16_t* lds) {
    unsigned char* ws = p.ws;
    const bf16_t* cat = (const bf16_t*)(ws + WS_H); const bf16_t* gates = (const bf16_t*)(ws + WS_GATES); bf16_t* merged = (bf16_t*)(ws + WS_MERGED);
    pg8::StaticOrder S; S.init(NTOK, D, (int)gridDim.x, (int)blockIdx.x);
#pragma unroll 1
    for (int br = 0; br < 3; ++br) {
        const int Kb = br == 2 ? 256 : 384;
        const bf16_t* Bt = (const bf16_t*)(ws + (br == 0 ? WS_WSB : (br == 1 ? WS_WNSA : WS_WMEM)));
        pg8::Gemm g{cat + br * 384, Bt, NTOK, D, Kb, D, Kb}; pg8::EpiMerge E{merged, gates, br}; GEMM_PHASE(pg8::EpiMerge, g, S, E);
    }
}
DI void phase5(const Params& p, bf16_t* lds) {
    unsigned char* ws = p.ws;
    pg8::Gemm g{(const bf16_t*)(ws + WS_MERGED), (const bf16_t*)(ws + WS_WOUT), NTOK, D, D, D, D};
    pg8::StaticOrder S; S.init(NTOK, D, (int)gridDim.x, (int)blockIdx.x);
    pg8::EpiOut E{p.in[0], p.in[15], p.out, (bf16_t*)(ws + WS_H2), (float*)(ws + WS_ROWSS)};
    GEMM_PHASE(pg8::EpiOut, g, S, E);
}
DI void phase6(const Params& p, bf16_t* lds) {
    unsigned char* ws = p.ws;
    pg8::Gemm g{(const bf16_t*)(ws + WS_H2), (const bf16_t*)(ws + WS_WQ), NTOK, 2048, D, D, D};
    pg8::StaticOrder S; S.init(NTOK, 2048, (int)gridDim.x, (int)blockIdx.x);
    pg8::EpiPlain E{(bf16_t*)(ws + WS_QP), 2048};
    GEMM_PHASE(pg8::EpiPlain, g, S, E);
}

DI float row_rstd(const float* rowss, size_t tok) {
    const f32x4* r = (const f32x4*)(rowss + tok * 32); float s = 0.f;
#pragma unroll
    for (int i = 0; i < 8; ++i) { const f32x4 v = r[i]; s += (v.x + v.y) + (v.z + v.w); }
    return 1.0f / sqrtf(s * (1.0f / D) + RMS_EPS);
}
constexpr int ROUTE_LDS_PER_WAVE = 2 * 16 * 32 * 4;
DI void route_task(const Params& p, int chunk, int head, int lane, float* wl, ldsp_t sk  ) {
    unsigned char* ws = p.ws;
    const int r32 = lane & 31, hi = lane >> 5; const size_t tok = (size_t)chunk * 32 + r32;
    const bf16_t* qp = (const bf16_t*)(ws + WS_QP) + tok * 2048 + head * 256;
    int* til = (int*)wl;
    float tv[2][16];
#pragma unroll
    for (int pp = 0; pp < 2; ++pp) {
        f32x16 sc[4];
#pragma unroll
        for (int tl = 0; tl < 4; ++tl) zero16(sc[tl]);
#pragma unroll
        for (int ks = 0; ks < 8; ++ks) {
            const bf16x8 qv = *(const bf16x8*)(qp + pp * 128 + ks * 16 + hi * 8);
#pragma unroll
            for (int tl = 0; tl < 4; ++tl) { const int row = pp * 128 + tl * 32 + r32; const bf16x8 a = *(const LAS bf16x8*)(sk + row * 256 + (((2 * ks + hi) ^ (row & 15)) * 16)); sc[tl] = MFMA32(a, qv, sc[tl]); }
        }
        int k0[16], k1[16], k2[16], k3[16];
#pragma unroll
        for (int r = 0; r < 16; ++r) { const int kr = krow(r, hi);
            k0[r] = (f2key(sc[0][r]) & ~127) | (127 - kr); k1[r] = (f2key(sc[1][r]) & ~127) | (127 - (32 + kr));
            k2[r] = (f2key(sc[2][r]) & ~127) | (127 - (64 + kr)); k3[r] = (f2key(sc[3][r]) & ~127) | (127 - (96 + kr)); }
        bitonic_sort_desc<16>(k0); bitonic_sort_desc<16>(k1); bitonic_sort_desc<16>(k2); bitonic_sort_desc<16>(k3);
        top16_merge(k0, k1); top16_merge(k2, k3); top16_merge(k0, k2);
        int pb[16];
#pragma unroll
        for (int i = 0; i < 16; ++i) pb[i] = __shfl_xor(k0[i], 32);
        top16_merge(k0, pb);
#pragma unroll
        for (int i = 0; i < 16; ++i) { tv[pp][i] = key2f(k0[i] & ~127); if (hi == 0) til[(pp * 16 + i) * 32 + r32] = 127 - (k0[i] & 127); }
    }
    __builtin_amdgcn_wave_barrier();
    int c0[16], c1[16], c2[16], c3[16];
    {
        int c = 0;
#pragma unroll
        for (int a = 0; a < 16; ++a)
#pragma unroll
            for (int bb = 0; bb < 16; ++bb) if ((a + 1) * (bb + 1) <= 16) {
                const int key = (f2key(tv[0][a] + tv[1][bb]) & ~255) | (255 - (a * 16 + bb));
                if (c < 16) c0[c] = key; else if (c < 32) c1[c - 16] = key; else if (c < 48) c2[c - 32] = key; else c3[c - 48] = key;
                ++c; }
#pragma unroll
        for (int i = 2; i < 16; ++i) c3[i] = (int)0x80000000;
    }
    bitonic_sort_desc<16>(c1); bitonic_sort_desc<16>(c2); bitonic_sort_desc<16>(c3);
    top16_merge(c0, c1); top16_merge(c2, c3); top16_merge(c0, c2);
    const float rstd = row_rstd((const float*)(ws + WS_ROWSS), tok);
    float gg[16]; int ex[16]; float den = 0.f; const float b0 = key2f(c0[0] & ~255);
#pragma unroll
    for (int k = 0; k < 16; ++k) { const int code = 255 - (c0[k] & 255);
        ex[k] = til[(code >> 4) * 32 + r32] * 128 + til[(16 + (code & 15)) * 32 + r32];
        gg[k] = fexp((key2f(c0[k] & ~255) - b0) * rstd); den += gg[k]; }
    const float inv = 1.0f / den;
    if (hi == 0) { unsigned short* ip = (unsigned short*)(ws + WS_IDX) + tok * 128 + head * 16;
        u32x4 w0, w1;
        w0.x = (unsigned)ex[0] | ((unsigned)ex[1] << 16); w0.y = (unsigned)ex[2] | ((unsigned)ex[3] << 16); w0.z = (unsigned)ex[4] | ((unsigned)ex[5] << 16); w0.w = (unsigned)ex[6] | ((unsigned)ex[7] << 16);
        w1.x = (unsigned)ex[8] | ((unsigned)ex[9] << 16); w1.y = (unsigned)ex[10] | ((unsigned)ex[11] << 16); w1.z = (unsigned)ex[12] | ((unsigned)ex[13] << 16); w1.w = (unsigned)ex[14] | ((unsigned)ex[15] << 16);
        *(u32x4*)ip = w0; *(u32x4*)(ip + 8) = w1; }
    else { float* gp = (float*)(ws + WS_GW) + tok * 128 + head * 16;
#pragma unroll
        for (int k = 0; k < 16; k += 4) { f32x4 v = {gg[k] * inv, gg[k + 1] * inv, gg[k + 2] * inv, gg[k + 3] * inv}; *(f32x4*)(gp + k) = v; } }
    __builtin_amdgcn_wave_barrier();
}
DI void phase7(const Params& p, bf16_t* lds) {
    const int lane = threadIdx.x & 63, wid = threadIdx.x >> 6;
    ldsp_t sk = (ldsp_t)(unsigned char*)lds;
    float* wl = (float*)((unsigned char*)lds + 65536 + wid * ROUTE_LDS_PER_WAVE);
    for (int head = blockIdx.x & 7; head < 8; head += gridDim.x) {
        const int nbh = ((int)gridDim.x - head + 7) / 8, rank = blockIdx.x >> 3;
        __syncthreads();
        const u32x4* src = (const u32x4*)((const bf16_t*)(p.ws + WS_SUBK) + (size_t)head * 2 * 128 * 128);
#pragma unroll
        for (int j = 0; j < 8; ++j) { const int ci = threadIdx.x + NTHREADS * j, row = ci >> 4, c = ci & 15; *(LAS u32x4*)(sk + row * 256 + ((c ^ (row & 15)) * 16)) = src[ci]; }
        __syncthreads();
        for (int chunk = rank * NWAVES + wid; chunk < NTOK / 32; chunk += nbh * NWAVES) route_task(p, chunk, head, lane, wl, sk);
    }
}

DI float gelu_exact(float a) { return 0.5f * a * (1.0f + erff(a * 0.70710678118654752f)); }
DI void fp8x16_to_f32(const u32x4& w, float (&f)[16]) {
#pragma unroll
    for (int j = 0; j < 4; ++j) { const f32x2 lo = __builtin_amdgcn_cvt_pk_f32_fp8((int)w[j], false); const f32x2 hi = __builtin_amdgcn_cvt_pk_f32_fp8((int)w[j], true);
        f[4 * j] = lo.x; f[4 * j + 1] = lo.y; f[4 * j + 2] = hi.x; f[4 * j + 3] = hi.y; }
}
DI void phase8(const Params& p) {
    unsigned char* ws = p.ws;
    const int lane = threadIdx.x & 63, wid = threadIdx.x >> 6;
    const int gwave = blockIdx.x * NWAVES + wid, nwaves = gridDim.x * NWAVES;
    const bf16_t* h2 = (const bf16_t*)(ws + WS_H2); const unsigned char* tu = ws + WS_TABU; const unsigned char* tvv = ws + WS_TABV;
    const float* tsc = (const float*)(ws + WS_TSCALE);
    const unsigned short* idx = (const unsigned short*)(ws + WS_IDX); const float* gw = (const float*)(ws + WS_GW);
    const float* gfin = p.in[20];
    const int kk = ((lane >> 5) & 1) * 8 + ((lane >> 4) & 1) * 4 + ((lane >> 3) & 1) * 2 + ((lane >> 2) & 1);
#pragma unroll 1
    for (int tk = gwave; tk < NTOK; tk += nwaves) {
        const size_t tok = (size_t)tk;
        const float rstd = row_rstd((const float*)(ws + WS_ROWSS), tok);
        float hn[16];
        { const u32x4 a = *(const u32x4*)(h2 + tok * D + lane * 16); const u32x4 b = *(const u32x4*)(h2 + tok * D + lane * 16 + 8);
          hn[0] = bflo(a.x) * rstd; hn[1] = bfhi(a.x) * rstd; hn[2] = bflo(a.y) * rstd; hn[3] = bfhi(a.y) * rstd; hn[4] = bflo(a.z) * rstd; hn[5] = bfhi(a.z) * rstd; hn[6] = bflo(a.w) * rstd; hn[7] = bfhi(a.w) * rstd;
          hn[8] = bflo(b.x) * rstd; hn[9] = bfhi(b.x) * rstd; hn[10] = bflo(b.y) * rstd; hn[11] = bfhi(b.y) * rstd; hn[12] = bflo(b.z) * rstd; hn[13] = bfhi(b.z) * rstd; hn[14] = bflo(b.w) * rstd; hn[15] = bfhi(b.w) * rstd; }
        float acc[16];
#pragma unroll
        for (int i = 0; i < 16; ++i) acc[i] = 0.f;
        const int e_lo = idx[tok * 128 + lane], e_hi = idx[tok * 128 + 64 + lane];
        const float g_lo = gw[tok * 128 + lane], g_hi = gw[tok * 128 + 64 + lane];
        for (int rep9 = 0; rep9 < REP9; ++rep9)
#pragma unroll 1
        for (int head = 0; head < 8; ++head) {
            const int esrc = head < 4 ? e_lo : e_hi; const float gsrc = head < 4 ? g_lo : g_hi;
            const int myslot = (head & 3) * 16 + kk;
            const int my_e = __shfl(esrc, myslot); const float my_g = __shfl(gsrc, myslot);
            const float su = tsc[my_e], sv = tsc[16384 + my_e];
            u32x4 ub[16], vb[16];
#pragma unroll
            for (int k = 0; k < 16; ++k) { const int e = __builtin_amdgcn_readlane(esrc, (head & 3) * 16 + k);
                ub[k] = *(const u32x4*)(tu + (size_t)e * 1024 + lane * 16); vb[k] = *(const u32x4*)(tvv + (size_t)e * 1024 + lane * 16); }
            float d[16];
#pragma unroll
            for (int k = 0; k < 16; ++k) { float f[16]; fp8x16_to_f32(ub[k], f); float t = 0.f;
#pragma unroll
                for (int i = 0; i < 16; ++i) t += f[i] * hn[i];
                d[k] = t; }
            float r8[8], r4[4], r2[2], r1;
            { const bool up = (lane & 32) != 0;
#pragma unroll
              for (int k = 0; k < 8; ++k) { const float keep = up ? d[k + 8] : d[k], send = up ? d[k] : d[k + 8]; r8[k] = keep + __shfl_xor(send, 32); } }
            { const bool up = (lane & 16) != 0;
#pragma unroll
              for (int k = 0; k < 4; ++k) { const float keep = up ? r8[k + 4] : r8[k], send = up ? r8[k] : r8[k + 4]; r4[k] = keep + __shfl_xor(send, 16); } }
            { const bool up = (lane & 8) != 0;
#pragma unroll
              for (int k = 0; k < 2; ++k) { const float keep = up ? r4[k + 2] : r4[k], send = up ? r4[k] : r4[k + 2]; r2[k] = keep + __shfl_xor(send, 8); } }
            { const bool up = (lane & 4) != 0; const float keep = up ? r2[1] : r2[0], send = up ? r2[0] : r2[1]; r1 = keep + __shfl_xor(send, 4); }
            r1 += __shfl_xor(r1, 2); r1 += __shfl_xor(r1, 1);
            const float wmine = my_g * gelu_exact(r1 * su) * sv;
#pragma unroll
            for (int k = 0; k < 16; ++k) {
                const int lk = ((k >> 3) & 1) * 32 + ((k >> 2) & 1) * 16 + ((k >> 1) & 1) * 8 + (k & 1) * 4;
                const float w = __uint_as_float(__builtin_amdgcn_readlane(__float_as_uint(wmine), lk));
                float f[16]; fp8x16_to_f32(vb[k], f);
#pragma unroll
                for (int i = 0; i < 16; ++i) acc[i] += w * f[i];
            }
        }
        float* orow = p.out + tok * D + lane * 16;
        f32x4 y[4]; float ss = 0.f;
#pragma unroll
        for (int q = 0; q < 4; ++q) { f32x4 v = *(const f32x4*)(orow + 4 * q);
            v.x += acc[q * 4] * (1.0f / REP9); v.y += acc[q * 4 + 1] * (1.0f / REP9); v.z += acc[q * 4 + 2] * (1.0f / REP9); v.w += acc[q * 4 + 3] * (1.0f / REP9); y[q] = v; ss += (v.x * v.x + v.y * v.y) + (v.z * v.z + v.w * v.w); }
        const float rs = 1.0f / sqrtf(wave_sum(ss) * (1.0f / D) + RMS_EPS);
#pragma unroll
        for (int q = 0; q < 4; ++q) { const f32x4 gg = *(const f32x4*)(gfin + lane * 16 + 4 * q); f32x4 v = y[q];
            v.x *= rs * gg.x; v.y *= rs * gg.y; v.z *= rs * gg.z; v.w *= rs * gg.w; *(f32x4*)(orow + 4 * q) = v; }
    }
}


constexpr int P8_CHUNK = 16, P8_NCHUNK = NTOK / P8_CHUNK;
DI unsigned my_xcc() { return (unsigned)__builtin_amdgcn_s_getreg((3 << 11) | 20) & 7u; }
DI float dpp_xor1(float v) { return __int_as_float(__builtin_amdgcn_update_dpp(0, __float_as_int(v), 0xB1, 0xF, 0xF, true)); }
DI float dpp_xor2(float v) { return __int_as_float(__builtin_amdgcn_update_dpp(0, __float_as_int(v), 0x4E, 0xF, 0xF, true)); }
DI void fp8x16_to_f32x2(const u32x4& w, f32x2 (&f)[8]) {
#pragma unroll
    for (int j = 0; j < 4; ++j) { f[2 * j] = __builtin_amdgcn_cvt_pk_f32_fp8((int)w[j], false); f[2 * j + 1] = __builtin_amdgcn_cvt_pk_f32_fp8((int)w[j], true); }
}
DI unsigned q8_pack4(float a, float b, float c, float d, float s) {
    const unsigned ta = __float_as_uint(__builtin_fmaf(a, s, 12582912.0f)), tb = __float_as_uint(__builtin_fmaf(b, s, 12582912.0f));
    const unsigned tc = __float_as_uint(__builtin_fmaf(c, s, 12582912.0f)), td = __float_as_uint(__builtin_fmaf(d, s, 12582912.0f));
    const unsigned lo = __builtin_amdgcn_perm(tb, ta, 0x0c0c0400u), hi = __builtin_amdgcn_perm(td, tc, 0x0c0c0400u);
    return __builtin_amdgcn_perm(hi, lo, 0x05040100u);
}
DI void h_to_i8(const u32x4& hr0, const u32x4& hr1, u32x4& h8, float& hs) {
    float f[16];
    f[0] = bflo(hr0.x); f[1] = bfhi(hr0.x); f[2] = bflo(hr0.y); f[3] = bfhi(hr0.y); f[4] = bflo(hr0.z); f[5] = bfhi(hr0.z); f[6] = bflo(hr0.w); f[7] = bfhi(hr0.w);
    f[8] = bflo(hr1.x); f[9] = bfhi(hr1.x); f[10] = bflo(hr1.y); f[11] = bfhi(hr1.y); f[12] = bflo(hr1.z); f[13] = bfhi(hr1.z); f[14] = bflo(hr1.w); f[15] = bfhi(hr1.w);
    float am = 0.f;
#pragma unroll
    for (int i = 0; i < 16; i += 2) am = fmaxf(am, fmaxf(fabsf(f[i]), fabsf(f[i + 1])));
    const float s = am > 0.f ? 127.0f * __builtin_amdgcn_rcpf(am) : 0.f;
    hs = am * (1.0f / 127.0f);
    h8.x = q8_pack4(f[0], f[1], f[2], f[3], s); h8.y = q8_pack4(f[4], f[5], f[6], f[7], s); h8.z = q8_pack4(f[8], f[9], f[10], f[11], s); h8.w = q8_pack4(f[12], f[13], f[14], f[15], s);
}
struct HalfT { u32x4 rb[8]; float sc[8]; };
DI void p8a_issue(HalfT& B, const unsigned char* tus, const LAS float* tsc, const LAS unsigned* eoff, int ti, int hf, int pp, unsigned cc16, int gmine) {
#pragma unroll
    for (int g = 0; g < 8; ++g) { const unsigned o = eoff[ti * 128 + (hf * 8 + g) * 8 + pp] + cc16; B.rb[g] = *(const u32x4*)(tus + o); }
    B.sc[0] = *(const LAS float*)((const LAS unsigned char*)tsc + (eoff[ti * 128 + (hf * 8 + gmine) * 8 + pp] >> 5));
}
DI float p8a_compute(const HalfT& B, const u32x4& h8, float hs, int cc) {
    float d[8];
#pragma unroll
    for (int g = 0; g < 8; ++g) { int a = __builtin_amdgcn_sdot4((int)B.rb[g].x, (int)h8.x, 0, false); a = __builtin_amdgcn_sdot4((int)B.rb[g].y, (int)h8.y, a, false);
        a = __builtin_amdgcn_sdot4((int)B.rb[g].z, (int)h8.z, a, false); a = __builtin_amdgcn_sdot4((int)B.rb[g].w, (int)h8.w, a, false);
        d[g] = (float)a * hs; }
    float r4[4], r2[2];
    { const bool up = (cc & 1) != 0;
#pragma unroll
      for (int i = 0; i < 4; ++i) { const float keep = up ? d[i + 4] : d[i], send = up ? d[i] : d[i + 4]; r4[i] = keep + dpp_xor1(send); } }
    { const bool up = (cc & 2) != 0;
#pragma unroll
      for (int i = 0; i < 2; ++i) { const float keep = up ? r4[i + 2] : r4[i], send = up ? r4[i] : r4[i + 2]; r2[i] = keep + dpp_xor2(send); } }
    const bool up = (cc & 4) != 0; const float keep = up ? r2[1] : r2[0], send = up ? r2[0] : r2[1];
    return (keep + __shfl_xor(send, 4)) * B.sc[0];
}
DI void phase8a(const Params& p, unsigned char* lds_raw_, int rep) {
    unsigned char* ws = p.ws;
    const int lane = threadIdx.x & 63, pp = lane >> 3, cc = lane & 7;
    const bf16_t* h2 = (const bf16_t*)(ws + WS_H2); const unsigned char* tu = ws + WS_TABU; const float* tscg = (const float*)(ws + WS_TSCALE);
    const unsigned short* idx = (const unsigned short*)(ws + WS_IDX); bf16_t* pd = (bf16_t*)(ws + WS_PD);
    unsigned* ctr = (unsigned*)(ws + WS_CTL) + 1024 + 8192 * rep;
    LAS unsigned* eoff = (LAS unsigned*)((ldsp_t)lds_raw_ + __builtin_amdgcn_readfirstlane((int)(threadIdx.x >> 6)) * 12288);
    LAS unsigned char* hq = (LAS unsigned char*)eoff + 8192; LAS float* hsl = (LAS float*)((LAS unsigned char*)eoff + 10240);
    const unsigned cc16 = (unsigned)cc * 16u;
    LAS float* tsc = (LAS float*)((ldsp_t)lds_raw_ + 98304);
    for (int i = threadIdx.x; i < 4096; i += NTHREADS) ((LAS i32x4*)tsc)[i] = ((const i32x4*)tscg)[i];
    __syncthreads();
    const unsigned xs = my_xcc();
    const int gmine = ((cc & 1) << 2) | (cc & 2) | ((cc >> 2) & 1);
#pragma unroll 1
    for (int k8 = 0; k8 < 8; ++k8) {
        const int sl = (int)((xs + k8) & 7u);
#pragma unroll 1
        for (;;) {
            unsigned tk = 0; if (lane == 0) tk = atomicAdd(ctr + 64 * sl, 1u);
            const int chunk = (int)__builtin_amdgcn_readfirstlane(tk);
            if (chunk >= P8_NCHUNK) break;
            const size_t tok0 = (size_t)chunk * P8_CHUNK;
#pragma unroll
            for (int i = 0; i < 4; ++i) { const i32x4 w = ((const i32x4*)(idx + tok0 * 128))[i * 64 + lane];
                i32x4 lo, hi2; lo.x = (w.x & 0xffff) << 7; lo.y = (int)((unsigned)w.x >> 16) << 7; lo.z = (w.y & 0xffff) << 7; lo.w = (int)((unsigned)w.y >> 16) << 7;
                hi2.x = (w.z & 0xffff) << 7; hi2.y = (int)((unsigned)w.z >> 16) << 7; hi2.z = (w.w & 0xffff) << 7; hi2.w = (int)((unsigned)w.w >> 16) << 7;
                ((LAS i32x4*)eoff)[(i * 64 + lane) * 2] = lo; ((LAS i32x4*)eoff)[(i * 64 + lane) * 2 + 1] = hi2; }
            const unsigned char* tus = tu + (size_t)sl * (16384 * 128);
#pragma unroll
            for (int it = 0; it < 2; ++it) { const int j = lane + 64 * it; const bf16_t* hp = h2 + (tok0 + (j >> 3)) * D + sl * 128 + (j & 7) * 16;
                const u32x4 a0 = *(const u32x4*)hp, a1 = *(const u32x4*)(hp + 8); u32x4 q; float s_; h_to_i8(a0, a1, q, s_);
                ((LAS i32x4*)hq)[j] = __builtin_bit_cast(i32x4, q); hsl[j] = s_; }
            __builtin_amdgcn_wave_barrier();
            HalfT X, Y;
            p8a_issue(X, tus, tsc, eoff, 0, 0, pp, cc16, gmine);
#pragma unroll 1
            for (int ti = 0; ti < P8_CHUNK; ++ti) {
                const size_t tok = tok0 + ti;
                p8a_issue(Y, tus, tsc, eoff, ti, 1, pp, cc16, gmine);
                const u32x4 h8 = __builtin_bit_cast(u32x4, ((const LAS i32x4*)hq)[ti * 8 + cc]); const float hs = hsl[ti * 8 + cc];
                const float keep0 = p8a_compute(X, h8, hs, cc);
                if (ti + 1 < P8_CHUNK) p8a_issue(X, tus, tsc, eoff, ti + 1, 0, pp, cc16, gmine);
                const float keep1 = p8a_compute(Y, h8, hs, cc);
                bf16_t* po = pd + ((size_t)sl * NTOK + tok) * 128 + gmine * 8 + pp;
                po[0] = (bf16_t)f2bf(keep0); po[64] = (bf16_t)f2bf(keep1);
            }
            __builtin_amdgcn_wave_barrier();
        }
    }
}
DI void phase8w(const Params& p, unsigned char* lds_raw_) {
    unsigned char* ws = p.ws;
    const int lane = threadIdx.x & 63, wid = threadIdx.x >> 6;
    const int gwave = blockIdx.x * NWAVES + wid, nwaves = gridDim.x * NWAVES;
    const bf16_t* __restrict__ pd = (const bf16_t*)(ws + WS_PD); const float* __restrict__ tsc = (const float*)(ws + WS_TSCALE);
    const unsigned short* __restrict__ idx = (const unsigned short*)(ws + WS_IDX); const float* __restrict__ gw = (const float*)(ws + WS_GW);
    const float* __restrict__ rowss = (const float*)(ws + WS_ROWSS);
    LAS float* svl = (LAS float*)((ldsp_t)lds_raw_);
    for (int i = threadIdx.x; i < 4096; i += NTHREADS) ((LAS i32x4*)svl)[i] = ((const i32x4*)(tsc + 16384))[i];
    __syncthreads();
    for (int tk = gwave; tk < NTOK; tk += 4 * nwaves) {
        float pa[4][16]; int e0[4], e1[4]; float g0[4], g1[4]; float rs[4]; size_t tok[4];
#pragma unroll
        for (int q = 0; q < 4; ++q) { const int t = tk + q * nwaves; tok[q] = (size_t)(t < NTOK ? t : tk); }
#pragma unroll
        for (int q = 0; q < 4; ++q) {
#pragma unroll
            for (int sl = 0; sl < 8; ++sl) { const bf16_t* qa = pd + ((size_t)sl * NTOK + tok[q]) * 128 + lane; pa[q][2 * sl] = bf2f(qa[0]); pa[q][2 * sl + 1] = bf2f(qa[64]); }
            e0[q] = idx[tok[q] * 128 + lane]; e1[q] = idx[tok[q] * 128 + 64 + lane]; g0[q] = gw[tok[q] * 128 + lane]; g1[q] = gw[tok[q] * 128 + 64 + lane];
            rs[q] = rowss[tok[q] * 32 + (lane & 31)]; }
        float v0[4], v1[4];
#pragma unroll
        for (int q = 0; q < 4; ++q) { v0[q] = svl[e0[q]]; v1[q] = svl[e1[q]]; }
#pragma unroll
        for (int q = 0; q < 4; ++q) {
            float ss = rs[q];
#pragma unroll
            for (int o = 1; o < 32; o <<= 1) ss += __shfl_xor(ss, o);
            const float rstd = 1.0f / sqrtf(ss * (1.0f / D) + RMS_EPS);
            float a0 = 0.f, a1 = 0.f;
#pragma unroll
            for (int sl = 0; sl < 8; ++sl) { a0 += pa[q][2 * sl]; a1 += pa[q][2 * sl + 1]; }
            const float w0 = g0[q] * gelu_exact(a0 * rstd) * v0[q], w1 = g1[q] * gelu_exact(a1 * rstd) * v1[q];
            const float wm = wave_max(fmaxf(fabsf(w0), fabsf(w1)));
            const float qs = wm > 0.f ? 127.0f / wm : 0.f;
            if (tk + q * nwaves < NTOK) { signed char* w8 = (signed char*)(ws + WS_WPEER) + tok[q] * 128;
                w8[lane] = (signed char)(int)__builtin_rintf(w0 * qs); w8[64 + lane] = (signed char)(int)__builtin_rintf(w1 * qs);
                if (lane == 0) ((float*)(ws + WS_WPEER + 8 * MiB))[tok[q]] = wm * (1.0f / 127.0f); }
        }
    }
}
struct HalfB { u32x4 rb[8]; unsigned w4[2]; };
DI void p8b_issue(HalfB& B, const unsigned char* tvs, const LAS unsigned* eoff, const LAS unsigned* w8l, int tl, int step, unsigned cc16) {
#pragma unroll
    for (int j = 0; j < 8; ++j) { const unsigned o = eoff[tl * 128 + step * 8 + j] + cc16; B.rb[j] = *(const u32x4*)(tvs + o); }
    B.w4[0] = w8l[tl * 32 + step * 2]; B.w4[1] = w8l[tl * 32 + step * 2 + 1];
}
DI void p8b_compute(const HalfB& B, int (&acc)[16]) {
#pragma unroll
    for (int g = 0; g < 2; ++g)
#pragma unroll
        for (int cg = 0; cg < 4; ++cg) { const unsigned a = B.rb[4 * g][cg], b = B.rb[4 * g + 1][cg], c = B.rb[4 * g + 2][cg], d = B.rb[4 * g + 3][cg];
            const unsigned t0 = __builtin_amdgcn_perm(b, a, 0x05010400u), t1 = __builtin_amdgcn_perm(b, a, 0x07030602u), t2 = __builtin_amdgcn_perm(d, c, 0x05010400u), t3 = __builtin_amdgcn_perm(d, c, 0x07030602u);
            acc[4 * cg] = __builtin_amdgcn_sdot4((int)__builtin_amdgcn_perm(t2, t0, 0x05040100u), (int)B.w4[g], acc[4 * cg], false);
            acc[4 * cg + 1] = __builtin_amdgcn_sdot4((int)__builtin_amdgcn_perm(t2, t0, 0x07060302u), (int)B.w4[g], acc[4 * cg + 1], false);
            acc[4 * cg + 2] = __builtin_amdgcn_sdot4((int)__builtin_amdgcn_perm(t3, t1, 0x05040100u), (int)B.w4[g], acc[4 * cg + 2], false);
            acc[4 * cg + 3] = __builtin_amdgcn_sdot4((int)__builtin_amdgcn_perm(t3, t1, 0x07060302u), (int)B.w4[g], acc[4 * cg + 3], false); }
}
DI void phase8b(const Params& p, unsigned char* lds_raw_) {
    unsigned char* ws = p.ws;
    const int lane = threadIdx.x & 63, pp = lane >> 3, cc = lane & 7;
    const unsigned char* tvv = ws + WS_TABV;
    const unsigned short* idx = (const unsigned short*)(ws + WS_IDX); const unsigned char* wp8 = ws + WS_WPEER; const float* wsc = (const float*)(ws + WS_WPEER + 8 * MiB); float* ssp = (float*)(ws + WS_SS);
    unsigned* ctr = (unsigned*)(ws + WS_CTL) + 2048;
    LAS unsigned* eoff = (LAS unsigned*)((ldsp_t)lds_raw_ + __builtin_amdgcn_readfirstlane((int)(threadIdx.x >> 6)) * 16384);
    LAS unsigned* w8l = eoff + P8_CHUNK * 128;
    const unsigned cc16 = (unsigned)cc * 16u;
    const unsigned xs = my_xcc();
#pragma unroll 1
    for (int k8 = 0; k8 < 8; ++k8) {
        const int sl = (int)((xs + k8) & 7u);
#pragma unroll 1
        for (;;) {
            unsigned tk = 0; if (lane == 0) tk = atomicAdd(ctr + 64 * sl, 1u);
            const int chunk = (int)__builtin_amdgcn_readfirstlane(tk);
            if (chunk >= P8_NCHUNK) break;
            const size_t tok0 = (size_t)chunk * P8_CHUNK;
#pragma unroll
            for (int i = 0; i < 4; ++i) { const i32x4 w = ((const i32x4*)(idx + tok0 * 128))[i * 64 + lane];
                i32x4 lo, hi2; lo.x = (w.x & 0xffff) << 7; lo.y = (int)((unsigned)w.x >> 16) << 7; lo.z = (w.y & 0xffff) << 7; lo.w = (int)((unsigned)w.y >> 16) << 7;
                hi2.x = (w.z & 0xffff) << 7; hi2.y = (int)((unsigned)w.z >> 16) << 7; hi2.z = (w.w & 0xffff) << 7; hi2.w = (int)((unsigned)w.w >> 16) << 7;
                ((LAS i32x4*)eoff)[(i * 64 + lane) * 2] = lo; ((LAS i32x4*)eoff)[(i * 64 + lane) * 2 + 1] = hi2; }
            const unsigned char* tvs = tvv + (size_t)sl * (16384 * 128);
#pragma unroll
            for (int i = 0; i < 2; ++i) ((LAS i32x4*)w8l)[i * 64 + lane] = ((const i32x4*)(wp8 + tok0 * 128))[i * 64 + lane];
            __builtin_amdgcn_wave_barrier();
#pragma unroll 1
            for (int grp = 0; grp < P8_CHUNK / 8; ++grp) {
                const int tl = grp * 8 + pp; const size_t tok = tok0 + tl;
                HalfB X, Y;
                const float wscale = wsc[tok];
                p8b_issue(X, tvs, eoff, w8l, tl, 0, cc16);
                const float* xo = p.out + tok * D + sl * 128 + cc * 16;
                f32x4 xv[4];
#pragma unroll
                for (int i = 0; i < 4; ++i) xv[i] = *(const f32x4*)(xo + 4 * i);
                int acc[16];
#pragma unroll
                for (int i = 0; i < 16; ++i) acc[i] = 0;
#pragma unroll 1
                for (int step = 0; step < 16; step += 2) {
                    p8b_issue(Y, tvs, eoff, w8l, tl, step + 1, cc16);
                    p8b_compute(X, acc);
                    if (step + 2 < 16) p8b_issue(X, tvs, eoff, w8l, tl, step + 2, cc16);
                    p8b_compute(Y, acc);
                }
                float v[16]; float ss = 0.f;
#pragma unroll
                for (int i = 0; i < 4; ++i) { v[4 * i] = __builtin_fmaf((float)acc[4 * i], wscale, xv[i].x); v[4 * i + 1] = __builtin_fmaf((float)acc[4 * i + 1], wscale, xv[i].y); v[4 * i + 2] = __builtin_fmaf((float)acc[4 * i + 2], wscale, xv[i].z); v[4 * i + 3] = __builtin_fmaf((float)acc[4 * i + 3], wscale, xv[i].w); }
#pragma unroll
                for (int i = 0; i < 16; ++i) ss += v[i] * v[i];
                u32x4 o0, o1;
                o0.x = pk2(v[0], v[1]); o0.y = pk2(v[2], v[3]); o0.z = pk2(v[4], v[5]); o0.w = pk2(v[6], v[7]); o1.x = pk2(v[8], v[9]); o1.y = pk2(v[10], v[11]); o1.z = pk2(v[12], v[13]); o1.w = pk2(v[14], v[15]);
                bf16_t* x3 = (bf16_t*)(ws + WS_X3) + tok * D + sl * 128 + cc * 16;
                *(u32x4*)x3 = o0; *(u32x4*)(x3 + 8) = o1;
                ss += dpp_xor1(ss); ss += dpp_xor2(ss); ss += __shfl_xor(ss, 4);
                if (cc == 0) ssp[tok * 8 + sl] = ss;
            }
            __builtin_amdgcn_wave_barrier();
        }
    }
}
DI void phase8c(const Params& p) {
    unsigned char* ws = p.ws;
    const int lane = threadIdx.x & 63, wid = threadIdx.x >> 6;
    const int gwave = blockIdx.x * NWAVES + wid, nwaves = gridDim.x * NWAVES;
    const float* ssp = (const float*)(ws + WS_SS); const bf16_t* x3 = (const bf16_t*)(ws + WS_X3);
    f32x4 gg[4];
#pragma unroll
    for (int j = 0; j < 4; ++j) gg[j] = *(const f32x4*)(p.in[20] + (j >> 1) * 512 + lane * 8 + (j & 1) * 4);
    for (int tk = gwave; tk < NTOK; tk += 2 * nwaves) {
        const bool two = tk + nwaves < NTOK; const size_t tokA = (size_t)tk, tokB = (size_t)(two ? tk + nwaves : tk);
        const u32x4 a0 = *(const u32x4*)(x3 + tokA * D + lane * 8), a1 = *(const u32x4*)(x3 + tokA * D + 512 + lane * 8);
        const u32x4 b0 = *(const u32x4*)(x3 + tokB * D + lane * 8), b1 = *(const u32x4*)(x3 + tokB * D + 512 + lane * 8);
        const f32x4 sa0 = *(const f32x4*)(ssp + tokA * 8), sa1 = *(const f32x4*)(ssp + tokA * 8 + 4), sb0 = *(const f32x4*)(ssp + tokB * 8), sb1 = *(const f32x4*)(ssp + tokB * 8 + 4);
        const float rsa = 1.0f / sqrtf(((sa0.x + sa0.y) + (sa0.z + sa0.w) + (sa1.x + sa1.y) + (sa1.z + sa1.w)) * (1.0f / D) + RMS_EPS);
        const float rsb = 1.0f / sqrtf(((sb0.x + sb0.y) + (sb0.z + sb0.w) + (sb1.x + sb1.y) + (sb1.z + sb1.w)) * (1.0f / D) + RMS_EPS);
        float* oa = p.out + tokA * D + lane * 8; float* ob = p.out + tokB * D + lane * 8;
#define OUT8(O, W, RS, G0, G1) { f32x4 v0 = {bflo(W.x) * RS * G0.x, bfhi(W.x) * RS * G0.y, bflo(W.y) * RS * G0.z, bfhi(W.y) * RS * G0.w}; f32x4 v1 = {bflo(W.z) * RS * G1.x, bfhi(W.z) * RS * G1.y, bflo(W.w) * RS * G1.z, bfhi(W.w) * RS * G1.w}; *(f32x4*)(O) = v0; *(f32x4*)((O) + 4) = v1; }
        OUT8(oa, a0, rsa, gg[0], gg[1]) OUT8(oa + 512, a1, rsa, gg[2], gg[3])
        if (two) { OUT8(ob, b0, rsb, gg[0], gg[1]) OUT8(ob + 512, b1, rsb, gg[2], gg[3]) }
#undef OUT8
    }
}

#define XB_TMO      128
#define XB_XCNT(j)  (256  + 64 * (j))
#define XB_XSUB(j)  (1280 + 64 * (j))
#define XB_XGEN(j)  (2304 + 64 * (j))
#define XB_TOP      3328
#define XB_TOPGEN   3392
#define XCD_BAR_WORDS 3456
#define XB_SPIN_CAP (1u << 18)

__device__ __forceinline__ unsigned xb_ld(unsigned* p)              { return __hip_atomic_load(p, __ATOMIC_RELAXED, __HIP_MEMORY_SCOPE_AGENT); }
__device__ __forceinline__ unsigned xb_add(unsigned* p, unsigned v) { return __hip_atomic_fetch_add(p, v, __ATOMIC_RELAXED, __HIP_MEMORY_SCOPE_AGENT); }
__device__ __forceinline__ unsigned xb_xcc_id() { return (unsigned)__builtin_amdgcn_s_getreg((3 << 11) | 20) & 0xFu; }
#define XB_SPIN(cond, bar) do { unsigned _sp = 0; while (cond) { __builtin_amdgcn_s_sleep(1); \
    if ((++_sp & 255u) == 0u) { if (xb_ld(&(bar)[XB_TMO])) break; if (_sp > XB_SPIN_CAP) { atomicAdd(&(bar)[XB_TMO], 1u); break; } } } } while (0)

struct XcdBarrier {
    unsigned* bar; unsigned x;
    volatile unsigned* st;
};

__device__ __forceinline__ XcdBarrier xcd_barrier_post(unsigned* bar, volatile unsigned* st) {
    XcdBarrier b; b.bar = bar; b.x = xb_xcc_id(); b.st = st;
    if (threadIdx.x == 0) (void)xb_add(&bar[XB_XCNT(b.x)], 1u);
    return b;
}
__device__ __forceinline__ void xcd_barrier_complete(unsigned* bar, unsigned x, unsigned& nloc, unsigned& nx) {
    const unsigned G = gridDim.x * gridDim.y * gridDim.z;
    unsigned sum, cnt, mine, sp = 0u;
    for (;;) {
        sum = 0u; cnt = 0u; mine = 0u;
#pragma unroll
        for (unsigned j = 0; j < 16; ++j) { const unsigned c = xb_ld(&bar[XB_XCNT(j)]); sum += c; cnt += (c > 0u) ? 1u : 0u; mine = (j == x) ? c : mine; }
        if (sum == G) break;
        __builtin_amdgcn_s_sleep(1);
        if ((++sp & 255u) == 0u) { if (xb_ld(&bar[XB_TMO])) break; if (sp > XB_SPIN_CAP) { atomicAdd(&bar[XB_TMO], 1u); break; } }
    }
    nloc = mine > 0u ? mine : 1u; nx = cnt > 0u ? cnt : 1u;
}

__device__ __forceinline__ void xcd_barrier(const XcdBarrier& b) {
    asm volatile("s_waitcnt vmcnt(0)" ::: "memory");
    __syncthreads();
    if (threadIdx.x == 0) {
        unsigned* bar = b.bar;
        __builtin_amdgcn_s_waitcnt(0);
        unsigned nloc = b.st[0], nx = b.st[1];
        if (nloc == 0u) { xcd_barrier_complete(bar, b.x, nloc, nx); b.st[0] = nloc; b.st[1] = nx; }
        const unsigned old = xb_add(&bar[XB_XSUB(b.x)], 1u);
        const unsigned gen = old / nloc;
        if (old + 1u == (gen + 1u) * nloc) {
            __builtin_amdgcn_fence(__ATOMIC_RELEASE, "agent");
            asm volatile("s_waitcnt vmcnt(0)" ::: "memory");
            const unsigned og = xb_add(&bar[XB_TOP], 1u);
            const unsigned tg = og / nx;
            if (og + 1u == (tg + 1u) * nx) xb_add(&bar[XB_TOPGEN], 1u);
            else XB_SPIN(xb_ld(&bar[XB_TOPGEN]) == tg, bar);
            __builtin_amdgcn_fence(__ATOMIC_ACQUIRE, "agent");
            xb_add(&bar[XB_XGEN(b.x)], 1u);
            asm volatile("s_waitcnt vmcnt(0)" ::: "memory");
        } else {
            XB_SPIN(xb_ld(&bar[XB_XGEN(b.x)]) == gen, bar);
            __builtin_amdgcn_fence(__ATOMIC_ACQUIRE, "agent");
            asm volatile("s_waitcnt vmcnt(0)" ::: "memory");
        }
    }
    __syncthreads();
}

constexpr int N_PHASES = 13;
__global__ void __launch_bounds__(NTHREADS) mega(Params p) {
    extern __shared__ __attribute__((aligned(16))) unsigned char lds_raw[];
    bf16_t* lds = (bf16_t*)lds_raw;
#if N_LAUNCH_MODE == 1
    cg::grid_group grid = cg::this_grid();
    XcdBarrier xbar = xcd_barrier_post((unsigned*)(p.ws + WS_CTL) + 4096, (volatile unsigned*)(p.ws + WS_CTL) + 12288 + 2 * blockIdx.x);
    if (p.ph_lo == 0x7fffffff) grid.sync();
#define SEAM(k) do { if (p.ph_lo <= (k) && (k) + 1 < p.ph_hi) { xcd_barrier(xbar); } } while (0)
#else
#define SEAM(k) do { } while (0)
#endif
#ifndef PHASE_MASK
#define PHASE_MASK 0x1fff
#endif
#define IN(k) (((PHASE_MASK >> (k)) & 1) && p.ph_lo <= (k) && (k) < p.ph_hi)
    if (IN(0)) for (int rep = 0; rep < REP0; ++rep) phase0(p, lds_raw);
    SEAM(0);
    if (IN(1)) for (int rep = 0; rep < REP1; ++rep) phase1(p, lds);
    SEAM(1);
    if (IN(2)) for (int rep = 0; rep < REP2; ++rep) phase2(p, lds);
    SEAM(2);
    if (IN(3)) for (int rep = 0; rep < REP3; ++rep) phase3a(p, rep, lds);
    SEAM(3);
    if (IN(4)) for (int rep = 0; rep < REP4; ++rep) phase3b(p, rep, lds_raw);
    SEAM(4);
    if (IN(5)) for (int rep = 0; rep < REP5; ++rep) phase4(p, lds);
    SEAM(5);
    if (IN(6)) for (int rep = 0; rep < REP6; ++rep) phase5(p, lds);
    SEAM(6);
    if (IN(7)) for (int rep = 0; rep < REP7; ++rep) phase6(p, lds);
    SEAM(7);
    if (IN(8)) for (int rep = 0; rep < REP8; ++rep) { __syncthreads(); phase7(p, lds); }
    SEAM(8);
    if (IN(9)) for (int rep = 0; rep < REP9; ++rep) phase8a(p, lds_raw, rep);
    SEAM(9);
    if (IN(10)) for (int rep = 0; rep < REP10; ++rep) phase8w(p, lds_raw);
    SEAM(10);
    if (IN(11)) phase8b(p, lds_raw);
    SEAM(11);
    if (IN(12)) phase8c(p);
}

extern "C" void kernel_launch(void* const* d_in, const int* in_sizes, int n_in, void* d_out, int out_size, void* d_ws, size_t ws_size, hipStream_t stream) {
    static int grid = 0;
    if (grid == 0) {
        if (n_in != 21 || out_size != NTOK * D || ws_size < WS_END) { fprintf(stderr, "kernel_launch: unexpected shapes: n_in %d out %d ws %zu\n", n_in, out_size, ws_size); grid = -1; return; }
        int dev = 0, cus = 0, per_cu = 0;
        hipGetDevice(&dev);
        hipDeviceGetAttribute(&cus, hipDeviceAttributeMultiprocessorCount, dev);
        hipFuncSetAttribute((const void*)mega, hipFuncAttributeMaxDynamicSharedMemorySize, LDS_BYTES);
        hipOccupancyMaxActiveBlocksPerMultiprocessor(&per_cu, (const void*)mega, NTHREADS, LDS_BYTES);
        if (per_cu < 1) per_cu = 1;
        if (per_cu > 1) per_cu = 1;
        grid = cus * per_cu;
    }
    if (grid < 0) return;
    hipMemsetAsync((char*)d_ws + WS_CTL, 0, 65536, stream);
    Params p{};
    for (int i = 0; i < 21; ++i) p.in[i] = (const float*)d_in[i];
    p.out = (float*)d_out; p.ws = (unsigned char*)d_ws;
#if N_LAUNCH_MODE == 1
    p.ph_lo = 0; p.ph_hi = N_PHASES;
    void* args[] = {&p};
    hipError_t e = hipLaunchCooperativeKernel((const void*)mega, dim3(grid), dim3(NTHREADS), args, LDS_BYTES, stream);
    if (e != hipSuccess) fprintf(stderr, "cooperative launch failed: %s (grid %d)\n", hipGetErrorString(e), grid);
#else
    for (int ph = 0; ph < N_PHASES; ++ph) { p.ph_lo = ph; p.ph_hi = ph + 1; hipLaunchKernelGGL(mega, dim3(grid), dim3(NTHREADS), LDS_BYTES, stream, p); }
#endif
}
```

```cpp
#include <hip/hip_runtime.h>
#include <hip/hip_cooperative_groups.h>
#include <cstdio>
#include <cstdint>
namespace cg = cooperative_groups;

#ifndef N_LAUNCH_MODE
#define N_LAUNCH_MODE 1
#endif

#define REP0 1
#define REP1 1
#define REP2 1
#define REP3 1
#define REP4 1
#define REP5 1
#define REP6 1
#define REP7 1
#define REP8 1
#define REP9 1
#define REP10 1

typedef unsigned short bf16_t;
typedef short bf16x8 __attribute__((ext_vector_type(8)));
typedef short s16x4 __attribute__((ext_vector_type(4)));
typedef float f32x2 __attribute__((ext_vector_type(2)));
typedef float f32x4 __attribute__((ext_vector_type(4)));
typedef float f32x16 __attribute__((ext_vector_type(16)));
typedef unsigned u32x2 __attribute__((ext_vector_type(2)));
typedef unsigned u32x4 __attribute__((ext_vector_type(4)));
typedef int i32x4 __attribute__((ext_vector_type(4)));
typedef __bf16 bf16x2_t __attribute__((ext_vector_type(2)));
#define DI __device__ __forceinline__
#define LAS __attribute__((address_space(3)))

constexpr int NB = 8, T = 4096, D = 1024, NTOK = NB * T;
constexpr int MEMT = 256;
constexpr int NTHREADS = 512, NWAVES = 8;
constexpr int LDP_QKV = 2560;
constexpr int C_SBQ = 0, C_SBK = 384, C_SBV = 768, C_NQ = 1152, C_NKV = 1536, C_MQ = 2304;
constexpr int LDG = 3072;
constexpr int NPROJ = 5888;
constexpr int IN_DIM = 5650;
constexpr float RMS_EPS = 1e-6f;
constexpr float LOG2E = 1.4426950408889634f, LN2 = 0.6931471805599453f;

constexpr size_t MiB = 1u << 20;
constexpr size_t WS_CTL = 0;
constexpr size_t WS_WIN = 1 * MiB;
constexpr size_t WS_WQ = WS_WIN + 12 * MiB;
constexpr size_t WS_WOUT = WS_WQ + 4 * MiB;
constexpr size_t WS_WSB = WS_WOUT + 2 * MiB;
constexpr size_t WS_WNSA = WS_WSB + 1 * MiB;
constexpr size_t WS_WMEM = WS_WNSA + 1 * MiB;
constexpr size_t WS_WMKV = WS_WMEM + 1 * MiB;
constexpr size_t WS_SUBK = WS_WMKV + 1 * MiB;
constexpr size_t WS_CMPW = WS_SUBK + MiB / 2;
constexpr size_t WS_H = 24 * MiB;
constexpr size_t WS_QKV = 88 * MiB;
constexpr size_t WS_MERGED = WS_QKV;
constexpr size_t WS_IDX = WS_QKV + 64 * MiB;
constexpr size_t WS_GW = WS_QKV + 80 * MiB;
constexpr size_t WS_ROWSS = WS_QKV + 96 * MiB;
constexpr size_t WS_GATES = 248 * MiB;
constexpr size_t WS_H2 = WS_GATES;
constexpr size_t WS_QP = WS_GATES + 64 * MiB;
constexpr size_t WS_TABU = 440 * MiB;
constexpr size_t WS_TABV = 456 * MiB;
constexpr size_t WS_PD = WS_GATES + 64 * MiB;
constexpr size_t WS_WPEER = WS_QKV;
constexpr size_t WS_SS = WS_QKV + 32 * MiB;
constexpr size_t WS_X3 = WS_H2;
constexpr size_t WS_H8 = 344 * MiB;
constexpr size_t WS_HSC = 376 * MiB;
constexpr size_t WS_W8 = 377 * MiB;
constexpr size_t WS_W8SC = 384 * MiB;
constexpr size_t WS_WMKV8 = 385 * MiB;
constexpr size_t WS_MEMN8 = 387 * MiB;
constexpr size_t WS_TSCALE = 472 * MiB;
constexpr size_t WS_END = 504 * MiB;
constexpr size_t DO_VSLC = 0;
constexpr size_t DO_VWIN = 8 * MiB;
constexpr size_t DO_SBV = 16 * MiB;
constexpr size_t DO_KC = 40 * MiB;
constexpr size_t DO_VCT = 41 * MiB;
constexpr size_t DO_MEMN = 42 * MiB;
constexpr size_t DO_MKV = 46 * MiB;
constexpr size_t DO_MVT = 48 * MiB;
constexpr size_t DO_NSAG = 50 * MiB;
constexpr size_t DO_SELM = 54 * MiB;
constexpr size_t DO_OC = 56 * MiB;
constexpr size_t DO_KSLC = 80 * MiB;
constexpr size_t DO_KWIN = 88 * MiB;
constexpr size_t DO_MKT = 120 * MiB;
constexpr size_t DO_SBK = 96 * MiB;

constexpr int LDS_MAIN = 131072;
constexpr int LDS_BYTES = 163840;

struct Params {
    const float* in[21];
    float* out;
    unsigned char* ws;
    int ph_lo, ph_hi;
};

DI unsigned f2bf(float f) { unsigned u = __float_as_uint(f); return (u + 0x7fffu + ((u >> 16) & 1u)) >> 16; }
DI unsigned pk2(float lo, float hi) { f32x2 v = {lo, hi}; bf16x2_t b = __builtin_convertvector(v, bf16x2_t); return __builtin_bit_cast(unsigned, b); }
DI float bf2f(unsigned short h) { return __uint_as_float((unsigned)h << 16); }
DI float bflo(unsigned w) { return __uint_as_float(w << 16); }
DI float bfhi(unsigned w) { return __uint_as_float(w & 0xffff0000u); }
DI float wave_sum(float v) {
#pragma unroll
    for (int o = 1; o < 64; o <<= 1) v += __shfl_xor(v, o);
    return v;
}
DI float fexp2(float x) { return __builtin_amdgcn_exp2f(x); }
DI float flog2(float x) { return __builtin_amdgcn_logf(x); }
DI float fexp(float x) { return __builtin_amdgcn_exp2f(x * LOG2E); }
DI float sigmoidf_(float x) { return 1.0f / (1.0f + fexp(-x)); }
DI int krow(int r, int hi) { return (r & 3) + 8 * (r >> 2) + 4 * hi; }
#define MFMA32(a, b, c) __builtin_amdgcn_mfma_f32_32x32x16_bf16((a), (b), (c), 0, 0, 0)
#define MFMA16(a, b, c) __builtin_amdgcn_mfma_f32_16x16x32_bf16((a), (b), (c), 0, 0, 0)

DI void zero16(f32x16& v) {
#pragma unroll
    for (int i = 0; i < 16; ++i) v[i] = 0.f;
}
DI unsigned pack_i8x4(float a, float b, float c, float d) {
    const int ia = (int)__builtin_rintf(a), ib = (int)__builtin_rintf(b), ic = (int)__builtin_rintf(c), id = (int)__builtin_rintf(d);
    return ((unsigned)ia & 0xffu) | (((unsigned)ib & 0xffu) << 8) | (((unsigned)ic & 0xffu) << 16) | ((unsigned)id << 24);
}
DI float wave_max(float v) {
#pragma unroll
    for (int o = 1; o < 64; o <<= 1) v = fmaxf(v, __shfl_xor(v, o));
    return v;
}
DI void rms_row_i8(const float* xrow, const float* g, unsigned* o8row, float* scale, int lane) {
    const f32x4* xr = (const f32x4*)xrow + lane;
    const f32x4* gr = (const f32x4*)g + lane;
    f32x4 v[4]; float s = 0.f;
#pragma unroll
    for (int j = 0; j < 4; ++j) { v[j] = xr[64 * j]; s += (v[j].x * v[j].x + v[j].y * v[j].y) + (v[j].z * v[j].z + v[j].w * v[j].w); }
    const float rstd = 1.0f / sqrtf(wave_sum(s) * (1.0f / D) + RMS_EPS);
    float am = 0.f;
#pragma unroll
    for (int j = 0; j < 4; ++j) { const f32x4 gg = gr[64 * j]; v[j].x *= rstd * gg.x; v[j].y *= rstd * gg.y; v[j].z *= rstd * gg.z; v[j].w *= rstd * gg.w;
        am = fmaxf(am, fmaxf(fmaxf(fabsf(v[j].x), fabsf(v[j].y)), fmaxf(fabsf(v[j].z), fabsf(v[j].w)))); }
    am = wave_max(am);
    const float qs = am > 0.f ? 127.0f / am : 0.f;
#pragma unroll
    for (int j = 0; j < 4; ++j) o8row[lane + 64 * j] = pack_i8x4(v[j].x * qs, v[j].y * qs, v[j].z * qs, v[j].w * qs);
    if (lane == 0) scale[0] = am * (1.0f / 127.0f);
}
template <bool MAP> DI void quant_cols_i8(const float* W, int ldw, int ncol, unsigned char* dst8, float* dsc, float* red) {
    const int c = threadIdx.x & 15, kg = threadIdx.x >> 4;
    for (int cb = blockIdx.x; cb < ncol / 16; cb += gridDim.x) {
        const int col = cb * 16 + c; int srcc = col;
        if (MAP) { if (col < 2304) srcc = col; else if (col < 2560) srcc = 2322 + (col - 2304); else if (col < 5632) srcc = 2578 + (col - 2560); else if (col < 5650) srcc = 2304 + (col - 5632); else srcc = -1; }
        const float* src = W + (size_t)(kg * 32) * ldw + (srcc < 0 ? 0 : srcc);
        float v[32]; float am = 0.f;
#pragma unroll
        for (int i = 0; i < 32; ++i) { v[i] = srcc < 0 ? 0.f : src[(size_t)i * ldw]; am = fmaxf(am, fabsf(v[i])); }
        __syncthreads();
        red[kg * 16 + c] = am;
        __syncthreads();
#pragma unroll
        for (int i = 0; i < 32; ++i) am = fmaxf(am, red[i * 16 + c]);
        const float qs = am > 0.f ? 127.0f / am : 0.f;
        u32x4 w0, w1;
        w0.x = pack_i8x4(v[0] * qs, v[1] * qs, v[2] * qs, v[3] * qs); w0.y = pack_i8x4(v[4] * qs, v[5] * qs, v[6] * qs, v[7] * qs); w0.z = pack_i8x4(v[8] * qs, v[9] * qs, v[10] * qs, v[11] * qs); w0.w = pack_i8x4(v[12] * qs, v[13] * qs, v[14] * qs, v[15] * qs);
        w1.x = pack_i8x4(v[16] * qs, v[17] * qs, v[18] * qs, v[19] * qs); w1.y = pack_i8x4(v[20] * qs, v[21] * qs, v[22] * qs, v[23] * qs); w1.z = pack_i8x4(v[24] * qs, v[25] * qs, v[26] * qs, v[27] * qs); w1.w = pack_i8x4(v[28] * qs, v[29] * qs, v[30] * qs, v[31] * qs);
        u32x4* dst = (u32x4*)(dst8 + (size_t)col * 1024 + kg * 32); dst[0] = w0; dst[1] = w1;
        if (kg == 0) dsc[col] = am * (1.0f / 127.0f);
    }
}
DI void rms_row_bf16(const float* xrow, const float* g, bf16_t* orow, int lane) {
    const f32x4* xr = (const f32x4*)xrow + lane;
    const f32x4* gr = (const f32x4*)g + lane;
    f32x4 v[4]; float s = 0.f;
#pragma unroll
    for (int j = 0; j < 4; ++j) { v[j] = xr[64 * j]; s += (v[j].x * v[j].x + v[j].y * v[j].y) + (v[j].z * v[j].z + v[j].w * v[j].w); }
    const float rstd = 1.0f / sqrtf(wave_sum(s) * (1.0f / D) + RMS_EPS);
    u32x2* o8 = (u32x2*)orow + lane;
#pragma unroll
    for (int j = 0; j < 4; ++j) { const f32x4 gg = gr[64 * j]; u32x2 w; w.x = pk2(v[j].x * rstd * gg.x, v[j].y * rstd * gg.y); w.y = pk2(v[j].z * rstd * gg.z, v[j].w * rstd * gg.w); o8[64 * j] = w; }
}
DI void transpose_w(const float* W, int K, int N, bf16_t* Wt, int gtid, int gthreads, float sc = 1.0f) {
    const int total = (K / 8) * N;
    for (int it = gtid; it < total; it += gthreads) {
        const int n = it % N, k8 = it / N;
        const float* s = W + (size_t)(k8 * 8) * N + n;
        u32x4 o; o.x = pk2(s[0] * sc, s[(size_t)N] * sc); o.y = pk2(s[(size_t)2 * N] * sc, s[(size_t)3 * N] * sc); o.z = pk2(s[(size_t)4 * N] * sc, s[(size_t)5 * N] * sc); o.w = pk2(s[(size_t)6 * N] * sc, s[(size_t)7 * N] * sc);
        *(u32x4*)(Wt + (size_t)n * K + k8 * 8) = o;
    }
}
DI void late_weights(const Params& p, int gtid, int gthreads) {
    unsigned char* ws = p.ws;
    transpose_w(p.in[16], D, 2048, (bf16_t*)(ws + WS_WQ), gtid, gthreads);
    transpose_w(p.in[14], D, D, (bf16_t*)(ws + WS_WOUT), gtid, gthreads);
    transpose_w(p.in[11], 384, D, (bf16_t*)(ws + WS_WSB), gtid, gthreads, 1.0f / 255.0f);
    transpose_w(p.in[12], 384, D, (bf16_t*)(ws + WS_WNSA), gtid, gthreads, 1.0f / 255.0f);
    transpose_w(p.in[13], 256, D, (bf16_t*)(ws + WS_WMEM), gtid, gthreads, 1.0f / 255.0f);
    transpose_w(p.in[8], 2048, 64, (bf16_t*)(ws + WS_CMPW), gtid, gthreads);
    transpose_w(p.in[9], 2048, 64, (bf16_t*)(ws + WS_CMPW) + 64 * 2048, gtid, gthreads);
    {
        const f32x4* s = (const f32x4*)p.in[17]; u32x2* o = (u32x2*)(ws + WS_SUBK);
        for (int i = gtid; i < 8 * 2 * 128 * 128 / 4; i += gthreads) { const f32x4 v = s[i]; u32x2 w; w.x = pk2(v.x, v.y); w.y = pk2(v.z, v.w); o[i] = w; }
    }
}
DI void phase0(const Params& p, unsigned char* lds_raw_) {
    const int gtid = blockIdx.x * NTHREADS + threadIdx.x, gthreads = gridDim.x * NTHREADS;
    const int lane = threadIdx.x & 63, gwave = gtid >> 6, nwaves = gthreads >> 6;
    unsigned char* ws = p.ws;
    quant_cols_i8<true>(p.in[4], IN_DIM, NPROJ, ws + WS_W8, (float*)(ws + WS_W8SC), (float*)lds_raw_);
    quant_cols_i8<false>(p.in[10], 512, 512, ws + WS_WMKV8, (float*)(ws + WS_WMKV8 + MiB), (float*)lds_raw_);
    for (int row = gwave; row < NTOK; row += nwaves) rms_row_i8(p.in[0] + (size_t)row * D, p.in[2], (unsigned*)(ws + WS_H8) + (size_t)row * (D / 4), (float*)(ws + WS_HSC) + row, lane);
    for (int row = gwave; row < NB * MEMT; row += nwaves) rms_row_i8(p.in[1] + (size_t)row * D, p.in[3], (unsigned*)(ws + WS_MEMN8) + (size_t)row * (D / 4), (float*)(ws + WS_MEMN8 + 2 * MiB) + row, lane);
}
DI void peer_table_rows(const Params& p, int lane, int first, int stride) {
    unsigned char* ws = p.ws;
    unsigned char* tabu = ws + WS_TABU; unsigned char* tabv = ws + WS_TABV; float* tsc = (float*)(ws + WS_TSCALE);
#pragma unroll 1
    for (int row0 = first; row0 < 32768; row0 += 4 * stride) {
        f32x4 v[4][4];
#pragma unroll
        for (int q = 0; q < 4; ++q) { const int row = row0 + q * stride < 32768 ? row0 + q * stride : row0; const bool isv = row >= 16384; const int e = row & 16383;
            const f32x4* src = (const f32x4*)((isv ? p.in[19] : p.in[18]) + (size_t)e * 1024 + lane * 16);
#pragma unroll
            for (int j = 0; j < 4; ++j) v[q][j] = src[j]; }
#pragma unroll
        for (int q = 0; q < 4; ++q) { const int row = row0 + q * stride; const bool isv = row >= 16384; const int e = row & 16383;
            float am = 0.f;
#pragma unroll
            for (int j = 0; j < 4; ++j) am = fmaxf(am, fmaxf(fmaxf(fabsf(v[q][j].x), fabsf(v[q][j].y)), fmaxf(fabsf(v[q][j].z), fabsf(v[q][j].w))));
#pragma unroll
            for (int o = 1; o < 64; o <<= 1) am = fmaxf(am, __shfl_xor(am, o));
            const float top = 127.0f;
            const float sc = am > 0.f ? top / am : 1.0f;
            u32x4 w;
#pragma unroll
            for (int j = 0; j < 4; ++j) w[j] = pack_i8x4(v[q][j].x * sc, v[q][j].y * sc, v[q][j].z * sc, v[q][j].w * sc);
            if (row < 32768) { *(u32x4*)((isv ? tabv : tabu) + (size_t)(lane >> 3) * (16384 * 128) + (size_t)e * 128 + (lane & 7) * 16) = w;
                if (lane == 0) tsc[row] = am > 0.f ? am / top : 1.0f; }
        }
    }
}

constexpr int GEMM_LDS_ROW = 72;
constexpr int GEMM_TILE_ELEMS = 128 * GEMM_LDS_ROW;
DI void gemm_mainloop(const bf16_t* __restrict__ Ag, int lda, const bf16_t* __restrict__ Bg, int ldb, int K, f32x4 (&acc)[4][2], bf16_t* lds) {
    const int tid = threadIdx.x, lane = tid & 63, wid = tid >> 6, wr = wid >> 2, wc = wid & 3;
    const int r0 = tid >> 3, kc = tid & 7;
    const bf16_t* ap0 = Ag + (size_t)r0 * lda + kc * 8; const bf16_t* ap1 = ap0 + (size_t)64 * lda;
    const bf16_t* bp0 = Bg + (size_t)r0 * ldb + kc * 8; const bf16_t* bp1 = bp0 + (size_t)64 * ldb;
    const int so0 = r0 * GEMM_LDS_ROW + kc * 8, so1 = so0 + 64 * GEMM_LDS_ROW;
    u32x4 ra0, ra1, rb0, rb1;
    ra0 = *(const u32x4*)ap0; ra1 = *(const u32x4*)ap1; rb0 = *(const u32x4*)bp0; rb1 = *(const u32x4*)bp1;
    __syncthreads();
    {
        bf16_t* As = lds; bf16_t* Bs = lds + GEMM_TILE_ELEMS;
        *(u32x4*)(As + so0) = ra0; *(u32x4*)(As + so1) = ra1; *(u32x4*)(Bs + so0) = rb0; *(u32x4*)(Bs + so1) = rb1;
    }
    __syncthreads();
    const int nk = K / 64;
    const int fr = lane & 15, fq = lane >> 4;
    for (int kt = 0; kt < nk; ++kt) {
        const int buf = kt & 1;
        if (kt + 1 < nk) { const int ko = (kt + 1) * 64; ra0 = *(const u32x4*)(ap0 + ko); ra1 = *(const u32x4*)(ap1 + ko); rb0 = *(const u32x4*)(bp0 + ko); rb1 = *(const u32x4*)(bp1 + ko); }
        const bf16_t* As = lds + buf * 2 * GEMM_TILE_ELEMS; const bf16_t* Bs = As + GEMM_TILE_ELEMS;
#pragma unroll
        for (int kk = 0; kk < 2; ++kk) {
            bf16x8 af[4], bfr[2];
#pragma unroll
            for (int m = 0; m < 4; ++m) af[m] = *(const bf16x8*)(As + (wr * 64 + m * 16 + fr) * GEMM_LDS_ROW + kk * 32 + fq * 8);
#pragma unroll
            for (int n = 0; n < 2; ++n) bfr[n] = *(const bf16x8*)(Bs + (wc * 32 + n * 16 + fr) * GEMM_LDS_ROW + kk * 32 + fq * 8);
#pragma unroll
            for (int m = 0; m < 4; ++m)
#pragma unroll
                for (int n = 0; n < 2; ++n) acc[m][n] = MFMA16(bfr[n], af[m], acc[m][n]);
        }
        if (kt + 1 < nk) {
            bf16_t* An = lds + (buf ^ 1) * 2 * GEMM_TILE_ELEMS; bf16_t* Bn = An + GEMM_TILE_ELEMS;
            *(u32x4*)(An + so0) = ra0; *(u32x4*)(An + so1) = ra1; *(u32x4*)(Bn + so0) = rb0; *(u32x4*)(Bn + so1) = rb1;
        }
        __syncthreads();
    }
}
DI void zero_acc(f32x4 (&acc)[4][2]) {
#pragma unroll
    for (int m = 0; m < 4; ++m)
#pragma unroll
        for (int n = 0; n < 2; ++n) acc[m][n] = (f32x4){0.f, 0.f, 0.f, 0.f};
}
DI void tile_coords(int tile, int ntn, int& pm, int& pn) { const int per = 8 * ntn, g = tile / per, r = tile % per; pm = g * 8 + (r & 7); pn = r >> 3; }
DI void store_bf16x4(bf16_t* p, f32x4 v) { u32x2 w; w.x = pk2(v.x, v.y); w.y = pk2(v.z, v.w); *(u32x2*)p = w; }

namespace pg8 {
#define PG8_LAS __attribute__((address_space(3)))
typedef short bf16x8 __attribute__((ext_vector_type(8)));
typedef float f32x4 __attribute__((ext_vector_type(4)));
typedef unsigned u32x4 __attribute__((ext_vector_type(4)));
typedef int i32x4v __attribute__((ext_vector_type(4)));
constexpr int BM = 256, BK = 64, HALF = 128, HTB = HALF * BK * 2  , STAGE_BYTES = 8 * HTB, NXCD = 8, WGM = 8;

__host__ __device__ __forceinline__ int lds_byte(int r, int c) { const int st = (r >> 4) * 2 + (c >> 5), rr = r & 15, cc = c & 31, ob = rr * 64 + cc * 2; return st * 1024 + (ob ^ (((ob >> 9) & 1) << 5)); }
__host__ __device__ __forceinline__ void stage_rc(int b, int& R, int& C) { const int st = b / 1024, sb = b % 1024, swz = sb ^ (((sb >> 9) & 1) << 5); R = (st >> 1) * 16 + swz / 64; C = (st & 1) * 32 + (swz % 64) / 2; }
__host__ __device__ __forceinline__ int perm32(int rho) { const int n = rho >> 4, i = rho & 15; return 8 * (i >> 2) + 4 * n + (i & 3); }

struct Unit { int pm, pn; };
struct Gemm { const bf16_t* A; const bf16_t* Bt; int M, N, K, lda, ldb; };

struct StaticOrder {
    int nM, nN, nwg, G, c;
    __host__ __device__ void init(int M, int N, int G_, int c_) { nM = M / BM; nN = N / BM; nwg = nM * nN; G = G_; c = c_; }
    __host__ __device__ bool next(int i, Unit& u) const {
        const long L = (long)i * G + c; if (L >= nwg) return false;
        int wgid = (int)L; { const int q = nwg / NXCD, r = nwg % NXCD, xcd = wgid % NXCD, off = wgid / NXCD; wgid = (xcd < r ? xcd * (q + 1) : r * (q + 1) + (xcd - r) * q) + off; }
        const int nig = WGM * nN, gid = wgid / nig, fm = gid * WGM, gsz = (nM - fm) < WGM ? (nM - fm) : WGM;
        u.pm = fm + ((wgid % nig) % gsz); u.pn = (wgid % nig) / gsz; return true;
    }
    __device__ __forceinline__ void a_ready(const Unit&) const {}
    __device__ __forceinline__ void done(const Unit&) const {}
};


template <class Epi, class Sched, bool ALIGN_EPI = false, bool SP2 = false, bool I8 = false>
__device__ __forceinline__ void gemm_phase(PG8_LAS unsigned char* lds, const Gemm g, const Sched& S, const Epi& E) {
    const int tid = threadIdx.x, wid = __builtin_amdgcn_readfirstlane(tid >> 6), lane = tid & 63, wr = wid >> 2, wc = wid & 3, fr = lane & 15, fq = lane >> 4;
    const int K = g.K, nt = K / BK;
    unsigned voffA[2], voffB[2];
#pragma unroll
    for (int i = 0; i < 2; ++i) { int R, C; stage_rc(tid * 16 + i * 8192, R, C); const int Rb = Epi::PERM ? ((R & ~31) + perm32(R & 31)) : R;
        voffA[i] = (unsigned)(R * g.lda + C) * 2u; voffB[i] = (unsigned)(Rb * g.ldb + C) * 2u; }
    const size_t kstep = (size_t)(BK * 2);
    const size_t hstepA = (size_t)HALF * g.lda * 2, hstepB = (size_t)HALF * g.ldb * 2;
    const size_t tstepA = 2 * hstepA, tstepB = 2 * hstepB;
    const unsigned ldsw = (unsigned)wid * 1024u;
    const int aoff = lds_byte(wr * 64 + fr, fq * 8), boff = lds_byte(wc * 32 + fr, fq * 8);
#define PG8_SA(b, h) (((b) * 2 + (h)) * HTB)
#define PG8_SB(b, h) ((4 + (b) * 2 + (h)) * HTB)
#define PG8_STAGE(bufoff, gbase, voff) do { _Pragma("unroll") for (int _i = 0; _i < 2; ++_i) \
        __builtin_amdgcn_global_load_lds((const unsigned*)((const char*)(gbase) + (voff)[_i]), (PG8_LAS unsigned*)(lds + (bufoff) + ldsw + _i * 8192), 16, 0, 0); } while (0)
#define PG8_LDA(dst, b, h) do { _Pragma("unroll") for (int m = 0; m < 4; ++m) _Pragma("unroll") for (int k = 0; k < 2; ++k) dst[m][k] = *(const PG8_LAS bf16x8*)(lds + PG8_SA(b, h) + aoff + m * 2048 + k * 1024); } while (0)
#define PG8_LDB(dst, b, h) do { _Pragma("unroll") for (int n = 0; n < 2; ++n) _Pragma("unroll") for (int k = 0; k < 2; ++k) dst[n][k] = *(const PG8_LAS bf16x8*)(lds + PG8_SB(b, h) + boff + n * 2048 + k * 1024); } while (0)
#define PG8_MMA(ai, bj, At, Bt) do { __builtin_amdgcn_s_setprio(1); _Pragma("unroll") for (int m = 0; m < 4; ++m) _Pragma("unroll") for (int n = 0; n < 2; ++n) _Pragma("unroll") for (int k = 0; k < 2; ++k) \
        { if constexpr (I8) acc[ai][bj][m][n] = __builtin_bit_cast(f32x4, __builtin_amdgcn_mfma_i32_16x16x64_i8(__builtin_bit_cast(i32x4v, Bt[n][k]), __builtin_bit_cast(i32x4v, At[m][k]), __builtin_bit_cast(i32x4v, acc[ai][bj][m][n]), 0, 0, 0)); \
          else acc[ai][bj][m][n] = __builtin_amdgcn_mfma_f32_16x16x32_bf16(Bt[n][k], At[m][k], acc[ai][bj][m][n], 0, 0, 0); } __builtin_amdgcn_s_setprio(0); } while (0)
#define PG8_WAIT_V(n) asm volatile("s_waitcnt vmcnt(" #n ")" ::: "memory")
#define PG8_WAIT_L(n) asm volatile("s_waitcnt lgkmcnt(" #n ")" ::: "memory")
#define PG8_BAR __builtin_amdgcn_s_barrier()
#define PG8_SCHED __builtin_amdgcn_sched_barrier(0)
    Unit cur, nxt; int ui = 0;
    if (!S.next(0, cur)) return;
    f32x4 acc[2][2][4][2];
    if constexpr (Epi::INIT) E.init(acc, cur, wr, wc, fr, fq);
    else {
#pragma unroll
    for (int a = 0; a < 2; ++a)
#pragma unroll
        for (int b = 0; b < 2; ++b)
#pragma unroll
            for (int m = 0; m < 4; ++m)
#pragma unroll
                for (int n = 0; n < 2; ++n) acc[a][b][m][n] = (f32x4){0.f, 0.f, 0.f, 0.f};
    }
    bf16x8 At[4][2], B0[2][2], B1[2][2];
    const char* cA = (const char*)g.A + (size_t)cur.pm * tstepA; const char* cB = (const char*)g.Bt + (size_t)cur.pn * tstepB;
    S.a_ready(cur);
    if constexpr (SP2) {
        PG8_STAGE(PG8_SB(0, 0), cB, voffB); PG8_STAGE(PG8_SB(0, 1), cB + hstepB, voffB); PG8_STAGE(PG8_SA(0, 0), cA, voffA); PG8_STAGE(PG8_SA(0, 1), cA + hstepA, voffA);
        if (wr == 1) PG8_BAR;
        PG8_WAIT_V(2); PG8_BAR;
        PG8_STAGE(PG8_SB(1, 0), cB + kstep, voffB); PG8_STAGE(PG8_SA(1, 0), cA + kstep, voffA); PG8_STAGE(PG8_SB(1, 1), cB + hstepB + kstep, voffB);
        PG8_WAIT_V(6); PG8_BAR;
    } else {
        PG8_STAGE(PG8_SB(0, 0), cB, voffB); PG8_STAGE(PG8_SA(0, 0), cA, voffA); PG8_STAGE(PG8_SB(0, 1), cB + hstepB, voffB); PG8_STAGE(PG8_SA(0, 1), cA + hstepA, voffA);
        if (wr == 1) PG8_BAR;
        PG8_WAIT_V(4); PG8_BAR;
        PG8_STAGE(PG8_SB(1, 0), cB + kstep, voffB); PG8_STAGE(PG8_SA(1, 0), cA + kstep, voffA); PG8_STAGE(PG8_SB(1, 1), cB + hstepB + kstep, voffB);
        PG8_WAIT_V(6); PG8_BAR;
    }
    for (;;) {
        const bool has_next = S.next(ui + 1, nxt);
        const char* nA = has_next ? (const char*)g.A + (size_t)nxt.pm * tstepA : cA; const char* nB = has_next ? (const char*)g.Bt + (size_t)nxt.pn * tstepB : cB;
        for (int t = 0; t < nt; t += 2) {
            const bool last = (t == nt - 2);
            const char* a1 = cA + (size_t)(t + 1) * kstep;
            const char* a2 = last ? nA : cA + (size_t)(t + 2) * kstep; const char* b2 = last ? nB : cB + (size_t)(t + 2) * kstep;
            const char* a3 = a2 + kstep; const char* b3 = b2 + kstep;
            if (last && has_next) S.a_ready(nxt);
            if constexpr (SP2) {
            PG8_LDB(B0, 0, 0); PG8_LDB(B1, 0, 1); PG8_SCHED; PG8_LDA(At, 0, 0); PG8_STAGE(PG8_SA(1, 1), a1 + hstepA, voffA);
            PG8_WAIT_V(8); PG8_WAIT_L(0); PG8_BAR; PG8_MMA(0, 0, At, B0); PG8_MMA(0, 1, At, B1); PG8_BAR; PG8_SCHED;
            PG8_LDA(At, 0, 1); PG8_STAGE(PG8_SB(0, 0), b2, voffB); PG8_STAGE(PG8_SB(0, 1), b2 + hstepB, voffB); PG8_STAGE(PG8_SA(0, 0), a2, voffA);
            PG8_WAIT_V(8); PG8_WAIT_L(0); PG8_BAR; PG8_MMA(1, 0, At, B0); PG8_MMA(1, 1, At, B1); PG8_BAR; PG8_SCHED;
            PG8_LDB(B0, 1, 0); PG8_LDB(B1, 1, 1); PG8_SCHED; PG8_LDA(At, 1, 0); PG8_STAGE(PG8_SA(0, 1), a2 + hstepA, voffA);
            PG8_WAIT_V(8); PG8_WAIT_L(0); PG8_BAR; PG8_MMA(0, 0, At, B0); PG8_MMA(0, 1, At, B1); PG8_BAR; PG8_SCHED;
            PG8_LDA(At, 1, 1); PG8_STAGE(PG8_SB(1, 0), b3, voffB); PG8_STAGE(PG8_SB(1, 1), b3 + hstepB, voffB); PG8_STAGE(PG8_SA(1, 0), a3, voffA);
            PG8_WAIT_V(8); PG8_WAIT_L(0); PG8_BAR; PG8_MMA(1, 0, At, B0); PG8_MMA(1, 1, At, B1); PG8_BAR; PG8_SCHED;
            } else {
            PG8_LDB(B0, 0, 0); PG8_SCHED; PG8_LDA(At, 0, 0); PG8_STAGE(PG8_SA(1, 1), a1 + hstepA, voffA);
            PG8_WAIT_L(8); PG8_BAR; PG8_WAIT_L(0); PG8_MMA(0, 0, At, B0); PG8_BAR; PG8_SCHED;
            PG8_LDB(B1, 0, 1); PG8_STAGE(PG8_SB(0, 0), b2, voffB);
            PG8_BAR; PG8_WAIT_L(0); PG8_MMA(0, 1, At, B1); PG8_BAR;
            PG8_LDA(At, 0, 1); PG8_STAGE(PG8_SA(0, 0), a2, voffA);
            PG8_BAR; PG8_WAIT_L(0); PG8_MMA(1, 0, At, B0); PG8_BAR; PG8_SCHED;
            PG8_STAGE(PG8_SB(0, 1), b2 + hstepB, voffB);
            PG8_WAIT_V(6); PG8_BAR; PG8_MMA(1, 1, At, B1); PG8_BAR;
            PG8_LDB(B0, 1, 0); PG8_SCHED; PG8_LDA(At, 1, 0); PG8_STAGE(PG8_SA(0, 1), a2 + hstepA, voffA);
            PG8_WAIT_L(8); PG8_BAR; PG8_WAIT_L(0); PG8_MMA(0, 0, At, B0); PG8_BAR; PG8_SCHED;
            PG8_LDB(B1, 1, 1); PG8_STAGE(PG8_SB(1, 0), b3, voffB);
            PG8_BAR; PG8_WAIT_L(0); PG8_MMA(0, 1, At, B1); PG8_BAR;
            PG8_LDA(At, 1, 1); PG8_STAGE(PG8_SA(1, 0), a3, voffA);
            PG8_BAR; PG8_WAIT_L(0); PG8_MMA(1, 0, At, B0); PG8_BAR; PG8_SCHED;
            PG8_STAGE(PG8_SB(1, 1), b3 + hstepB, voffB);
            PG8_WAIT_V(6); PG8_BAR; PG8_MMA(1, 1, At, B1); PG8_BAR;
            }
        }
        if constexpr (ALIGN_EPI) { if (wr == 0) PG8_BAR; }
        if constexpr (!Epi::AFTER_DRAIN) { E(acc, cur, wr, wc, fr, fq); S.done(cur); }
        if (!has_next) break;
        if constexpr (Epi::INIT) E.init(acc, nxt, wr, wc, fr, fq);
        else {
#pragma unroll
        for (int a = 0; a < 2; ++a)
#pragma unroll
            for (int b = 0; b < 2; ++b)
#pragma unroll
                for (int m = 0; m < 4; ++m)
#pragma unroll
                    for (int n = 0; n < 2; ++n) acc[a][b][m][n] = (f32x4){0.f, 0.f, 0.f, 0.f};
        }
        cur = nxt; cA = nA; cB = nB; ++ui;
        if constexpr (ALIGN_EPI) { if (wr == 1) PG8_BAR; }
    }
    PG8_WAIT_V(0);
    if constexpr (!ALIGN_EPI) { if (wr == 0) PG8_BAR; }
    PG8_BAR;
    if constexpr (Epi::AFTER_DRAIN) { E.fused(acc, cur, wr, wc, fr, fq, lds, wid, lane); S.done(cur); }
#undef PG8_SA
#undef PG8_SB
#undef PG8_STAGE
#undef PG8_LDA
#undef PG8_LDB
#undef PG8_MMA
#undef PG8_WAIT_V
#undef PG8_WAIT_L
#undef PG8_BAR
#undef PG8_SCHED
}
}

namespace pg8 {
__device__ __forceinline__ unsigned pkbf(float lo, float hi) { f32x2 v = {lo, hi}; bf16x2_t b = __builtin_convertvector(v, bf16x2_t); return __builtin_bit_cast(unsigned, b); }
__device__ __forceinline__ u32x4 pack8bf(const f32x4& v0, const f32x4& v1) { u32x4 w; w.x = pkbf(v0[0], v0[1]); w.y = pkbf(v0[2], v0[3]); w.z = pkbf(v1[0], v1[1]); w.w = pkbf(v1[2], v1[3]); return w; }
__device__ __forceinline__ float sigm(float x) { return __builtin_amdgcn_rcpf(1.0f + __builtin_amdgcn_exp2f(-x * 1.4426950408889634f)); }
__device__ __forceinline__ float sigm255_1(float a, float nb) { const float e = __builtin_amdgcn_exp2f(__builtin_fmaf(a, -1.4426950408889634f, nb)); return __builtin_amdgcn_rcpf(__builtin_fmaf(e, 1.0f / 255.0f, 1.0f / 255.0f)); }
__device__ __forceinline__ f32x4 sigm255(f32x4 a, f32x4 nb) { f32x4 r; r[0] = sigm255_1(a[0], nb[0]); r[1] = sigm255_1(a[1], nb[1]); r[2] = sigm255_1(a[2], nb[2]); r[3] = sigm255_1(a[3], nb[3]); return r; }
__device__ __forceinline__ f32x4 sigm4(f32x4 v) { v[0] = sigm(v[0]); v[1] = sigm(v[1]); v[2] = sigm(v[2]); v[3] = sigm(v[3]); return v; }
struct EpiProj8 { static constexpr bool PERM = true, AFTER_DRAIN = false, INIT = false;
    ::bf16_t* qkv; unsigned char* gates; float* nsag; const float* bm; const float* hsc; const float* wsc;
    __device__ __forceinline__ void operator()(const f32x4 (&acc)[2][2][4][2], const Unit& u, int wr, int wc, int fr, int fq) const {
        const int row0 = u.pm * BM + wr * 64 + fr, colb = u.pn * BM + wc * 32 + 8 * fq;
        f32x4 cs[2][2];
#pragma unroll
        for (int bj = 0; bj < 2; ++bj)
#pragma unroll
            for (int n = 0; n < 2; ++n) cs[bj][n] = *(const f32x4*)(wsc + colb + bj * HALF + n * 4);
        if (u.pn < 10) {
#pragma unroll
            for (int ai = 0; ai < 2; ++ai)
#pragma unroll
                for (int m = 0; m < 4; ++m) { const size_t row = (size_t)(row0 + ai * HALF + m * 16); const float rs = hsc[row];
#pragma unroll
                    for (int bj = 0; bj < 2; ++bj) { f32x4 v[2];
#pragma unroll
                        for (int n = 0; n < 2; ++n) { const i32x4v ia = __builtin_bit_cast(i32x4v, acc[ai][bj][m][n]);
                            v[n][0] = (float)ia[0] * rs * cs[bj][n][0]; v[n][1] = (float)ia[1] * rs * cs[bj][n][1]; v[n][2] = (float)ia[2] * rs * cs[bj][n][2]; v[n][3] = (float)ia[3] * rs * cs[bj][n][3]; }
                        *(u32x4*)(qkv + row * 2560 + colb + bj * HALF) = pack8bf(v[0], v[1]); } }
        } else if (u.pn < 22) {
            f32x4 bb[2][2];
#pragma unroll
            for (int bj = 0; bj < 2; ++bj)
#pragma unroll
                for (int n = 0; n < 2; ++n) { bb[bj][n] = *(const f32x4*)(bm + colb + bj * HALF + n * 4 - 2560) * -1.4426950408889634f; cs[bj][n] *= -1.4426950408889634f; }
#pragma unroll
            for (int ai = 0; ai < 2; ++ai)
#pragma unroll
                for (int m = 0; m < 4; ++m) { const size_t row = (size_t)(row0 + ai * HALF + m * 16); const float rs = hsc[row];
#pragma unroll
                    for (int bj = 0; bj < 2; ++bj) { const int c = colb + bj * HALF - 2560;
                        u32x2 w;
#pragma unroll
                        for (int n = 0; n < 2; ++n) { const i32x4v ia = __builtin_bit_cast(i32x4v, acc[ai][bj][m][n]); float r[4];
#pragma unroll
                            for (int j = 0; j < 4; ++j) { const float e = __builtin_amdgcn_exp2f(__builtin_fmaf((float)ia[j] * rs, cs[bj][n][j], bb[bj][n][j])); r[j] = __builtin_amdgcn_rcpf(__builtin_fmaf(e, 1.0f / 255.0f, 1.0f / 255.0f)); }
                            const unsigned pk = __builtin_amdgcn_cvt_pk_u8_f32(r[3], 3, __builtin_amdgcn_cvt_pk_u8_f32(r[2], 2, __builtin_amdgcn_cvt_pk_u8_f32(r[1], 1, __builtin_amdgcn_cvt_pk_u8_f32(r[0], 0, 0u))));
                            if (n == 0) w.x = pk; else w.y = pk; }
                        *(u32x2*)(gates + row * 3072 + c) = w; } }
        } else {
#pragma unroll
            for (int ai = 0; ai < 2; ++ai)
#pragma unroll
                for (int m = 0; m < 4; ++m) { const size_t row = (size_t)(row0 + ai * HALF + m * 16); const float rs = hsc[row];
                    const int c = colb - 5632; if (c < 32) {
#pragma unroll
                        for (int n = 0; n < 2; ++n) { const i32x4v ia = __builtin_bit_cast(i32x4v, acc[ai][0][m][n]);
                            f32x4 v = {(float)ia[0] * rs * cs[0][n][0], (float)ia[1] * rs * cs[0][n][1], (float)ia[2] * rs * cs[0][n][2], (float)ia[3] * rs * cs[0][n][3]};
                            *(f32x4*)(nsag + row * 32 + c + n * 4) = sigm4(v); } } }
        }
    }
};
struct EpiPlain8 { static constexpr bool PERM = true, AFTER_DRAIN = false, INIT = false;
    ::bf16_t* O; int ldc; const float* hsc; const float* wsc;
    __device__ __forceinline__ void operator()(const f32x4 (&acc)[2][2][4][2], const Unit& u, int wr, int wc, int fr, int fq) const {
        const int row0 = u.pm * BM + wr * 64 + fr, colb = u.pn * BM + wc * 32 + 8 * fq;
        f32x4 cs[2][2];
#pragma unroll
        for (int bj = 0; bj < 2; ++bj)
#pragma unroll
            for (int n = 0; n < 2; ++n) cs[bj][n] = *(const f32x4*)(wsc + colb + bj * HALF + n * 4);
#pragma unroll
        for (int ai = 0; ai < 2; ++ai)
#pragma unroll
            for (int m = 0; m < 4; ++m) { const size_t row = (size_t)(row0 + ai * HALF + m * 16); const float rs = hsc[row];
#pragma unroll
                for (int bj = 0; bj < 2; ++bj) { f32x4 v[2];
#pragma unroll
                    for (int n = 0; n < 2; ++n) { const i32x4v ia = __builtin_bit_cast(i32x4v, acc[ai][bj][m][n]);
                        v[n][0] = (float)ia[0] * rs * cs[bj][n][0]; v[n][1] = (float)ia[1] * rs * cs[bj][n][1]; v[n][2] = (float)ia[2] * rs * cs[bj][n][2]; v[n][3] = (float)ia[3] * rs * cs[bj][n][3]; }
                    *(u32x4*)(O + row * ldc + colb + bj * HALF) = pack8bf(v[0], v[1]); } }
    }
};
struct EpiPlain { static constexpr bool PERM = true, AFTER_DRAIN = false, INIT = false;
    ::bf16_t* O; int ldc;
    __device__ __forceinline__ void operator()(const f32x4 (&acc)[2][2][4][2], const Unit& u, int wr, int wc, int fr, int fq) const {
        const int row0 = u.pm * BM + wr * 64 + fr;
#pragma unroll
        for (int ai = 0; ai < 2; ++ai)
#pragma unroll
            for (int m = 0; m < 4; ++m) { const size_t row = (size_t)(row0 + ai * HALF + m * 16);
#pragma unroll
                for (int bj = 0; bj < 2; ++bj) { const int col8 = u.pn * BM + bj * HALF + wc * 32 + 8 * fq; *(u32x4*)(O + row * ldc + col8) = pack8bf(acc[ai][bj][m][0], acc[ai][bj][m][1]); } }
    }
};
struct EpiMerge { static constexpr bool PERM = true, AFTER_DRAIN = false, INIT = false;
    ::bf16_t* merged; const ::bf16_t* gates; int br;
    __device__ __forceinline__ void operator()(const f32x4 (&acc)[2][2][4][2], const Unit& u, int wr, int wc, int fr, int fq) const {
        const int row0 = u.pm * BM + wr * 64 + fr, colb = u.pn * BM + wc * 32 + 8 * fq;
        u32x2 gw[2][4][2];
#pragma unroll
        for (int ai = 0; ai < 2; ++ai)
#pragma unroll
            for (int m = 0; m < 4; ++m)
#pragma unroll
                for (int bj = 0; bj < 2; ++bj) gw[ai][m][bj] = *(const u32x2*)((const unsigned char*)gates + (size_t)(row0 + ai * HALF + m * 16) * 3072 + br * 1024 + colb + bj * HALF);
#pragma unroll
        for (int ai = 0; ai < 2; ++ai) {
            u32x4 old[4][2];
            if (br != 0) {
#pragma unroll
                for (int m = 0; m < 4; ++m)
#pragma unroll
                    for (int bj = 0; bj < 2; ++bj) old[m][bj] = *(const u32x4*)(merged + (size_t)(row0 + ai * HALF + m * 16) * 1024 + colb + bj * HALF);
            }
#pragma unroll
            for (int m = 0; m < 4; ++m)
#pragma unroll
                for (int bj = 0; bj < 2; ++bj) {
                    const u32x2 g2 = gw[ai][m][bj];
                    f32x4 v0 = acc[ai][bj][m][0], v1 = acc[ai][bj][m][1];
                    v0[0] *= (float)(g2.x & 0xffu); v0[1] *= (float)((g2.x >> 8) & 0xffu); v0[2] *= (float)((g2.x >> 16) & 0xffu); v0[3] *= (float)(g2.x >> 24);
                    v1[0] *= (float)(g2.y & 0xffu); v1[1] *= (float)((g2.y >> 8) & 0xffu); v1[2] *= (float)((g2.y >> 16) & 0xffu); v1[3] *= (float)(g2.y >> 24);
                    if (br != 0) { const u32x4 o = old[m][bj];
                        v0[0] += __uint_as_float(o.x << 16); v0[1] += __uint_as_float(o.x & 0xffff0000u); v0[2] += __uint_as_float(o.y << 16); v0[3] += __uint_as_float(o.y & 0xffff0000u);
                        v1[0] += __uint_as_float(o.z << 16); v1[1] += __uint_as_float(o.z & 0xffff0000u); v1[2] += __uint_as_float(o.w << 16); v1[3] += __uint_as_float(o.w & 0xffff0000u); }
                    *(u32x4*)(merged + (size_t)(row0 + ai * HALF + m * 16) * 1024 + colb + bj * HALF) = pack8bf(v0, v1); }
            asm volatile("" ::: "memory");
        }
    }
};
struct EpiOut { static constexpr bool PERM = false, AFTER_DRAIN = false, INIT = true;
    const float* x; const float* gf; float* x2; ::bf16_t* h2; float* rowss;
    __device__ __forceinline__ void init(f32x4 (&acc)[2][2][4][2], const Unit& u, int wr, int wc, int fr, int fq) const {
        const int row0 = u.pm * BM + wr * 64 + fr, colb = u.pn * BM + wc * 32 + 4 * fq;
#pragma unroll
        for (int ai = 0; ai < 2; ++ai)
#pragma unroll
            for (int bj = 0; bj < 2; ++bj)
#pragma unroll
                for (int m = 0; m < 4; ++m)
#pragma unroll
                    for (int n = 0; n < 2; ++n) acc[ai][bj][m][n] = *(const f32x4*)(x + (size_t)(row0 + ai * HALF + m * 16) * 1024 + colb + bj * HALF + n * 16);
    }
    __device__ __forceinline__ void operator()(const f32x4 (&acc)[2][2][4][2], const Unit& u, int wr, int wc, int fr, int fq) const {
        const int row0 = u.pm * BM + wr * 64 + fr, colb = u.pn * BM + wc * 32 + 4 * fq;
        f32x4 gg[2][2];
#pragma unroll
        for (int bj = 0; bj < 2; ++bj)
#pragma unroll
            for (int n = 0; n < 2; ++n) gg[bj][n] = *(const f32x4*)(gf + colb + bj * HALF + n * 16);
#pragma unroll
        for (int ai = 0; ai < 2; ++ai)
#pragma unroll
            for (int m = 0; m < 4; ++m) { const size_t row = (size_t)(row0 + ai * HALF + m * 16);
#pragma unroll
                for (int bj = 0; bj < 2; ++bj) { float ss = 0.f;
#pragma unroll
                    for (int n = 0; n < 2; ++n) { const int col = colb + bj * HALF + n * 16;
                        const f32x4 v = acc[ai][bj][m][n]; *(f32x4*)(x2 + row * 1024 + col) = v;
                        ss += (v[0] * v[0] + v[1] * v[1]) + (v[2] * v[2] + v[3] * v[3]);
                        const f32x4 g4 = gg[bj][n]; u32x2 w; w.x = pkbf(v[0] * g4[0], v[1] * g4[1]); w.y = pkbf(v[2] * g4[2], v[3] * g4[3]); *(u32x2*)(h2 + row * 1024 + col) = w; }
                    ss += __shfl_xor(ss, 16); ss += __shfl_xor(ss, 32);
                    if (fq == 0) rowss[row * 32 + u.pn * 8 + bj * 4 + wc] = ss; } }
    }
};
}

#define GEMM_PHASE(EPI, g, S, E) pg8::gemm_phase<EPI, pg8::StaticOrder, true, true>((PG8_LAS unsigned char*)lds, g, S, E)
DI void phase1(const Params& p, bf16_t* lds) {
    unsigned char* ws = p.ws;
    {
        pg8::Gemm g{(const bf16_t*)(ws + WS_H8), (const bf16_t*)(ws + WS_W8), NTOK, NPROJ, D / 2, D / 2, D / 2};
        pg8::StaticOrder S; S.init(NTOK, NPROJ, (int)gridDim.x, (int)blockIdx.x);
        pg8::EpiProj8 E{(bf16_t*)(ws + WS_QKV), ws + WS_GATES, (float*)((unsigned char*)p.out + DO_NSAG), p.in[5], (const float*)(ws + WS_HSC), (const float*)(ws + WS_W8SC)};
        pg8::gemm_phase<pg8::EpiProj8, pg8::StaticOrder, true, true, true>((PG8_LAS unsigned char*)lds, g, S, E);
    }
    {
        pg8::Gemm g{(const bf16_t*)(ws + WS_MEMN8), (const bf16_t*)(ws + WS_WMKV8), NB * MEMT, 512, D / 2, D / 2, D / 2};
        const int cm = ((int)gridDim.x == 256 && blockIdx.x >= 128 && blockIdx.x < 144) ? (int)blockIdx.x - 128 : ((int)gridDim.x == 256 ? (1 << 20) : (int)blockIdx.x);
        pg8::StaticOrder S; S.init(NB * MEMT, 512, (int)gridDim.x, cm);
        pg8::EpiPlain8 E{(bf16_t*)((unsigned char*)p.out + DO_MKV), 512, (const float*)(ws + WS_MEMN8 + 2 * MiB), (const float*)(ws + WS_WMKV8 + MiB)};
        pg8::gemm_phase<pg8::EpiPlain8, pg8::StaticOrder, true, true, true>((PG8_LAS unsigned char*)lds, g, S, E);
    }
    if ((int)gridDim.x == 256) { if (blockIdx.x >= 144) late_weights(p, ((int)blockIdx.x - 144) * NTHREADS + (int)threadIdx.x, 112 * NTHREADS); }
    else late_weights(p, (int)(blockIdx.x * NTHREADS + threadIdx.x), (int)(gridDim.x * NTHREADS));
}
DI void transpose64(const bf16_t* src, size_t sp, bf16_t* dst, size_t dp, unsigned short* scr, int lane) {
#pragma unroll
    for (int i = 0; i < 8; ++i) { const int r = i * 8 + (lane >> 3), c8 = lane & 7; const u32x4 v = *(const u32x4*)(src + (size_t)r * sp + c8 * 8);
        unsigned short* s = scr + r * 66 + c8 * 8;
        s[0] = (unsigned short)(v.x & 0xffff); s[1] = (unsigned short)(v.x >> 16); s[2] = (unsigned short)(v.y & 0xffff); s[3] = (unsigned short)(v.y >> 16);
        s[4] = (unsigned short)(v.z & 0xffff); s[5] = (unsigned short)(v.z >> 16); s[6] = (unsigned short)(v.w & 0xffff); s[7] = (unsigned short)(v.w >> 16); }
    __builtin_amdgcn_s_waitcnt(0xc07f);
    __builtin_amdgcn_wave_barrier();
#pragma unroll
    for (int i = 0; i < 8; ++i) { const int c = i * 8 + (lane >> 3), r8 = lane & 7; const unsigned short* s = scr + (r8 * 8) * 66 + c;
        u32x4 o; o.x = (unsigned)s[0] | ((unsigned)s[66] << 16); o.y = (unsigned)s[2 * 66] | ((unsigned)s[3 * 66] << 16); o.z = (unsigned)s[4 * 66] | ((unsigned)s[5 * 66] << 16); o.w = (unsigned)s[6 * 66] | ((unsigned)s[7 * 66] << 16);
        *(u32x4*)(dst + (size_t)c * dp + r8 * 8) = o; }
    __builtin_amdgcn_s_waitcnt(0xc07f);
    __builtin_amdgcn_wave_barrier();
}
DI void transpose64_vtiles(const bf16_t* src, size_t sp, bf16_t* dst  , unsigned short* scr, int lane) {
#pragma unroll
    for (int i = 0; i < 8; ++i) { const int r = i * 8 + (lane >> 3), c8 = lane & 7; const u32x4 v = *(const u32x4*)(src + (size_t)r * sp + c8 * 8);
        unsigned short* sdst = scr + r * 66 + c8 * 8;
        sdst[0] = (unsigned short)(v.x & 0xffff); sdst[1] = (unsigned short)(v.x >> 16); sdst[2] = (unsigned short)(v.y & 0xffff); sdst[3] = (unsigned short)(v.y >> 16);
        sdst[4] = (unsigned short)(v.z & 0xffff); sdst[5] = (unsigned short)(v.z >> 16); sdst[6] = (unsigned short)(v.w & 0xffff); sdst[7] = (unsigned short)(v.w >> 16); }
    __builtin_amdgcn_s_waitcnt(0xc07f);
    __builtin_amdgcn_wave_barrier();
#pragma unroll
    for (int i = 0; i < 8; ++i) { const int d = i * 8 + (lane >> 3), r8 = lane & 7; const unsigned short* sp2 = scr + (r8 * 8) * 66 + d;
        u32x2 lo, hi2; lo.x = (unsigned)sp2[0] | ((unsigned)sp2[66] << 16); lo.y = (unsigned)sp2[2 * 66] | ((unsigned)sp2[3 * 66] << 16); hi2.x = (unsigned)sp2[4 * 66] | ((unsigned)sp2[5 * 66] << 16); hi2.y = (unsigned)sp2[6 * 66] | ((unsigned)sp2[7 * 66] << 16);
        const int half = r8 >> 2, q = 2 * (r8 & 3), msk = (d >> 2) & 7;
        unsigned char* tb = (unsigned char*)dst + half * 4096 + d * 64;
        *(u32x2*)(tb + ((q ^ msk) * 8)) = lo; *(u32x2*)(tb + (((q + 1) ^ msk) * 8)) = hi2; }
    __builtin_amdgcn_s_waitcnt(0xc07f);
    __builtin_amdgcn_wave_barrier();
}
DI void copy64_ktiles(const bf16_t* src, size_t sp, bf16_t* dst, int lane) {
#pragma unroll
    for (int i = 0; i < 8; ++i) { const int r = i * 8 + (lane >> 3), c8 = lane & 7; const u32x4 v = *(const u32x4*)(src + (size_t)r * sp + c8 * 8);
        const int rr = r & 31;
        *(u32x4*)((unsigned char*)dst + (r >> 5) * 4096 + rr * 128 + ((c8 ^ ((rr >> 1) & 7)) * 16)) = v; }
}
DI void phase2(const Params& p, bf16_t* lds) {
    unsigned char* ws = p.ws; unsigned char* dout = (unsigned char*)p.out;
    const int lane = threadIdx.x & 63, wid = threadIdx.x >> 6;
    const int gwave = blockIdx.x * NWAVES + wid, nwaves = gridDim.x * NWAVES;
    unsigned short* scr = (unsigned short*)lds + wid * (64 * 66);
    const bf16_t* qkv = (const bf16_t*)(ws + WS_QKV);
    const int n_items = 1024 + 1024 + 3072 + 128;
    for (int it = gwave; it < n_items; it += nwaves) {
        if (it < 2048) { const int which = it >> 10, r = it & 1023, b = r >> 7, g = (r >> 6) & 1, tt = r & 63;
            const bf16_t* src = qkv + (size_t)(b * T + tt * 64) * LDP_QKV + C_NKV + (which ? 5 : 3) * 128 + g * 64;
            bf16_t* dst = (bf16_t*)(dout + (which ? DO_VWIN : DO_VSLC)) + ((size_t)(b * 2 + g) * 128 + tt * 2) * 2048;
            transpose64_vtiles(src, LDP_QKV, dst, scr, lane);
        } else if (it < 2048 + 3072) { const int r = it - 2048, b = r / 384, hh = (r / 64) % 6, tt = r & 63;
            const bf16_t* src = qkv + (size_t)(b * T + tt * 64) * LDP_QKV + C_SBV + hh * 64;
            bf16_t* dst = (bf16_t*)(dout + DO_SBV) + ((size_t)(b * 6 + hh) * 128 + tt * 2) * 2048;
            transpose64_vtiles(src, LDP_QKV, dst, scr, lane);
        } else { const int r = it - 5120, b = r >> 4, hh = (r >> 2) & 3, mt = r & 3;
            const bf16_t* srcv = (const bf16_t*)(dout + DO_MKV) + (size_t)(b * MEMT + mt * 64) * 512 + 256 + hh * 64;
            transpose64_vtiles(srcv, 512, (bf16_t*)(dout + DO_MVT) + ((size_t)(b * 4 + hh) * 8 + mt * 2) * 2048, scr, lane);
        }
    }
    __syncthreads();
    {
        bf16_t* kc = (bf16_t*)(dout + DO_KC); bf16_t* vct = (bf16_t*)(dout + DO_VCT);
        const int r32 = lane & 31, hi = lane >> 5;
        float* red = (float*)lds;
        for (int task = blockIdx.x; task < 2 * 16 * 8; task += gridDim.x) {
            const int which = task >> 7, bg = (task >> 3) & 15, chunk = task & 7, b = bg >> 1, g = bg & 1;
            const bf16_t* wt = (const bf16_t*)(ws + WS_CMPW) + (size_t)which * 64 * 2048;
            const float* pe = p.in[6 + which];
            const int n = chunk * 32 + r32;
            f32x16 acc[2]; zero16(acc[0]); zero16(acc[1]);
#pragma unroll
            for (int li = 0; li < 4; ++li) {
                const int l = wid * 4 + li; int token = 16 * n + l; if (token > T - 1) token = T - 1;
                const bf16_t* xr = qkv + (size_t)(b * T + token) * LDP_QKV + C_NKV + which * 128 + g * 64 + hi * 8;
#pragma unroll
                for (int ds = 0; ds < 4; ++ds) {
                    const bf16x8 xf = *(const bf16x8*)(xr + ds * 16);
                    const f32x4 p0 = *(const f32x4*)(pe + l * 64 + ds * 16 + hi * 8), p1 = *(const f32x4*)(pe + l * 64 + ds * 16 + hi * 8 + 4);
                    u32x4 pw; pw.x = pk2(p0.x, p0.y); pw.y = pk2(p0.z, p0.w); pw.z = pk2(p1.x, p1.y); pw.w = pk2(p1.z, p1.w);
                    const bf16x8 pf = __builtin_bit_cast(bf16x8, pw);
#pragma unroll
                    for (int eb = 0; eb < 2; ++eb) {
                        const bf16x8 wf = *(const bf16x8*)(wt + (size_t)(32 * eb + r32) * 2048 + l * 64 + ds * 16 + hi * 8);
                        if (which == 0) { acc[eb] = MFMA32(wf, xf, acc[eb]); acc[eb] = MFMA32(wf, pf, acc[eb]); }
                        else { acc[eb] = MFMA32(xf, wf, acc[eb]); acc[eb] = MFMA32(pf, wf, acc[eb]); }
                    }
                }
            }
#pragma unroll
            for (int eb = 0; eb < 2; ++eb)
#pragma unroll
                for (int r = 0; r < 16; ++r) red[(wid * 32 + eb * 16 + r) * 64 + lane] = acc[eb][r];
            __syncthreads();
            {
                const int eb = wid >> 2, mg = wid & 3;
                f32x4 v = {0.f, 0.f, 0.f, 0.f};
#pragma unroll
                for (int w2 = 0; w2 < 8; ++w2) { v.x += red[(w2 * 32 + eb * 16 + 4 * mg) * 64 + lane]; v.y += red[(w2 * 32 + eb * 16 + 4 * mg + 1) * 64 + lane]; v.z += red[(w2 * 32 + eb * 16 + 4 * mg + 2) * 64 + lane]; v.w += red[(w2 * 32 + eb * 16 + 4 * mg + 3) * 64 + lane]; }
                if (which == 0) {
                    if (n == 255) v = (f32x4){0.f, 0.f, 0.f, 0.f};
                    store_bf16x4(kc + ((size_t)bg * 256 + n) * 64 + 32 * eb + 8 * mg + 4 * hi, v);
                } else {
                    const int n0 = chunk * 32 + 8 * mg + 4 * hi;
                    if (n0 + 3 == 255) v.w = 0.f;
                    store_bf16x4(vct + ((size_t)bg * 64 + 32 * eb + r32) * 256 + n0, v);
                }
            }
            __syncthreads();
        }
    }
}

DI bf16x8 pack8(const f32x16& p, int base) {
    u32x4 w; w.x = pk2(p[base], p[base + 1]); w.y = pk2(p[base + 2], p[base + 3]); w.z = pk2(p[base + 4], p[base + 5]); w.w = pk2(p[base + 6], p[base + 7]);
    return __builtin_bit_cast(bf16x8, w);
}
DI f32x16 st_tile(const bf16_t* kbase, size_t kpitch, const bf16x8 (&qf)[4], int r32, int hi) {
    f32x16 s;
#pragma unroll
    for (int i = 0; i < 16; ++i) s[i] = 0.f;
    const bf16_t* kp = kbase + (size_t)r32 * kpitch + hi * 8;
#pragma unroll
    for (int ks = 0; ks < 4; ++ks) { const bf16x8 a = *(const bf16x8*)(kp + ks * 16); s = MFMA32(a, qf[ks], s); }
    return s;
}
DI void pv_tile(f32x16 (&o)[2], const bf16_t* vT, size_t vpitch, const f32x16& pr, int r32, int hi) {
    const bf16x8 pf0 = pack8(pr, 0), pf1 = pack8(pr, 8);
#pragma unroll
    for (int db = 0; db < 2; ++db) {
        const bf16_t* vp = vT + (size_t)(32 * db + r32) * vpitch + 4 * hi;
#pragma unroll
        for (int s2 = 0; s2 < 2; ++s2) {
            const s16x4 lo = *(const s16x4*)(vp + 16 * s2); const s16x4 hh = *(const s16x4*)(vp + 16 * s2 + 8);
            const bf16x8 a = {lo[0], lo[1], lo[2], lo[3], hh[0], hh[1], hh[2], hh[3]};
            o[db] = MFMA32(a, s2 ? pf1 : pf0, o[db]);
        }
    }
}
DI void load_q(bf16x8 (&qf)[4], const bf16_t* qrow  , int hi) {
#pragma unroll
    for (int ks = 0; ks < 4; ++ks) qf[ks] = *(const bf16x8*)(qrow + ks * 16 + hi * 8);
}
DI void softmax_tile(f32x16& sv, unsigned vmask, float& m, float& l, f32x16 (&o)[2]) {
    float tm = -1e30f;
#pragma unroll
    for (int r = 0; r < 16; ++r) tm = fmaxf(tm, ((vmask >> r) & 1u) ? sv[r] : -1e30f);
    tm = fmaxf(tm, __shfl_xor(tm, 32));
    const float mn = fmaxf(m, tm);
    const float alpha = fexp(m - mn);
    float ps = 0.f;
#pragma unroll
    for (int r = 0; r < 16; ++r) { const float pv = ((vmask >> r) & 1u) ? fexp(sv[r] - mn) : 0.f; sv[r] = pv; ps += pv; }
    l = l * alpha + ps; m = mn;
#pragma unroll
    for (int r = 0; r < 16; ++r) { o[0][r] *= alpha; o[1][r] *= alpha; }
}

struct KF { bf16x8 k[4]; };
struct VF { s16x4 v[2][2][2]; };
DI void load_kf(KF& f, const bf16_t* kbase, size_t kpitch, int r32, int hi) {
    const bf16_t* kp = kbase + (size_t)r32 * kpitch + hi * 8;
#pragma unroll
    for (int ks = 0; ks < 4; ++ks) f.k[ks] = *(const bf16x8*)(kp + ks * 16);
}
DI void load_vf(VF& f, const bf16_t* vT, size_t vpitch, int r32, int hi) {
#pragma unroll
    for (int db = 0; db < 2; ++db) { const bf16_t* vp = vT + (size_t)(32 * db + r32) * vpitch + 4 * hi;
#pragma unroll
        for (int s2 = 0; s2 < 2; ++s2) { f.v[db][s2][0] = *(const s16x4*)(vp + 16 * s2); f.v[db][s2][1] = *(const s16x4*)(vp + 16 * s2 + 8); } }
}
DI f32x16 qk_frag(const KF& f, const bf16x8 (&qf)[4]) {
    f32x16 s; zero16(s);
#pragma unroll
    for (int ks = 0; ks < 4; ++ks) s = MFMA32(f.k[ks], qf[ks], s);
    return s;
}
DI void pv_frag(f32x16 (&o)[2], const VF& f, const f32x16& pr) {
    const bf16x8 pf0 = pack8(pr, 0), pf1 = pack8(pr, 8);
#pragma unroll
    for (int db = 0; db < 2; ++db)
#pragma unroll
        for (int s2 = 0; s2 < 2; ++s2) { const s16x4 lo = f.v[db][s2][0], hh = f.v[db][s2][1];
            const bf16x8 a = {lo[0], lo[1], lo[2], lo[3], hh[0], hh[1], hh[2], hh[3]};
            o[db] = MFMA32(a, s2 ? pf1 : pf0, o[db]); }
}
template <bool GUARD = false> DI void softmax_core(f32x16& e, float A, float& m, float& l, f32x16 (&o)[2]) {
    float tm = fmaxf(fmaxf(fmaxf(e[0], e[1]), fmaxf(e[2], e[3])), fmaxf(fmaxf(e[4], e[5]), fmaxf(e[6], e[7])));
    tm = fmaxf(tm, fmaxf(fmaxf(fmaxf(e[8], e[9]), fmaxf(e[10], e[11])), fmaxf(fmaxf(e[12], e[13]), fmaxf(e[14], e[15]))));
    tm += A;
    tm = fmaxf(tm, __shfl_xor(tm, 32));
    if (__any(tm > m + 8.0f)) {
        const float mn = fmaxf(m, tm); const float alpha = fexp2(m - mn); l *= alpha; m = mn;
#pragma unroll
        for (int r = 0; r < 16; ++r) { o[0][r] *= alpha; o[1][r] *= alpha; }
    }
    const float c = A - m;
    float ps = 0.f;
#pragma unroll
    for (int r = 0; r < 16; ++r) { float pv = fexp2(e[r] + c); if (GUARD) pv = (e[r] > -1e29f) ? pv : 0.f; e[r] = pv; ps += pv; }
    l += ps;
}
constexpr float SCL2 = 0.125f * LOG2E;

DI int f2key(float v) { const int u = __float_as_int(v); return u ^ ((u >> 31) & 0x7fffffff); }
DI float key2f(int k) { return __int_as_float(k ^ ((k >> 31) & 0x7fffffff)); }
template <int N> DI void bitonic_sort_desc(int (&a)[N]) {
#pragma unroll
    for (int k = 2; k <= N; k <<= 1)
#pragma unroll
        for (int j = k >> 1; j > 0; j >>= 1)
#pragma unroll
            for (int i = 0; i < N; ++i) { const int l = i ^ j; if (l > i) { const bool desc = ((i & k) == 0); const int hi_ = max(a[i], a[l]), lo_ = min(a[i], a[l]); a[i] = desc ? hi_ : lo_; a[l] = desc ? lo_ : hi_; } }
}
DI void top16_merge(int (&a)[16], const int (&b)[16]) {
#pragma unroll
    for (int i = 0; i < 16; ++i) a[i] = max(a[i], b[15 - i]);
#pragma unroll
    for (int j = 8; j > 0; j >>= 1)
#pragma unroll
        for (int i = 0; i < 16; ++i) { const int l = i ^ j; if (l > i) { const int hi_ = max(a[i], a[l]), lo_ = min(a[i], a[l]); a[i] = hi_; a[l] = lo_; } }
}
DI void nsa_cmp_task(const Params& p, int b, int g, int chunk, int lane, float* impl  ) {
    unsigned char* ws = p.ws; unsigned char* dout = (unsigned char*)p.out;
    const int r32 = lane & 31, hi = lane >> 5;
    const int tq0 = chunk * 32, t = tq0 + r32, cur = tq0 >> 6;
    const size_t tok = (size_t)b * T + t;
    const bf16_t* qkv = (const bf16_t*)(ws + WS_QKV);
    const float scale = 0.125f;
#pragma unroll
    for (int k = 0; k < 32; ++k) impl[k * 64 + lane] = 0.f;
    const bf16_t* kc = (const bf16_t*)(dout + DO_KC) + (size_t)(b * 2 + g) * 256 * 64;
    const bf16_t* vct = (const bf16_t*)(dout + DO_VCT) + (size_t)(b * 2 + g) * 64 * 256;
    int ntile = (tq0 / 16) / 32 + 1; if (ntile > 8) ntile = 8;
#pragma unroll 1
    for (int rr = 0; rr < 3; ++rr) {
        const int head = g * 3 + rr;
        bf16x8 qr[4]; load_q(qr, qkv + tok * LDP_QKV + C_NQ + head * 64, hi);
        const float slope = fexp2(-(8.0f * (float)(head + 1)) / 6.0f);
        float m = -1e30f, l = 0.f;
        f32x16 oc[2]; zero16(oc[0]); zero16(oc[1]);
        float* tmp = impl + 32 * 64; float* tmpm = impl + 64 * 64;
#pragma unroll 1
        for (int tile = 0; tile < ntile; ++tile) {
            KF kf; VF vf; load_kf(kf, kc + (size_t)tile * 32 * 64, 64, r32, hi); load_vf(vf, vct + tile * 32, 256, r32, hi);
            f32x16 s = qk_frag(kf, qr);
            float tm = -1e30f;
#pragma unroll
            for (int r = 0; r < 16; ++r) { const int n = tile * 32 + krow(r, hi); const int dist = t - (16 * n + 31); const bool valid = dist >= 0 && n < 255;
                const float sv = valid ? s[r] * scale - slope * (float)dist : -1e30f; s[r] = sv; tm = fmaxf(tm, sv); }
            tm = fmaxf(tm, __shfl_xor(tm, 32));
            if (__any(tm > m)) {
                const float mn = fmaxf(m, tm); const float alpha = fexp(m - mn); l *= alpha; m = mn;
#pragma unroll
                for (int r = 0; r < 16; ++r) { oc[0][r] *= alpha; oc[1][r] *= alpha; }
            }
            float ps = 0.f;
#pragma unroll
            for (int r = 0; r < 16; ++r) { const float pv = (s[r] > -1e29f) ? fexp(s[r] - m) : 0.f; s[r] = pv; ps += pv; }
            l += ps;
#pragma unroll
            for (int mm = 0; mm < 4; ++mm) tmp[(tile * 4 + mm) * 64 + lane] = (s[4 * mm] + s[4 * mm + 1]) + (s[4 * mm + 2] + s[4 * mm + 3]);
            tmpm[tile * 64 + lane] = m;
            pv_frag(oc, vf, s);
        }
        l += __shfl_xor(l, 32);
        const float inv = l > 0.f ? 1.0f / l : 0.f;
#pragma unroll 1
        for (int tile = 0; tile < ntile; ++tile) { const float sc = fexp(tmpm[tile * 64 + lane] - m) * inv;
#pragma unroll
            for (int mm = 0; mm < 4; ++mm) impl[(tile * 4 + mm) * 64 + lane] += tmp[(tile * 4 + mm) * 64 + lane] * sc; }
#pragma unroll
        for (int r = 0; r < 16; ++r) { oc[0][r] *= inv; oc[1][r] *= inv; }
        const float g_c = ((const float*)(dout + DO_NSAG))[tok * 32 + head * 3];
        bf16_t* orow = (bf16_t*)(dout + DO_OC) + tok * 384 + head * 64;
#pragma unroll
        for (int db = 0; db < 2; ++db)
#pragma unroll
            for (int mg = 0; mg < 4; ++mg) { f32x4 v = {g_c * oc[db][4 * mg], g_c * oc[db][4 * mg + 1], g_c * oc[db][4 * mg + 2], g_c * oc[db][4 * mg + 3]}; store_bf16x4(orow + 32 * db + 8 * mg + 4 * hi, v); }
    }
    unsigned long long selmask;
    if (cur + 1 <= 16) selmask = (1ull << (cur + 1)) - 1ull;
    else {
        int k0[16], k1[16];
#pragma unroll
        for (int k = 0; k < 32; ++k) { const int j = 2 * k + hi; const float iv = impl[k * 64 + lane]; const float v = (j == 0 || j == cur || j == cur - 1) ? 1e4f : (j <= cur ? iv : -1.0f);
            const int key = (__float_as_int(v) & ~63) | (63 - j);
            if (k < 16) k0[k] = key; else k1[k - 16] = key; }
        bitonic_sort_desc<16>(k0); bitonic_sort_desc<16>(k1); top16_merge(k0, k1);
        int pb[16];
#pragma unroll
        for (int i = 0; i < 16; ++i) pb[i] = __shfl_xor(k0[i], 32);
        top16_merge(k0, pb);
        selmask = 0ull;
#pragma unroll
        for (int i = 0; i < 16; ++i) selmask |= 1ull << (63 - (k0[i] & 63));
    }
    if (hi == 0) ((unsigned long long*)(dout + DO_SELM))[(size_t)(b * 2 + g) * T + t] = selmask;
}
typedef LAS unsigned char* ldsp_t;
struct KOff { unsigned o[4]; };
DI KOff koff_make(int lane, unsigned pitch_bytes) { KOff k;
#pragma unroll
    for (int i = 0; i < 4; ++i) { const int r = i * 8 + (lane >> 3), c8 = (lane & 7) ^ ((i * 4 + (lane >> 4)) & 7); k.o[i] = (unsigned)r * pitch_bytes + (unsigned)c8 * 16u; }
    return k; }
DI void dma_k(ldsp_t kbuf  , const bf16_t* krow0  , const KOff& k) {
#pragma unroll
    for (int i = 0; i < 4; ++i) __builtin_amdgcn_global_load_lds((const unsigned*)((const unsigned char*)krow0 + k.o[i]), (LAS unsigned*)(kbuf + i * 1024), 16, 0, 0);
}
DI void dma_v(ldsp_t vbuf  , const bf16_t* vtile, int lane) {
#pragma unroll
    for (int i = 0; i < 4; ++i) __builtin_amdgcn_global_load_lds((const unsigned*)((const unsigned char*)vtile + i * 1024 + lane * 16), (LAS unsigned*)(vbuf + i * 1024), 16, 0, 0);
}
DI f32x16 qk_lds(ldsp_t kbuf, const bf16x8 (&qf)[4], int r32, int hi) {
    f32x16 s; zero16(s);
    const int sw = (r32 >> 1) & 7;
#pragma unroll
    for (int ks = 0; ks < 4; ++ks) { const bf16x8 a = *(const LAS bf16x8*)(kbuf + r32 * 128 + (((2 * ks + hi) ^ sw) * 16)); s = MFMA32(a, qf[ks], s); }
    return s;
}
DI void pv_lds(f32x16 (&o)[2], ldsp_t vbuf, const f32x16& pr, int r32, int hi) {
    const bf16x8 pf0 = pack8(pr, 0), pf1 = pack8(pr, 8);
#pragma unroll
    for (int db = 0; db < 2; ++db) { const int d = 32 * db + r32, msk = (d >> 2) & 7; ldsp_t rowp = vbuf + d * 64;
#pragma unroll
        for (int s2 = 0; s2 < 2; ++s2) { const s16x4 lo = *(const LAS s16x4*)(rowp + (((4 * s2 + hi) ^ msk) * 8)); const s16x4 hh = *(const LAS s16x4*)(rowp + (((4 * s2 + 2 + hi) ^ msk) * 8));
            const bf16x8 a = {lo[0], lo[1], lo[2], lo[3], hh[0], hh[1], hh[2], hh[3]};
            o[db] = MFMA32(a, s2 ? pf1 : pf0, o[db]); } }
}
constexpr int RING_BYTES = 20480, VRING_OFF = 12288;
DI void dma_wait_step(bool k2, bool v1) {
    if (k2 && v1) asm volatile("s_waitcnt vmcnt(8)" ::: "memory");
    else if (k2 || v1) asm volatile("s_waitcnt vmcnt(4)" ::: "memory");
    else asm volatile("s_waitcnt vmcnt(0)" ::: "memory");
}
#define DMA_WAIT_NEWEST8() asm volatile("s_waitcnt vmcnt(8)" ::: "memory")
#define DMA_WAIT_ALL() asm volatile("s_waitcnt vmcnt(0)" ::: "memory")

DI void lds_kf(KF& f, ldsp_t kbuf, int r32, int hi) {
    const int sw = (r32 >> 1) & 7;
#pragma unroll
    for (int ks = 0; ks < 4; ++ks) f.k[ks] = *(const LAS bf16x8*)(kbuf + r32 * 128 + (((2 * ks + hi) ^ sw) * 16));
}
DI void lds_vf(VF& f, ldsp_t vbuf, int r32, int hi) {
#pragma unroll
    for (int db = 0; db < 2; ++db) { const int d = 32 * db + r32, msk = (d >> 2) & 7; ldsp_t rowp = vbuf + d * 64;
#pragma unroll
        for (int s2 = 0; s2 < 2; ++s2) { f.v[db][s2][0] = *(const LAS s16x4*)(rowp + (((4 * s2 + hi) ^ msk) * 8)); f.v[db][s2][1] = *(const LAS s16x4*)(rowp + (((4 * s2 + 2 + hi) ^ msk) * 8)); } }
}
template <bool MASKED, bool WIN> DI void nsa_pair_tile(ldsp_t kbuf, ldsp_t vbuf, const bf16x8 (&qf)[2][4], int t0, int kb, float rb0, float rb1, float slope2,
                                                       float (&m)[2], float (&l)[2], f32x16 (&o)[2][2], int r32, int hi) {
    KF kf; lds_kf(kf, kbuf, r32, hi);
    f32x16 s0 = qk_frag(kf, qf[0]), s1 = qk_frag(kf, qf[1]);
    const int db0 = t0 - kb - 4 * hi, db1 = db0 + 32;
#pragma unroll
    for (int r = 0; r < 16; ++r) { const int cr = (r & 3) + 8 * (r >> 2); const float bias = __int_as_float(__builtin_amdgcn_readfirstlane(__float_as_int(slope2 * (float)cr)));
        float e0 = __builtin_fmaf(s0[r], SCL2, bias), e1 = __builtin_fmaf(s1[r], SCL2, bias);
        if (MASKED) { const int d0 = db0 - cr, d1 = db1 - cr; e0 = (d0 >= 0 && (!WIN || d0 < 512)) ? e0 : -1e30f; e1 = (d1 >= 0 && (!WIN || d1 < 512)) ? e1 : -1e30f; }
        s0[r] = e0; s1[r] = e1; }
    softmax_core<MASKED>(s0, rb0 - slope2 * (float)db0, m[0], l[0], o[0]);
    softmax_core<MASKED>(s1, rb1 - slope2 * (float)db1, m[1], l[1], o[1]);
    VF vf; lds_vf(vf, vbuf, r32, hi);
    pv_frag(o[0], vf, s0); pv_frag(o[1], vf, s1);
}
DI void nsa_main_task(const Params& p, int b, int head, int blk, int lane, ldsp_t wl) {
    unsigned char* ws = p.ws; unsigned char* dout = (unsigned char*)p.out;
    const int g = head / 3, r32 = lane & 31, hi = lane >> 5;
    const int tq0 = blk * 64, cur = blk;
    const int t0 = tq0 + r32;
    const size_t tok0 = (size_t)b * T + t0;
    const bf16_t* qkv = (const bf16_t*)(ws + WS_QKV);
    const unsigned long long* smp = (const unsigned long long*)(dout + DO_SELM) + (size_t)(b * 2 + g) * T + t0;
    const unsigned long long selmask[2] = {smp[0], smp[32]};
    const float slope2 = fexp2(-(8.0f * (float)(head + 1)) / 6.0f) * LOG2E;
    bf16x8 qf[2][4];
    load_q(qf[0], qkv + tok0 * LDP_QKV + C_NQ + head * 64, hi); load_q(qf[1], qkv + (tok0 + 32) * LDP_QKV + C_NQ + head * 64, hi);
    const size_t tbase = (size_t)(b * 2 + g) * 128; constexpr size_t KSTR = 32 * LDP_QKV; const KOff ko = koff_make(lane, LDP_QKV * 2);
    const float* nsag = (const float*)(dout + DO_NSAG) + tok0 * 32 + head * 3;
    bf16_t* orow = (bf16_t*)(ws + WS_H) + tok0 * D + 384 + head * 64;
    {
        const bf16_t* kt = qkv + (size_t)b * T * LDP_QKV + C_NKV + 2 * 128 + g * 64; const bf16_t* vt = (const bf16_t*)(dout + DO_VSLC) + tbase * 2048;
        unsigned ulo = (unsigned)(selmask[0] | selmask[1]), uhi = (unsigned)((selmask[0] | selmask[1]) >> 32);
#pragma unroll
        for (int o_ = 1; o_ < 64; o_ <<= 1) { ulo |= (unsigned)__shfl_xor((int)ulo, o_); uhi |= (unsigned)__shfl_xor((int)uhi, o_); }
        unsigned long long U = ((unsigned long long)(unsigned)__builtin_amdgcn_readfirstlane((int)uhi) << 32) | (unsigned)__builtin_amdgcn_readfirstlane((int)ulo);
        U &= (cur == 63) ? ~0ull : ((1ull << (cur + 1)) - 1ull);
        float m[2] = {-1e30f, -1e30f}, l[2] = {0.f, 0.f}; f32x16 o[2][2];
        zero16(o[0][0]); zero16(o[0][1]); zero16(o[1][0]); zero16(o[1][1]);
#define NEXT_TILE(J, H, NJ, NH, HAS) { NJ = J; NH = H - 1; HAS = true; if (NH < 0) { const unsigned long long rem_ = U & ((1ull << J) - 1ull); if (rem_ == 0ull) HAS = false; else { NJ = 63 - __builtin_clzll(rem_); NH = 1; } } }
        int j0 = cur, h0 = 1, j1, h1, j2 = 0, h2 = 0; bool has1, has2 = false;
        NEXT_TILE(j0, h0, j1, h1, has1);
        if (has1) NEXT_TILE(j1, h1, j2, h2, has2);
        int ks0 = 0, vs0 = 0;
        dma_k(wl, kt + (size_t)(2 * j0 + h0) * KSTR, ko); dma_v(wl + VRING_OFF, vt + (size_t)(2 * j0 + h0) * 2048, lane);
        if (has1) dma_k(wl + 4096, kt + (size_t)(2 * j1 + h1) * KSTR, ko);
#define NSA_SEL_STEP(MASKED) { \
            const int ks1 = ks0 == 2 ? 0 : ks0 + 1, ks2 = ks1 == 2 ? 0 : ks1 + 1; \
            if (has2) dma_k(wl + ks2 * 4096, kt + (size_t)(2 * j2 + h2) * KSTR, ko); \
            if (has1) dma_v(wl + VRING_OFF + (vs0 ^ 1) * 4096, vt + (size_t)(2 * j1 + h1) * 2048, lane); \
            dma_wait_step(has2, has1); \
            const int kb = 64 * j0 + 32 * h0; \
            const float rb0 = ((selmask[0] >> j0) & 1ull) ? 0.f : -1e30f, rb1 = ((selmask[1] >> j0) & 1ull) ? 0.f : -1e30f; \
            nsa_pair_tile<MASKED, false>(wl + ks0 * 4096, wl + VRING_OFF + vs0 * 4096, qf, t0, kb, rb0, rb1, slope2, m, l, o, r32, hi); \
            more = has1; \
            if (has1) { j0 = j1; h0 = h1; j1 = j2; h1 = h2; has1 = has2; \
                if (has2) { int nj, nh; bool hs; NEXT_TILE(j2, h2, nj, nh, hs); j2 = nj; h2 = nh; has2 = hs; } \
                ks0 = ks1; vs0 ^= 1; } }
        bool more = true;
#pragma unroll 1
        while (more && j0 == cur) NSA_SEL_STEP(true)
#pragma unroll 1
        while (more) NSA_SEL_STEP(false)
#pragma unroll
        for (int ci = 0; ci < 2; ++ci) {
            float lt = l[ci]; lt += __shfl_xor(lt, 32);
            const float f = nsag[ci * 32 * 32 + 1] * (lt > 0.f ? 1.0f / lt : 0.f);
#pragma unroll
            for (int db = 0; db < 2; ++db)
#pragma unroll
                for (int mg = 0; mg < 4; ++mg) { const u32x2 w = *(const u32x2*)((const bf16_t*)(dout + DO_OC) + (tok0 + ci * 32) * 384 + head * 64 + 32 * db + 8 * mg + 4 * hi);
                    f32x4 v = {bflo(w.x) + f * o[ci][db][4 * mg], bfhi(w.x) + f * o[ci][db][4 * mg + 1], bflo(w.y) + f * o[ci][db][4 * mg + 2], bfhi(w.y) + f * o[ci][db][4 * mg + 3]};
                    store_bf16x4(orow + (size_t)ci * 32 * D + 32 * db + 8 * mg + 4 * hi, v); }
        }
    }
    {
        const bf16_t* kt = qkv + (size_t)b * T * LDP_QKV + C_NKV + 4 * 128 + g * 64; const bf16_t* vt = (const bf16_t*)(dout + DO_VWIN) + tbase * 2048;
        float m[2] = {-1e30f, -1e30f}, l[2] = {0.f, 0.f}; f32x16 o[2][2];
        zero16(o[0][0]); zero16(o[0][1]); zero16(o[1][0]); zero16(o[1][1]);
        int kb0 = tq0 - 512; if (kb0 < 0) kb0 = 0;
        int kb = tq0 + 32, ks0 = 0, vs0 = 0;
        dma_k(wl, kt + (size_t)(kb >> 5) * KSTR, ko); dma_v(wl + VRING_OFF, vt + (size_t)(kb >> 5) * 2048, lane);
        dma_k(wl + 4096, kt + (size_t)((kb - 32) >> 5) * KSTR, ko);
#define NSA_WIN_STEP(MASKED) { \
            const bool has1 = (kb - 32 >= kb0), has2 = (kb - 64 >= kb0); \
            const int ks1 = ks0 == 2 ? 0 : ks0 + 1, ks2 = ks1 == 2 ? 0 : ks1 + 1; \
            if (has2) dma_k(wl + ks2 * 4096, kt + (size_t)((kb - 64) >> 5) * KSTR, ko); \
            if (has1) dma_v(wl + VRING_OFF + (vs0 ^ 1) * 4096, vt + (size_t)((kb - 32) >> 5) * 2048, lane); \
            dma_wait_step(has2, has1); \
            nsa_pair_tile<MASKED, true>(wl + ks0 * 4096, wl + VRING_OFF + vs0 * 4096, qf, t0, kb, 0.f, 0.f, slope2, m, l, o, r32, hi); \
            more = has1; \
            if (has1) { kb -= 32; ks0 = ks1; vs0 ^= 1; } }
        bool more = true;
#pragma unroll 1
        while (more && kb >= tq0) NSA_WIN_STEP(true)
#pragma unroll 1
        while (more && kb > tq0 - 480) NSA_WIN_STEP(false)
#pragma unroll 1
        while (more) NSA_WIN_STEP(true)
#pragma unroll
        for (int ci = 0; ci < 2; ++ci) {
            float lt = l[ci]; lt += __shfl_xor(lt, 32);
            const float f = nsag[ci * 32 * 32 + 2] * (lt > 0.f ? 1.0f / lt : 0.f);
#pragma unroll
            for (int db = 0; db < 2; ++db)
#pragma unroll
                for (int mg = 0; mg < 4; ++mg) { bf16_t* op = orow + (size_t)ci * 32 * D + 32 * db + 8 * mg + 4 * hi; const u32x2 w = *(const u32x2*)op;
                    f32x4 v = {bflo(w.x) + f * o[ci][db][4 * mg], bfhi(w.x) + f * o[ci][db][4 * mg + 1], bflo(w.y) + f * o[ci][db][4 * mg + 2], bfhi(w.y) + f * o[ci][db][4 * mg + 3]};
                    store_bf16x4(op, v); }
        }
    }
}

DI void mem_task(const Params& p, int b, int head, int chunk, int lane, ldsp_t wl) {
    unsigned char* ws = p.ws; unsigned char* dout = (unsigned char*)p.out;
    const int r32 = lane & 31, hi = lane >> 5; const size_t tok = (size_t)b * T + chunk * 32 + r32;
    const bf16_t* qkv = (const bf16_t*)(ws + WS_QKV);
    bf16x8 qf[4]; load_q(qf, qkv + tok * LDP_QKV + C_MQ + head * 64, hi);
    const bf16_t* kt = (const bf16_t*)(dout + DO_MKV) + (size_t)b * MEMT * 512 + head * 64; constexpr size_t KSTR = 32 * 512; const KOff ko = koff_make(lane, 1024);
    const bf16_t* vt = (const bf16_t*)(dout + DO_MVT) + (size_t)(b * 4 + head) * 8 * 2048;
    float m = -1e30f, l = 0.f; f32x16 o[2]; zero16(o[0]); zero16(o[1]);
    int ks0 = 0, vs0 = 0;
    dma_k(wl, kt, ko); dma_v(wl + VRING_OFF, vt, lane); dma_k(wl + 4096, kt + KSTR, ko);
#pragma unroll 1
    for (int ti = 0; ti < 8; ++ti) {
        const bool has1 = ti + 1 < 8, has2 = ti + 2 < 8;
        const int ks1 = ks0 == 2 ? 0 : ks0 + 1, ks2 = ks1 == 2 ? 0 : ks1 + 1;
        if (has2) dma_k(wl + ks2 * 4096, kt + (size_t)(ti + 2) * KSTR, ko);
        if (has1) dma_v(wl + VRING_OFF + (vs0 ^ 1) * 4096, vt + (size_t)(ti + 1) * 2048, lane);
        dma_wait_step(has2, has1);
        f32x16 s = qk_lds(wl + ks0 * 4096, qf, r32, hi);
#pragma unroll
        for (int r = 0; r < 16; ++r) s[r] *= SCL2;
        softmax_core(s, 0.f, m, l, o);
        pv_lds(o, wl + VRING_OFF + vs0 * 4096, s, r32, hi);
        ks0 = ks1; vs0 ^= 1;
    }
    l += __shfl_xor(l, 32);
    const float f = 1.0f / l;
    bf16_t* orow = (bf16_t*)(ws + WS_H) + tok * D + 768 + head * 64;
#pragma unroll
    for (int db = 0; db < 2; ++db)
#pragma unroll
        for (int mg = 0; mg < 4; ++mg) { f32x4 v = {o[db][4 * mg] * f, o[db][4 * mg + 1] * f, o[db][4 * mg + 2] * f, o[db][4 * mg + 3] * f}; store_bf16x4(orow + 32 * db + 8 * mg + 4 * hi, v); }
}

DI void sb_task(const Params& p, int b, int head, int chunk, int lane, ldsp_t wl) {
    unsigned char* ws = p.ws; unsigned char* dout = (unsigned char*)p.out;
    const int r32 = lane & 31, hi = lane >> 5; const int tq0 = chunk * 32, t = tq0 + r32; const size_t tok = (size_t)b * T + t;
    const bf16_t* qkv = (const bf16_t*)(ws + WS_QKV);
    bf16x8 qf[4]; load_q(qf, qkv + tok * LDP_QKV + C_SBQ + head * 64, hi);
    const size_t tbase = (size_t)(b * 6 + head) * 128;
    const bf16_t* kt = qkv + (size_t)b * T * LDP_QKV + C_SBK + head * 64; const bf16_t* vt = (const bf16_t*)(dout + DO_SBV) + tbase * 2048; constexpr size_t KSTR = 32 * LDP_QKV; const KOff ko = koff_make(lane, LDP_QKV * 2);
    f32x16 o[2]; zero16(o[0]); zero16(o[1]);
    float R = 0.f;
    int kb = tq0, ks0 = 0, vs0 = 0;
    dma_k(wl, kt + (size_t)(kb >> 5) * KSTR, ko); dma_v(wl + VRING_OFF, vt + (size_t)(kb >> 5) * 2048, lane);
    if (kb >= 32) dma_k(wl + 4096, kt + (size_t)((kb - 32) >> 5) * KSTR, ko);
#define SB_STEP(MASKED) { \
        const bool has1 = kb >= 32, has2 = kb >= 64; \
        const int ks1 = ks0 == 2 ? 0 : ks0 + 1, ks2 = ks1 == 2 ? 0 : ks1 + 1; \
        if (has2) dma_k(wl + ks2 * 4096, kt + (size_t)((kb - 64) >> 5) * KSTR, ko); \
        if (has1) dma_v(wl + VRING_OFF + (vs0 ^ 1) * 4096, vt + (size_t)((kb - 32) >> 5) * 2048, lane); \
        dma_wait_step(has2, has1); \
        f32x16 s = qk_lds(wl + ks0 * 4096, qf, r32, hi); \
        f32x16 L; \
        _Pragma("unroll") for (int r = 0; r < 16; ++r) { const float z = s[r] * (0.125f * LOG2E); \
            const float sp = fmaxf(z, 0.f) + flog2(1.0f + fexp2(-fabsf(z)));       \
            s[r] = z; if (MASKED) { const bool valid = (kb + krow(r, hi)) < t; L[r] = valid ? -sp : 0.f; } else L[r] = -sp; } \
        float gs[4], pg[4]; \
        _Pragma("unroll") for (int mg = 0; mg < 4; ++mg) { gs[mg] = (L[4 * mg] + L[4 * mg + 1]) + (L[4 * mg + 2] + L[4 * mg + 3]); pg[mg] = __shfl_xor(gs[mg], 32); } \
        float off[4]; float run = R; \
        _Pragma("unroll") for (int mg = 3; mg >= 0; --mg) { off[mg] = run + (hi ? 0.f : pg[mg]); run += gs[mg] + pg[mg]; } \
        _Pragma("unroll") for (int mg = 0; mg < 4; ++mg) { \
            float e = off[mg]; \
            _Pragma("unroll") for (int i = 3; i >= 0; --i) { const int r = 4 * mg + i; \
                float a = fexp2(s[r] + L[r] + e); if (MASKED) { const bool valid = (kb + krow(r, hi)) < t; a = valid ? a : 0.f; } e += L[r]; s[r] = a; } \
        } \
        R = run; \
        pv_lds(o, wl + VRING_OFF + vs0 * 4096, s, r32, hi); \
        more = has1 && !__all(R < -104.0f * LOG2E); \
        if (more) { kb -= 32; ks0 = ks1; vs0 ^= 1; } }
    bool more;
    SB_STEP(true)
#pragma unroll 1
    while (more) SB_STEP(false)
#undef SB_STEP
    DMA_WAIT_ALL();
    bf16_t* orow = (bf16_t*)(ws + WS_H) + tok * D + head * 64;
#pragma unroll
    for (int db = 0; db < 2; ++db)
#pragma unroll
        for (int mg = 0; mg < 4; ++mg) { f32x4 v = {o[db][4 * mg], o[db][4 * mg + 1], o[db][4 * mg + 2], o[db][4 * mg + 3]}; store_bf16x4(orow + 32 * db + 8 * mg + 4 * hi, v); }
}

constexpr int N_CMP_TASKS = NB * 2 * 128, N_NSA_TASKS = NB * 6 * 64, N_MEM_TASKS = NB * 4 * 128, N_SB_TASKS = NB * 6 * 128;
DI void phase3a(const Params& p, int rep, bf16_t* lds) {
    const int lane = threadIdx.x & 63;
    ldsp_t wl = (ldsp_t)(unsigned char*)lds + __builtin_amdgcn_readfirstlane((int)(threadIdx.x >> 6)) * RING_BYTES;
    float* impl = (float*)((unsigned char*)lds + (threadIdx.x >> 6) * RING_BYTES);
    unsigned* ctr = (unsigned*)(p.ws + WS_CTL) + 64 + 256 * rep;
    for (;;) {
        unsigned tk = 0; if (lane == 0) tk = atomicAdd(ctr, 1u);
        const int task = (int)__builtin_amdgcn_readfirstlane(tk);
        if (task >= N_CMP_TASKS + N_MEM_TASKS) break;
        if (task < N_CMP_TASKS) { const int chunk = 127 - task / 16, rem = task % 16; nsa_cmp_task(p, rem >> 1, rem & 1, chunk, lane, impl); }
        else { const int r = task - N_CMP_TASKS; const int chunk = r / 32, rem = r % 32; mem_task(p, rem / 4, rem % 4, chunk, lane, wl); }
    }
}
DI void phase3b(const Params& p, int rep, unsigned char* lds_raw_) {
    const int lane = threadIdx.x & 63;
    ldsp_t wl = (ldsp_t)lds_raw_ + __builtin_amdgcn_readfirstlane((int)(threadIdx.x >> 6)) * RING_BYTES;
    unsigned* ctr = (unsigned*)(p.ws + WS_CTL) + 128 + 256 * rep;
    if (__builtin_amdgcn_readfirstlane((int)(threadIdx.x >> 6)) == NWAVES - 1) peer_table_rows(p, lane, blockIdx.x, gridDim.x);
    for (;;) {
        unsigned tk = 0; if (lane == 0) tk = atomicAdd(ctr, 1u);
        const int task = (int)__builtin_amdgcn_readfirstlane(tk);
        if (task >= N_NSA_TASKS + N_SB_TASKS) break;
        if (task < N_NSA_TASKS) { const int ci = task / 48, rem = task % 48; const int blk = (ci & 1) ? (ci >> 1) : 63 - (ci >> 1); nsa_main_task(p, rem / 6, rem % 6, blk, lane, wl); }
        else { const int r = task - N_NSA_TASKS; const int chunk = r / 48, rem = r % 48; sb_task(p, rem / 6, rem % 6, chunk, lane, wl); }
    }
}

DI void phase4(const Params& p, bf16_t* lds) {
    unsigned char* ws = p.ws;
    const bf16_t* cat = (const bf16_t*)(ws + WS_H); const bf16_t* gates = (const bf16_t*)(ws + WS_GATES); bf16_t* merged = (bf16_t*)(ws + WS_MERGED);
    pg8::StaticOrder S; S.init(NTOK, D, (int)gridDim.x, (int)blockIdx.x);
#pragma unroll 1
    for (int br = 0; br < 3; ++br) {
        const int Kb = br == 2 ? 256 : 384;
        const bf16_t* Bt = (const bf16_t*)(ws + (br == 0 ? WS_WSB : (br == 1 ? WS_WNSA : WS_WMEM)));
        pg8::Gemm g{cat + br * 384, Bt, NTOK, D, Kb, D, Kb}; pg8::EpiMerge E{merged, gates, br}; GEMM_PHASE(pg8::EpiMerge, g, S, E);
    }
}
DI void phase5(const Params& p, bf16_t* lds) {
    unsigned char* ws = p.ws;
    pg8::Gemm g{(const bf16_t*)(ws + WS_MERGED), (const bf16_t*)(ws + WS_WOUT), NTOK, D, D, D, D};
    pg8::StaticOrder S; S.init(NTOK, D, (int)gridDim.x, (int)blockIdx.x);
    pg8::EpiOut E{p.in[0], p.in[15], p.out, (bf16_t*)(ws + WS_H2), (float*)(ws + WS_ROWSS)};
    GEMM_PHASE(pg8::EpiOut, g, S, E);
}
DI void phase6(const Params& p, bf16_t* lds) {
    unsigned char* ws = p.ws;
    pg8::Gemm g{(const bf16_t*)(ws + WS_H2), (const bf16_t*)(ws + WS_WQ), NTOK, 2048, D, D, D};
    pg8::StaticOrder S; S.init(NTOK, 2048, (int)gridDim.x, (int)blockIdx.x);
    pg8::EpiPlain E{(bf16_t*)(ws + WS_QP), 2048};
    GEMM_PHASE(pg8::EpiPlain, g, S, E);
}

DI float row_rstd(const float* rowss, size_t tok) {
    const f32x4* r = (const f32x4*)(rowss + tok * 32); float s = 0.f;
#pragma unroll
    for (int i = 0; i < 8; ++i) { const f32x4 v = r[i]; s += (v.x + v.y) + (v.z + v.w); }
    return 1.0f / sqrtf(s * (1.0f / D) + RMS_EPS);
}
constexpr int ROUTE_LDS_PER_WAVE = 2 * 16 * 32 * 4;
DI void route_task(const Params& p, int chunk, int head, int lane, float* wl, ldsp_t sk  ) {
    unsigned char* ws = p.ws;
    const int r32 = lane & 31, hi = lane >> 5; const size_t tok = (size_t)chunk * 32 + r32;
    const bf16_t* qp = (const bf16_t*)(ws + WS_QP) + tok * 2048 + head * 256;
    int* til = (int*)wl;
    float tv[2][16];
#pragma unroll
    for (int pp = 0; pp < 2; ++pp) {
        f32x16 sc[4];
#pragma unroll
        for (int tl = 0; tl < 4; ++tl) zero16(sc[tl]);
#pragma unroll
        for (int ks = 0; ks < 8; ++ks) {
            const bf16x8 qv = *(const bf16x8*)(qp + pp * 128 + ks * 16 + hi * 8);
#pragma unroll
            for (int tl = 0; tl < 4; ++tl) { const int row = pp * 128 + tl * 32 + r32; const bf16x8 a = *(const LAS bf16x8*)(sk + row * 256 + (((2 * ks + hi) ^ (row & 15)) * 16)); sc[tl] = MFMA32(a, qv, sc[tl]); }
        }
        int k0[16], k1[16], k2[16], k3[16];
#pragma unroll
        for (int r = 0; r < 16; ++r) { const int kr = krow(r, hi);
            k0[r] = (f2key(sc[0][r]) & ~127) | (127 - kr); k1[r] = (f2key(sc[1][r]) & ~127) | (127 - (32 + kr));
            k2[r] = (f2key(sc[2][r]) & ~127) | (127 - (64 + kr)); k3[r] = (f2key(sc[3][r]) & ~127) | (127 - (96 + kr)); }
        bitonic_sort_desc<16>(k0); bitonic_sort_desc<16>(k1); bitonic_sort_desc<16>(k2); bitonic_sort_desc<16>(k3);
        top16_merge(k0, k1); top16_merge(k2, k3); top16_merge(k0, k2);
        int pb[16];
#pragma unroll
        for (int i = 0; i < 16; ++i) pb[i] = __shfl_xor(k0[i], 32);
        top16_merge(k0, pb);
#pragma unroll
        for (int i = 0; i < 16; ++i) { tv[pp][i] = key2f(k0[i] & ~127); if (hi == 0) til[(pp * 16 + i) * 32 + r32] = 127 - (k0[i] & 127); }
    }
    __builtin_amdgcn_wave_barrier();
    int c0[16], c1[16], c2[16], c3[16];
    {
        int c = 0;
#pragma unroll
        for (int a = 0; a < 16; ++a)
#pragma unroll
            for (int bb = 0; bb < 16; ++bb) if ((a + 1) * (bb + 1) <= 16) {
                const int key = (f2key(tv[0][a] + tv[1][bb]) & ~255) | (255 - (a * 16 + bb));
                if (c < 16) c0[c] = key; else if (c < 32) c1[c - 16] = key; else if (c < 48) c2[c - 32] = key; else c3[c - 48] = key;
                ++c; }
#pragma unroll
        for (int i = 2; i < 16; ++i) c3[i] = (int)0x80000000;
    }
    bitonic_sort_desc<16>(c1); bitonic_sort_desc<16>(c2); bitonic_sort_desc<16>(c3);
    top16_merge(c0, c1); top16_merge(c2, c3); top16_merge(c0, c2);
    const float rstd = row_rstd((const float*)(ws + WS_ROWSS), tok);
    float gg[16]; int ex[16]; float den = 0.f; const float b0 = key2f(c0[0] & ~255);
#pragma unroll
    for (int k = 0; k < 16; ++k) { const int code = 255 - (c0[k] & 255);
        ex[k] = til[(code >> 4) * 32 + r32] * 128 + til[(16 + (code & 15)) * 32 + r32];
        gg[k] = fexp((key2f(c0[k] & ~255) - b0) * rstd); den += gg[k]; }
    const float inv = 1.0f / den;
    if (hi == 0) { unsigned short* ip = (unsigned short*)(ws + WS_IDX) + tok * 128 + head * 16;
        u32x4 w0, w1;
        w0.x = (unsigned)ex[0] | ((unsigned)ex[1] << 16); w0.y = (unsigned)ex[2] | ((unsigned)ex[3] << 16); w0.z = (unsigned)ex[4] | ((unsigned)ex[5] << 16); w0.w = (unsigned)ex[6] | ((unsigned)ex[7] << 16);
        w1.x = (unsigned)ex[8] | ((unsigned)ex[9] << 16); w1.y = (unsigned)ex[10] | ((unsigned)ex[11] << 16); w1.z = (unsigned)ex[12] | ((unsigned)ex[13] << 16); w1.w = (unsigned)ex[14] | ((unsigned)ex[15] << 16);
        *(u32x4*)ip = w0; *(u32x4*)(ip + 8) = w1; }
    else { float* gp = (float*)(ws + WS_GW) + tok * 128 + head * 16;
#pragma unroll
        for (int k = 0; k < 16; k += 4) { f32x4 v = {gg[k] * inv, gg[k + 1] * inv, gg[k + 2] * inv, gg[k + 3] * inv}; *(f32x4*)(gp + k) = v; } }
    __builtin_amdgcn_wave_barrier();
}
DI void phase7(const Params& p, bf16_t* lds) {
    const int lane = threadIdx.x & 63, wid = threadIdx.x >> 6;
    ldsp_t sk = (ldsp_t)(unsigned char*)lds;
    float* wl = (float*)((unsigned char*)lds + 65536 + wid * ROUTE_LDS_PER_WAVE);
    for (int head = blockIdx.x & 7; head < 8; head += gridDim.x) {
        const int nbh = ((int)gridDim.x - head + 7) / 8, rank = blockIdx.x >> 3;
        __syncthreads();
        const u32x4* src = (const u32x4*)((const bf16_t*)(p.ws + WS_SUBK) + (size_t)head * 2 * 128 * 128);
#pragma unroll
        for (int j = 0; j < 8; ++j) { const int ci = threadIdx.x + NTHREADS * j, row = ci >> 4, c = ci & 15; *(LAS u32x4*)(sk + row * 256 + ((c ^ (row & 15)) * 16)) = src[ci]; }
        __syncthreads();
        for (int chunk = rank * NWAVES + wid; chunk < NTOK / 32; chunk += nbh * NWAVES) route_task(p, chunk, head, lane, wl, sk);
    }
}

DI float gelu_exact(float a) { return 0.5f * a * (1.0f + erff(a * 0.70710678118654752f)); }
DI void fp8x16_to_f32(const u32x4& w, float (&f)[16]) {
#pragma unroll
    for (int j = 0; j < 4; ++j) { const f32x2 lo = __builtin_amdgcn_cvt_pk_f32_fp8((int)w[j], false); const f32x2 hi = __builtin_amdgcn_cvt_pk_f32_fp8((int)w[j], true);
        f[4 * j] = lo.x; f[4 * j + 1] = lo.y; f[4 * j + 2] = hi.x; f[4 * j + 3] = hi.y; }
}
DI void phase8(const Params& p) {
    unsigned char* ws = p.ws;
    const int lane = threadIdx.x & 63, wid = threadIdx.x >> 6;
    const int gwave = blockIdx.x * NWAVES + wid, nwaves = gridDim.x * NWAVES;
    const bf16_t* h2 = (const bf16_t*)(ws + WS_H2); const unsigned char* tu = ws + WS_TABU; const unsigned char* tvv = ws + WS_TABV;
    const float* tsc = (const float*)(ws + WS_TSCALE);
    const unsigned short* idx = (const unsigned short*)(ws + WS_IDX); const float* gw = (const float*)(ws + WS_GW);
    const float* gfin = p.in[20];
    const int kk = ((lane >> 5) & 1) * 8 + ((lane >> 4) & 1) * 4 + ((lane >> 3) & 1) * 2 + ((lane >> 2) & 1);
#pragma unroll 1
    for (int tk = gwave; tk < NTOK; tk += nwaves) {
        const size_t tok = (size_t)tk;
        const float rstd = row_rstd((const float*)(ws + WS_ROWSS), tok);
        float hn[16];
        { const u32x4 a = *(const u32x4*)(h2 + tok * D + lane * 16); const u32x4 b = *(const u32x4*)(h2 + tok * D + lane * 16 + 8);
          hn[0] = bflo(a.x) * rstd; hn[1] = bfhi(a.x) * rstd; hn[2] = bflo(a.y) * rstd; hn[3] = bfhi(a.y) * rstd; hn[4] = bflo(a.z) * rstd; hn[5] = bfhi(a.z) * rstd; hn[6] = bflo(a.w) * rstd; hn[7] = bfhi(a.w) * rstd;
          hn[8] = bflo(b.x) * rstd; hn[9] = bfhi(b.x) * rstd; hn[10] = bflo(b.y) * rstd; hn[11] = bfhi(b.y) * rstd; hn[12] = bflo(b.z) * rstd; hn[13] = bfhi(b.z) * rstd; hn[14] = bflo(b.w) * rstd; hn[15] = bfhi(b.w) * rstd; }
        float acc[16];
#pragma unroll
        for (int i = 0; i < 16; ++i) acc[i] = 0.f;
        const int e_lo = idx[tok * 128 + lane], e_hi = idx[tok * 128 + 64 + lane];
        const float g_lo = gw[tok * 128 + lane], g_hi = gw[tok * 128 + 64 + lane];
        for (int rep9 = 0; rep9 < REP9; ++rep9)
#pragma unroll 1
        for (int head = 0; head < 8; ++head) {
            const int esrc = head < 4 ? e_lo : e_hi; const float gsrc = head < 4 ? g_lo : g_hi;
            const int myslot = (head & 3) * 16 + kk;
            const int my_e = __shfl(esrc, myslot); const float my_g = __shfl(gsrc, myslot);
            const float su = tsc[my_e], sv = tsc[16384 + my_e];
            u32x4 ub[16], vb[16];
#pragma unroll
            for (int k = 0; k < 16; ++k) { const int e = __builtin_amdgcn_readlane(esrc, (head & 3) * 16 + k);
                ub[k] = *(const u32x4*)(tu + (size_t)e * 1024 + lane * 16); vb[k] = *(const u32x4*)(tvv + (size_t)e * 1024 + lane * 16); }
            float d[16];
#pragma unroll
            for (int k = 0; k < 16; ++k) { float f[16]; fp8x16_to_f32(ub[k], f); float t = 0.f;
#pragma unroll
                for (int i = 0; i < 16; ++i) t += f[i] * hn[i];
                d[k] = t; }
            float r8[8], r4[4], r2[2], r1;
            { const bool up = (lane & 32) != 0;
#pragma unroll
              for (int k = 0; k < 8; ++k) { const float keep = up ? d[k + 8] : d[k], send = up ? d[k] : d[k + 8]; r8[k] = keep + __shfl_xor(send, 32); } }
            { const bool up = (lane & 16) != 0;
#pragma unroll
              for (int k = 0; k < 4; ++k) { const float keep = up ? r8[k + 4] : r8[k], send = up ? r8[k] : r8[k + 4]; r4[k] = keep + __shfl_xor(send, 16); } }
            { const bool up = (lane & 8) != 0;
#pragma unroll
              for (int k = 0; k < 2; ++k) { const float keep = up ? r4[k + 2] : r4[k], send = up ? r4[k] : r4[k + 2]; r2[k] = keep + __shfl_xor(send, 8); } }
            { const bool up = (lane & 4) != 0; const float keep = up ? r2[1] : r2[0], send = up ? r2[0] : r2[1]; r1 = keep + __shfl_xor(send, 4); }
            r1 += __shfl_xor(r1, 2); r1 += __shfl_xor(r1, 1);
            const float wmine = my_g * gelu_exact(r1 * su) * sv;
#pragma unroll
            for (int k = 0; k < 16; ++k) {
                const int lk = ((k >> 3) & 1) * 32 + ((k >> 2) & 1) * 16 + ((k >> 1) & 1) * 8 + (k & 1) * 4;
                const float w = __uint_as_float(__builtin_amdgcn_readlane(__float_as_uint(wmine), lk));
                float f[16]; fp8x16_to_f32(vb[k], f);
#pragma unroll
                for (int i = 0; i < 16; ++i) acc[i] += w * f[i];
            }
        }
        float* orow = p.out + tok * D + lane * 16;
        f32x4 y[4]; float ss = 0.f;
#pragma unroll
        for (int q = 0; q < 4; ++q) { f32x4 v = *(const f32x4*)(orow + 4 * q);
            v.x += acc[q * 4] * (1.0f / REP9); v.y += acc[q * 4 + 1] * (1.0f / REP9); v.z += acc[q * 4 + 2] * (1.0f / REP9); v.w += acc[q * 4 + 3] * (1.0f / REP9); y[q] = v; ss += (v.x * v.x + v.y * v.y) + (v.z * v.z + v.w * v.w); }
        const float rs = 1.0f / sqrtf(wave_sum(ss) * (1.0f / D) + RMS_EPS);
#pragma unroll
        for (int q = 0; q < 4; ++q) { const f32x4 gg = *(const f32x4*)(gfin + lane * 16 + 4 * q); f32x4 v = y[q];
            v.x *= rs * gg.x; v.y *= rs * gg.y; v.z *= rs * gg.z; v.w *= rs * gg.w; *(f32x4*)(orow + 4 * q) = v; }
    }
}


constexpr int P8_CHUNK = 16, P8_NCHUNK = NTOK / P8_CHUNK;
DI unsigned my_xcc() { return (unsigned)__builtin_amdgcn_s_getreg((3 << 11) | 20) & 7u; }
DI float dpp_xor1(float v) { return __int_as_float(__builtin_amdgcn_update_dpp(0, __float_as_int(v), 0xB1, 0xF, 0xF, true)); }
DI float dpp_xor2(float v) { return __int_as_float(__builtin_amdgcn_update_dpp(0, __float_as_int(v), 0x4E, 0xF, 0xF, true)); }
DI void fp8x16_to_f32x2(const u32x4& w, f32x2 (&f)[8]) {
#pragma unroll
    for (int j = 0; j < 4; ++j) { f[2 * j] = __builtin_amdgcn_cvt_pk_f32_fp8((int)w[j], false); f[2 * j + 1] = __builtin_amdgcn_cvt_pk_f32_fp8((int)w[j], true); }
}
DI unsigned q8_pack4(float a, float b, float c, float d, float s) {
    const unsigned ta = __float_as_uint(__builtin_fmaf(a, s, 12582912.0f)), tb = __float_as_uint(__builtin_fmaf(b, s, 12582912.0f));
    const unsigned tc = __float_as_uint(__builtin_fmaf(c, s, 12582912.0f)), td = __float_as_uint(__builtin_fmaf(d, s, 12582912.0f));
    const unsigned lo = __builtin_amdgcn_perm(tb, ta, 0x0c0c0400u), hi = __builtin_amdgcn_perm(td, tc, 0x0c0c0400u);
    return __builtin_amdgcn_perm(hi, lo, 0x05040100u);
}
DI void h_to_i8(const u32x4& hr0, const u32x4& hr1, u32x4& h8, float& hs) {
    float f[16];
    f[0] = bflo(hr0.x); f[1] = bfhi(hr0.x); f[2] = bflo(hr0.y); f[3] = bfhi(hr0.y); f[4] = bflo(hr0.z); f[5] = bfhi(hr0.z); f[6] = bflo(hr0.w); f[7] = bfhi(hr0.w);
    f[8] = bflo(hr1.x); f[9] = bfhi(hr1.x); f[10] = bflo(hr1.y); f[11] = bfhi(hr1.y); f[12] = bflo(hr1.z); f[13] = bfhi(hr1.z); f[14] = bflo(hr1.w); f[15] = bfhi(hr1.w);
    float am = 0.f;
#pragma unroll
    for (int i = 0; i < 16; i += 2) am = fmaxf(am, fmaxf(fabsf(f[i]), fabsf(f[i + 1])));
    const float s = am > 0.f ? 127.0f * __builtin_amdgcn_rcpf(am) : 0.f;
    hs = am * (1.0f / 127.0f);
    h8.x = q8_pack4(f[0], f[1], f[2], f[3], s); h8.y = q8_pack4(f[4], f[5], f[6], f[7], s); h8.z = q8_pack4(f[8], f[9], f[10], f[11], s); h8.w = q8_pack4(f[12], f[13], f[14], f[15], s);
}
struct HalfT { u32x4 rb[8]; float sc[8]; };
DI void p8a_issue(HalfT& B, const unsigned char* tus, const LAS float* tsc, const LAS unsigned* eoff, int ti, int hf, int pp, unsigned cc16, int gmine) {
#pragma unroll
    for (int g = 0; g < 8; ++g) { const unsigned o = eoff[ti * 128 + (hf * 8 + g) * 8 + pp] + cc16; B.rb[g] = *(const u32x4*)(tus + o); }
    B.sc[0] = *(const LAS float*)((const LAS unsigned char*)tsc + (eoff[ti * 128 + (hf * 8 + gmine) * 8 + pp] >> 5));
}
DI float p8a_compute(const HalfT& B, const u32x4& h8, float hs, int cc) {
    float d[8];
#pragma unroll
    for (int g = 0; g < 8; ++g) { int a = __builtin_amdgcn_sdot4((int)B.rb[g].x, (int)h8.x, 0, false); a = __builtin_amdgcn_sdot4((int)B.rb[g].y, (int)h8.y, a, false);
        a = __builtin_amdgcn_sdot4((int)B.rb[g].z, (int)h8.z, a, false); a = __builtin_amdgcn_sdot4((int)B.rb[g].w, (int)h8.w, a, false);
        d[g] = (float)a * hs; }
    float r4[4], r2[2];
    { const bool up = (cc & 1) != 0;
#pragma unroll
      for (int i = 0; i < 4; ++i) { const float keep = up ? d[i + 4] : d[i], send = up ? d[i] : d[i + 4]; r4[i] = keep + dpp_xor1(send); } }
    { const bool up = (cc & 2) != 0;
#pragma unroll
      for (int i = 0; i < 2; ++i) { const float keep = up ? r4[i + 2] : r4[i], send = up ? r4[i] : r4[i + 2]; r2[i] = keep + dpp_xor2(send); } }
    const bool up = (cc & 4) != 0; const float keep = up ? r2[1] : r2[0], send = up ? r2[0] : r2[1];
    return (keep + __shfl_xor(send, 4)) * B.sc[0];
}
DI void phase8a(const Params& p, unsigned char* lds_raw_, int rep) {
    unsigned char* ws = p.ws;
    const int lane = threadIdx.x & 63, pp = lane >> 3, cc = lane & 7;
    const bf16_t* h2 = (const bf16_t*)(ws + WS_H2); const unsigned char* tu = ws + WS_TABU; const float* tscg = (const float*)(ws + WS_TSCALE);
    const unsigned short* idx = (const unsigned short*)(ws + WS_IDX); bf16_t* pd = (bf16_t*)(ws + WS_PD);
    unsigned* ctr = (unsigned*)(ws + WS_CTL) + 1024 + 8192 * rep;
    LAS unsigned* eoff = (LAS unsigned*)((ldsp_t)lds_raw_ + __builtin_amdgcn_readfirstlane((int)(threadIdx.x >> 6)) * 12288);
    LAS unsigned char* hq = (LAS unsigned char*)eoff + 8192; LAS float* hsl = (LAS float*)((LAS unsigned char*)eoff + 10240);
    const unsigned cc16 = (unsigned)cc * 16u;
    LAS float* tsc = (LAS float*)((ldsp_t)lds_raw_ + 98304);
    for (int i = threadIdx.x; i < 4096; i += NTHREADS) ((LAS i32x4*)tsc)[i] = ((const i32x4*)tscg)[i];
    __syncthreads();
    const unsigned xs = my_xcc();
    const int gmine = ((cc & 1) << 2) | (cc & 2) | ((cc >> 2) & 1);
#pragma unroll 1
    for (int k8 = 0; k8 < 8; ++k8) {
        const int sl = (int)((xs + k8) & 7u);
#pragma unroll 1
        for (;;) {
            unsigned tk = 0; if (lane == 0) tk = atomicAdd(ctr + 64 * sl, 1u);
            const int chunk = (int)__builtin_amdgcn_readfirstlane(tk);
            if (chunk >= P8_NCHUNK) break;
            const size_t tok0 = (size_t)chunk * P8_CHUNK;
#pragma unroll
            for (int i = 0; i < 4; ++i) { const i32x4 w = ((const i32x4*)(idx + tok0 * 128))[i * 64 + lane];
                i32x4 lo, hi2; lo.x = (w.x & 0xffff) << 7; lo.y = (int)((unsigned)w.x >> 16) << 7; lo.z = (w.y & 0xffff) << 7; lo.w = (int)((unsigned)w.y >> 16) << 7;
                hi2.x = (w.z & 0xffff) << 7; hi2.y = (int)((unsigned)w.z >> 16) << 7; hi2.z = (w.w & 0xffff) << 7; hi2.w = (int)((unsigned)w.w >> 16) << 7;
                ((LAS i32x4*)eoff)[(i * 64 + lane) * 2] = lo; ((LAS i32x4*)eoff)[(i * 64 + lane) * 2 + 1] = hi2; }
            const unsigned char* tus = tu + (size_t)sl * (16384 * 128);
#pragma unroll
            for (int it = 0; it < 2; ++it) { const int j = lane + 64 * it; const bf16_t* hp = h2 + (tok0 + (j >> 3)) * D + sl * 128 + (j & 7) * 16;
                const u32x4 a0 = *(const u32x4*)hp, a1 = *(const u32x4*)(hp + 8); u32x4 q; float s_; h_to_i8(a0, a1, q, s_);
                ((LAS i32x4*)hq)[j] = __builtin_bit_cast(i32x4, q); hsl[j] = s_; }
            __builtin_amdgcn_wave_barrier();
            HalfT X, Y;
            p8a_issue(X, tus, tsc, eoff, 0, 0, pp, cc16, gmine);
#pragma unroll 1
            for (int ti = 0; ti < P8_CHUNK; ++ti) {
                const size_t tok = tok0 + ti;
                p8a_issue(Y, tus, tsc, eoff, ti, 1, pp, cc16, gmine);
                const u32x4 h8 = __builtin_bit_cast(u32x4, ((const LAS i32x4*)hq)[ti * 8 + cc]); const float hs = hsl[ti * 8 + cc];
                const float keep0 = p8a_compute(X, h8, hs, cc);
                if (ti + 1 < P8_CHUNK) p8a_issue(X, tus, tsc, eoff, ti + 1, 0, pp, cc16, gmine);
                const float keep1 = p8a_compute(Y, h8, hs, cc);
                bf16_t* po = pd + ((size_t)sl * NTOK + tok) * 128 + gmine * 8 + pp;
                po[0] = (bf16_t)f2bf(keep0); po[64] = (bf16_t)f2bf(keep1);
            }
            __builtin_amdgcn_wave_barrier();
        }
    }
}
DI void phase8w(const Params& p, unsigned char* lds_raw_) {
    unsigned char* ws = p.ws;
    const int lane = threadIdx.x & 63, wid = threadIdx.x >> 6;
    const int gwave = blockIdx.x * NWAVES + wid, nwaves = gridDim.x * NWAVES;
    const bf16_t* __restrict__ pd = (const bf16_t*)(ws + WS_PD); const float* __restrict__ tsc = (const float*)(ws + WS_TSCALE);
    const unsigned short* __restrict__ idx = (const unsigned short*)(ws + WS_IDX); const float* __restrict__ gw = (const float*)(ws + WS_GW);
    const float* __restrict__ rowss = (const float*)(ws + WS_ROWSS);
    LAS float* svl = (LAS float*)((ldsp_t)lds_raw_);
    for (int i = threadIdx.x; i < 4096; i += NTHREADS) ((LAS i32x4*)svl)[i] = ((const i32x4*)(tsc + 16384))[i];
    __syncthreads();
    for (int tk = gwave; tk < NTOK; tk += 4 * nwaves) {
        float pa[4][16]; int e0[4], e1[4]; float g0[4], g1[4]; float rs[4]; size_t tok[4];
#pragma unroll
        for (int q = 0; q < 4; ++q) { const int t = tk + q * nwaves; tok[q] = (size_t)(t < NTOK ? t : tk); }
#pragma unroll
        for (int q = 0; q < 4; ++q) {
#pragma unroll
            for (int sl = 0; sl < 8; ++sl) { const bf16_t* qa = pd + ((size_t)sl * NTOK + tok[q]) * 128 + lane; pa[q][2 * sl] = bf2f(qa[0]); pa[q][2 * sl + 1] = bf2f(qa[64]); }
            e0[q] = idx[tok[q] * 128 + lane]; e1[q] = idx[tok[q] * 128 + 64 + lane]; g0[q] = gw[tok[q] * 128 + lane]; g1[q] = gw[tok[q] * 128 + 64 + lane];
            rs[q] = rowss[tok[q] * 32 + (lane & 31)]; }
        float v0[4], v1[4];
#pragma unroll
        for (int q = 0; q < 4; ++q) { v0[q] = svl[e0[q]]; v1[q] = svl[e1[q]]; }
#pragma unroll
        for (int q = 0; q < 4; ++q) {
            float ss = rs[q];
#pragma unroll
            for (int o = 1; o < 32; o <<= 1) ss += __shfl_xor(ss, o);
            const float rstd = 1.0f / sqrtf(ss * (1.0f / D) + RMS_EPS);
            float a0 = 0.f, a1 = 0.f;
#pragma unroll
            for (int sl = 0; sl < 8; ++sl) { a0 += pa[q][2 * sl]; a1 += pa[q][2 * sl + 1]; }
            const float w0 = g0[q] * gelu_exact(a0 * rstd) * v0[q], w1 = g1[q] * gelu_exact(a1 * rstd) * v1[q];
            const float wm = wave_max(fmaxf(fabsf(w0), fabsf(w1)));
            const float qs = wm > 0.f ? 127.0f / wm : 0.f;
            if (tk + q * nwaves < NTOK) { signed char* w8 = (signed char*)(ws + WS_WPEER) + tok[q] * 128;
                w8[lane] = (signed char)(int)__builtin_rintf(w0 * qs); w8[64 + lane] = (signed char)(int)__builtin_rintf(w1 * qs);
                if (lane == 0) ((float*)(ws + WS_WPEER + 8 * MiB))[tok[q]] = wm * (1.0f / 127.0f); }
        }
    }
}
struct HalfB { u32x4 rb[8]; unsigned w4[2]; };
DI void p8b_issue(HalfB& B, const unsigned char* tvs, const LAS unsigned* eoff, const LAS unsigned* w8l, int tl, int step, unsigned cc16) {
#pragma unroll
    for (int j = 0; j < 8; ++j) { const unsigned o = eoff[tl * 128 + step * 8 + j] + cc16; B.rb[j] = *(const u32x4*)(tvs + o); }
    B.w4[0] = w8l[tl * 32 + step * 2]; B.w4[1] = w8l[tl * 32 + step * 2 + 1];
}
DI void p8b_compute(const HalfB& B, int (&acc)[16]) {
#pragma unroll
    for (int g = 0; g < 2; ++g)
#pragma unroll
        for (int cg = 0; cg < 4; ++cg) { const unsigned a = B.rb[4 * g][cg], b = B.rb[4 * g + 1][cg], c = B.rb[4 * g + 2][cg], d = B.rb[4 * g + 3][cg];
            const unsigned t0 = __builtin_amdgcn_perm(b, a, 0x05010400u), t1 = __builtin_amdgcn_perm(b, a, 0x07030602u), t2 = __builtin_amdgcn_perm(d, c, 0x05010400u), t3 = __builtin_amdgcn_perm(d, c, 0x07030602u);
            acc[4 * cg] = __builtin_amdgcn_sdot4((int)__builtin_amdgcn_perm(t2, t0, 0x05040100u), (int)B.w4[g], acc[4 * cg], false);
            acc[4 * cg + 1] = __builtin_amdgcn_sdot4((int)__builtin_amdgcn_perm(t2, t0, 0x07060302u), (int)B.w4[g], acc[4 * cg + 1], false);
            acc[4 * cg + 2] = __builtin_amdgcn_sdot4((int)__builtin_amdgcn_perm(t3, t1, 0x05040100u), (int)B.w4[g], acc[4 * cg + 2], false);
            acc[4 * cg + 3] = __builtin_amdgcn_sdot4((int)__builtin_amdgcn_perm(t3, t1, 0x07060302u), (int)B.w4[g], acc[4 * cg + 3], false); }
}
DI void phase8b(const Params& p, unsigned char* lds_raw_) {
    unsigned char* ws = p.ws;
    const int lane = threadIdx.x & 63, pp = lane >> 3, cc = lane & 7;
    const unsigned char* tvv = ws + WS_TABV;
    const unsigned short* idx = (const unsigned short*)(ws + WS_IDX); const unsigned char* wp8 = ws + WS_WPEER; const float* wsc = (const float*)(ws + WS_WPEER + 8 * MiB); float* ssp = (float*)(ws + WS_SS);
    unsigned* ctr = (unsigned*)(ws + WS_CTL) + 2048;
    LAS unsigned* eoff = (LAS unsigned*)((ldsp_t)lds_raw_ + __builtin_amdgcn_readfirstlane((int)(threadIdx.x >> 6)) * 16384);
    LAS unsigned* w8l = eoff + P8_CHUNK * 128;
    const unsigned cc16 = (unsigned)cc * 16u;
    const unsigned xs = my_xcc();
#pragma unroll 1
    for (int k8 = 0; k8 < 8; ++k8) {
        const int sl = (int)((xs + k8) & 7u);
#pragma unroll 1
        for (;;) {
            unsigned tk = 0; if (lane == 0) tk = atomicAdd(ctr + 64 * sl, 1u);
            const int chunk = (int)__builtin_amdgcn_readfirstlane(tk);
            if (chunk >= P8_NCHUNK) break;
            const size_t tok0 = (size_t)chunk * P8_CHUNK;
#pragma unroll
            for (int i = 0; i < 4; ++i) { const i32x4 w = ((const i32x4*)(idx + tok0 * 128))[i * 64 + lane];
                i32x4 lo, hi2; lo.x = (w.x & 0xffff) << 7; lo.y = (int)((unsigned)w.x >> 16) << 7; lo.z = (w.y & 0xffff) << 7; lo.w = (int)((unsigned)w.y >> 16) << 7;
                hi2.x = (w.z & 0xffff) << 7; hi2.y = (int)((unsigned)w.z >> 16) << 7; hi2.z = (w.w & 0xffff) << 7; hi2.w = (int)((unsigned)w.w >> 16) << 7;
                ((LAS i32x4*)eoff)[(i * 64 + lane) * 2] = lo; ((LAS i32x4*)eoff)[(i * 64 + lane) * 2 + 1] = hi2; }
            const unsigned char* tvs = tvv + (size_t)sl * (16384 * 128);
#pragma unroll
            for (int i = 0; i < 2; ++i) ((LAS i32x4*)w8l)[i * 64 + lane] = ((const i32x4*)(wp8 + tok0 * 128))[i * 64 + lane];
            __builtin_amdgcn_wave_barrier();
#pragma unroll 1
            for (int grp = 0; grp < P8_CHUNK / 8; ++grp) {
                const int tl = grp * 8 + pp; const size_t tok = tok0 + tl;
                HalfB X, Y;
                const float wscale = wsc[tok];
                p8b_issue(X, tvs, eoff, w8l, tl, 0, cc16);
                const float* xo = p.out + tok * D + sl * 128 + cc * 16;
                f32x4 xv[4];
#pragma unroll
                for (int i = 0; i < 4; ++i) xv[i] = *(const f32x4*)(xo + 4 * i);
                int acc[16];
#pragma unroll
                for (int i = 0; i < 16; ++i) acc[i] = 0;
#pragma unroll 1
                for (int step = 0; step < 16; step += 2) {
                    p8b_issue(Y, tvs, eoff, w8l, tl, step + 1, cc16);
                    p8b_compute(X, acc);
                    if (step + 2 < 16) p8b_issue(X, tvs, eoff, w8l, tl, step + 2, cc16);
                    p8b_compute(Y, acc);
                }
                float v[16]; float ss = 0.f;
#pragma unroll
                for (int i = 0; i < 4; ++i) { v[4 * i] = __builtin_fmaf((float)acc[4 * i], wscale, xv[i].x); v[4 * i + 1] = __builtin_fmaf((float)acc[4 * i + 1], wscale, xv[i].y); v[4 * i + 2] = __builtin_fmaf((float)acc[4 * i + 2], wscale, xv[i].z); v[4 * i + 3] = __builtin_fmaf((float)acc[4 * i + 3], wscale, xv[i].w); }
#pragma unroll
                for (int i = 0; i < 16; ++i) ss += v[i] * v[i];
                u32x4 o0, o1;
                o0.x = pk2(v[0], v[1]); o0.y = pk2(v[2], v[3]); o0.z = pk2(v[4], v[5]); o0.w = pk2(v[6], v[7]); o1.x = pk2(v[8], v[9]); o1.y = pk2(v[10], v[11]); o1.z = pk2(v[12], v[13]); o1.w = pk2(v[14], v[15]);
                bf16_t* x3 = (bf16_t*)(ws + WS_X3) + tok * D + sl * 128 + cc * 16;
                *(u32x4*)x3 = o0; *(u32x4*)(x3 + 8) = o1;
                ss += dpp_xor1(ss); ss += dpp_xor2(ss); ss += __shfl_xor(ss, 4);
                if (cc == 0) ssp[tok * 8 + sl] = ss;
            }
            __builtin_amdgcn_wave_barrier();
        }
    }
}
DI void phase8c(const Params& p) {
    unsigned char* ws = p.ws;
    const int lane = threadIdx.x & 63, wid = threadIdx.x >> 6;
    const int gwave = blockIdx.x * NWAVES + wid, nwaves = gridDim.x * NWAVES;
    const float* ssp = (const float*)(ws + WS_SS); const bf16_t* x3 = (const bf16_t*)(ws + WS_X3);
    f32x4 gg[4];
#pragma unroll
    for (int j = 0; j < 4; ++j) gg[j] = *(const f32x4*)(p.in[20] + (j >> 1) * 512 + lane * 8 + (j & 1) * 4);
    for (int tk = gwave; tk < NTOK; tk += 2 * nwaves) {
        const bool two = tk + nwaves < NTOK; const size_t tokA = (size_t)tk, tokB = (size_t)(two ? tk + nwaves : tk);
        const u32x4 a0 = *(const u32x4*)(x3 + tokA * D + lane * 8), a1 = *(const u32x4*)(x3 + tokA * D + 512 + lane * 8);
        const u32x4 b0 = *(const u32x4*)(x3 + tokB * D + lane * 8), b1 = *(const u32x4*)(x3 + tokB * D + 512 + lane * 8);
        const f32x4 sa0 = *(const f32x4*)(ssp + tokA * 8), sa1 = *(const f32x4*)(ssp + tokA * 8 + 4), sb0 = *(const f32x4*)(ssp + tokB * 8), sb1 = *(const f32x4*)(ssp + tokB * 8 + 4);
        const float rsa = 1.0f / sqrtf(((sa0.x + sa0.y) + (sa0.z + sa0.w) + (sa1.x + sa1.y) + (sa1.z + sa1.w)) * (1.0f / D) + RMS_EPS);
        const float rsb = 1.0f / sqrtf(((sb0.x + sb0.y) + (sb0.z + sb0.w) + (sb1.x + sb1.y) + (sb1.z + sb1.w)) * (1.0f / D) + RMS_EPS);
        float* oa = p.out + tokA * D + lane * 8; float* ob = p.out + tokB * D + lane * 8;
#define OUT8(O, W, RS, G0, G1) { f32x4 v0 = {bflo(W.x) * RS * G0.x, bfhi(W.x) * RS * G0.y, bflo(W.y) * RS * G0.z, bfhi(W.y) * RS * G0.w}; f32x4 v1 = {bflo(W.z) * RS * G1.x, bfhi(W.z) * RS * G1.y, bflo(W.w) * RS * G1.z, bfhi(W.w) * RS * G1.w}; *(f32x4*)(O) = v0; *(f32x4*)((O) + 4) = v1; }
        OUT8(oa, a0, rsa, gg[0], gg[1]) OUT8(oa + 512, a1, rsa, gg[2], gg[3])
        if (two) { OUT8(ob, b0, rsb, gg[0], gg[1]) OUT8(ob + 512, b1, rsb, gg[2], gg[3]) }
#undef OUT8
    }
}

#define XB_TMO      128
#define XB_XCNT(j)  (256  + 64 * (j))
#define XB_XSUB(j)  (1280 + 64 * (j))
#define XB_XGEN(j)  (2304 + 64 * (j))
#define XB_TOP      3328
#define XB_TOPGEN   3392
#define XCD_BAR_WORDS 3456
#define XB_SPIN_CAP (1u << 18)

__device__ __forceinline__ unsigned xb_ld(unsigned* p)              { return __hip_atomic_load(p, __ATOMIC_RELAXED, __HIP_MEMORY_SCOPE_AGENT); }
__device__ __forceinline__ unsigned xb_add(unsigned* p, unsigned v) { return __hip_atomic_fetch_add(p, v, __ATOMIC_RELAXED, __HIP_MEMORY_SCOPE_AGENT); }
__device__ __forceinline__ unsigned xb_xcc_id() { return (unsigned)__builtin_amdgcn_s_getreg((3 << 11) | 20) & 0xFu; }
#define XB_SPIN(cond, bar) do { unsigned _sp = 0; while (cond) { __builtin_amdgcn_s_sleep(1); \
    if ((++_sp & 255u) == 0u) { if (xb_ld(&(bar)[XB_TMO])) break; if (_sp > XB_SPIN_CAP) { atomicAdd(&(bar)[XB_TMO], 1u); break; } } } } while (0)

struct XcdBarrier {
    unsigned* bar; unsigned x;
    volatile unsigned* st;
};

__device__ __forceinline__ XcdBarrier xcd_barrier_post(unsigned* bar, volatile unsigned* st) {
    XcdBarrier b; b.bar = bar; b.x = xb_xcc_id(); b.st = st;
    if (threadIdx.x == 0) (void)xb_add(&bar[XB_XCNT(b.x)], 1u);
    return b;
}
__device__ __forceinline__ void xcd_barrier_complete(unsigned* bar, unsigned x, unsigned& nloc, unsigned& nx) {
    const unsigned G = gridDim.x * gridDim.y * gridDim.z;
    unsigned sum, cnt, mine, sp = 0u;
    for (;;) {
        sum = 0u; cnt = 0u; mine = 0u;
#pragma unroll
        for (unsigned j = 0; j < 16; ++j) { const unsigned c = xb_ld(&bar[XB_XCNT(j)]); sum += c; cnt += (c > 0u) ? 1u : 0u; mine = (j == x) ? c : mine; }
        if (sum == G) break;
        __builtin_amdgcn_s_sleep(1);
        if ((++sp & 255u) == 0u) { if (xb_ld(&bar[XB_TMO])) break; if (sp > XB_SPIN_CAP) { atomicAdd(&bar[XB_TMO], 1u); break; } }
    }
    nloc = mine > 0u ? mine : 1u; nx = cnt > 0u ? cnt : 1u;
}

__device__ __forceinline__ void xcd_barrier(const XcdBarrier& b) {
    asm volatile("s_waitcnt vmcnt(0)" ::: "memory");
    __syncthreads();
    if (threadIdx.x == 0) {
        unsigned* bar = b.bar;
        __builtin_amdgcn_s_waitcnt(0);
        unsigned nloc = b.st[0], nx = b.st[1];
        if (nloc == 0u) { xcd_barrier_complete(bar, b.x, nloc, nx); b.st[0] = nloc; b.st[1] = nx; }
        const unsigned old = xb_add(&bar[XB_XSUB(b.x)], 1u);
        const unsigned gen = old / nloc;
        if (old + 1u == (gen + 1u) * nloc) {
            __builtin_amdgcn_fence(__ATOMIC_RELEASE, "agent");
            asm volatile("s_waitcnt vmcnt(0)" ::: "memory");
            const unsigned og = xb_add(&bar[XB_TOP], 1u);
            const unsigned tg = og / nx;
            if (og + 1u == (tg + 1u) * nx) xb_add(&bar[XB_TOPGEN], 1u);
            else XB_SPIN(xb_ld(&bar[XB_TOPGEN]) == tg, bar);
            __builtin_amdgcn_fence(__ATOMIC_ACQUIRE, "agent");
            xb_add(&bar[XB_XGEN(b.x)], 1u);
            asm volatile("s_waitcnt vmcnt(0)" ::: "memory");
        } else {
            XB_SPIN(xb_ld(&bar[XB_XGEN(b.x)]) == gen, bar);
            __builtin_amdgcn_fence(__ATOMIC_ACQUIRE, "agent");
            asm volatile("s_waitcnt vmcnt(0)" ::: "memory");
        }
    }
    __syncthreads();
}

constexpr int N_PHASES = 13;
__global__ void __launch_bounds__(NTHREADS) mega(Params p) {
    extern __shared__ __attribute__((aligned(16))) unsigned char lds_raw[];
    bf16_t* lds = (bf16_t*)lds_raw;
#if N_LAUNCH_MODE == 1
    cg::grid_group grid = cg::this_grid();
    XcdBarrier xbar = xcd_barrier_post((unsigned*)(p.ws + WS_CTL) + 4096, (volatile unsigned*)(p.ws + WS_CTL) + 12288 + 2 * blockIdx.x);
    if (p.ph_lo == 0x7fffffff) grid.sync();
#define SEAM(k) do { if (p.ph_lo <= (k) && (k) + 1 < p.ph_hi) { xcd_barrier(xbar); } } while (0)
#else
#define SEAM(k) do { } while (0)
#endif
#ifndef PHASE_MASK
#define PHASE_MASK 0x1fff
#endif
#define IN(k) (((PHASE_MASK >> (k)) & 1) && p.ph_lo <= (k) && (k) < p.ph_hi)
    if (IN(0)) for (int rep = 0; rep < REP0; ++rep) phase0(p, lds_raw);
    SEAM(0);
    if (IN(1)) for (int rep = 0; rep < REP1; ++rep) phase1(p, lds);
    SEAM(1);
    if (IN(2)) for (int rep = 0; rep < REP2; ++rep) phase2(p, lds);
    SEAM(2);
    if (IN(3)) for (int rep = 0; rep < REP3; ++rep) phase3a(p, rep, lds);
    SEAM(3);
    if (IN(4)) for (int rep = 0; rep < REP4; ++rep) phase3b(p, rep, lds_raw);
    SEAM(4);
    if (IN(5)) for (int rep = 0; rep < REP5; ++rep) phase4(p, lds);
    SEAM(5);
    if (IN(6)) for (int rep = 0; rep < REP6; ++rep) phase5(p, lds);
    SEAM(6);
    if (IN(7)) for (int rep = 0; rep < REP7; ++rep) phase6(p, lds);
    SEAM(7);
    if (IN(8)) for (int rep = 0; rep < REP8; ++rep) { __syncthreads(); phase7(p, lds); }
    SEAM(8);
    if (IN(9)) for (int rep = 0; rep < REP9; ++rep) phase8a(p, lds_raw, rep);
    SEAM(9);
    if (IN(10)) for (int rep = 0; rep < REP10; ++rep) phase8w(p, lds_raw);
    SEAM(10);
    if (IN(11)) phase8b(p, lds_raw);
    SEAM(11);
    if (IN(12)) phase8c(p);
}

extern "C" void kernel_launch(void* const* d_in, const int* in_sizes, int n_in, void* d_out, int out_size, void* d_ws, size_t ws_size, hipStream_t stream) {
    static int grid = 0;
    if (grid == 0) {
        if (n_in != 21 || out_size != NTOK * D || ws_size < WS_END) { fprintf(stderr, "kernel_launch: unexpected shapes: n_in %d out %d ws %zu\n", n_in, out_size, ws_size); grid = -1; return; }
        int dev = 0, cus = 0, per_cu = 0;
        hipGetDevice(&dev);
        hipDeviceGetAttribute(&cus, hipDeviceAttributeMultiprocessorCount, dev);
        hipFuncSetAttribute((const void*)mega, hipFuncAttributeMaxDynamicSharedMemorySize, LDS_BYTES);
        hipOccupancyMaxActiveBlocksPerMultiprocessor(&per_cu, (const void*)mega, NTHREADS, LDS_BYTES);
        if (per_cu < 1) per_cu = 1;
        if (per_cu > 1) per_cu = 1;
        grid = cus * per_cu;
    }
    if (grid < 0) return;
    hipMemsetAsync((char*)d_ws + WS_CTL, 0, 65536, stream);
    Params p{};
    for (int i = 0; i < 21; ++i) p.in[i] = (const float*)d_in[i];
    p.out = (float*)d_out; p.ws = (unsigned char*)d_ws;
#if N_LAUNCH_MODE == 1
    p.ph_lo = 0; p.ph_hi = N_PHASES;
    void* args[] = {&p};
    hipError_t e = hipLaunchCooperativeKernel((const void*)mega, dim3(grid), dim3(NTHREADS), args, LDS_BYTES, stream);
    if (e != hipSuccess) fprintf(stderr, "cooperative launch failed: %s (grid %d)\n", hipGetErrorString(e), grid);
#else
    for (int ph = 0; ph < N_PHASES; ++ph) { p.ph_lo = ph; p.ph_hi = ph + 1; hipLaunchKernelGGL(mega, dim3(grid), dim3(NTHREADS), LDS_BYTES, stream, p); }
#endif
}
```

```cpp
#include <hip/hip_runtime.h>
#include <hip/hip_cooperative_groups.h>
#include <cstdio>
#include <cstdint>
namespace cg = cooperative_groups;

#ifndef N_LAUNCH_MODE
#define N_LAUNCH_MODE 1
#endif

#define REP0 1
#define REP1 1
#define REP2 1
#define REP3 1
#define REP4 1
#define REP5 1
#define REP6 1
#define REP7 1
#define REP8 1
#define REP9 1
#define REP10 1

typedef unsigned short bf16_t;
typedef short bf16x8 __attribute__((ext_vector_type(8)));
typedef short s16x4 __attribute__((ext_vector_type(4)));
typedef float f32x2 __attribute__((ext_vector_type(2)));
typedef float f32x4 __attribute__((ext_vector_type(4)));
typedef float f32x16 __attribute__((ext_vector_type(16)));
typedef unsigned u32x2 __attribute__((ext_vector_type(2)));
typedef unsigned u32x4 __attribute__((ext_vector_type(4)));
typedef int i32x4 __attribute__((ext_vector_type(4)));
typedef __bf16 bf16x2_t __attribute__((ext_vector_type(2)));
#define DI __device__ __forceinline__
#define LAS __attribute__((address_space(3)))

constexpr int NB = 8, T = 4096, D = 1024, NTOK = NB * T;
constexpr int MEMT = 256;
constexpr int NTHREADS = 512, NWAVES = 8;
constexpr int LDP_QKV = 2560;
constexpr int C_SBQ = 0, C_SBK = 384, C_SBV = 768, C_NQ = 1152, C_NKV = 1536, C_MQ = 2304;
constexpr int LDG = 3072;
constexpr int NPROJ = 5888;
constexpr int IN_DIM = 5650;
constexpr float RMS_EPS = 1e-6f;
constexpr float LOG2E = 1.4426950408889634f, LN2 = 0.6931471805599453f;

constexpr size_t MiB = 1u << 20;
constexpr size_t WS_CTL = 0;
constexpr size_t WS_WIN = 1 * MiB;
constexpr size_t WS_WQ = WS_WIN + 12 * MiB;
constexpr size_t WS_WOUT = WS_WQ + 4 * MiB;
constexpr size_t WS_WSB = WS_WOUT + 2 * MiB;
constexpr size_t WS_WNSA = WS_WSB + 1 * MiB;
constexpr size_t WS_WMEM = WS_WNSA + 1 * MiB;
constexpr size_t WS_WMKV = WS_WMEM + 1 * MiB;
constexpr size_t WS_SUBK = WS_WMKV + 1 * MiB;
constexpr size_t WS_CMPW = WS_SUBK + MiB / 2;
constexpr size_t WS_H = 24 * MiB;
constexpr size_t WS_QKV = 88 * MiB;
constexpr size_t WS_MERGED = WS_QKV;
constexpr size_t WS_IDX = WS_QKV + 64 * MiB;
constexpr size_t WS_GW = WS_QKV + 80 * MiB;
constexpr size_t WS_ROWSS = WS_QKV + 96 * MiB;
constexpr size_t WS_GATES = 248 * MiB;
constexpr size_t WS_H2 = WS_GATES;
constexpr size_t WS_QP = WS_GATES + 64 * MiB;
constexpr size_t WS_TABU = 440 * MiB;
constexpr size_t WS_TABV = 456 * MiB;
constexpr size_t WS_PD = WS_GATES + 64 * MiB;
constexpr size_t WS_WPEER = WS_QKV;
constexpr size_t WS_SS = WS_QKV + 32 * MiB;
constexpr size_t WS_X3 = WS_H2;
constexpr size_t WS_H8 = 344 * MiB;
constexpr size_t WS_HSC = 376 * MiB;
constexpr size_t WS_W8 = 377 * MiB;
constexpr size_t WS_W8SC = 384 * MiB;
constexpr size_t WS_WMKV8 = 385 * MiB;
constexpr size_t WS_MEMN8 = 387 * MiB;
constexpr size_t WS_TSCALE = 472 * MiB;
constexpr size_t WS_END = 504 * MiB;
constexpr size_t DO_VSLC = 0;
constexpr size_t DO_VWIN = 8 * MiB;
constexpr size_t DO_SBV = 16 * MiB;
constexpr size_t DO_KC = 40 * MiB;
constexpr size_t DO_VCT = 41 * MiB;
constexpr size_t DO_MEMN = 42 * MiB;
constexpr size_t DO_MKV = 46 * MiB;
constexpr size_t DO_MVT = 48 * MiB;
constexpr size_t DO_NSAG = 50 * MiB;
constexpr size_t DO_SELM = 54 * MiB;
constexpr size_t DO_OC = 56 * MiB;
constexpr size_t DO_KSLC = 80 * MiB;
constexpr size_t DO_KWIN = 88 * MiB;
constexpr size_t DO_MKT = 120 * MiB;
constexpr size_t DO_SBK = 96 * MiB;

constexpr int LDS_MAIN = 131072;
constexpr int LDS_BYTES = 163840;

struct Params {
    const float* in[21];
    float* out;
    unsigned char* ws;
    int ph_lo, ph_hi;
};

DI unsigned f2bf(float f) { unsigned u = __float_as_uint(f); return (u + 0x7fffu + ((u >> 16) & 1u)) >> 16; }
DI unsigned pk2(float lo, float hi) { f32x2 v = {lo, hi}; bf16x2_t b = __builtin_convertvector(v, bf16x2_t); return __builtin_bit_cast(unsigned, b); }
DI float bf2f(unsigned short h) { return __uint_as_float((unsigned)h << 16); }
DI float bflo(unsigned w) { return __uint_as_float(w << 16); }
DI float bfhi(unsigned w) { return __uint_as_float(w & 0xffff0000u); }
DI float wave_sum(float v) {
#pragma unroll
    for (int o = 1; o < 64; o <<= 1) v += __shfl_xor(v, o);
    return v;
}
DI float fexp2(float x) { return __builtin_amdgcn_exp2f(x); }
DI float flog2(float x) { return __builtin_amdgcn_logf(x); }
DI float fexp(float x) { return __builtin_amdgcn_exp2f(x * LOG2E); }
DI float sigmoidf_(float x) { return 1.0f / (1.0f + fexp(-x)); }
DI int krow(int r, int hi) { return (r & 3) + 8 * (r >> 2) + 4 * hi; }
#define MFMA32(a, b, c) __builtin_amdgcn_mfma_f32_32x32x16_bf16((a), (b), (c), 0, 0, 0)
#define MFMA16(a, b, c) __builtin_amdgcn_mfma_f32_16x16x32_bf16((a), (b), (c), 0, 0, 0)

DI void zero16(f32x16& v) {
#pragma unroll
    for (int i = 0; i < 16; ++i) v[i] = 0.f;
}
DI unsigned pack_i8x4(float a, float b, float c, float d) {
    const int ia = (int)__builtin_rintf(a), ib = (int)__builtin_rintf(b), ic = (int)__builtin_rintf(c), id = (int)__builtin_rintf(d);
    return ((unsigned)ia & 0xffu) | (((unsigned)ib & 0xffu) << 8) | (((unsigned)ic & 0xffu) << 16) | ((unsigned)id << 24);
}
DI float wave_max(float v) {
#pragma unroll
    for (int o = 1; o < 64; o <<= 1) v = fmaxf(v, __shfl_xor(v, o));
    return v;
}
DI void rms_row_i8(const float* xrow, const float* g, unsigned* o8row, float* scale, int lane) {
    const f32x4* xr = (const f32x4*)xrow + lane;
    const f32x4* gr = (const f32x4*)g + lane;
    f32x4 v[4]; float s = 0.f;
#pragma unroll
    for (int j = 0; j < 4; ++j) { v[j] = xr[64 * j]; s += (v[j].x * v[j].x + v[j].y * v[j].y) + (v[j].z * v[j].z + v[j].w * v[j].w); }
    const float rstd = 1.0f / sqrtf(wave_sum(s) * (1.0f / D) + RMS_EPS);
    float am = 0.f;
#pragma unroll
    for (int j = 0; j < 4; ++j) { const f32x4 gg = gr[64 * j]; v[j].x *= rstd * gg.x; v[j].y *= rstd * gg.y; v[j].z *= rstd * gg.z; v[j].w *= rstd * gg.w;
        am = fmaxf(am, fmaxf(fmaxf(fabsf(v[j].x), fabsf(v[j].y)), fmaxf(fabsf(v[j].z), fabsf(v[j].w)))); }
    am = wave_max(am);
    const float qs = am > 0.f ? 127.0f / am : 0.f;
#pragma unroll
    for (int j = 0; j < 4; ++j) o8row[lane + 64 * j] = pack_i8x4(v[j].x * qs, v[j].y * qs, v[j].z * qs, v[j].w * qs);
    if (lane == 0) scale[0] = am * (1.0f / 127.0f);
}
template <bool MAP> DI void quant_cols_i8(const float* W, int ldw, int ncol, unsigned char* dst8, float* dsc, float* red) {
    const int c = threadIdx.x & 15, kg = threadIdx.x >> 4;
    for (int cb = blockIdx.x; cb < ncol / 16; cb += gridDim.x) {
        const int col = cb * 16 + c; int srcc = col;
        if (MAP) { if (col < 2304) srcc = col; else if (col < 2560) srcc = 2322 + (col - 2304); else if (col < 5632) srcc = 2578 + (col - 2560); else if (col < 5650) srcc = 2304 + (col - 5632); else srcc = -1; }
        const float* src = W + (size_t)(kg * 32) * ldw + (srcc < 0 ? 0 : srcc);
        float v[32]; float am = 0.f;
#pragma unroll
        for (int i = 0; i < 32; ++i) { v[i] = srcc < 0 ? 0.f : src[(size_t)i * ldw]; am = fmaxf(am, fabsf(v[i])); }
        __syncthreads();
        red[kg * 16 + c] = am;
        __syncthreads();
#pragma unroll
        for (int i = 0; i < 32; ++i) am = fmaxf(am, red[i * 16 + c]);
        const float qs = am > 0.f ? 127.0f / am : 0.f;
        u32x4 w0, w1;
        w0.x = pack_i8x4(v[0] * qs, v[1] * qs, v[2] * qs, v[3] * qs); w0.y = pack_i8x4(v[4] * qs, v[5] * qs, v[6] * qs, v[7] * qs); w0.z = pack_i8x4(v[8] * qs, v[9] * qs, v[10] * qs, v[11] * qs); w0.w = pack_i8x4(v[12] * qs, v[13] * qs, v[14] * qs, v[15] * qs);
        w1.x = pack_i8x4(v[16] * qs, v[17] * qs, v[18] * qs, v[19] * qs); w1.y = pack_i8x4(v[20] * qs, v[21] * qs, v[22] * qs, v[23] * qs); w1.z = pack_i8x4(v[24] * qs, v[25] * qs, v[26] * qs, v[27] * qs); w1.w = pack_i8x4(v[28] * qs, v[29] * qs, v[30] * qs, v[31] * qs);
        u32x4* dst = (u32x4*)(dst8 + (size_t)col * 1024 + kg * 32); dst[0] = w0; dst[1] = w1;
        if (kg == 0) dsc[col] = am * (1.0f / 127.0f);
    }
}
DI void rms_row_bf16(const float* xrow, const float* g, bf16_t* orow, int lane) {
    const f32x4* xr = (const f32x4*)xrow + lane;
    const f32x4* gr = (const f32x4*)g + lane;
    f32x4 v[4]; float s = 0.f;
#pragma unroll
    for (int j = 0; j < 4; ++j) { v[j] = xr[64 * j]; s += (v[j].x * v[j].x + v[j].y * v[j].y) + (v[j].z * v[j].z + v[j].w * v[j].w); }
    const float rstd = 1.0f / sqrtf(wave_sum(s) * (1.0f / D) + RMS_EPS);
    u32x2* o8 = (u32x2*)orow + lane;
#pragma unroll
    for (int j = 0; j < 4; ++j) { const f32x4 gg = gr[64 * j]; u32x2 w; w.x = pk2(v[j].x * rstd * gg.x, v[j].y * rstd * gg.y); w.y = pk2(v[j].z * rstd * gg.z, v[j].w * rstd * gg.w); o8[64 * j] = w; }
}
DI void transpose_w(const float* W, int K, int N, bf16_t* Wt, int gtid, int gthreads, float sc = 1.0f) {
    const int total = (K / 8) * N;
    for (int it = gtid; it < total; it += gthreads) {
        const int n = it % N, k8 = it / N;
        const float* s = W + (size_t)(k8 * 8) * N + n;
        u32x4 o; o.x = pk2(s[0] * sc, s[(size_t)N] * sc); o.y = pk2(s[(size_t)2 * N] * sc, s[(size_t)3 * N] * sc); o.z = pk2(s[(size_t)4 * N] * sc, s[(size_t)5 * N] * sc); o.w = pk2(s[(size_t)6 * N] * sc, s[(size_t)7 * N] * sc);
        *(u32x4*)(Wt + (size_t)n * K + k8 * 8) = o;
    }
}
DI void late_weights(const Params& p, int gtid, int gthreads) {
    unsigned char* ws = p.ws;
    transpose_w(p.in[16], D, 2048, (bf16_t*)(ws + WS_WQ), gtid, gthreads);
    transpose_w(p.in[14], D, D, (bf16_t*)(ws + WS_WOUT), gtid, gthreads);
    transpose_w(p.in[11], 384, D, (bf16_t*)(ws + WS_WSB), gtid, gthreads, 1.0f / 255.0f);
    transpose_w(p.in[12], 384, D, (bf16_t*)(ws + WS_WNSA), gtid, gthreads, 1.0f / 255.0f);
    transpose_w(p.in[13], 256, D, (bf16_t*)(ws + WS_WMEM), gtid, gthreads, 1.0f / 255.0f);
    transpose_w(p.in[8], 2048, 64, (bf16_t*)(ws + WS_CMPW), gtid, gthreads);
    transpose_w(p.in[9], 2048, 64, (bf16_t*)(ws + WS_CMPW) + 64 * 2048, gtid, gthreads);
    {
        const f32x4* s = (const f32x4*)p.in[17]; u32x2* o = (u32x2*)(ws + WS_SUBK);
        for (int i = gtid; i < 8 * 2 * 128 * 128 / 4; i += gthreads) { const f32x4 v = s[i]; u32x2 w; w.x = pk2(v.x, v.y); w.y = pk2(v.z, v.w); o[i] = w; }
    }
}
DI void phase0(const Params& p, unsigned char* lds_raw_) {
    const int gtid = blockIdx.x * NTHREADS + threadIdx.x, gthreads = gridDim.x * NTHREADS;
    const int lane = threadIdx.x & 63, gwave = gtid >> 6, nwaves = gthreads >> 6;
    unsigned char* ws = p.ws;
    quant_cols_i8<true>(p.in[4], IN_DIM, NPROJ, ws + WS_W8, (float*)(ws + WS_W8SC), (float*)lds_raw_);
    quant_cols_i8<false>(p.in[10], 512, 512, ws + WS_WMKV8, (float*)(ws + WS_WMKV8 + MiB), (float*)lds_raw_);
    for (int row = gwave; row < NTOK; row += nwaves) rms_row_i8(p.in[0] + (size_t)row * D, p.in[2], (unsigned*)(ws + WS_H8) + (size_t)row * (D / 4), (float*)(ws + WS_HSC) + row, lane);
    for (int row = gwave; row < NB * MEMT; row += nwaves) rms_row_i8(p.in[1] + (size_t)row * D, p.in[3], (unsigned*)(ws + WS_MEMN8) + (size_t)row * (D / 4), (float*)(ws + WS_MEMN8 + 2 * MiB) + row, lane);
}
DI void peer_table_rows(const Params& p, int lane, int first, int stride) {
    unsigned char* ws = p.ws;
    unsigned char* tabu = ws + WS_TABU; unsigned char* tabv = ws + WS_TABV; float* tsc = (float*)(ws + WS_TSCALE);
#pragma unroll 1
    for (int row0 = first; row0 < 32768; row0 += 4 * stride) {
        f32x4 v[4][4];
#pragma unroll
        for (int q = 0; q < 4; ++q) { const int row = row0 + q * stride < 32768 ? row0 + q * stride : row0; const bool isv = row >= 16384; const int e = row & 16383;
            const f32x4* src = (const f32x4*)((isv ? p.in[19] : p.in[18]) + (size_t)e * 1024 + lane * 16);
#pragma unroll
            for (int j = 0; j < 4; ++j) v[q][j] = src[j]; }
#pragma unroll
        for (int q = 0; q < 4; ++q) { const int row = row0 + q * stride; const bool isv = row >= 16384; const int e = row & 16383;
            float am = 0.f;
#pragma unroll
            for (int j = 0; j < 4; ++j) am = fmaxf(am, fmaxf(fmaxf(fabsf(v[q][j].x), fabsf(v[q][j].y)), fmaxf(fabsf(v[q][j].z), fabsf(v[q][j].w))));
#pragma unroll
            for (int o = 1; o < 64; o <<= 1) am = fmaxf(am, __shfl_xor(am, o));
            const float top = 127.0f;
            const float sc = am > 0.f ? top / am : 1.0f;
            u32x4 w;
#pragma unroll
            for (int j = 0; j < 4; ++j) w[j] = pack_i8x4(v[q][j].x * sc, v[q][j].y * sc, v[q][j].z * sc, v[q][j].w * sc);
            if (row < 32768) { *(u32x4*)((isv ? tabv : tabu) + (size_t)(lane >> 3) * (16384 * 128) + (size_t)e * 128 + (lane & 7) * 16) = w;
                if (lane == 0) tsc[row] = am > 0.f ? am / top : 1.0f; }
        }
    }
}

constexpr int GEMM_LDS_ROW = 72;
constexpr int GEMM_TILE_ELEMS = 128 * GEMM_LDS_ROW;
DI void gemm_mainloop(const bf16_t* __restrict__ Ag, int lda, const bf16_t* __restrict__ Bg, int ldb, int K, f32x4 (&acc)[4][2], bf16_t* lds) {
    const int tid = threadIdx.x, lane = tid & 63, wid = tid >> 6, wr = wid >> 2, wc = wid & 3;
    const int r0 = tid >> 3, kc = tid & 7;
    const bf16_t* ap0 = Ag + (size_t)r0 * lda + kc * 8; const bf16_t* ap1 = ap0 + (size_t)64 * lda;
    const bf16_t* bp0 = Bg + (size_t)r0 * ldb + kc * 8; const bf16_t* bp1 = bp0 + (size_t)64 * ldb;
    const int so0 = r0 * GEMM_LDS_ROW + kc * 8, so1 = so0 + 64 * GEMM_LDS_ROW;
    u32x4 ra0, ra1, rb0, rb1;
    ra0 = *(const u32x4*)ap0; ra1 = *(const u32x4*)ap1; rb0 = *(const u32x4*)bp0; rb1 = *(const u32x4*)bp1;
    __syncthreads();
    {
        bf16_t* As = lds; bf16_t* Bs = lds + GEMM_TILE_ELEMS;
        *(u32x4*)(As + so0) = ra0; *(u32x4*)(As + so1) = ra1; *(u32x4*)(Bs + so0) = rb0; *(u32x4*)(Bs + so1) = rb1;
    }
    __syncthreads();
    const int nk = K / 64;
    const int fr = lane & 15, fq = lane >> 4;
    for (int kt = 0; kt < nk; ++kt) {
        const int buf = kt & 1;
        if (kt + 1 < nk) { const int ko = (kt + 1) * 64; ra0 = *(const u32x4*)(ap0 + ko); ra1 = *(const u32x4*)(ap1 + ko); rb0 = *(const u32x4*)(bp0 + ko); rb1 = *(const u32x4*)(bp1 + ko); }
        const bf16_t* As = lds + buf * 2 * GEMM_TILE_ELEMS; const bf16_t* Bs = As + GEMM_TILE_ELEMS;
#pragma unroll
        for (int kk = 0; kk < 2; ++kk) {
            bf16x8 af[4], bfr[2];
#pragma unroll
            for (int m = 0; m < 4; ++m) af[m] = *(const bf16x8*)(As + (wr * 64 + m * 16 + fr) * GEMM_LDS_ROW + kk * 32 + fq * 8);
#pragma unroll
            for (int n = 0; n < 2; ++n) bfr[n] = *(const bf16x8*)(Bs + (wc * 32 + n * 16 + fr) * GEMM_LDS_ROW + kk * 32 + fq * 8);
#pragma unroll
            for (int m = 0; m < 4; ++m)
#pragma unroll
                for (int n = 0; n < 2; ++n) acc[m][n] = MFMA16(bfr[n], af[m], acc[m][n]);
        }
        if (kt + 1 < nk) {
            bf16_t* An = lds + (buf ^ 1) * 2 * GEMM_TILE_ELEMS; bf16_t* Bn = An + GEMM_TILE_ELEMS;
            *(u32x4*)(An + so0) = ra0; *(u32x4*)(An + so1) = ra1; *(u32x4*)(Bn + so0) = rb0; *(u32x4*)(Bn + so1) = rb1;
        }
        __syncthreads();
    }
}
DI void zero_acc(f32x4 (&acc)[4][2]) {
#pragma unroll
    for (int m = 0; m < 4; ++m)
#pragma unroll
        for (int n = 0; n < 2; ++n) acc[m][n] = (f32x4){0.f, 0.f, 0.f, 0.f};
}
DI void tile_coords(int tile, int ntn, int& pm, int& pn) { const int per = 8 * ntn, g = tile / per, r = tile % per; pm = g * 8 + (r & 7); pn = r >> 3; }
DI void store_bf16x4(bf16_t* p, f32x4 v) { u32x2 w; w.x = pk2(v.x, v.y); w.y = pk2(v.z, v.w); *(u32x2*)p = w; }

namespace pg8 {
#define PG8_LAS __attribute__((address_space(3)))
typedef short bf16x8 __attribute__((ext_vector_type(8)));
typedef float f32x4 __attribute__((ext_vector_type(4)));
typedef unsigned u32x4 __attribute__((ext_vector_type(4)));
typedef int i32x4v __attribute__((ext_vector_type(4)));
constexpr int BM = 256, BK = 64, HALF = 128, HTB = HALF * BK * 2  , STAGE_BYTES = 8 * HTB, NXCD = 8, WGM = 8;

__host__ __device__ __forceinline__ int lds_byte(int r, int c) { const int st = (r >> 4) * 2 + (c >> 5), rr = r & 15, cc = c & 31, ob = rr * 64 + cc * 2; return st * 1024 + (ob ^ (((ob >> 9) & 1) << 5)); }
__host__ __device__ __forceinline__ void stage_rc(int b, int& R, int& C) { const int st = b / 1024, sb = b % 1024, swz = sb ^ (((sb >> 9) & 1) << 5); R = (st >> 1) * 16 + swz / 64; C = (st & 1) * 32 + (swz % 64) / 2; }
__host__ __device__ __forceinline__ int perm32(int rho) { const int n = rho >> 4, i = rho & 15; return 8 * (i >> 2) + 4 * n + (i & 3); }

struct Unit { int pm, pn; };
struct Gemm { const bf16_t* A; const bf16_t* Bt; int M, N, K, lda, ldb; };

struct StaticOrder {
    int nM, nN, nwg, G, c;
    __host__ __device__ void init(int M, int N, int G_, int c_) { nM = M / BM; nN = N / BM; nwg = nM * nN; G = G_; c = c_; }
    __host__ __device__ bool next(int i, Unit& u) const {
        const long L = (long)i * G + c; if (L >= nwg) return false;
        int wgid = (int)L; { const int q = nwg / NXCD, r = nwg % NXCD, xcd = wgid % NXCD, off = wgid / NXCD; wgid = (xcd < r ? xcd * (q + 1) : r * (q + 1) + (xcd - r) * q) + off; }
        const int nig = WGM * nN, gid = wgid / nig, fm = gid * WGM, gsz = (nM - fm) < WGM ? (nM - fm) : WGM;
        u.pm = fm + ((wgid % nig) % gsz); u.pn = (wgid % nig) / gsz; return true;
    }
    __device__ __forceinline__ void a_ready(const Unit&) const {}
    __device__ __forceinline__ void done(const Unit&) const {}
};


template <class Epi, class Sched, bool ALIGN_EPI = false, bool SP2 = false, bool I8 = false>
__device__ __forceinline__ void gemm_phase(PG8_LAS unsigned char* lds, const Gemm g, const Sched& S, const Epi& E) {
    const int tid = threadIdx.x, wid = __builtin_amdgcn_readfirstlane(tid >> 6), lane = tid & 63, wr = wid >> 2, wc = wid & 3, fr = lane & 15, fq = lane >> 4;
    const int K = g.K, nt = K / BK;
    unsigned voffA[2], voffB[2];
#pragma unroll
    for (int i = 0; i < 2; ++i) { int R, C; stage_rc(tid * 16 + i * 8192, R, C); const int Rb = Epi::PERM ? ((R & ~31) + perm32(R & 31)) : R;
        voffA[i] = (unsigned)(R * g.lda + C) * 2u; voffB[i] = (unsigned)(Rb * g.ldb + C) * 2u; }
    const size_t kstep = (size_t)(BK * 2);
    const size_t hstepA = (size_t)HALF * g.lda * 2, hstepB = (size_t)HALF * g.ldb * 2;
    const size_t tstepA = 2 * hstepA, tstepB = 2 * hstepB;
    const unsigned ldsw = (unsigned)wid * 1024u;
    const int aoff = lds_byte(wr * 64 + fr, fq * 8), boff = lds_byte(wc * 32 + fr, fq * 8);
#define PG8_SA(b, h) (((b) * 2 + (h)) * HTB)
#define PG8_SB(b, h) ((4 + (b) * 2 + (h)) * HTB)
#define PG8_STAGE(bufoff, gbase, voff) do { _Pragma("unroll") for (int _i = 0; _i < 2; ++_i) \
        __builtin_amdgcn_global_load_lds((const unsigned*)((const char*)(gbase) + (voff)[_i]), (PG8_LAS unsigned*)(lds + (bufoff) + ldsw + _i * 8192), 16, 0, 0); } while (0)
#define PG8_LDA(dst, b, h) do { _Pragma("unroll") for (int m = 0; m < 4; ++m) _Pragma("unroll") for (int k = 0; k < 2; ++k) dst[m][k] = *(const PG8_LAS bf16x8*)(lds + PG8_SA(b, h) + aoff + m * 2048 + k * 1024); } while (0)
#define PG8_LDB(dst, b, h) do { _Pragma("unroll") for (int n = 0; n < 2; ++n) _Pragma("unroll") for (int k = 0; k < 2; ++k) dst[n][k] = *(const PG8_LAS bf16x8*)(lds + PG8_SB(b, h) + boff + n * 2048 + k * 1024); } while (0)
#define PG8_MMA(ai, bj, At, Bt) do { __builtin_amdgcn_s_setprio(1); _Pragma("unroll") for (int m = 0; m < 4; ++m) _Pragma("unroll") for (int n = 0; n < 2; ++n) _Pragma("unroll") for (int k = 0; k < 2; ++k) \
        { if constexpr (I8) acc[ai][bj][m][n] = __builtin_bit_cast(f32x4, __builtin_amdgcn_mfma_i32_16x16x64_i8(__builtin_bit_cast(i32x4v, Bt[n][k]), __builtin_bit_cast(i32x4v, At[m][k]), __builtin_bit_cast(i32x4v, acc[ai][bj][m][n]), 0, 0, 0)); \
          else acc[ai][bj][m][n] = __builtin_amdgcn_mfma_f32_16x16x32_bf16(Bt[n][k], At[m][k], acc[ai][bj][m][n], 0, 0, 0); } __builtin_amdgcn_s_setprio(0); } while (0)
#define PG8_WAIT_V(n) asm volatile("s_waitcnt vmcnt(" #n ")" ::: "memory")
#define PG8_WAIT_L(n) asm volatile("s_waitcnt lgkmcnt(" #n ")" ::: "memory")
#define PG8_BAR __builtin_amdgcn_s_barrier()
#define PG8_SCHED __builtin_amdgcn_sched_barrier(0)
    Unit cur, nxt; int ui = 0;
    if (!S.next(0, cur)) return;
    f32x4 acc[2][2][4][2];
    if constexpr (Epi::INIT) E.init(acc, cur, wr, wc, fr, fq);
    else {
#pragma unroll
    for (int a = 0; a < 2; ++a)
#pragma unroll
        for (int b = 0; b < 2; ++b)
#pragma unroll
            for (int m = 0; m < 4; ++m)
#pragma unroll
                for (int n = 0; n < 2; ++n) acc[a][b][m][n] = (f32x4){0.f, 0.f, 0.f, 0.f};
    }
    bf16x8 At[4][2], B0[2][2], B1[2][2];
    const char* cA = (const char*)g.A + (size_t)cur.pm * tstepA; const char* cB = (const char*)g.Bt + (size_t)cur.pn * tstepB;
    S.a_ready(cur);
    if constexpr (SP2) {
        PG8_STAGE(PG8_SB(0, 0), cB, voffB); PG8_STAGE(PG8_SB(0, 1), cB + hstepB, voffB); PG8_STAGE(PG8_SA(0, 0), cA, voffA); PG8_STAGE(PG8_SA(0, 1), cA + hstepA, voffA);
        if (wr == 1) PG8_BAR;
        PG8_WAIT_V(2); PG8_BAR;
        PG8_STAGE(PG8_SB(1, 0), cB + kstep, voffB); PG8_STAGE(PG8_SA(1, 0), cA + kstep, voffA); PG8_STAGE(PG8_SB(1, 1), cB + hstepB + kstep, voffB);
        PG8_WAIT_V(6); PG8_BAR;
    } else {
        PG8_STAGE(PG8_SB(0, 0), cB, voffB); PG8_STAGE(PG8_SA(0, 0), cA, voffA); PG8_STAGE(PG8_SB(0, 1), cB + hstepB, voffB); PG8_STAGE(PG8_SA(0, 1), cA + hstepA, voffA);
        if (wr == 1) PG8_BAR;
        PG8_WAIT_V(4); PG8_BAR;
        PG8_STAGE(PG8_SB(1, 0), cB + kstep, voffB); PG8_STAGE(PG8_SA(1, 0), cA + kstep, voffA); PG8_STAGE(PG8_SB(1, 1), cB + hstepB + kstep, voffB);
        PG8_WAIT_V(6); PG8_BAR;
    }
    for (;;) {
        const bool has_next = S.next(ui + 1, nxt);
        const char* nA = has_next ? (const char*)g.A + (size_t)nxt.pm * tstepA : cA; const char* nB = has_next ? (const char*)g.Bt + (size_t)nxt.pn * tstepB : cB;
        for (int t = 0; t < nt; t += 2) {
            const bool last = (t == nt - 2);
            const char* a1 = cA + (size_t)(t + 1) * kstep;
            const char* a2 = last ? nA : cA + (size_t)(t + 2) * kstep; const char* b2 = last ? nB : cB + (size_t)(t + 2) * kstep;
            const char* a3 = a2 + kstep; const char* b3 = b2 + kstep;
            if (last && has_next) S.a_ready(nxt);
            if constexpr (SP2) {
            PG8_LDB(B0, 0, 0); PG8_LDB(B1, 0, 1); PG8_SCHED; PG8_LDA(At, 0, 0); PG8_STAGE(PG8_SA(1, 1), a1 + hstepA, voffA);
            PG8_WAIT_V(8); PG8_WAIT_L(0); PG8_BAR; PG8_MMA(0, 0, At, B0); PG8_MMA(0, 1, At, B1); PG8_BAR; PG8_SCHED;
            PG8_LDA(At, 0, 1); PG8_STAGE(PG8_SB(0, 0), b2, voffB); PG8_STAGE(PG8_SB(0, 1), b2 + hstepB, voffB); PG8_STAGE(PG8_SA(0, 0), a2, voffA);
            PG8_WAIT_V(8); PG8_WAIT_L(0); PG8_BAR; PG8_MMA(1, 0, At, B0); PG8_MMA(1, 1, At, B1); PG8_BAR; PG8_SCHED;
            PG8_LDB(B0, 1, 0); PG8_LDB(B1, 1, 1); PG8_SCHED; PG8_LDA(At, 1, 0); PG8_STAGE(PG8_SA(0, 1), a2 + hstepA, voffA);
            PG8_WAIT_V(8); PG8_WAIT_L(0); PG8_BAR; PG8_MMA(0, 0, At, B0); PG8_MMA(0, 1, At, B1); PG8_BAR; PG8_SCHED;
            PG8_LDA(At, 1, 1); PG8_STAGE(PG8_SB(1, 0), b3, voffB); PG8_STAGE(PG8_SB(1, 1), b3 + hstepB, voffB); PG8_STAGE(PG8_SA(1, 0), a3, voffA);
            PG8_WAIT_V(8); PG8_WAIT_L(0); PG8_BAR; PG8_MMA(1, 0, At, B0); PG8_MMA(1, 1, At, B1); PG8_BAR; PG8_SCHED;
            } else {
            PG8_LDB(B0, 0, 0); PG8_SCHED; PG8_LDA(At, 0, 0); PG8_STAGE(PG8_SA(1, 1), a1 + hstepA, voffA);
            PG8_WAIT_L(8); PG8_BAR; PG8_WAIT_L(0); PG8_MMA(0, 0, At, B0); PG8_BAR; PG8_SCHED;
            PG8_LDB(B1, 0, 1); PG8_STAGE(PG8_SB(0, 0), b2, voffB);
            PG8_BAR; PG8_WAIT_L(0); PG8_MMA(0, 1, At, B1); PG8_BAR;
            PG8_LDA(At, 0, 1); PG8_STAGE(PG8_SA(0, 0), a2, voffA);
            PG8_BAR; PG8_WAIT_L(0); PG8_MMA(1, 0, At, B0); PG8_BAR; PG8_SCHED;
            PG8_STAGE(PG8_SB(0, 1), b2 + hstepB, voffB);
            PG8_WAIT_V(6); PG8_BAR; PG8_MMA(1, 1, At, B1); PG8_BAR;
            PG8_LDB(B0, 1, 0); PG8_SCHED; PG8_LDA(At, 1, 0); PG8_STAGE(PG8_SA(0, 1), a2 + hstepA, voffA);
            PG8_WAIT_L(8); PG8_BAR; PG8_WAIT_L(0); PG8_MMA(0, 0, At, B0); PG8_BAR; PG8_SCHED;
            PG8_LDB(B1, 1, 1); PG8_STAGE(PG8_SB(1, 0), b3, voffB);
            PG8_BAR; PG8_WAIT_L(0); PG8_MMA(0, 1, At, B1); PG8_BAR;
            PG8_LDA(At, 1, 1); PG8_STAGE(PG8_SA(1, 0), a3, voffA);
            PG8_BAR; PG8_WAIT_L(0); PG8_MMA(1, 0, At, B0); PG8_BAR; PG8_SCHED;
            PG8_STAGE(PG8_SB(1, 1), b3 + hstepB, voffB);
            PG8_WAIT_V(6); PG8_BAR; PG8_MMA(1, 1, At, B1); PG8_BAR;
            }
        }
        if constexpr (ALIGN_EPI) { if (wr == 0) PG8_BAR; }
        if constexpr (!Epi::AFTER_DRAIN) { E(acc, cur, wr, wc, fr, fq); S.done(cur); }
        if (!has_next) break;
        if constexpr (Epi::INIT) E.init(acc, nxt, wr, wc, fr, fq);
        else {
#pragma unroll
        for (int a = 0; a < 2; ++a)
#pragma unroll
            for (int b = 0; b < 2; ++b)
#pragma unroll
                for (int m = 0; m < 4; ++m)
#pragma unroll
                    for (int n = 0; n < 2; ++n) acc[a][b][m][n] = (f32x4){0.f, 0.f, 0.f, 0.f};
        }
        cur = nxt; cA = nA; cB = nB; ++ui;
        if constexpr (ALIGN_EPI) { if (wr == 1) PG8_BAR; }
    }
    PG8_WAIT_V(0);
    if constexpr (!ALIGN_EPI) { if (wr == 0) PG8_BAR; }
    PG8_BAR;
    if constexpr (Epi::AFTER_DRAIN) { E.fused(acc, cur, wr, wc, fr, fq, lds, wid, lane); S.done(cur); }
#undef PG8_SA
#undef PG8_SB
#undef PG8_STAGE
#undef PG8_LDA
#undef PG8_LDB
#undef PG8_MMA
#undef PG8_WAIT_V
#undef PG8_WAIT_L
#undef PG8_BAR
#undef PG8_SCHED
}
}

namespace pg8 {
__device__ __forceinline__ unsigned pkbf(float lo, float hi) { f32x2 v = {lo, hi}; bf16x2_t b = __builtin_convertvector(v, bf16x2_t); return __builtin_bit_cast(unsigned, b); }
__device__ __forceinline__ u32x4 pack8bf(const f32x4& v0, const f32x4& v1) { u32x4 w; w.x = pkbf(v0[0], v0[1]); w.y = pkbf(v0[2], v0[3]); w.z = pkbf(v1[0], v1[1]); w.w = pkbf(v1[2], v1[3]); return w; }
__device__ __forceinline__ float sigm(float x) { return __builtin_amdgcn_rcpf(1.0f + __builtin_amdgcn_exp2f(-x * 1.4426950408889634f)); }
__device__ __forceinline__ float sigm255_1(float a, float nb) { const float e = __builtin_amdgcn_exp2f(__builtin_fmaf(a, -1.4426950408889634f, nb)); return __builtin_amdgcn_rcpf(__builtin_fmaf(e, 1.0f / 255.0f, 1.0f / 255.0f)); }
__device__ __forceinline__ f32x4 sigm255(f32x4 a, f32x4 nb) { f32x4 r; r[0] = sigm255_1(a[0], nb[0]); r[1] = sigm255_1(a[1], nb[1]); r[2] = sigm255_1(a[2], nb[2]); r[3] = sigm255_1(a[3], nb[3]); return r; }
__device__ __forceinline__ f32x4 sigm4(f32x4 v) { v[0] = sigm(v[0]); v[1] = sigm(v[1]); v[2] = sigm(v[2]); v[3] = sigm(v[3]); return v; }
struct EpiProj8 { static constexpr bool PERM = true, AFTER_DRAIN = false, INIT = false;
    ::bf16_t* qkv; unsigned char* gates; float* nsag; const float* bm; const float* hsc; const float* wsc;
    __device__ __forceinline__ void operator()(const f32x4 (&acc)[2][2][4][2], const Unit& u, int wr, int wc, int fr, int fq) const {
        const int row0 = u.pm * BM + wr * 64 + fr, colb = u.pn * BM + wc * 32 + 8 * fq;
        f32x4 cs[2][2];
#pragma unroll
        for (int bj = 0; bj < 2; ++bj)
#pragma unroll
            for (int n = 0; n < 2; ++n) cs[bj][n] = *(const f32x4*)(wsc + colb + bj * HALF + n * 4);
        if (u.pn < 10) {
#pragma unroll
            for (int ai = 0; ai < 2; ++ai)
#pragma unroll
                for (int m = 0; m < 4; ++m) { const size_t row = (size_t)(row0 + ai * HALF + m * 16); const float rs = hsc[row];
#pragma unroll
                    for (int bj = 0; bj < 2; ++bj) { f32x4 v[2];
#pragma unroll
                        for (int n = 0; n < 2; ++n) { const i32x4v ia = __builtin_bit_cast(i32x4v, acc[ai][bj][m][n]);
                            v[n][0] = (float)ia[0] * rs * cs[bj][n][0]; v[n][1] = (float)ia[1] * rs * cs[bj][n][1]; v[n][2] = (float)ia[2] * rs * cs[bj][n][2]; v[n][3] = (float)ia[3] * rs * cs[bj][n][3]; }
                        *(u32x4*)(qkv + row * 2560 + colb + bj * HALF) = pack8bf(v[0], v[1]); } }
        } else if (u.pn < 22) {
            f32x4 bb[2][2];
#pragma unroll
            for (int bj = 0; bj < 2; ++bj)
#pragma unroll
                for (int n = 0; n < 2; ++n) { bb[bj][n] = *(const f32x4*)(bm + colb + bj * HALF + n * 4 - 2560) * -1.4426950408889634f; cs[bj][n] *= -1.4426950408889634f; }
#pragma unroll
            for (int ai = 0; ai < 2; ++ai)
#pragma unroll
                for (int m = 0; m < 4; ++m) { const size_t row = (size_t)(row0 + ai * HALF + m * 16); const float rs = hsc[row];
#pragma unroll
                    for (int bj = 0; bj < 2; ++bj) { const int c = colb + bj * HALF - 2560;
                        u32x2 w;
#pragma unroll
                        for (int n = 0; n < 2; ++n) { const i32x4v ia = __builtin_bit_cast(i32x4v, acc[ai][bj][m][n]); float r[4];
#pragma unroll
                            for (int j = 0; j < 4; ++j) { const float e = __builtin_amdgcn_exp2f(__builtin_fmaf((float)ia[j] * rs, cs[bj][n][j], bb[bj][n][j])); r[j] = __builtin_amdgcn_rcpf(__builtin_fmaf(e, 1.0f / 255.0f, 1.0f / 255.0f)); }
                            const unsigned pk = __builtin_amdgcn_cvt_pk_u8_f32(r[3], 3, __builtin_amdgcn_cvt_pk_u8_f32(r[2], 2, __builtin_amdgcn_cvt_pk_u8_f32(r[1], 1, __builtin_amdgcn_cvt_pk_u8_f32(r[0], 0, 0u))));
                            if (n == 0) w.x = pk; else w.y = pk; }
                        *(u32x2*)(gates + row * 3072 + c) = w; } }
        } else {
#pragma unroll
            for (int ai = 0; ai < 2; ++ai)
#pragma unroll
                for (int m = 0; m < 4; ++m) { const size_t row = (size_t)(row0 + ai * HALF + m * 16); const float rs = hsc[row];
                    const int c = colb - 5632; if (c < 32) {
#pragma unroll
                        for (int n = 0; n < 2; ++n) { const i32x4v ia = __builtin_bit_cast(i32x4v, acc[ai][0][m][n]);
                            f32x4 v = {(float)ia[0] * rs * cs[0][n][0], (float)ia[1] * rs * cs[0][n][1], (float)ia[2] * rs * cs[0][n][2], (float)ia[3] * rs * cs[0][n][3]};
                            *(f32x4*)(nsag + row * 32 + c + n * 4) = sigm4(v); } } }
        }
    }
};
struct EpiPlain8 { static constexpr bool PERM = true, AFTER_DRAIN = false, INIT = false;
    ::bf16_t* O; int ldc; const float* hsc; const float* wsc;
    __device__ __forceinline__ void operator()(const f32x4 (&acc)[2][2][4][2], const Unit& u, int wr, int wc, int fr, int fq) const {
        const int row0 = u.pm * BM + wr * 64 + fr, colb = u.pn * BM + wc * 32 + 8 * fq;
        f32x4 cs[2][2];
#pragma unroll
        for (int bj = 0; bj < 2; ++bj)
#pragma unroll
            for (int n = 0; n < 2; ++n) cs[bj][n] = *(const f32x4*)(wsc + colb + bj * HALF + n * 4);
#pragma unroll
        for (int ai = 0; ai < 2; ++ai)
#pragma unroll
            for (int m = 0; m < 4; ++m) { const size_t row = (size_t)(row0 + ai * HALF + m * 16); const float rs = hsc[row];
#pragma unroll
                for (int bj = 0; bj < 2; ++bj) { f32x4 v[2];
#pragma unroll
                    for (int n = 0; n < 2; ++n) { const i32x4v ia = __builtin_bit_cast(i32x4v, acc[ai][bj][m][n]);
                        v[n][0] = (float)ia[0] * rs * cs[bj][n][0]; v[n][1] = (float)ia[1] * rs * cs[bj][n][1]; v[n][2] = (float)ia[2] * rs * cs[bj][n][2]; v[n][3] = (float)ia[3] * rs * cs[bj][n][3]; }
                    *(u32x4*)(O + row * ldc + colb + bj * HALF) = pack8bf(v[0], v[1]); } }
    }
};
struct EpiPlain { static constexpr bool PERM = true, AFTER_DRAIN = false, INIT = false;
    ::bf16_t* O; int ldc;
    __device__ __forceinline__ void operator()(const f32x4 (&acc)[2][2][4][2], const Unit& u, int wr, int wc, int fr, int fq) const {
        const int row0 = u.pm * BM + wr * 64 + fr;
#pragma unroll
        for (int ai = 0; ai < 2; ++ai)
#pragma unroll
            for (int m = 0; m < 4; ++m) { const size_t row = (size_t)(row0 + ai * HALF + m * 16);
#pragma unroll
                for (int bj = 0; bj < 2; ++bj) { const int col8 = u.pn * BM + bj * HALF + wc * 32 + 8 * fq; *(u32x4*)(O + row * ldc + col8) = pack8bf(acc[ai][bj][m][0], acc[ai][bj][m][1]); } }
    }
};
struct EpiMerge { static constexpr bool PERM = true, AFTER_DRAIN = false, INIT = false;
    ::bf16_t* merged; const ::bf16_t* gates; int br;
    __device__ __forceinline__ void operator()(const f32x4 (&acc)[2][2][4][2], const Unit& u, int wr, int wc, int fr, int fq) const {
        const int row0 = u.pm * BM + wr * 64 + fr, colb = u.pn * BM + wc * 32 + 8 * fq;
        u32x2 gw[2][4][2];
#pragma unroll
        for (int ai = 0; ai < 2; ++ai)
#pragma unroll
            for (int m = 0; m < 4; ++m)
#pragma unroll
                for (int bj = 0; bj < 2; ++bj) gw[ai][m][bj] = *(const u32x2*)((const unsigned char*)gates + (size_t)(row0 + ai * HALF + m * 16) * 3072 + br * 1024 + colb + bj * HALF);
#pragma unroll
        for (int ai = 0; ai < 2; ++ai) {
            u32x4 old[4][2];
            if (br != 0) {
#pragma unroll
                for (int m = 0; m < 4; ++m)
#pragma unroll
                    for (int bj = 0; bj < 2; ++bj) old[m][bj] = *(const u32x4*)(merged + (size_t)(row0 + ai * HALF + m * 16) * 1024 + colb + bj * HALF);
            }
#pragma unroll
            for (int m = 0; m < 4; ++m)
#pragma unroll
                for (int bj = 0; bj < 2; ++bj) {
                    const u32x2 g2 = gw[ai][m][bj];
                    f32x4 v0 = acc[ai][bj][m][0], v1 = acc[ai][bj][m][1];
                    v0[0] *= (float)(g2.x & 0xffu); v0[1] *= (float)((g2.x >> 8) & 0xffu); v0[2] *= (float)((g2.x >> 16) & 0xffu); v0[3] *= (float)(g2.x >> 24);
                    v1[0] *= (float)(g2.y & 0xffu); v1[1] *= (float)((g2.y >> 8) & 0xffu); v1[2] *= (float)((g2.y >> 16) & 0xffu); v1[3] *= (float)(g2.y >> 24);
                    if (br != 0) { const u32x4 o = old[m][bj];
                        v0[0] += __uint_as_float(o.x << 16); v0[1] += __uint_as_float(o.x & 0xffff0000u); v0[2] += __uint_as_float(o.y << 16); v0[3] += __uint_as_float(o.y & 0xffff0000u);
                        v1[0] += __uint_as_float(o.z << 16); v1[1] += __uint_as_float(o.z & 0xffff0000u); v1[2] += __uint_as_float(o.w << 16); v1[3] += __uint_as_float(o.w & 0xffff0000u); }
                    *(u32x4*)(merged + (size_t)(row0 + ai * HALF + m * 16) * 1024 + colb + bj * HALF) = pack8bf(v0, v1); }
            asm volatile("" ::: "memory");
        }
    }
};
struct EpiOut { static constexpr bool PERM = false, AFTER_DRAIN = false, INIT = true;
    const float* x; const float* gf; float* x2; ::bf16_t* h2; float* rowss;
    __device__ __forceinline__ void init(f32x4 (&acc)[2][2][4][2], const Unit& u, int wr, int wc, int fr, int fq) const {
        const int row0 = u.pm * BM + wr * 64 + fr, colb = u.pn * BM + wc * 32 + 4 * fq;
#pragma unroll
        for (int ai = 0; ai < 2; ++ai)
#pragma unroll
            for (int bj = 0; bj < 2; ++bj)
#pragma unroll
                for (int m = 0; m < 4; ++m)
#pragma unroll
                    for (int n = 0; n < 2; ++n) acc[ai][bj][m][n] = *(const f32x4*)(x + (size_t)(row0 + ai * HALF + m * 16) * 1024 + colb + bj * HALF + n * 16);
    }
    __device__ __forceinline__ void operator()(const f32x4 (&acc)[2][2][4][2], const Unit& u, int wr, int wc, int fr, int fq) const {
        const int row0 = u.pm * BM + wr * 64 + fr, colb = u.pn * BM + wc * 32 + 4 * fq;
        f32x4 gg[2][2];
#pragma unroll
        for (int bj = 0; bj < 2; ++bj)
#pragma unroll
            for (int n = 0; n < 2; ++n) gg[bj][n] = *(const f32x4*)(gf + colb + bj * HALF + n * 16);
#pragma unroll
        for (int ai = 0; ai < 2; ++ai)
#pragma unroll
            for (int m = 0; m < 4; ++m) { const size_t row = (size_t)(row0 + ai * HALF + m * 16);
#pragma unroll
                for (int bj = 0; bj < 2; ++bj) { float ss = 0.f;
#pragma unroll
                    for (int n = 0; n < 2; ++n) { const int col = colb + bj * HALF + n * 16;
                        const f32x4 v = acc[ai][bj][m][n]; *(f32x4*)(x2 + row * 1024 + col) = v;
                        ss += (v[0] * v[0] + v[1] * v[1]) + (v[2] * v[2] + v[3] * v[3]);
                        const f32x4 g4 = gg[bj][n]; u32x2 w; w.x = pkbf(v[0] * g4[0], v[1] * g4[1]); w.y = pkbf(v[2] * g4[2], v[3] * g4[3]); *(u32x2*)(h2 + row * 1024 + col) = w; }
                    ss += __shfl_xor(ss, 16); ss += __shfl_xor(ss, 32);
                    if (fq == 0) rowss[row * 32 + u.pn * 8 + bj * 4 + wc] = ss; } }
    }
};
}

#define GEMM_PHASE(EPI, g, S, E) pg8::gemm_phase<EPI, pg8::StaticOrder, true, true>((PG8_LAS unsigned char*)lds, g, S, E)
DI void phase1(const Params& p, bf16_t* lds) {
    unsigned char* ws = p.ws;
    {
        pg8::Gemm g{(const bf16_t*)(ws + WS_H8), (const bf16_t*)(ws + WS_W8), NTOK, NPROJ, D / 2, D / 2, D / 2};
        pg8::StaticOrder S; S.init(NTOK, NPROJ, (int)gridDim.x, (int)blockIdx.x);
        pg8::EpiProj8 E{(bf16_t*)(ws + WS_QKV), ws + WS_GATES, (float*)((unsigned char*)p.out + DO_NSAG), p.in[5], (const float*)(ws + WS_HSC), (const float*)(ws + WS_W8SC)};
        pg8::gemm_phase<pg8::EpiProj8, pg8::StaticOrder, true, true, true>((PG8_LAS unsigned char*)lds, g, S, E);
    }
    {
        pg8::Gemm g{(const bf16_t*)(ws + WS_MEMN8), (const bf16_t*)(ws + WS_WMKV8), NB * MEMT, 512, D / 2, D / 2, D / 2};
        const int cm = ((int)gridDim.x == 256 && blockIdx.x >= 128 && blockIdx.x < 144) ? (int)blockIdx.x - 128 : ((int)gridDim.x == 256 ? (1 << 20) : (int)blockIdx.x);
        pg8::StaticOrder S; S.init(NB * MEMT, 512, (int)gridDim.x, cm);
        pg8::EpiPlain8 E{(bf16_t*)((unsigned char*)p.out + DO_MKV), 512, (const float*)(ws + WS_MEMN8 + 2 * MiB), (const float*)(ws + WS_WMKV8 + MiB)};
        pg8::gemm_phase<pg8::EpiPlain8, pg8::StaticOrder, true, true, true>((PG8_LAS unsigned char*)lds, g, S, E);
    }
    if ((int)gridDim.x == 256) { if (blockIdx.x >= 144) late_weights(p, ((int)blockIdx.x - 144) * NTHREADS + (int)threadIdx.x, 112 * NTHREADS); }
    else late_weights(p, (int)(blockIdx.x * NTHREADS + threadIdx.x), (int)(gridDim.x * NTHREADS));
}
DI void transpose64(const bf16_t* src, size_t sp, bf16_t* dst, size_t dp, unsigned short* scr, int lane) {
#pragma unroll
    for (int i = 0; i < 8; ++i) { const int r = i * 8 + (lane >> 3), c8 = lane & 7; const u32x4 v = *(const u32x4*)(src + (size_t)r * sp + c8 * 8);
        unsigned short* s = scr + r * 66 + c8 * 8;
        s[0] = (unsigned short)(v.x & 0xffff); s[1] = (unsigned short)(v.x >> 16); s[2] = (unsigned short)(v.y & 0xffff); s[3] = (unsigned short)(v.y >> 16);
        s[4] = (unsigned short)(v.z & 0xffff); s[5] = (unsigned short)(v.z >> 16); s[6] = (unsigned short)(v.w & 0xffff); s[7] = (unsigned short)(v.w >> 16); }
    __builtin_amdgcn_s_waitcnt(0xc07f);
    __builtin_amdgcn_wave_barrier();
#pragma unroll
    for (int i = 0; i < 8; ++i) { const int c = i * 8 + (lane >> 3), r8 = lane & 7; const unsigned short* s = scr + (r8 * 8) * 66 + c;
        u32x4 o; o.x = (unsigned)s[0] | ((unsigned)s[66] << 16); o.y = (unsigned)s[2 * 66] | ((unsigned)s[3 * 66] << 16); o.z = (unsigned)s[4 * 66] | ((unsigned)s[5 * 66] << 16); o.w = (unsigned)s[6 * 66] | ((unsigned)s[7 * 66] << 16);
        *(u32x4*)(dst + (size_t)c * dp + r8 * 8) = o; }
    __builtin_amdgcn_s_waitcnt(0xc07f);
    __builtin_amdgcn_wave_barrier();
}
DI void transpose64_vtiles(const bf16_t* src, size_t sp, bf16_t* dst  , unsigned short* scr, int lane) {
#pragma unroll
    for (int i = 0; i < 8; ++i) { const int r = i * 8 + (lane >> 3), c8 = lane & 7; const u32x4 v = *(const u32x4*)(src + (size_t)r * sp + c8 * 8);
        unsigned short* sdst = scr + r * 66 + c8 * 8;
        sdst[0] = (unsigned short)(v.x & 0xffff); sdst[1] = (unsigned short)(v.x >> 16); sdst[2] = (unsigned short)(v.y & 0xffff); sdst[3] = (unsigned short)(v.y >> 16);
        sdst[4] = (unsigned short)(v.z & 0xffff); sdst[5] = (unsigned short)(v.z >> 16); sdst[6] = (unsigned short)(v.w & 0xffff); sdst[7] = (unsigned short)(v.w >> 16); }
    __builtin_amdgcn_s_waitcnt(0xc07f);
    __builtin_amdgcn_wave_barrier();
#pragma unroll
    for (int i = 0; i < 8; ++i) { const int d = i * 8 + (lane >> 3), r8 = lane & 7; const unsigned short* sp2 = scr + (r8 * 8) * 66 + d;
        u32x2 lo, hi2; lo.x = (unsigned)sp2[0] | ((unsigned)sp2[66] << 16); lo.y = (unsigned)sp2[2 * 66] | ((unsigned)sp2[3 * 66] << 16); hi2.x = (unsigned)sp2[4 * 66] | ((unsigned)sp2[5 * 66] << 16); hi2.y = (unsigned)sp2[6 * 66] | ((unsigned)sp2[7 * 66] << 16);
        const int half = r8 >> 2, q = 2 * (r8 & 3), msk = (d >> 2) & 7;
        unsigned char* tb = (unsigned char*)dst + half * 4096 + d * 64;
        *(u32x2*)(tb + ((q ^ msk) * 8)) = lo; *(u32x2*)(tb + (((q + 1) ^ msk) * 8)) = hi2; }
    __builtin_amdgcn_s_waitcnt(0xc07f);
    __builtin_amdgcn_wave_barrier();
}
DI void copy64_ktiles(const bf16_t* src, size_t sp, bf16_t* dst, int lane) {
#pragma unroll
    for (int i = 0; i < 8; ++i) { const int r = i * 8 + (lane >> 3), c8 = lane & 7; const u32x4 v = *(const u32x4*)(src + (size_t)r * sp + c8 * 8);
        const int rr = r & 31;
        *(u32x4*)((unsigned char*)dst + (r >> 5) * 4096 + rr * 128 + ((c8 ^ ((rr >> 1) & 7)) * 16)) = v; }
}
DI void phase2(const Params& p, bf16_t* lds) {
    unsigned char* ws = p.ws; unsigned char* dout = (unsigned char*)p.out;
    const int lane = threadIdx.x & 63, wid = threadIdx.x >> 6;
    const int gwave = blockIdx.x * NWAVES + wid, nwaves = gridDim.x * NWAVES;
    unsigned short* scr = (unsigned short*)lds + wid * (64 * 66);
    const bf16_t* qkv = (const bf16_t*)(ws + WS_QKV);
    __syncthreads();
    {
        bf16_t* kc = (bf16_t*)(dout + DO_KC); bf16_t* vct = (bf16_t*)(dout + DO_VCT);
        const int r32 = lane & 31, hi = lane >> 5;
        float* red = (float*)lds;
        for (int task = blockIdx.x; task < 2 * 16 * 8; task += gridDim.x) {
            const int which = task >> 7, bg = (task >> 3) & 15, chunk = task & 7, b = bg >> 1, g = bg & 1;
            const bf16_t* wt = (const bf16_t*)(ws + WS_CMPW) + (size_t)which * 64 * 2048;
            const float* pe = p.in[6 + which];
            const int n = chunk * 32 + r32;
            f32x16 acc[2]; zero16(acc[0]); zero16(acc[1]);
#pragma unroll
            for (int li = 0; li < 4; ++li) {
                const int l = wid * 4 + li; int token = 16 * n + l; if (token > T - 1) token = T - 1;
                const bf16_t* xr = qkv + (size_t)(b * T + token) * LDP_QKV + C_NKV + which * 128 + g * 64 + hi * 8;
#pragma unroll
                for (int ds = 0; ds < 4; ++ds) {
                    const bf16x8 xf = *(const bf16x8*)(xr + ds * 16);
                    const f32x4 p0 = *(const f32x4*)(pe + l * 64 + ds * 16 + hi * 8), p1 = *(const f32x4*)(pe + l * 64 + ds * 16 + hi * 8 + 4);
                    u32x4 pw; pw.x = pk2(p0.x, p0.y); pw.y = pk2(p0.z, p0.w); pw.z = pk2(p1.x, p1.y); pw.w = pk2(p1.z, p1.w);
                    const bf16x8 pf = __builtin_bit_cast(bf16x8, pw);
#pragma unroll
                    for (int eb = 0; eb < 2; ++eb) {
                        const bf16x8 wf = *(const bf16x8*)(wt + (size_t)(32 * eb + r32) * 2048 + l * 64 + ds * 16 + hi * 8);
                        if (which == 0) { acc[eb] = MFMA32(wf, xf, acc[eb]); acc[eb] = MFMA32(wf, pf, acc[eb]); }
                        else { acc[eb] = MFMA32(xf, wf, acc[eb]); acc[eb] = MFMA32(pf, wf, acc[eb]); }
                    }
                }
            }
#pragma unroll
            for (int eb = 0; eb < 2; ++eb)
#pragma unroll
                for (int r = 0; r < 16; ++r) red[(wid * 32 + eb * 16 + r) * 64 + lane] = acc[eb][r];
            __syncthreads();
            {
                const int eb = wid >> 2, mg = wid & 3;
                f32x4 v = {0.f, 0.f, 0.f, 0.f};
#pragma unroll
                for (int w2 = 0; w2 < 8; ++w2) { v.x += red[(w2 * 32 + eb * 16 + 4 * mg) * 64 + lane]; v.y += red[(w2 * 32 + eb * 16 + 4 * mg + 1) * 64 + lane]; v.z += red[(w2 * 32 + eb * 16 + 4 * mg + 2) * 64 + lane]; v.w += red[(w2 * 32 + eb * 16 + 4 * mg + 3) * 64 + lane]; }
                if (which == 0) {
                    if (n == 255) v = (f32x4){0.f, 0.f, 0.f, 0.f};
                    store_bf16x4(kc + ((size_t)bg * 256 + n) * 64 + 32 * eb + 8 * mg + 4 * hi, v);
                } else {
                    const int n0 = chunk * 32 + 8 * mg + 4 * hi;
                    if (n0 + 3 == 255) v.w = 0.f;
                    store_bf16x4(vct + ((size_t)bg * 64 + 32 * eb + r32) * 256 + n0, v);
                }
            }
            __syncthreads();
        }
    }
}

DI bf16x8 pack8(const f32x16& p, int base) {
    u32x4 w; w.x = pk2(p[base], p[base + 1]); w.y = pk2(p[base + 2], p[base + 3]); w.z = pk2(p[base + 4], p[base + 5]); w.w = pk2(p[base + 6], p[base + 7]);
    return __builtin_bit_cast(bf16x8, w);
}
DI f32x16 st_tile(const bf16_t* kbase, size_t kpitch, const bf16x8 (&qf)[4], int r32, int hi) {
    f32x16 s;
#pragma unroll
    for (int i = 0; i < 16; ++i) s[i] = 0.f;
    const bf16_t* kp = kbase + (size_t)r32 * kpitch + hi * 8;
#pragma unroll
    for (int ks = 0; ks < 4; ++ks) { const bf16x8 a = *(const bf16x8*)(kp + ks * 16); s = MFMA32(a, qf[ks], s); }
    return s;
}
DI void pv_tile(f32x16 (&o)[2], const bf16_t* vT, size_t vpitch, const f32x16& pr, int r32, int hi) {
    const bf16x8 pf0 = pack8(pr, 0), pf1 = pack8(pr, 8);
#pragma unroll
    for (int db = 0; db < 2; ++db) {
        const bf16_t* vp = vT + (size_t)(32 * db + r32) * vpitch + 4 * hi;
#pragma unroll
        for (int s2 = 0; s2 < 2; ++s2) {
            const s16x4 lo = *(const s16x4*)(vp + 16 * s2); const s16x4 hh = *(const s16x4*)(vp + 16 * s2 + 8);
            const bf16x8 a = {lo[0], lo[1], lo[2], lo[3], hh[0], hh[1], hh[2], hh[3]};
            o[db] = MFMA32(a, s2 ? pf1 : pf0, o[db]);
        }
    }
}
DI void load_q(bf16x8 (&qf)[4], const bf16_t* qrow  , int hi) {
#pragma unroll
    for (int ks = 0; ks < 4; ++ks) qf[ks] = *(const bf16x8*)(qrow + ks * 16 + hi * 8);
}
DI void softmax_tile(f32x16& sv, unsigned vmask, float& m, float& l, f32x16 (&o)[2]) {
    float tm = -1e30f;
#pragma unroll
    for (int r = 0; r < 16; ++r) tm = fmaxf(tm, ((vmask >> r) & 1u) ? sv[r] : -1e30f);
    tm = fmaxf(tm, __shfl_xor(tm, 32));
    const float mn = fmaxf(m, tm);
    const float alpha = fexp(m - mn);
    float ps = 0.f;
#pragma unroll
    for (int r = 0; r < 16; ++r) { const float pv = ((vmask >> r) & 1u) ? fexp(sv[r] - mn) : 0.f; sv[r] = pv; ps += pv; }
    l = l * alpha + ps; m = mn;
#pragma unroll
    for (int r = 0; r < 16; ++r) { o[0][r] *= alpha; o[1][r] *= alpha; }
}

struct KF { bf16x8 k[4]; };
struct VF { s16x4 v[2][2][2]; };
DI void load_kf(KF& f, const bf16_t* kbase, size_t kpitch, int r32, int hi) {
    const bf16_t* kp = kbase + (size_t)r32 * kpitch + hi * 8;
#pragma unroll
    for (int ks = 0; ks < 4; ++ks) f.k[ks] = *(const bf16x8*)(kp + ks * 16);
}
DI void load_vf(VF& f, const bf16_t* vT, size_t vpitch, int r32, int hi) {
#pragma unroll
    for (int db = 0; db < 2; ++db) { const bf16_t* vp = vT + (size_t)(32 * db + r32) * vpitch + 4 * hi;
#pragma unroll
        for (int s2 = 0; s2 < 2; ++s2) { f.v[db][s2][0] = *(const s16x4*)(vp + 16 * s2); f.v[db][s2][1] = *(const s16x4*)(vp + 16 * s2 + 8); } }
}
DI f32x16 qk_frag(const KF& f, const bf16x8 (&qf)[4]) {
    f32x16 s; zero16(s);
#pragma unroll
    for (int ks = 0; ks < 4; ++ks) s = MFMA32(f.k[ks], qf[ks], s);
    return s;
}
DI void pv_frag(f32x16 (&o)[2], const VF& f, const f32x16& pr) {
    const bf16x8 pf0 = pack8(pr, 0), pf1 = pack8(pr, 8);
#pragma unroll
    for (int db = 0; db < 2; ++db)
#pragma unroll
        for (int s2 = 0; s2 < 2; ++s2) { const s16x4 lo = f.v[db][s2][0], hh = f.v[db][s2][1];
            const bf16x8 a = {lo[0], lo[1], lo[2], lo[3], hh[0], hh[1], hh[2], hh[3]};
            o[db] = MFMA32(a, s2 ? pf1 : pf0, o[db]); }
}
template <bool GUARD = false> DI void softmax_core(f32x16& e, float A, float& m, float& l, f32x16 (&o)[2]) {
    float tm = fmaxf(fmaxf(fmaxf(e[0], e[1]), fmaxf(e[2], e[3])), fmaxf(fmaxf(e[4], e[5]), fmaxf(e[6], e[7])));
    tm = fmaxf(tm, fmaxf(fmaxf(fmaxf(e[8], e[9]), fmaxf(e[10], e[11])), fmaxf(fmaxf(e[12], e[13]), fmaxf(e[14], e[15]))));
    tm += A;
    tm = fmaxf(tm, __shfl_xor(tm, 32));
    if (__any(tm > m + 8.0f)) {
        const float mn = fmaxf(m, tm); const float alpha = fexp2(m - mn); l *= alpha; m = mn;
#pragma unroll
        for (int r = 0; r < 16; ++r) { o[0][r] *= alpha; o[1][r] *= alpha; }
    }
    const float c = A - m;
    float ps = 0.f;
#pragma unroll
    for (int r = 0; r < 16; ++r) { float pv = fexp2(e[r] + c); if (GUARD) pv = (e[r] > -1e29f) ? pv : 0.f; e[r] = pv; ps += pv; }
    l += ps;
}
constexpr float SCL2 = 0.125f * LOG2E;

DI int f2key(float v) { const int u = __float_as_int(v); return u ^ ((u >> 31) & 0x7fffffff); }
DI float key2f(int k) { return __int_as_float(k ^ ((k >> 31) & 0x7fffffff)); }
template <int N> DI void bitonic_sort_desc(int (&a)[N]) {
#pragma unroll
    for (int k = 2; k <= N; k <<= 1)
#pragma unroll
        for (int j = k >> 1; j > 0; j >>= 1)
#pragma unroll
            for (int i = 0; i < N; ++i) { const int l = i ^ j; if (l > i) { const bool desc = ((i & k) == 0); const int hi_ = max(a[i], a[l]), lo_ = min(a[i], a[l]); a[i] = desc ? hi_ : lo_; a[l] = desc ? lo_ : hi_; } }
}
DI void top16_merge(int (&a)[16], const int (&b)[16]) {
#pragma unroll
    for (int i = 0; i < 16; ++i) a[i] = max(a[i], b[15 - i]);
#pragma unroll
    for (int j = 8; j > 0; j >>= 1)
#pragma unroll
        for (int i = 0; i < 16; ++i) { const int l = i ^ j; if (l > i) { const int hi_ = max(a[i], a[l]), lo_ = min(a[i], a[l]); a[i] = hi_; a[l] = lo_; } }
}
DI void nsa_cmp_task(const Params& p, int b, int g, int chunk, int lane, float* impl  ) {
    unsigned char* ws = p.ws; unsigned char* dout = (unsigned char*)p.out;
    const int r32 = lane & 31, hi = lane >> 5;
    const int tq0 = chunk * 32, t = tq0 + r32, cur = tq0 >> 6;
    const size_t tok = (size_t)b * T + t;
    const bf16_t* qkv = (const bf16_t*)(ws + WS_QKV);
    const float scale = 0.125f;
#pragma unroll
    for (int k = 0; k < 32; ++k) impl[k * 64 + lane] = 0.f;
    const bf16_t* kc = (const bf16_t*)(dout + DO_KC) + (size_t)(b * 2 + g) * 256 * 64;
    const bf16_t* vct = (const bf16_t*)(dout + DO_VCT) + (size_t)(b * 2 + g) * 64 * 256;
    int ntile = (tq0 / 16) / 32 + 1; if (ntile > 8) ntile = 8;
#pragma unroll 1
    for (int rr = 0; rr < 3; ++rr) {
        const int head = g * 3 + rr;
        bf16x8 qr[4]; load_q(qr, qkv + tok * LDP_QKV + C_NQ + head * 64, hi);
        const float slope = fexp2(-(8.0f * (float)(head + 1)) / 6.0f);
        float m = -1e30f, l = 0.f;
        f32x16 oc[2]; zero16(oc[0]); zero16(oc[1]);
        float* tmp = impl + 32 * 64; float* tmpm = impl + 64 * 64;
#pragma unroll 1
        for (int tile = 0; tile < ntile; ++tile) {
            KF kf; VF vf; load_kf(kf, kc + (size_t)tile * 32 * 64, 64, r32, hi); load_vf(vf, vct + tile * 32, 256, r32, hi);
            f32x16 s = qk_frag(kf, qr);
            float tm = -1e30f;
#pragma unroll
            for (int r = 0; r < 16; ++r) { const int n = tile * 32 + krow(r, hi); const int dist = t - (16 * n + 31); const bool valid = dist >= 0 && n < 255;
                const float sv = valid ? s[r] * scale - slope * (float)dist : -1e30f; s[r] = sv; tm = fmaxf(tm, sv); }
            tm = fmaxf(tm, __shfl_xor(tm, 32));
            if (__any(tm > m)) {
                const float mn = fmaxf(m, tm); const float alpha = fexp(m - mn); l *= alpha; m = mn;
#pragma unroll
                for (int r = 0; r < 16; ++r) { oc[0][r] *= alpha; oc[1][r] *= alpha; }
            }
            float ps = 0.f;
#pragma unroll
            for (int r = 0; r < 16; ++r) { const float pv = (s[r] > -1e29f) ? fexp(s[r] - m) : 0.f; s[r] = pv; ps += pv; }
            l += ps;
#pragma unroll
            for (int mm = 0; mm < 4; ++mm) tmp[(tile * 4 + mm) * 64 + lane] = (s[4 * mm] + s[4 * mm + 1]) + (s[4 * mm + 2] + s[4 * mm + 3]);
            tmpm[tile * 64 + lane] = m;
            pv_frag(oc, vf, s);
        }
        l += __shfl_xor(l, 32);
        const float inv = l > 0.f ? 1.0f / l : 0.f;
#pragma unroll 1
        for (int tile = 0; tile < ntile; ++tile) { const float sc = fexp(tmpm[tile * 64 + lane] - m) * inv;
#pragma unroll
            for (int mm = 0; mm < 4; ++mm) impl[(tile * 4 + mm) * 64 + lane] += tmp[(tile * 4 + mm) * 64 + lane] * sc; }
#pragma unroll
        for (int r = 0; r < 16; ++r) { oc[0][r] *= inv; oc[1][r] *= inv; }
        const float g_c = ((const float*)(dout + DO_NSAG))[tok * 32 + head * 3];
        bf16_t* orow = (bf16_t*)(dout + DO_OC) + tok * 384 + head * 64;
#pragma unroll
        for (int db = 0; db < 2; ++db)
#pragma unroll
            for (int mg = 0; mg < 4; ++mg) { f32x4 v = {g_c * oc[db][4 * mg], g_c * oc[db][4 * mg + 1], g_c * oc[db][4 * mg + 2], g_c * oc[db][4 * mg + 3]}; store_bf16x4(orow + 32 * db + 8 * mg + 4 * hi, v); }
    }
    unsigned long long selmask;
    if (cur + 1 <= 16) selmask = (1ull << (cur + 1)) - 1ull;
    else {
        int k0[16], k1[16];
#pragma unroll
        for (int k = 0; k < 32; ++k) { const int j = 2 * k + hi; const float iv = impl[k * 64 + lane]; const float v = (j == 0 || j == cur || j == cur - 1) ? 1e4f : (j <= cur ? iv : -1.0f);
            const int key = (__float_as_int(v) & ~63) | (63 - j);
            if (k < 16) k0[k] = key; else k1[k - 16] = key; }
        bitonic_sort_desc<16>(k0); bitonic_sort_desc<16>(k1); top16_merge(k0, k1);
        int pb[16];
#pragma unroll
        for (int i = 0; i < 16; ++i) pb[i] = __shfl_xor(k0[i], 32);
        top16_merge(k0, pb);
        selmask = 0ull;
#pragma unroll
        for (int i = 0; i < 16; ++i) selmask |= 1ull << (63 - (k0[i] & 63));
    }
    if (hi == 0) ((unsigned long long*)(dout + DO_SELM))[(size_t)(b * 2 + g) * T + t] = selmask;
}
typedef LAS unsigned char* ldsp_t;
struct KOff { unsigned o[4]; };
DI KOff koff_make(int lane, unsigned pitch_bytes) { KOff k;
#pragma unroll
    for (int i = 0; i < 4; ++i) { const int r = i * 8 + (lane >> 3), c8 = (lane & 7) ^ ((i * 4 + (lane >> 4)) & 7); k.o[i] = (unsigned)r * pitch_bytes + (unsigned)c8 * 16u; }
    return k; }
DI void dma_k(ldsp_t kbuf  , const bf16_t* krow0  , const KOff& k) {
#pragma unroll
    for (int i = 0; i < 4; ++i) __builtin_amdgcn_global_load_lds((const unsigned*)((const unsigned char*)krow0 + k.o[i]), (LAS unsigned*)(kbuf + i * 1024), 16, 0, 0);
}
DI KOff voff_make(int lane, unsigned pitch_bytes) { KOff k;
#pragma unroll
    for (int i = 0; i < 4; ++i) { const int r = i * 8 + (lane >> 3), c8 = (lane & 7) ^ (((lane >> 4) & 1) << 2); k.o[i] = (unsigned)r * pitch_bytes + (unsigned)c8 * 16u; }
    return k; }
DI void dma_v(ldsp_t vbuf  , const bf16_t* vrow0  , const KOff& k) {
#pragma unroll
    for (int i = 0; i < 4; ++i) __builtin_amdgcn_global_load_lds((const unsigned*)((const unsigned char*)vrow0 + k.o[i]), (LAS unsigned*)(vbuf + i * 1024), 16, 0, 0);
}
struct VTr { unsigned b[2]; };
DI VTr vtr_make(int lane) { const unsigned h = lane >> 5, blk = (lane >> 4) & 1, q = (lane & 15) >> 2, p = lane & 3, x = 2 * blk + (p >> 1), mm = (q >> 1) & 1, rowb = 4 * h + q;
    VTr v; v.b[0] = 128u * rowb + 16u * (x + 4u * (0u ^ mm)) + 8u * (p & 1); v.b[1] = 128u * rowb + 16u * (x + 4u * (1u ^ mm)) + 8u * (p & 1); return v; }
DI s16x4 tr_read(ldsp_t a) { return __builtin_amdgcn_ds_read_tr16_b64_v4i16((LAS s16x4*)a); }
DI f32x16 qk_lds(ldsp_t kbuf, const bf16x8 (&qf)[4], int r32, int hi) {
    f32x16 s; zero16(s);
    const int sw = (r32 >> 1) & 7;
#pragma unroll
    for (int ks = 0; ks < 4; ++ks) { const bf16x8 a = *(const LAS bf16x8*)(kbuf + r32 * 128 + (((2 * ks + hi) ^ sw) * 16)); s = MFMA32(a, qf[ks], s); }
    return s;
}
DI void pv_lds(f32x16 (&o)[2], ldsp_t vbuf, const f32x16& pr, const VTr& vt_) {
    const bf16x8 pf0 = pack8(pr, 0), pf1 = pack8(pr, 8);
#pragma unroll
    for (int db = 0; db < 2; ++db)
#pragma unroll
        for (int s2 = 0; s2 < 2; ++s2) { const s16x4 lo = tr_read(vbuf + vt_.b[db] + 2048 * s2), hh = tr_read(vbuf + vt_.b[db] + 2048 * s2 + 1024);
            const bf16x8 a = {lo[0], lo[1], lo[2], lo[3], hh[0], hh[1], hh[2], hh[3]};
            o[db] = MFMA32(a, s2 ? pf1 : pf0, o[db]); }
}
constexpr int RING_BYTES = 20480, VRING_OFF = 12288;
DI void dma_wait_step(bool k2, bool v1) {
    if (k2 && v1) asm volatile("s_waitcnt vmcnt(8)" ::: "memory");
    else if (k2 || v1) asm volatile("s_waitcnt vmcnt(4)" ::: "memory");
    else asm volatile("s_waitcnt vmcnt(0)" ::: "memory");
}
#define DMA_WAIT_NEWEST8() asm volatile("s_waitcnt vmcnt(8)" ::: "memory")
#define DMA_WAIT_ALL() asm volatile("s_waitcnt vmcnt(0)" ::: "memory")

DI void lds_kf(KF& f, ldsp_t kbuf, int r32, int hi) {
    const int sw = (r32 >> 1) & 7;
#pragma unroll
    for (int ks = 0; ks < 4; ++ks) f.k[ks] = *(const LAS bf16x8*)(kbuf + r32 * 128 + (((2 * ks + hi) ^ sw) * 16));
}
DI void lds_vf(VF& f, ldsp_t vbuf, const VTr& vt_) {
#pragma unroll
    for (int db = 0; db < 2; ++db)
#pragma unroll
        for (int s2 = 0; s2 < 2; ++s2) { f.v[db][s2][0] = tr_read(vbuf + vt_.b[db] + 2048 * s2); f.v[db][s2][1] = tr_read(vbuf + vt_.b[db] + 2048 * s2 + 1024); }
}
template <bool MASKED, bool WIN> DI void nsa_pair_tile(ldsp_t kbuf, ldsp_t vbuf, const bf16x8 (&qf)[2][4], int t0, int kb, float rb0, float rb1, float slope2,
                                                       float (&m)[2], float (&l)[2], f32x16 (&o)[2][2], int r32, int hi, const VTr& vtr) {
    KF kf; lds_kf(kf, kbuf, r32, hi);
    f32x16 s0 = qk_frag(kf, qf[0]), s1 = qk_frag(kf, qf[1]);
    const int db0 = t0 - kb - 4 * hi, db1 = db0 + 32;
#pragma unroll
    for (int r = 0; r < 16; ++r) { const int cr = (r & 3) + 8 * (r >> 2); const float bias = __int_as_float(__builtin_amdgcn_readfirstlane(__float_as_int(slope2 * (float)cr)));
        float e0 = __builtin_fmaf(s0[r], SCL2, bias), e1 = __builtin_fmaf(s1[r], SCL2, bias);
        if (MASKED) { const int d0 = db0 - cr, d1 = db1 - cr; e0 = (d0 >= 0 && (!WIN || d0 < 512)) ? e0 : -1e30f; e1 = (d1 >= 0 && (!WIN || d1 < 512)) ? e1 : -1e30f; }
        s0[r] = e0; s1[r] = e1; }
    softmax_core<MASKED>(s0, rb0 - slope2 * (float)db0, m[0], l[0], o[0]);
    softmax_core<MASKED>(s1, rb1 - slope2 * (float)db1, m[1], l[1], o[1]);
    VF vf; lds_vf(vf, vbuf, vtr);
    pv_frag(o[0], vf, s0); pv_frag(o[1], vf, s1);
}
DI void nsa_main_task(const Params& p, int b, int head, int blk, int lane, ldsp_t wl) {
    unsigned char* ws = p.ws; unsigned char* dout = (unsigned char*)p.out;
    const int g = head / 3, r32 = lane & 31, hi = lane >> 5;
    const int tq0 = blk * 64, cur = blk;
    const int t0 = tq0 + r32;
    const size_t tok0 = (size_t)b * T + t0;
    const bf16_t* qkv = (const bf16_t*)(ws + WS_QKV);
    const unsigned long long* smp = (const unsigned long long*)(dout + DO_SELM) + (size_t)(b * 2 + g) * T + t0;
    const unsigned long long selmask[2] = {smp[0], smp[32]};
    const float slope2 = fexp2(-(8.0f * (float)(head + 1)) / 6.0f) * LOG2E;
    bf16x8 qf[2][4];
    load_q(qf[0], qkv + tok0 * LDP_QKV + C_NQ + head * 64, hi); load_q(qf[1], qkv + (tok0 + 32) * LDP_QKV + C_NQ + head * 64, hi);
    const size_t tbase = (size_t)(b * 2 + g) * 128; constexpr size_t KSTR = 32 * LDP_QKV; const KOff ko = koff_make(lane, LDP_QKV * 2), vo = voff_make(lane, LDP_QKV * 2); const VTr vtr = vtr_make(lane);
    const float* nsag = (const float*)(dout + DO_NSAG) + tok0 * 32 + head * 3;
    bf16_t* orow = (bf16_t*)(ws + WS_H) + tok0 * D + 384 + head * 64;
    {
        const bf16_t* kt = qkv + (size_t)b * T * LDP_QKV + C_NKV + 2 * 128 + g * 64; const bf16_t* vt = kt + 128;
        unsigned ulo = (unsigned)(selmask[0] | selmask[1]), uhi = (unsigned)((selmask[0] | selmask[1]) >> 32);
#pragma unroll
        for (int o_ = 1; o_ < 64; o_ <<= 1) { ulo |= (unsigned)__shfl_xor((int)ulo, o_); uhi |= (unsigned)__shfl_xor((int)uhi, o_); }
        unsigned long long U = ((unsigned long long)(unsigned)__builtin_amdgcn_readfirstlane((int)uhi) << 32) | (unsigned)__builtin_amdgcn_readfirstlane((int)ulo);
        U &= (cur == 63) ? ~0ull : ((1ull << (cur + 1)) - 1ull);
        float m[2] = {-1e30f, -1e30f}, l[2] = {0.f, 0.f}; f32x16 o[2][2];
        zero16(o[0][0]); zero16(o[0][1]); zero16(o[1][0]); zero16(o[1][1]);
#define NEXT_TILE(J, H, NJ, NH, HAS) { NJ = J; NH = H - 1; HAS = true; if (NH < 0) { const unsigned long long rem_ = U & ((1ull << J) - 1ull); if (rem_ == 0ull) HAS = false; else { NJ = 63 - __builtin_clzll(rem_); NH = 1; } } }
        int j0 = cur, h0 = 1, j1, h1, j2 = 0, h2 = 0; bool has1, has2 = false;
        NEXT_TILE(j0, h0, j1, h1, has1);
        if (has1) NEXT_TILE(j1, h1, j2, h2, has2);
        int ks0 = 0, vs0 = 0;
        dma_k(wl, kt + (size_t)(2 * j0 + h0) * KSTR, ko); dma_v(wl + VRING_OFF, vt + (size_t)(2 * j0 + h0) * KSTR, vo);
        if (has1) dma_k(wl + 4096, kt + (size_t)(2 * j1 + h1) * KSTR, ko);
#define NSA_SEL_STEP(MASKED) { \
            const int ks1 = ks0 == 2 ? 0 : ks0 + 1, ks2 = ks1 == 2 ? 0 : ks1 + 1; \
            if (has2) dma_k(wl + ks2 * 4096, kt + (size_t)(2 * j2 + h2) * KSTR, ko); \
            if (has1) dma_v(wl + VRING_OFF + (vs0 ^ 1) * 4096, vt + (size_t)(2 * j1 + h1) * KSTR, vo); \
            dma_wait_step(has2, has1); \
            const int kb = 64 * j0 + 32 * h0; \
            const float rb0 = ((selmask[0] >> j0) & 1ull) ? 0.f : -1e30f, rb1 = ((selmask[1] >> j0) & 1ull) ? 0.f : -1e30f; \
            nsa_pair_tile<MASKED, false>(wl + ks0 * 4096, wl + VRING_OFF + vs0 * 4096, qf, t0, kb, rb0, rb1, slope2, m, l, o, r32, hi, vtr); \
            more = has1; \
            if (has1) { j0 = j1; h0 = h1; j1 = j2; h1 = h2; has1 = has2; \
                if (has2) { int nj, nh; bool hs; NEXT_TILE(j2, h2, nj, nh, hs); j2 = nj; h2 = nh; has2 = hs; } \
                ks0 = ks1; vs0 ^= 1; } }
        bool more = true;
#pragma unroll 1
        while (more && j0 == cur) NSA_SEL_STEP(true)
#pragma unroll 1
        while (more) NSA_SEL_STEP(false)
#pragma unroll
        for (int ci = 0; ci < 2; ++ci) {
            float lt = l[ci]; lt += __shfl_xor(lt, 32);
            const float f = nsag[ci * 32 * 32 + 1] * (lt > 0.f ? 1.0f / lt : 0.f);
#pragma unroll
            for (int db = 0; db < 2; ++db)
#pragma unroll
                for (int mg = 0; mg < 4; ++mg) { const u32x2 w = *(const u32x2*)((const bf16_t*)(dout + DO_OC) + (tok0 + ci * 32) * 384 + head * 64 + 32 * db + 8 * mg + 4 * hi);
                    f32x4 v = {bflo(w.x) + f * o[ci][db][4 * mg], bfhi(w.x) + f * o[ci][db][4 * mg + 1], bflo(w.y) + f * o[ci][db][4 * mg + 2], bfhi(w.y) + f * o[ci][db][4 * mg + 3]};
                    store_bf16x4(orow + (size_t)ci * 32 * D + 32 * db + 8 * mg + 4 * hi, v); }
        }
    }
    {
        const bf16_t* kt = qkv + (size_t)b * T * LDP_QKV + C_NKV + 4 * 128 + g * 64; const bf16_t* vt = kt + 128;
        float m[2] = {-1e30f, -1e30f}, l[2] = {0.f, 0.f}; f32x16 o[2][2];
        zero16(o[0][0]); zero16(o[0][1]); zero16(o[1][0]); zero16(o[1][1]);
        int kb0 = tq0 - 512; if (kb0 < 0) kb0 = 0;
        int kb = tq0 + 32, ks0 = 0, vs0 = 0;
        dma_k(wl, kt + (size_t)(kb >> 5) * KSTR, ko); dma_v(wl + VRING_OFF, vt + (size_t)(kb >> 5) * KSTR, vo);
        dma_k(wl + 4096, kt + (size_t)((kb - 32) >> 5) * KSTR, ko);
#define NSA_WIN_STEP(MASKED) { \
            const bool has1 = (kb - 32 >= kb0), has2 = (kb - 64 >= kb0); \
            const int ks1 = ks0 == 2 ? 0 : ks0 + 1, ks2 = ks1 == 2 ? 0 : ks1 + 1; \
            if (has2) dma_k(wl + ks2 * 4096, kt + (size_t)((kb - 64) >> 5) * KSTR, ko); \
            if (has1) dma_v(wl + VRING_OFF + (vs0 ^ 1) * 4096, vt + (size_t)((kb - 32) >> 5) * KSTR, vo); \
            dma_wait_step(has2, has1); \
            nsa_pair_tile<MASKED, true>(wl + ks0 * 4096, wl + VRING_OFF + vs0 * 4096, qf, t0, kb, 0.f, 0.f, slope2, m, l, o, r32, hi, vtr); \
            more = has1; \
            if (has1) { kb -= 32; ks0 = ks1; vs0 ^= 1; } }
        bool more = true;
#pragma unroll 1
        while (more && kb >= tq0) NSA_WIN_STEP(true)
#pragma unroll 1
        while (more && kb > tq0 - 480) NSA_WIN_STEP(false)
#pragma unroll 1
        while (more) NSA_WIN_STEP(true)
#pragma unroll
        for (int ci = 0; ci < 2; ++ci) {
            float lt = l[ci]; lt += __shfl_xor(lt, 32);
            const float f = nsag[ci * 32 * 32 + 2] * (lt > 0.f ? 1.0f / lt : 0.f);
#pragma unroll
            for (int db = 0; db < 2; ++db)
#pragma unroll
                for (int mg = 0; mg < 4; ++mg) { bf16_t* op = orow + (size_t)ci * 32 * D + 32 * db + 8 * mg + 4 * hi; const u32x2 w = *(const u32x2*)op;
                    f32x4 v = {bflo(w.x) + f * o[ci][db][4 * mg], bfhi(w.x) + f * o[ci][db][4 * mg + 1], bflo(w.y) + f * o[ci][db][4 * mg + 2], bfhi(w.y) + f * o[ci][db][4 * mg + 3]};
                    store_bf16x4(op, v); }
        }
    }
}

DI void mem_task(const Params& p, int b, int head, int chunk, int lane, ldsp_t wl) {
    unsigned char* ws = p.ws; unsigned char* dout = (unsigned char*)p.out;
    const int r32 = lane & 31, hi = lane >> 5; const size_t tok = (size_t)b * T + chunk * 32 + r32;
    const bf16_t* qkv = (const bf16_t*)(ws + WS_QKV);
    bf16x8 qf[4]; load_q(qf, qkv + tok * LDP_QKV + C_MQ + head * 64, hi);
    const bf16_t* kt = (const bf16_t*)(dout + DO_MKV) + (size_t)b * MEMT * 512 + head * 64; constexpr size_t KSTR = 32 * 512; const KOff ko = koff_make(lane, 1024);
    const bf16_t* vt = kt + 256; const KOff vo = voff_make(lane, 1024); const VTr vtr = vtr_make(lane);
    float m = -1e30f, l = 0.f; f32x16 o[2]; zero16(o[0]); zero16(o[1]);
    int ks0 = 0, vs0 = 0;
    dma_k(wl, kt, ko); dma_v(wl + VRING_OFF, vt, vo); dma_k(wl + 4096, kt + KSTR, ko);
#pragma unroll 1
    for (int ti = 0; ti < 8; ++ti) {
        const bool has1 = ti + 1 < 8, has2 = ti + 2 < 8;
        const int ks1 = ks0 == 2 ? 0 : ks0 + 1, ks2 = ks1 == 2 ? 0 : ks1 + 1;
        if (has2) dma_k(wl + ks2 * 4096, kt + (size_t)(ti + 2) * KSTR, ko);
        if (has1) dma_v(wl + VRING_OFF + (vs0 ^ 1) * 4096, vt + (size_t)(ti + 1) * KSTR, vo);
        dma_wait_step(has2, has1);
        f32x16 s = qk_lds(wl + ks0 * 4096, qf, r32, hi);
#pragma unroll
        for (int r = 0; r < 16; ++r) s[r] *= SCL2;
        softmax_core(s, 0.f, m, l, o);
        pv_lds(o, wl + VRING_OFF + vs0 * 4096, s, vtr);
        ks0 = ks1; vs0 ^= 1;
    }
    l += __shfl_xor(l, 32);
    const float f = 1.0f / l;
    bf16_t* orow = (bf16_t*)(ws + WS_H) + tok * D + 768 + head * 64;
#pragma unroll
    for (int db = 0; db < 2; ++db)
#pragma unroll
        for (int mg = 0; mg < 4; ++mg) { f32x4 v = {o[db][4 * mg] * f, o[db][4 * mg + 1] * f, o[db][4 * mg + 2] * f, o[db][4 * mg + 3] * f}; store_bf16x4(orow + 32 * db + 8 * mg + 4 * hi, v); }
}

DI void sb_task(const Params& p, int b, int head, int chunk, int lane, ldsp_t wl) {
    unsigned char* ws = p.ws; unsigned char* dout = (unsigned char*)p.out;
    const int r32 = lane & 31, hi = lane >> 5; const int tq0 = chunk * 32, t = tq0 + r32; const size_t tok = (size_t)b * T + t;
    const bf16_t* qkv = (const bf16_t*)(ws + WS_QKV);
    bf16x8 qf[4]; load_q(qf, qkv + tok * LDP_QKV + C_SBQ + head * 64, hi);
    const size_t tbase = (size_t)(b * 6 + head) * 128;
    const bf16_t* kt = qkv + (size_t)b * T * LDP_QKV + C_SBK + head * 64; const bf16_t* vt = qkv + (size_t)b * T * LDP_QKV + C_SBV + head * 64; constexpr size_t KSTR = 32 * LDP_QKV; const KOff ko = koff_make(lane, LDP_QKV * 2), vo = voff_make(lane, LDP_QKV * 2); const VTr vtr = vtr_make(lane);
    f32x16 o[2]; zero16(o[0]); zero16(o[1]);
    float R = 0.f;
    int kb = tq0, ks0 = 0, vs0 = 0;
    dma_k(wl, kt + (size_t)(kb >> 5) * KSTR, ko); dma_v(wl + VRING_OFF, vt + (size_t)(kb >> 5) * KSTR, vo);
    if (kb >= 32) dma_k(wl + 4096, kt + (size_t)((kb - 32) >> 5) * KSTR, ko);
#define SB_STEP(MASKED) { \
        const bool has1 = kb >= 32, has2 = kb >= 64; \
        const int ks1 = ks0 == 2 ? 0 : ks0 + 1, ks2 = ks1 == 2 ? 0 : ks1 + 1; \
        if (has2) dma_k(wl + ks2 * 4096, kt + (size_t)((kb - 64) >> 5) * KSTR, ko); \
        if (has1) dma_v(wl + VRING_OFF + (vs0 ^ 1) * 4096, vt + (size_t)((kb - 32) >> 5) * KSTR, vo); \
        dma_wait_step(has2, has1); \
        f32x16 s = qk_lds(wl + ks0 * 4096, qf, r32, hi); \
        f32x16 L; \
        _Pragma("unroll") for (int r = 0; r < 16; ++r) { const float z = s[r] * (0.125f * LOG2E); \
            const float sp = fmaxf(z, 0.f) + flog2(1.0f + fexp2(-fabsf(z)));       \
            s[r] = z; if (MASKED) { const bool valid = (kb + krow(r, hi)) < t; L[r] = valid ? -sp : 0.f; } else L[r] = -sp; } \
        float gs[4], pg[4]; \
        _Pragma("unroll") for (int mg = 0; mg < 4; ++mg) { gs[mg] = (L[4 * mg] + L[4 * mg + 1]) + (L[4 * mg + 2] + L[4 * mg + 3]); pg[mg] = __shfl_xor(gs[mg], 32); } \
        float off[4]; float run = R; \
        _Pragma("unroll") for (int mg = 3; mg >= 0; --mg) { off[mg] = run + (hi ? 0.f : pg[mg]); run += gs[mg] + pg[mg]; } \
        _Pragma("unroll") for (int mg = 0; mg < 4; ++mg) { \
            float e = off[mg]; \
            _Pragma("unroll") for (int i = 3; i >= 0; --i) { const int r = 4 * mg + i; \
                float a = fexp2(s[r] + L[r] + e); if (MASKED) { const bool valid = (kb + krow(r, hi)) < t; a = valid ? a : 0.f; } e += L[r]; s[r] = a; } \
        } \
        R = run; \
        pv_lds(o, wl + VRING_OFF + vs0 * 4096, s, vtr); \
        more = has1 && !__all(R < -104.0f * LOG2E); \
        if (more) { kb -= 32; ks0 = ks1; vs0 ^= 1; } }
    bool more;
    SB_STEP(true)
#pragma unroll 1
    while (more) SB_STEP(false)
#undef SB_STEP
    DMA_WAIT_ALL();
    bf16_t* orow = (bf16_t*)(ws + WS_H) + tok * D + head * 64;
#pragma unroll
    for (int db = 0; db < 2; ++db)
#pragma unroll
        for (int mg = 0; mg < 4; ++mg) { f32x4 v = {o[db][4 * mg], o[db][4 * mg + 1], o[db][4 * mg + 2], o[db][4 * mg + 3]}; store_bf16x4(orow + 32 * db + 8 * mg + 4 * hi, v); }
}

constexpr int N_CMP_TASKS = NB * 2 * 128, N_NSA_TASKS = NB * 6 * 64, N_MEM_TASKS = NB * 4 * 128, N_SB_TASKS = NB * 6 * 128;
DI void phase3a(const Params& p, int rep, bf16_t* lds) {
    const int lane = threadIdx.x & 63;
    ldsp_t wl = (ldsp_t)(unsigned char*)lds + __builtin_amdgcn_readfirstlane((int)(threadIdx.x >> 6)) * RING_BYTES;
    float* impl = (float*)((unsigned char*)lds + (threadIdx.x >> 6) * RING_BYTES);
    unsigned* ctr = (unsigned*)(p.ws + WS_CTL) + 64 + 256 * rep;
    for (;;) {
        unsigned tk = 0; if (lane == 0) tk = atomicAdd(ctr, 1u);
        const int task = (int)__builtin_amdgcn_readfirstlane(tk);
        if (task >= N_CMP_TASKS + N_MEM_TASKS) break;
        if (task < N_CMP_TASKS) { const int chunk = 127 - task / 16, rem = task % 16; nsa_cmp_task(p, rem >> 1, rem & 1, chunk, lane, impl); }
        else { const int r = task - N_CMP_TASKS; const int chunk = r / 32, rem = r % 32; mem_task(p, rem / 4, rem % 4, chunk, lane, wl); }
    }
}
DI void phase3b(const Params& p, int rep, unsigned char* lds_raw_) {
    const int lane = threadIdx.x & 63;
    ldsp_t wl = (ldsp_t)lds_raw_ + __builtin_amdgcn_readfirstlane((int)(threadIdx.x >> 6)) * RING_BYTES;
    unsigned* ctr = (unsigned*)(p.ws + WS_CTL) + 128 + 256 * rep;
    if (__builtin_amdgcn_readfirstlane((int)(threadIdx.x >> 6)) == NWAVES - 1) peer_table_rows(p, lane, blockIdx.x, gridDim.x);
    for (;;) {
        unsigned tk = 0; if (lane == 0) tk = atomicAdd(ctr, 1u);
        const int task = (int)__builtin_amdgcn_readfirstlane(tk);
        if (task >= N_NSA_TASKS + N_SB_TASKS) break;
        if (task < N_NSA_TASKS) { const int ci = task / 48, rem = task % 48; const int blk = (ci & 1) ? (ci >> 1) : 63 - (ci >> 1); nsa_main_task(p, rem / 6, rem % 6, blk, lane, wl); }
        else { const int r = task - N_NSA_TASKS; const int chunk = r / 48, rem = r % 48; sb_task(p, rem / 6, rem % 6, chunk, lane, wl); }
    }
}

DI void phase4(const Params& p, bf16_t* lds) {
    unsigned char* ws = p.ws;
    const bf16_t* cat = (const bf16_t*)(ws + WS_H); const bf16_t* gates = (const bf16_t*)(ws + WS_GATES); bf16_t* merged = (bf16_t*)(ws + WS_MERGED);
    pg8::StaticOrder S; S.init(NTOK, D, (int)gridDim.x, (int)blockIdx.x);
#pragma unroll 1
    for (int br = 0; br < 3; ++br) {
        const int Kb = br == 2 ? 256 : 384;
        const bf16_t* Bt = (const bf16_t*)(ws + (br == 0 ? WS_WSB : (br == 1 ? WS_WNSA : WS_WMEM)));
        pg8::Gemm g{cat + br * 384, Bt, NTOK, D, Kb, D, Kb}; pg8::EpiMerge E{merged, gates, br}; GEMM_PHASE(pg8::EpiMerge, g, S, E);
    }
}
DI void phase5(const Params& p, bf16_t* lds) {
    unsigned char* ws = p.ws;
    pg8::Gemm g{(const bf16_t*)(ws + WS_MERGED), (const bf16_t*)(ws + WS_WOUT), NTOK, D, D, D, D};
    pg8::StaticOrder S; S.init(NTOK, D, (int)gridDim.x, (int)blockIdx.x);
    pg8::EpiOut E{p.in[0], p.in[15], p.out, (bf16_t*)(ws + WS_H2), (float*)(ws + WS_ROWSS)};
    GEMM_PHASE(pg8::EpiOut, g, S, E);
}
DI void phase6(const Params& p, bf16_t* lds) {
    unsigned char* ws = p.ws;
    pg8::Gemm g{(const bf16_t*)(ws + WS_H2), (const bf16_t*)(ws + WS_WQ), NTOK, 2048, D, D, D};
    pg8::StaticOrder S; S.init(NTOK, 2048, (int)gridDim.x, (int)blockIdx.x);
    pg8::EpiPlain E{(bf16_t*)(ws + WS_QP), 2048};
    GEMM_PHASE(pg8::EpiPlain, g, S, E);
}

DI float row_rstd(const float* rowss, size_t tok) {
    const f32x4* r = (const f32x4*)(rowss + tok * 32); float s = 0.f;
#pragma unroll
    for (int i = 0; i < 8; ++i) { const f32x4 v = r[i]; s += (v.x + v.y) + (v.z + v.w); }
    return 1.0f / sqrtf(s * (1.0f / D) + RMS_EPS);
}
constexpr int ROUTE_LDS_PER_WAVE = 2 * 16 * 32 * 4;
DI void route_task(const Params& p, int chunk, int head, int lane, float* wl, ldsp_t sk  ) {
    unsigned char* ws = p.ws;
    const int r32 = lane & 31, hi = lane >> 5; const size_t tok = (size_t)chunk * 32 + r32;
    const bf16_t* qp = (const bf16_t*)(ws + WS_QP) + tok * 2048 + head * 256;
    int* til = (int*)wl;
    float tv[2][16];
#pragma unroll
    for (int pp = 0; pp < 2; ++pp) {
        f32x16 sc[4];
#pragma unroll
        for (int tl = 0; tl < 4; ++tl) zero16(sc[tl]);
#pragma unroll
        for (int ks = 0; ks < 8; ++ks) {
            const bf16x8 qv = *(const bf16x8*)(qp + pp * 128 + ks * 16 + hi * 8);
#pragma unroll
            for (int tl = 0; tl < 4; ++tl) { const int row = pp * 128 + tl * 32 + r32; const bf16x8 a = *(const LAS bf16x8*)(sk + row * 256 + (((2 * ks + hi) ^ (row & 15)) * 16)); sc[tl] = MFMA32(a, qv, sc[tl]); }
        }
        int k0[16], k1[16], k2[16], k3[16];
#pragma unroll
        for (int r = 0; r < 16; ++r) { const int kr = krow(r, hi);
            k0[r] = (f2key(sc[0][r]) & ~127) | (127 - kr); k1[r] = (f2key(sc[1][r]) & ~127) | (127 - (32 + kr));
            k2[r] = (f2key(sc[2][r]) & ~127) | (127 - (64 + kr)); k3[r] = (f2key(sc[3][r]) & ~127) | (127 - (96 + kr)); }
        bitonic_sort_desc<16>(k0); bitonic_sort_desc<16>(k1); bitonic_sort_desc<16>(k2); bitonic_sort_desc<16>(k3);
        top16_merge(k0, k1); top16_merge(k2, k3); top16_merge(k0, k2);
        int pb[16];
#pragma unroll
        for (int i = 0; i < 16; ++i) pb[i] = __shfl_xor(k0[i], 32);
        top16_merge(k0, pb);
#pragma unroll
        for (int i = 0; i < 16; ++i) { tv[pp][i] = key2f(k0[i] & ~127); if (hi == 0) til[(pp * 16 + i) * 32 + r32] = 127 - (k0[i] & 127); }
    }
    __builtin_amdgcn_wave_barrier();
    int c0[16], c1[16], c2[16], c3[16];
    {
        int c = 0;
#pragma unroll
        for (int a = 0; a < 16; ++a)
#pragma unroll
            for (int bb = 0; bb < 16; ++bb) if ((a + 1) * (bb + 1) <= 16) {
                const int key = (f2key(tv[0][a] + tv[1][bb]) & ~255) | (255 - (a * 16 + bb));
                if (c < 16) c0[c] = key; else if (c < 32) c1[c - 16] = key; else if (c < 48) c2[c - 32] = key; else c3[c - 48] = key;
                ++c; }
#pragma unroll
        for (int i = 2; i < 16; ++i) c3[i] = (int)0x80000000;
    }
    bitonic_sort_desc<16>(c1); bitonic_sort_desc<16>(c2); bitonic_sort_desc<16>(c3);
    top16_merge(c0, c1); top16_merge(c2, c3); top16_merge(c0, c2);
    const float rstd = row_rstd((const float*)(ws + WS_ROWSS), tok);
    float gg[16]; int ex[16]; float den = 0.f; const float b0 = key2f(c0[0] & ~255);
#pragma unroll
    for (int k = 0; k < 16; ++k) { const int code = 255 - (c0[k] & 255);
        ex[k] = til[(code >> 4) * 32 + r32] * 128 + til[(16 + (code & 15)) * 32 + r32];
        gg[k] = fexp((key2f(c0[k] & ~255) - b0) * rstd); den += gg[k]; }
    const float inv = 1.0f / den;
    if (hi == 0) { unsigned short* ip = (unsigned short*)(ws + WS_IDX) + tok * 128 + head * 16;
        u32x4 w0, w1;
        w0.x = (unsigned)ex[0] | ((unsigned)ex[1] << 16); w0.y = (unsigned)ex[2] | ((unsigned)ex[3] << 16); w0.z = (unsigned)ex[4] | ((unsigned)ex[5] << 16); w0.w = (unsigned)ex[6] | ((unsigned)ex[7] << 16);
        w1.x = (unsigned)ex[8] | ((unsigned)ex[9] << 16); w1.y = (unsigned)ex[10] | ((unsigned)ex[11] << 16); w1.z = (unsigned)ex[12] | ((unsigned)ex[13] << 16); w1.w = (unsigned)ex[14] | ((unsigned)ex[15] << 16);
        *(u32x4*)ip = w0; *(u32x4*)(ip + 8) = w1; }
    else { float* gp = (float*)(ws + WS_GW) + tok * 128 + head * 16;
#pragma unroll
        for (int k = 0; k < 16; k += 4) { f32x4 v = {gg[k] * inv, gg[k + 1] * inv, gg[k + 2] * inv, gg[k + 3] * inv}; *(f32x4*)(gp + k) = v; } }
    __builtin_amdgcn_wave_barrier();
}
DI void phase7(const Params& p, bf16_t* lds) {
    const int lane = threadIdx.x & 63, wid = threadIdx.x >> 6;
    ldsp_t sk = (ldsp_t)(unsigned char*)lds;
    float* wl = (float*)((unsigned char*)lds + 65536 + wid * ROUTE_LDS_PER_WAVE);
    for (int head = blockIdx.x & 7; head < 8; head += gridDim.x) {
        const int nbh = ((int)gridDim.x - head + 7) / 8, rank = blockIdx.x >> 3;
        __syncthreads();
        const u32x4* src = (const u32x4*)((const bf16_t*)(p.ws + WS_SUBK) + (size_t)head * 2 * 128 * 128);
#pragma unroll
        for (int j = 0; j < 8; ++j) { const int ci = threadIdx.x + NTHREADS * j, row = ci >> 4, c = ci & 15; *(LAS u32x4*)(sk + row * 256 + ((c ^ (row & 15)) * 16)) = src[ci]; }
        __syncthreads();
        for (int chunk = rank * NWAVES + wid; chunk < NTOK / 32; chunk += nbh * NWAVES) route_task(p, chunk, head, lane, wl, sk);
    }
}

DI float gelu_exact(float a) { return 0.5f * a * (1.0f + erff(a * 0.70710678118654752f)); }
DI void fp8x16_to_f32(const u32x4& w, float (&f)[16]) {
#pragma unroll
    for (int j = 0; j < 4; ++j) { const f32x2 lo = __builtin_amdgcn_cvt_pk_f32_fp8((int)w[j], false); const f32x2 hi = __builtin_amdgcn_cvt_pk_f32_fp8((int)w[j], true);
        f[4 * j] = lo.x; f[4 * j + 1] = lo.y; f[4 * j + 2] = hi.x; f[4 * j + 3] = hi.y; }
}
DI void phase8(const Params& p) {
    unsigned char* ws = p.ws;
    const int lane = threadIdx.x & 63, wid = threadIdx.x >> 6;
    const int gwave = blockIdx.x * NWAVES + wid, nwaves = gridDim.x * NWAVES;
    const bf16_t* h2 = (const bf16_t*)(ws + WS_H2); const unsigned char* tu = ws + WS_TABU; const unsigned char* tvv = ws + WS_TABV;
    const float* tsc = (const float*)(ws + WS_TSCALE);
    const unsigned short* idx = (const unsigned short*)(ws + WS_IDX); const float* gw = (const float*)(ws + WS_GW);
    const float* gfin = p.in[20];
    const int kk = ((lane >> 5) & 1) * 8 + ((lane >> 4) & 1) * 4 + ((lane >> 3) & 1) * 2 + ((lane >> 2) & 1);
#pragma unroll 1
    for (int tk = gwave; tk < NTOK; tk += nwaves) {
        const size_t tok = (size_t)tk;
        const float rstd = row_rstd((const float*)(ws + WS_ROWSS), tok);
        float hn[16];
        { const u32x4 a = *(const u32x4*)(h2 + tok * D + lane * 16); const u32x4 b = *(const u32x4*)(h2 + tok * D + lane * 16 + 8);
          hn[0] = bflo(a.x) * rstd; hn[1] = bfhi(a.x) * rstd; hn[2] = bflo(a.y) * rstd; hn[3] = bfhi(a.y) * rstd; hn[4] = bflo(a.z) * rstd; hn[5] = bfhi(a.z) * rstd; hn[6] = bflo(a.w) * rstd; hn[7] = bfhi(a.w) * rstd;
          hn[8] = bflo(b.x) * rstd; hn[9] = bfhi(b.x) * rstd; hn[10] = bflo(b.y) * rstd; hn[11] = bfhi(b.y) * rstd; hn[12] = bflo(b.z) * rstd; hn[13] = bfhi(b.z) * rstd; hn[14] = bflo(b.w) * rstd; hn[15] = bfhi(b.w) * rstd; }
        float acc[16];
#pragma unroll
        for (int i = 0; i < 16; ++i) acc[i] = 0.f;
        const int e_lo = idx[tok * 128 + lane], e_hi = idx[tok * 128 + 64 + lane];
        const float g_lo = gw[tok * 128 + lane], g_hi = gw[tok * 128 + 64 + lane];
        for (int rep9 = 0; rep9 < REP9; ++rep9)
#pragma unroll 1
        for (int head = 0; head < 8; ++head) {
            const int esrc = head < 4 ? e_lo : e_hi; const float gsrc = head < 4 ? g_lo : g_hi;
            const int myslot = (head & 3) * 16 + kk;
            const int my_e = __shfl(esrc, myslot); const float my_g = __shfl(gsrc, myslot);
            const float su = tsc[my_e], sv = tsc[16384 + my_e];
            u32x4 ub[16], vb[16];
#pragma unroll
            for (int k = 0; k < 16; ++k) { const int e = __builtin_amdgcn_readlane(esrc, (head & 3) * 16 + k);
                ub[k] = *(const u32x4*)(tu + (size_t)e * 1024 + lane * 16); vb[k] = *(const u32x4*)(tvv + (size_t)e * 1024 + lane * 16); }
            float d[16];
#pragma unroll
            for (int k = 0; k < 16; ++k) { float f[16]; fp8x16_to_f32(ub[k], f); float t = 0.f;
#pragma unroll
                for (int i = 0; i < 16; ++i) t += f[i] * hn[i];
                d[k] = t; }
            float r8[8], r4[4], r2[2], r1;
            { const bool up = (lane & 32) != 0;
#pragma unroll
              for (int k = 0; k < 8; ++k) { const float keep = up ? d[k + 8] : d[k], send = up ? d[k] : d[k + 8]; r8[k] = keep + __shfl_xor(send, 32); } }
            { const bool up = (lane & 16) != 0;
#pragma unroll
              for (int k = 0; k < 4; ++k) { const float keep = up ? r8[k + 4] : r8[k], send = up ? r8[k] : r8[k + 4]; r4[k] = keep + __shfl_xor(send, 16); } }
            { const bool up = (lane & 8) != 0;
#pragma unroll
              for (int k = 0; k < 2; ++k) { const float keep = up ? r4[k + 2] : r4[k], send = up ? r4[k] : r4[k + 2]; r2[k] = keep + __shfl_xor(send, 8); } }
            { const bool up = (lane & 4) != 0; const float keep = up ? r2[1] : r2[0], send = up ? r2[0] : r2[1]; r1 = keep + __shfl_xor(send, 4); }
            r1 += __shfl_xor(r1, 2); r1 += __shfl_xor(r1, 1);
            const float wmine = my_g * gelu_exact(r1 * su) * sv;
#pragma unroll
            for (int k = 0; k < 16; ++k) {
                const int lk = ((k >> 3) & 1) * 32 + ((k >> 2) & 1) * 16 + ((k >> 1) & 1) * 8 + (k & 1) * 4;
                const float w = __uint_as_float(__builtin_amdgcn_readlane(__float_as_uint(wmine), lk));
                float f[16]; fp8x16_to_f32(vb[k], f);
#pragma unroll
                for (int i = 0; i < 16; ++i) acc[i] += w * f[i];
            }
        }
        float* orow = p.out + tok * D + lane * 16;
        f32x4 y[4]; float ss = 0.f;
#pragma unroll
        for (int q = 0; q < 4; ++q) { f32x4 v = *(const f32x4*)(orow + 4 * q);
            v.x += acc[q * 4] * (1.0f / REP9); v.y += acc[q * 4 + 1] * (1.0f / REP9); v.z += acc[q * 4 + 2] * (1.0f / REP9); v.w += acc[q * 4 + 3] * (1.0f / REP9); y[q] = v; ss += (v.x * v.x + v.y * v.y) + (v.z * v.z + v.w * v.w); }
        const float rs = 1.0f / sqrtf(wave_sum(ss) * (1.0f / D) + RMS_EPS);
#pragma unroll
        for (int q = 0; q < 4; ++q) { const f32x4 gg = *(const f32x4*)(gfin + lane * 16 + 4 * q); f32x4 v = y[q];
            v.x *= rs * gg.x; v.y *= rs * gg.y; v.z *= rs * gg.z; v.w *= rs * gg.w; *(f32x4*)(orow + 4 * q) = v; }
    }
}


constexpr int P8_CHUNK = 16, P8_NCHUNK = NTOK / P8_CHUNK;
DI unsigned my_xcc() { return (unsigned)__builtin_amdgcn_s_getreg((3 << 11) | 20) & 7u; }
DI float dpp_xor1(float v) { return __int_as_float(__builtin_amdgcn_update_dpp(0, __float_as_int(v), 0xB1, 0xF, 0xF, true)); }
DI float dpp_xor2(float v) { return __int_as_float(__builtin_amdgcn_update_dpp(0, __float_as_int(v), 0x4E, 0xF, 0xF, true)); }
DI void fp8x16_to_f32x2(const u32x4& w, f32x2 (&f)[8]) {
#pragma unroll
    for (int j = 0; j < 4; ++j) { f[2 * j] = __builtin_amdgcn_cvt_pk_f32_fp8((int)w[j], false); f[2 * j + 1] = __builtin_amdgcn_cvt_pk_f32_fp8((int)w[j], true); }
}
DI unsigned q8_pack4(float a, float b, float c, float d, float s) {
    const unsigned ta = __float_as_uint(__builtin_fmaf(a, s, 12582912.0f)), tb = __float_as_uint(__builtin_fmaf(b, s, 12582912.0f));
    const unsigned tc = __float_as_uint(__builtin_fmaf(c, s, 12582912.0f)), td = __float_as_uint(__builtin_fmaf(d, s, 12582912.0f));
    const unsigned lo = __builtin_amdgcn_perm(tb, ta, 0x0c0c0400u), hi = __builtin_amdgcn_perm(td, tc, 0x0c0c0400u);
    return __builtin_amdgcn_perm(hi, lo, 0x05040100u);
}
DI void h_to_i8(const u32x4& hr0, const u32x4& hr1, u32x4& h8, float& hs) {
    float f[16];
    f[0] = bflo(hr0.x); f[1] = bfhi(hr0.x); f[2] = bflo(hr0.y); f[3] = bfhi(hr0.y); f[4] = bflo(hr0.z); f[5] = bfhi(hr0.z); f[6] = bflo(hr0.w); f[7] = bfhi(hr0.w);
    f[8] = bflo(hr1.x); f[9] = bfhi(hr1.x); f[10] = bflo(hr1.y); f[11] = bfhi(hr1.y); f[12] = bflo(hr1.z); f[13] = bfhi(hr1.z); f[14] = bflo(hr1.w); f[15] = bfhi(hr1.w);
    float am = 0.f;
#pragma unroll
    for (int i = 0; i < 16; i += 2) am = fmaxf(am, fmaxf(fabsf(f[i]), fabsf(f[i + 1])));
    const float s = am > 0.f ? 127.0f * __builtin_amdgcn_rcpf(am) : 0.f;
    hs = am * (1.0f / 127.0f);
    h8.x = q8_pack4(f[0], f[1], f[2], f[3], s); h8.y = q8_pack4(f[4], f[5], f[6], f[7], s); h8.z = q8_pack4(f[8], f[9], f[10], f[11], s); h8.w = q8_pack4(f[12], f[13], f[14], f[15], s);
}
struct HalfT { u32x4 rb[8]; float sc[8]; };
DI void p8a_issue(HalfT& B, const unsigned char* tus, const LAS float* tsc, const LAS unsigned* eoff, int ti, int hf, int pp, unsigned cc16, int gmine) {
#pragma unroll
    for (int g = 0; g < 8; ++g) { const unsigned o = eoff[ti * 128 + (hf * 8 + g) * 8 + pp] + cc16; B.rb[g] = *(const u32x4*)(tus + o); }
    B.sc[0] = *(const LAS float*)((const LAS unsigned char*)tsc + (eoff[ti * 128 + (hf * 8 + gmine) * 8 + pp] >> 5));
}
DI float p8a_compute(const HalfT& B, const u32x4& h8, float hs, int cc) {
    float d[8];
#pragma unroll
    for (int g = 0; g < 8; ++g) { int a = __builtin_amdgcn_sdot4((int)B.rb[g].x, (int)h8.x, 0, false); a = __builtin_amdgcn_sdot4((int)B.rb[g].y, (int)h8.y, a, false);
        a = __builtin_amdgcn_sdot4((int)B.rb[g].z, (int)h8.z, a, false); a = __builtin_amdgcn_sdot4((int)B.rb[g].w, (int)h8.w, a, false);
        d[g] = (float)a * hs; }
    float r4[4], r2[2];
    { const bool up = (cc & 1) != 0;
#pragma unroll
      for (int i = 0; i < 4; ++i) { const float keep = up ? d[i + 4] : d[i], send = up ? d[i] : d[i + 4]; r4[i] = keep + dpp_xor1(send); } }
    { const bool up = (cc & 2) != 0;
#pragma unroll
      for (int i = 0; i < 2; ++i) { const float keep = up ? r4[i + 2] : r4[i], send = up ? r4[i] : r4[i + 2]; r2[i] = keep + dpp_xor2(send); } }
    const bool up = (cc & 4) != 0; const float keep = up ? r2[1] : r2[0], send = up ? r2[0] : r2[1];
    return (keep + __shfl_xor(send, 4)) * B.sc[0];
}
DI void phase8a(const Params& p, unsigned char* lds_raw_, int rep) {
    unsigned char* ws = p.ws;
    const int lane = threadIdx.x & 63, pp = lane >> 3, cc = lane & 7;
    const bf16_t* h2 = (const bf16_t*)(ws + WS_H2); const unsigned char* tu = ws + WS_TABU; const float* tscg = (const float*)(ws + WS_TSCALE);
    const unsigned short* idx = (const unsigned short*)(ws + WS_IDX); bf16_t* pd = (bf16_t*)(ws + WS_PD);
    unsigned* ctr = (unsigned*)(ws + WS_CTL) + 1024 + 8192 * rep;
    LAS unsigned* eoff = (LAS unsigned*)((ldsp_t)lds_raw_ + __builtin_amdgcn_readfirstlane((int)(threadIdx.x >> 6)) * 12288);
    LAS unsigned char* hq = (LAS unsigned char*)eoff + 8192; LAS float* hsl = (LAS float*)((LAS unsigned char*)eoff + 10240);
    const unsigned cc16 = (unsigned)cc * 16u;
    LAS float* tsc = (LAS float*)((ldsp_t)lds_raw_ + 98304);
    for (int i = threadIdx.x; i < 4096; i += NTHREADS) ((LAS i32x4*)tsc)[i] = ((const i32x4*)tscg)[i];
    __syncthreads();
    const unsigned xs = my_xcc();
    const int gmine = ((cc & 1) << 2) | (cc & 2) | ((cc >> 2) & 1);
#pragma unroll 1
    for (int k8 = 0; k8 < 8; ++k8) {
        const int sl = (int)((xs + k8) & 7u);
#pragma unroll 1
        for (;;) {
            unsigned tk = 0; if (lane == 0) tk = atomicAdd(ctr + 64 * sl, 1u);
            const int chunk = (int)__builtin_amdgcn_readfirstlane(tk);
            if (chunk >= P8_NCHUNK) break;
            const size_t tok0 = (size_t)chunk * P8_CHUNK;
#pragma unroll
            for (int i = 0; i < 4; ++i) { const i32x4 w = ((const i32x4*)(idx + tok0 * 128))[i * 64 + lane];
                i32x4 lo, hi2; lo.x = (w.x & 0xffff) << 7; lo.y = (int)((unsigned)w.x >> 16) << 7; lo.z = (w.y & 0xffff) << 7; lo.w = (int)((unsigned)w.y >> 16) << 7;
                hi2.x = (w.z & 0xffff) << 7; hi2.y = (int)((unsigned)w.z >> 16) << 7; hi2.z = (w.w & 0xffff) << 7; hi2.w = (int)((unsigned)w.w >> 16) << 7;
                ((LAS i32x4*)eoff)[(i * 64 + lane) * 2] = lo; ((LAS i32x4*)eoff)[(i * 64 + lane) * 2 + 1] = hi2; }
            const unsigned char* tus = tu + (size_t)sl * (16384 * 128);
#pragma unroll
            for (int it = 0; it < 2; ++it) { const int j = lane + 64 * it; const bf16_t* hp = h2 + (tok0 + (j >> 3)) * D + sl * 128 + (j & 7) * 16;
                const u32x4 a0 = *(const u32x4*)hp, a1 = *(const u32x4*)(hp + 8); u32x4 q; float s_; h_to_i8(a0, a1, q, s_);
                ((LAS i32x4*)hq)[j] = __builtin_bit_cast(i32x4, q); hsl[j] = s_; }
            __builtin_amdgcn_wave_barrier();
            HalfT X, Y;
            p8a_issue(X, tus, tsc, eoff, 0, 0, pp, cc16, gmine);
#pragma unroll 1
            for (int ti = 0; ti < P8_CHUNK; ++ti) {
                const size_t tok = tok0 + ti;
                p8a_issue(Y, tus, tsc, eoff, ti, 1, pp, cc16, gmine);
                const u32x4 h8 = __builtin_bit_cast(u32x4, ((const LAS i32x4*)hq)[ti * 8 + cc]); const float hs = hsl[ti * 8 + cc];
                const float keep0 = p8a_compute(X, h8, hs, cc);
                if (ti + 1 < P8_CHUNK) p8a_issue(X, tus, tsc, eoff, ti + 1, 0, pp, cc16, gmine);
                const float keep1 = p8a_compute(Y, h8, hs, cc);
                bf16_t* po = pd + ((size_t)sl * NTOK + tok) * 128 + gmine * 8 + pp;
                po[0] = (bf16_t)f2bf(keep0); po[64] = (bf16_t)f2bf(keep1);
            }
            __builtin_amdgcn_wave_barrier();
        }
    }
}
DI void phase8w(const Params& p, unsigned char* lds_raw_) {
    unsigned char* ws = p.ws;
    const int lane = threadIdx.x & 63, wid = threadIdx.x >> 6;
    const int gwave = blockIdx.x * NWAVES + wid, nwaves = gridDim.x * NWAVES;
    const bf16_t* __restrict__ pd = (const bf16_t*)(ws + WS_PD); const float* __restrict__ tsc = (const float*)(ws + WS_TSCALE);
    const unsigned short* __restrict__ idx = (const unsigned short*)(ws + WS_IDX); const float* __restrict__ gw = (const float*)(ws + WS_GW);
    const float* __restrict__ rowss = (const float*)(ws + WS_ROWSS);
    LAS float* svl = (LAS float*)((ldsp_t)lds_raw_);
    for (int i = threadIdx.x; i < 4096; i += NTHREADS) ((LAS i32x4*)svl)[i] = ((const i32x4*)(tsc + 16384))[i];
    __syncthreads();
    for (int tk = gwave; tk < NTOK; tk += 4 * nwaves) {
        float pa[4][16]; int e0[4], e1[4]; float g0[4], g1[4]; float rs[4]; size_t tok[4];
#pragma unroll
        for (int q = 0; q < 4; ++q) { const int t = tk + q * nwaves; tok[q] = (size_t)(t < NTOK ? t : tk); }
#pragma unroll
        for (int q = 0; q < 4; ++q) {
#pragma unroll
            for (int sl = 0; sl < 8; ++sl) { const bf16_t* qa = pd + ((size_t)sl * NTOK + tok[q]) * 128 + lane; pa[q][2 * sl] = bf2f(qa[0]); pa[q][2 * sl + 1] = bf2f(qa[64]); }
            e0[q] = idx[tok[q] * 128 + lane]; e1[q] = idx[tok[q] * 128 + 64 + lane]; g0[q] = gw[tok[q] * 128 + lane]; g1[q] = gw[tok[q] * 128 + 64 + lane];
            rs[q] = rowss[tok[q] * 32 + (lane & 31)]; }
        float v0[4], v1[4];
#pragma unroll
        for (int q = 0; q < 4; ++q) { v0[q] = svl[e0[q]]; v1[q] = svl[e1[q]]; }
#pragma unroll
        for (int q = 0; q < 4; ++q) {
            float ss = rs[q];
#pragma unroll
            for (int o = 1; o < 32; o <<= 1) ss += __shfl_xor(ss, o);
            const float rstd = 1.0f / sqrtf(ss * (1.0f / D) + RMS_EPS);
            float a0 = 0.f, a1 = 0.f;
#pragma unroll
            for (int sl = 0; sl < 8; ++sl) { a0 += pa[q][2 * sl]; a1 += pa[q][2 * sl + 1]; }
            const float w0 = g0[q] * gelu_exact(a0 * rstd) * v0[q], w1 = g1[q] * gelu_exact(a1 * rstd) * v1[q];
            const float wm = wave_max(fmaxf(fabsf(w0), fabsf(w1)));
            const float qs = wm > 0.f ? 127.0f / wm : 0.f;
            if (tk + q * nwaves < NTOK) { signed char* w8 = (signed char*)(ws + WS_WPEER) + tok[q] * 128;
                w8[lane] = (signed char)(int)__builtin_rintf(w0 * qs); w8[64 + lane] = (signed char)(int)__builtin_rintf(w1 * qs);
                if (lane == 0) ((float*)(ws + WS_WPEER + 8 * MiB))[tok[q]] = wm * (1.0f / 127.0f); }
        }
    }
}
struct HalfB { u32x4 rb[8]; unsigned w4[2]; };
DI void p8b_issue(HalfB& B, const unsigned char* tvs, const LAS unsigned* eoff, const LAS unsigned* w8l, int tl, int step, unsigned cc16) {
#pragma unroll
    for (int j = 0; j < 8; ++j) { const unsigned o = eoff[tl * 128 + step * 8 + j] + cc16; B.rb[j] = *(const u32x4*)(tvs + o); }
    B.w4[0] = w8l[tl * 32 + step * 2]; B.w4[1] = w8l[tl * 32 + step * 2 + 1];
}
DI void p8b_compute(const HalfB& B, int (&acc)[16]) {
#pragma unroll
    for (int g = 0; g < 2; ++g)
#pragma unroll
        for (int cg = 0; cg < 4; ++cg) { const unsigned a = B.rb[4 * g][cg], b = B.rb[4 * g + 1][cg], c = B.rb[4 * g + 2][cg], d = B.rb[4 * g + 3][cg];
            const unsigned t0 = __builtin_amdgcn_perm(b, a, 0x05010400u), t1 = __builtin_amdgcn_perm(b, a, 0x07030602u), t2 = __builtin_amdgcn_perm(d, c, 0x05010400u), t3 = __builtin_amdgcn_perm(d, c, 0x07030602u);
            acc[4 * cg] = __builtin_amdgcn_sdot4((int)__builtin_amdgcn_perm(t2, t0, 0x05040100u), (int)B.w4[g], acc[4 * cg], false);
            acc[4 * cg + 1] = __builtin_amdgcn_sdot4((int)__builtin_amdgcn_perm(t2, t0, 0x07060302u), (int)B.w4[g], acc[4 * cg + 1], false);
            acc[4 * cg + 2] = __builtin_amdgcn_sdot4((int)__builtin_amdgcn_perm(t3, t1, 0x05040100u), (int)B.w4[g], acc[4 * cg + 2], false);
            acc[4 * cg + 3] = __builtin_amdgcn_sdot4((int)__builtin_amdgcn_perm(t3, t1, 0x07060302u), (int)B.w4[g], acc[4 * cg + 3], false); }
}
DI void phase8b(const Params& p, unsigned char* lds_raw_) {
    unsigned char* ws = p.ws;
    const int lane = threadIdx.x & 63, pp = lane >> 3, cc = lane & 7;
    const unsigned char* tvv = ws + WS_TABV;
    const unsigned short* idx = (const unsigned short*)(ws + WS_IDX); const unsigned char* wp8 = ws + WS_WPEER; const float* wsc = (const float*)(ws + WS_WPEER + 8 * MiB); float* ssp = (float*)(ws + WS_SS);
    unsigned* ctr = (unsigned*)(ws + WS_CTL) + 2048;
    LAS unsigned* eoff = (LAS unsigned*)((ldsp_t)lds_raw_ + __builtin_amdgcn_readfirstlane((int)(threadIdx.x >> 6)) * 16384);
    LAS unsigned* w8l = eoff + P8_CHUNK * 128;
    const unsigned cc16 = (unsigned)cc * 16u;
    const unsigned xs = my_xcc();
#pragma unroll 1
    for (int k8 = 0; k8 < 8; ++k8) {
        const int sl = (int)((xs + k8) & 7u);
#pragma unroll 1
        for (;;) {
            unsigned tk = 0; if (lane == 0) tk = atomicAdd(ctr + 64 * sl, 1u);
            const int chunk = (int)__builtin_amdgcn_readfirstlane(tk);
            if (chunk >= P8_NCHUNK) break;
            const size_t tok0 = (size_t)chunk * P8_CHUNK;
#pragma unroll
            for (int i = 0; i < 4; ++i) { const i32x4 w = ((const i32x4*)(idx + tok0 * 128))[i * 64 + lane];
                i32x4 lo, hi2; lo.x = (w.x & 0xffff) << 7; lo.y = (int)((unsigned)w.x >> 16) << 7; lo.z = (w.y & 0xffff) << 7; lo.w = (int)((unsigned)w.y >> 16) << 7;
                hi2.x = (w.z & 0xffff) << 7; hi2.y = (int)((unsigned)w.z >> 16) << 7; hi2.z = (w.w & 0xffff) << 7; hi2.w = (int)((unsigned)w.w >> 16) << 7;
                ((LAS i32x4*)eoff)[(i * 64 + lane) * 2] = lo; ((LAS i32x4*)eoff)[(i * 64 + lane) * 2 + 1] = hi2; }
            const unsigned char* tvs = tvv + (size_t)sl * (16384 * 128);
#pragma unroll
            for (int i = 0; i < 2; ++i) ((LAS i32x4*)w8l)[i * 64 + lane] = ((const i32x4*)(wp8 + tok0 * 128))[i * 64 + lane];
            __builtin_amdgcn_wave_barrier();
#pragma unroll 1
            for (int grp = 0; grp < P8_CHUNK / 8; ++grp) {
                const int tl = grp * 8 + pp; const size_t tok = tok0 + tl;
                HalfB X, Y;
                const float wscale = wsc[tok];
                p8b_issue(X, tvs, eoff, w8l, tl, 0, cc16);
                const float* xo = p.out + tok * D + sl * 128 + cc * 16;
                f32x4 xv[4];
#pragma unroll
                for (int i = 0; i < 4; ++i) xv[i] = *(const f32x4*)(xo + 4 * i);
                int acc[16];
#pragma unroll
                for (int i = 0; i < 16; ++i) acc[i] = 0;
#pragma unroll 1
                for (int step = 0; step < 16; step += 2) {
                    p8b_issue(Y, tvs, eoff, w8l, tl, step + 1, cc16);
                    p8b_compute(X, acc);
                    if (step + 2 < 16) p8b_issue(X, tvs, eoff, w8l, tl, step + 2, cc16);
                    p8b_compute(Y, acc);
                }
                float v[16]; float ss = 0.f;
#pragma unroll
                for (int i = 0; i < 4; ++i) { v[4 * i] = __builtin_fmaf((float)acc[4 * i], wscale, xv[i].x); v[4 * i + 1] = __builtin_fmaf((float)acc[4 * i + 1], wscale, xv[i].y); v[4 * i + 2] = __builtin_fmaf((float)acc[4 * i + 2], wscale, xv[i].z); v[4 * i + 3] = __builtin_fmaf((float)acc[4 * i + 3], wscale, xv[i].w); }
#pragma unroll
                for (int i = 0; i < 16; ++i) ss += v[i] * v[i];
                u32x4 o0, o1;
                o0.x = pk2(v[0], v[1]); o0.y = pk2(v[2], v[3]); o0.z = pk2(v[4], v[5]); o0.w = pk2(v[6], v[7]); o1.x = pk2(v[8], v[9]); o1.y = pk2(v[10], v[11]); o1.z = pk2(v[12], v[13]); o1.w = pk2(v[14], v[15]);
                bf16_t* x3 = (bf16_t*)(ws + WS_X3) + tok * D + sl * 128 + cc * 16;
                *(u32x4*)x3 = o0; *(u32x4*)(x3 + 8) = o1;
                ss += dpp_xor1(ss); ss += dpp_xor2(ss); ss += __shfl_xor(ss, 4);
                if (cc == 0) ssp[tok * 8 + sl] = ss;
            }
            __builtin_amdgcn_wave_barrier();
        }
    }
}
DI void phase8c(const Params& p) {
    unsigned char* ws = p.ws;
    const int lane = threadIdx.x & 63, wid = threadIdx.x >> 6;
    const int gwave = blockIdx.x * NWAVES + wid, nwaves = gridDim.x * NWAVES;
    const float* ssp = (const float*)(ws + WS_SS); const bf16_t* x3 = (const bf16_t*)(ws + WS_X3);
    f32x4 gg[4];
#pragma unroll
    for (int j = 0; j < 4; ++j) gg[j] = *(const f32x4*)(p.in[20] + (j >> 1) * 512 + lane * 8 + (j & 1) * 4);
    for (int tk = gwave; tk < NTOK; tk += 2 * nwaves) {
        const bool two = tk + nwaves < NTOK; const size_t tokA = (size_t)tk, tokB = (size_t)(two ? tk + nwaves : tk);
        const u32x4 a0 = *(const u32x4*)(x3 + tokA * D + lane * 8), a1 = *(const u32x4*)(x3 + tokA * D + 512 + lane * 8);
        const u32x4 b0 = *(const u32x4*)(x3 + tokB * D + lane * 8), b1 = *(const u32x4*)(x3 + tokB * D + 512 + lane * 8);
        const f32x4 sa0 = *(const f32x4*)(ssp + tokA * 8), sa1 = *(const f32x4*)(ssp + tokA * 8 + 4), sb0 = *(const f32x4*)(ssp + tokB * 8), sb1 = *(const f32x4*)(ssp + tokB * 8 + 4);
        const float rsa = 1.0f / sqrtf(((sa0.x + sa0.y) + (sa0.z + sa0.w) + (sa1.x + sa1.y) + (sa1.z + sa1.w)) * (1.0f / D) + RMS_EPS);
        const float rsb = 1.0f / sqrtf(((sb0.x + sb0.y) + (sb0.z + sb0.w) + (sb1.x + sb1.y) + (sb1.z + sb1.w)) * (1.0f / D) + RMS_EPS);
        float* oa = p.out + tokA * D + lane * 8; float* ob = p.out + tokB * D + lane * 8;
#define OUT8(O, W, RS, G0, G1) { f32x4 v0 = {bflo(W.x) * RS * G0.x, bfhi(W.x) * RS * G0.y, bflo(W.y) * RS * G0.z, bfhi(W.y) * RS * G0.w}; f32x4 v1 = {bflo(W.z) * RS * G1.x, bfhi(W.z) * RS * G1.y, bflo(W.w) * RS * G1.z, bfhi(W.w) * RS * G1.w}; *(f32x4*)(O) = v0; *(f32x4*)((O) + 4) = v1; }
        OUT8(oa, a0, rsa, gg[0], gg[1]) OUT8(oa + 512, a1, rsa, gg[2], gg[3])
        if (two) { OUT8(ob, b0, rsb, gg[0], gg[1]) OUT8(ob + 512, b1, rsb, gg[2], gg[3]) }
#undef OUT8
    }
}

#define XB_TMO      128
#define XB_XCNT(j)  (256  + 64 * (j))
#define XB_XSUB(j)  (1280 + 64 * (j))
#define XB_XGEN(j)  (2304 + 64 * (j))
#define XB_TOP      3328
#define XB_TOPGEN   3392
#define XCD_BAR_WORDS 3456
#define XB_SPIN_CAP (1u << 18)

__device__ __forceinline__ unsigned xb_ld(unsigned* p)              { return __hip_atomic_load(p, __ATOMIC_RELAXED, __HIP_MEMORY_SCOPE_AGENT); }
__device__ __forceinline__ unsigned xb_add(unsigned* p, unsigned v) { return __hip_atomic_fetch_add(p, v, __ATOMIC_RELAXED, __HIP_MEMORY_SCOPE_AGENT); }
__device__ __forceinline__ unsigned xb_xcc_id() { return (unsigned)__builtin_amdgcn_s_getreg((3 << 11) | 20) & 0xFu; }
#define XB_SPIN(cond, bar) do { unsigned _sp = 0; while (cond) { __builtin_amdgcn_s_sleep(1); \
    if ((++_sp & 255u) == 0u) { if (xb_ld(&(bar)[XB_TMO])) break; if (_sp > XB_SPIN_CAP) { atomicAdd(&(bar)[XB_TMO], 1u); break; } } } } while (0)

struct XcdBarrier {
    unsigned* bar; unsigned x;
    volatile unsigned* st;
};

__device__ __forceinline__ XcdBarrier xcd_barrier_post(unsigned* bar, volatile unsigned* st) {
    XcdBarrier b; b.bar = bar; b.x = xb_xcc_id(); b.st = st;
    if (threadIdx.x == 0) (void)xb_add(&bar[XB_XCNT(b.x)], 1u);
    return b;
}
__device__ __forceinline__ void xcd_barrier_complete(unsigned* bar, unsigned x, unsigned& nloc, unsigned& nx) {
    const unsigned G = gridDim.x * gridDim.y * gridDim.z;
    unsigned sum, cnt, mine, sp = 0u;
    for (;;) {
        sum = 0u; cnt = 0u; mine = 0u;
#pragma unroll
        for (unsigned j = 0; j < 16; ++j) { const unsigned c = xb_ld(&bar[XB_XCNT(j)]); sum += c; cnt += (c > 0u) ? 1u : 0u; mine = (j == x) ? c : mine; }
        if (sum == G) break;
        __builtin_amdgcn_s_sleep(1);
        if ((++sp & 255u) == 0u) { if (xb_ld(&bar[XB_TMO])) break; if (sp > XB_SPIN_CAP) { atomicAdd(&bar[XB_TMO], 1u); break; } }
    }
    nloc = mine > 0u ? mine : 1u; nx = cnt > 0u ? cnt : 1u;
}

__device__ __forceinline__ void xcd_barrier(const XcdBarrier& b) {
    asm volatile("s_waitcnt vmcnt(0)" ::: "memory");
    __syncthreads();
    if (threadIdx.x == 0) {
        unsigned* bar = b.bar;
        __builtin_amdgcn_s_waitcnt(0);
        unsigned nloc = b.st[0], nx = b.st[1];
        if (nloc == 0u) { xcd_barrier_complete(bar, b.x, nloc, nx); b.st[0] = nloc; b.st[1] = nx; }
        const unsigned old = xb_add(&bar[XB_XSUB(b.x)], 1u);
        const unsigned gen = old / nloc;
        if (old + 1u == (gen + 1u) * nloc) {
            __builtin_amdgcn_fence(__ATOMIC_RELEASE, "agent");
            asm volatile("s_waitcnt vmcnt(0)" ::: "memory");
            const unsigned og = xb_add(&bar[XB_TOP], 1u);
            const unsigned tg = og / nx;
            if (og + 1u == (tg + 1u) * nx) xb_add(&bar[XB_TOPGEN], 1u);
            else XB_SPIN(xb_ld(&bar[XB_TOPGEN]) == tg, bar);
            __builtin_amdgcn_fence(__ATOMIC_ACQUIRE, "agent");
            xb_add(&bar[XB_XGEN(b.x)], 1u);
            asm volatile("s_waitcnt vmcnt(0)" ::: "memory");
        } else {
            XB_SPIN(xb_ld(&bar[XB_XGEN(b.x)]) == gen, bar);
            __builtin_amdgcn_fence(__ATOMIC_ACQUIRE, "agent");
            asm volatile("s_waitcnt vmcnt(0)" ::: "memory");
        }
    }
    __syncthreads();
}

constexpr int N_PHASES = 13;
__global__ void __launch_bounds__(NTHREADS) mega(Params p) {
    extern __shared__ __attribute__((aligned(16))) unsigned char lds_raw[];
    bf16_t* lds = (bf16_t*)lds_raw;
#if N_LAUNCH_MODE == 1
    cg::grid_group grid = cg::this_grid();
    XcdBarrier xbar = xcd_barrier_post((unsigned*)(p.ws + WS_CTL) + 4096, (volatile unsigned*)(p.ws + WS_CTL) + 12288 + 2 * blockIdx.x);
    if (p.ph_lo == 0x7fffffff) grid.sync();
#define SEAM(k) do { if (p.ph_lo <= (k) && (k) + 1 < p.ph_hi) { xcd_barrier(xbar); } } while (0)
#else
#define SEAM(k) do { } while (0)
#endif
#ifndef PHASE_MASK
#define PHASE_MASK 0x1fff
#endif
#define IN(k) (((PHASE_MASK >> (k)) & 1) && p.ph_lo <= (k) && (k) < p.ph_hi)
    if (IN(0)) for (int rep = 0; rep < REP0; ++rep) phase0(p, lds_raw);
    SEAM(0);
    if (IN(1)) for (int rep = 0; rep < REP1; ++rep) phase1(p, lds);
    SEAM(1);
    if (IN(2)) for (int rep = 0; rep < REP2; ++rep) phase2(p, lds);
    SEAM(2);
    if (IN(3)) for (int rep = 0; rep < REP3; ++rep) phase3a(p, rep, lds);
    SEAM(3);
    if (IN(4)) for (int rep = 0; rep < REP4; ++rep) phase3b(p, rep, lds_raw);
    SEAM(4);
    if (IN(5)) for (int rep = 0; rep < REP5; ++rep) phase4(p, lds);
    SEAM(5);
    if (IN(6)) for (int rep = 0; rep < REP6; ++rep) phase5(p, lds);
    SEAM(6);
    if (IN(7)) for (int rep = 0; rep < REP7; ++rep) phase6(p, lds);
    SEAM(7);
    if (IN(8)) for (int rep = 0; rep < REP8; ++rep) { __syncthreads(); phase7(p, lds); }
    SEAM(8);
    if (IN(9)) for (int rep = 0; rep < REP9; ++rep) phase8a(p, lds_raw, rep);
    SEAM(9);
    if (IN(10)) for (int rep = 0; rep < REP10; ++rep) phase8w(p, lds_raw);
    SEAM(10);
    if (IN(11)) phase8b(p, lds_raw);
    SEAM(11);
    if (IN(12)) phase8c(p);
}

extern "C" void kernel_launch(void* const* d_in, const int* in_sizes, int n_in, void* d_out, int out_size, void* d_ws, size_t ws_size, hipStream_t stream) {
    static int grid = 0;
    if (grid == 0) {
        if (n_in != 21 || out_size != NTOK * D || ws_size < WS_END) { fprintf(stderr, "kernel_launch: unexpected shapes: n_in %d out %d ws %zu\n", n_in, out_size, ws_size); grid = -1; return; }
        int dev = 0, cus = 0, per_cu = 0;
        hipGetDevice(&dev);
        hipDeviceGetAttribute(&cus, hipDeviceAttributeMultiprocessorCount, dev);
        hipFuncSetAttribute((const void*)mega, hipFuncAttributeMaxDynamicSharedMemorySize, LDS_BYTES);
        hipOccupancyMaxActiveBlocksPerMultiprocessor(&per_cu, (const void*)mega, NTHREADS, LDS_BYTES);
        if (per_cu < 1) per_cu = 1;
        if (per_cu > 1) per_cu = 1;
        grid = cus * per_cu;
    }
    if (grid < 0) return;
    hipMemsetAsync((char*)d_ws + WS_CTL, 0, 65536, stream);
    Params p{};
    for (int i = 0; i < 21; ++i) p.in[i] = (const float*)d_in[i];
    p.out = (float*)d_out; p.ws = (unsigned char*)d_ws;
#if N_LAUNCH_MODE == 1
    p.ph_lo = 0; p.ph_hi = N_PHASES;
    void* args[] = {&p};
    hipError_t e = hipLaunchCooperativeKernel((const void*)mega, dim3(grid), dim3(NTHREADS), args, LDS_BYTES, stream);
    if (e != hipSuccess) fprintf(stderr, "cooperative launch failed: %s (grid %d)\n", hipGetErrorString(e), grid);
#else
    for (int ph = 0; ph < N_PHASES; ++ph) { p.ph_lo = ph; p.ph_hi = ph + 1; hipLaunchKernelGGL(mega, dim3(grid), dim3(NTHREADS), LDS_BYTES, stream, p); }
#endif
}
```
